# Optimizing an MI355X kernel written in HIP

```python
import numpy as np
import jax
import jax.numpy as jnp
from jax import lax


D_MODEL = 1024
BATCH = 4
SEQ = 4096
DEPTH = 2

PLE_DIM = 256
N_HEADS = 16
HEAD_DIM = 64
ATT_DIM = N_HEADS * HEAD_DIM
NSA_KV_HEADS = 4
NSA_KV_DIM = NSA_KV_HEADS * HEAD_DIM
CMP_BLOCK = 32
CMP_STRIDE = 16
CMP_HIDDEN = 256
SEL_BLOCK = 64
SEL_TOPN = 16
WINDOW = 512
NSA_Q_BLOCK = 64
NSA_PROJ = ATT_DIM + 6 * NSA_KV_DIM + 3 * N_HEADS
MOBA_KV_HEADS = 4
MOBA_KV_DIM = MOBA_KV_HEADS * HEAD_DIM
MOBA_BLOCK = 256
MOBA_TOPK = 3
MOBA_Q_BLOCK = 16
N_GROUPS = 4
EXPERTS_PER_GROUP = 8
N_EXPERTS = N_GROUPS * EXPERTS_PER_GROUP
TOPK_IN_GROUP = 2
D_EXPERT = 128
NORM_EPS = 1e-6
FORCED_SCORE = 1e9

kernel_name = 'hybrid_nsa_moba_yoco_hmoe'


def rms_norm(x, g):
    xf = x.astype(jnp.float32)
    y = xf * lax.rsqrt(jnp.mean(xf * xf, axis=-1, keepdims=True) + NORM_EPS)
    return (y * g.astype(jnp.float32)).astype(x.dtype)


def to_heads(t, n_heads):
    b, s = t.shape[0], t.shape[1]
    return t.reshape(b, s, n_heads, HEAD_DIM).transpose(0, 2, 1, 3)


def alibi_slopes(n_heads):
    return jnp.asarray(2.0 ** (-8.0 * np.arange(1, n_heads + 1) / n_heads), dtype=jnp.float32)


def masked_softmax(s, mask, axis=-1):
    s = jnp.where(mask, s, -jnp.inf)
    m = jnp.max(s, axis=axis, keepdims=True)
    m = jnp.where(jnp.isfinite(m), m, 0.0)
    e = jnp.exp(s - m)
    return e / jnp.maximum(jnp.sum(e, axis=axis, keepdims=True), 1e-30)


def compress_blocks(k, pos, w1, w2):
    b, g, s, d = k.shape
    n_cmp = (s - CMP_BLOCK) // CMP_STRIDE + 1
    idx = np.arange(n_cmp)[:, None] * CMP_STRIDE + np.arange(CMP_BLOCK)[None, :]
    blk = (k[:, :, idx] + pos).reshape(b, g, n_cmp, CMP_BLOCK * d)
    return jax.nn.gelu(blk @ w1) @ w2


def cmp_sel_overlap(n_cmp, n_sel):
    c0 = np.arange(n_cmp)[:, None] * CMP_STRIDE
    s0 = np.arange(n_sel)[None, :] * SEL_BLOCK
    ov = np.clip(np.minimum(c0 + CMP_BLOCK, s0 + SEL_BLOCK) - np.maximum(c0, s0), 0, None)
    return jnp.asarray(ov / CMP_BLOCK, dtype=jnp.float32)


def nsa_attention(xn, w_in, q_gain, k_gain, ck_pos, ck_w1, ck_w2, cv_pos, cv_w1, cv_w2, w_out):
    b, s, _ = xn.shape
    g, r = NSA_KV_HEADS, N_HEADS // NSA_KV_HEADS
    splits = np.cumsum([ATT_DIM] + [NSA_KV_DIM] * 6).tolist()
    q, kc, vc, ks, vs, kw, vw, gl = jnp.split(xn @ w_in, splits, axis=-1)
    q = (rms_norm(to_heads(q, N_HEADS), q_gain) * HEAD_DIM ** -0.5).reshape(b, g, r, s, HEAD_DIM)
    kc = rms_norm(compress_blocks(to_heads(kc, g), ck_pos, ck_w1, ck_w2), k_gain[0])
    vc = compress_blocks(to_heads(vc, g), cv_pos, cv_w1, cv_w2)
    n_cmp = kc.shape[2]
    n_sel = s // SEL_BLOCK
    n_top = min(SEL_TOPN, n_sel)
    ks = rms_norm(to_heads(ks, g), k_gain[1]).reshape(b, g, n_sel, SEL_BLOCK, HEAD_DIM)
    vs = to_heads(vs, g).reshape(b, g, n_sel, SEL_BLOCK, HEAD_DIM)
    pad = ((0, 0), (0, 0), (WINDOW, 0), (0, 0))
    kw = jnp.pad(rms_norm(to_heads(kw, g), k_gain[2]), pad)
    vw = jnp.pad(to_heads(vw, g), pad)
    gates = jax.nn.sigmoid(gl).reshape(b, s, N_HEADS, 3).transpose(0, 2, 1, 3).reshape(b, g, r, s, 3)
    slopes = alibi_slopes(N_HEADS).reshape(1, g, r, 1, 1)
    cmp_end = jnp.arange(n_cmp) * CMP_STRIDE + (CMP_BLOCK - 1)
    overlap = cmp_sel_overlap(n_cmp, n_sel)
    blk_ids = jnp.arange(n_sel)
    bi = jnp.arange(b)[:, None, None, None]
    gi = jnp.arange(g)[None, :, None, None]

    def query_block(c):
        start = c * NSA_Q_BLOCK
        t = start + jnp.arange(NSA_Q_BLOCK)
        qc = lax.dynamic_slice_in_dim(q, start, NSA_Q_BLOCK, axis=3)
        gc = lax.dynamic_slice_in_dim(gates, start, NSA_Q_BLOCK, axis=3)
        dist_c = (t[:, None] - cmp_end[None, :]).astype(jnp.float32)
        s_c = jnp.einsum('bgrqd,bgnd->bgrqn', qc, kc).astype(jnp.float32) - slopes * dist_c
        p_c = masked_softmax(s_c, dist_c >= 0)
        o_c = jnp.einsum('bgrqn,bgnd->bgrqd', p_c.astype(vc.dtype), vc)
        imp = jnp.einsum('bgrqn,nj->bgqj', p_c, overlap)
        cur = (t // SEL_BLOCK)[:, None]
        forced = (blk_ids == 0) | (blk_ids == cur) | (blk_ids == cur - 1)
        imp = jnp.where(blk_ids <= cur, jnp.where(forced, FORCED_SCORE, imp), -jnp.inf)
        _, sel = lax.top_k(imp, n_top)
        k_g = ks[bi, gi, sel]
        v_g = vs[bi, gi, sel]
        pos = sel[..., None] * SEL_BLOCK + jnp.arange(SEL_BLOCK)
        dist_s = (t[:, None, None] - pos)[:, :, None].astype(jnp.float32)
        s_s = jnp.einsum('bgrqd,bgqnld->bgrqnl', qc, k_g).astype(jnp.float32) - slopes[..., None] * dist_s
        p_s = masked_softmax(s_s, dist_s >= 0, axis=(-2, -1))
        o_s = jnp.einsum('bgrqnl,bgqnld->bgrqd', p_s.astype(v_g.dtype), v_g)
        kwc = lax.dynamic_slice_in_dim(kw, start, NSA_Q_BLOCK + WINDOW, axis=2)
        vwc = lax.dynamic_slice_in_dim(vw, start, NSA_Q_BLOCK + WINDOW, axis=2)
        kp = start - WINDOW + jnp.arange(NSA_Q_BLOCK + WINDOW)
        dist_w = t[:, None] - kp[None, :]
        s_w = jnp.einsum('bgrqd,bgkd->bgrqk', qc, kwc).astype(jnp.float32) - slopes * dist_w.astype(jnp.float32)
        p_w = masked_softmax(s_w, (dist_w >= 0) & (dist_w < WINDOW) & (kp[None, :] >= 0))
        o_w = jnp.einsum('bgrqk,bgkd->bgrqd', p_w.astype(vwc.dtype), vwc)
        o = gc[..., 0:1] * o_c + gc[..., 1:2] * o_s + gc[..., 2:3] * o_w
        return o.transpose(0, 3, 1, 2, 4).reshape(b, NSA_Q_BLOCK, ATT_DIM)

    o = lax.map(query_block, jnp.arange(s // NSA_Q_BLOCK))
    o = o.transpose(1, 0, 2, 3).reshape(b, s, ATT_DIM)
    return o @ w_out


def shared_kv(h, kv_norm, w_kv, k_gain):
    b, s, _ = h.shape
    k, v = jnp.split(rms_norm(h, kv_norm) @ w_kv, 2, axis=-1)
    k = rms_norm(to_heads(k, MOBA_KV_HEADS), k_gain)
    v = to_heads(v, MOBA_KV_HEADS)
    nb = -(-s // MOBA_BLOCK)
    pad = ((0, 0), (0, 0), (0, nb * MOBA_BLOCK - s), (0, 0))
    kb = jnp.pad(k, pad).reshape(b, MOBA_KV_HEADS, nb, MOBA_BLOCK, HEAD_DIM)
    vb = jnp.pad(v, pad).reshape(b, MOBA_KV_HEADS, nb, MOBA_BLOCK, HEAD_DIM)
    km = jnp.mean(kb.astype(jnp.float32), axis=3).astype(kb.dtype)
    return kb, vb, km


def moba_attention(xn, kb, vb, km, w_q, q_gain, w_out):
    b, s, _ = xn.shape
    g, r = MOBA_KV_HEADS, N_HEADS // MOBA_KV_HEADS
    q = (rms_norm(to_heads(xn @ w_q, N_HEADS), q_gain) * HEAD_DIM ** -0.5).reshape(b, g, r, s, HEAD_DIM)
    nb = kb.shape[2]
    ktop = min(MOBA_TOPK, nb)
    slopes = alibi_slopes(N_HEADS).reshape(1, g, r, 1, 1)
    bi = jnp.arange(b)[:, None, None, None, None]
    gi = jnp.arange(g)[None, :, None, None, None]
    blk_ids = jnp.arange(nb)
    offs = jnp.arange(MOBA_BLOCK)

    def query_block(c):
        start = c * MOBA_Q_BLOCK
        t = start + jnp.arange(MOBA_Q_BLOCK)
        cb = start // MOBA_BLOCK
        qc = lax.dynamic_slice_in_dim(q, start, MOBA_Q_BLOCK, axis=3)
        sg = jnp.einsum('bgrqd,bgnd->bgrqn', qc, km).astype(jnp.float32)
        sg = jnp.where(blk_ids < cb, sg, -jnp.inf)
        _, idx = lax.top_k(sg, ktop)
        k_g = kb[bi, gi, idx]
        v_g = vb[bi, gi, idx]
        pos = idx[..., None] * MOBA_BLOCK + offs
        dist = (t[:, None, None] - pos).astype(jnp.float32)
        s_sel = jnp.einsum('bgrqd,bgrqkld->bgrqkl', qc, k_g).astype(jnp.float32)
        s_sel = jnp.where((idx < cb)[..., None], s_sel - slopes[..., None] * dist, -jnp.inf)
        ko = lax.dynamic_index_in_dim(kb, cb, axis=2, keepdims=False)
        vo = lax.dynamic_index_in_dim(vb, cb, axis=2, keepdims=False)
        dist_o = t[:, None] - (cb * MOBA_BLOCK + offs)[None, :]
        s_own = jnp.einsum('bgrqd,bgld->bgrql', qc, ko).astype(jnp.float32)
        s_own = jnp.where(dist_o >= 0, s_own - slopes * dist_o.astype(jnp.float32), -jnp.inf)
        n_sel_keys = ktop * MOBA_BLOCK
        sc = jnp.concatenate([s_sel.reshape(b, g, r, MOBA_Q_BLOCK, n_sel_keys), s_own], axis=-1)
        pr = jax.nn.softmax(sc, axis=-1)
        p_sel = pr[..., :n_sel_keys].reshape(s_sel.shape).astype(vb.dtype)
        p_own = pr[..., n_sel_keys:].astype(vb.dtype)
        o = (jnp.einsum('bgrqkl,bgrqkld->bgrqd', p_sel, v_g)
             + jnp.einsum('bgrql,bgld->bgrqd', p_own, vo))
        return o.transpose(0, 3, 1, 2, 4).reshape(b, MOBA_Q_BLOCK, ATT_DIM)

    o = lax.map(query_block, jnp.arange(s // MOBA_Q_BLOCK))
    o = o.transpose(1, 0, 2, 3).reshape(b, s, ATT_DIM)
    return o @ w_out


def hier_moe(xn, w_group, b_group, w_expert, b_expert, w_gate, w_up, w_down):
    b, s, d = xn.shape
    xt = xn.reshape(b * s, d)
    g_prob = jax.nn.softmax((xt @ w_group + b_group).astype(jnp.float32), axis=-1)
    g_w, g_idx = lax.top_k(g_prob, 1)
    e_logits = (xt @ w_expert + b_expert).astype(jnp.float32).reshape(-1, N_GROUPS, EXPERTS_PER_GROUP)
    e_logits = jnp.einsum('tge,tg->te', e_logits, jax.nn.one_hot(g_idx[:, 0], N_GROUPS, dtype=jnp.float32))
    e_prob = jax.nn.softmax(e_logits, axis=-1)
    e_w, e_idx = lax.top_k(e_prob, TOPK_IN_GROUP)
    e_w = e_w / jnp.sum(e_w, axis=-1, keepdims=True)
    comb = g_w * e_w
    expert_id = g_idx * EXPERTS_PER_GROUP + e_idx
    cw = jnp.einsum('tk,tke->te', comb, jax.nn.one_hot(expert_id, N_EXPERTS, dtype=jnp.float32)).astype(xt.dtype)
    hid = jax.nn.silu(jnp.einsum('td,edf->tef', xt, w_gate)) * jnp.einsum('td,edf->tef', xt, w_up)
    y = jnp.einsum('tef,efd->td', hid * cw[:, :, None], w_down)
    return y.reshape(b, s, d)


def setup_inputs(seed: int = 0) -> dict:
    key = jax.random.key(seed)
    keys = iter(jax.random.split(key, 40))

    def nrm(shape, scale):
        return jax.random.normal(next(keys), shape, jnp.float32) * scale

    def gain(shape):
        return 1.0 + 0.05 * jax.random.normal(next(keys), shape, jnp.float32)

    n_a = (DEPTH + 1) // 2
    n_b = DEPTH - n_a
    cmp_in = CMP_BLOCK * HEAD_DIM
    return {
        'x': nrm((BATCH, SEQ, D_MODEL), 1.0),
        'p': nrm((DEPTH, BATCH, SEQ, PLE_DIM), 1.0),
        'ln_mix': gain((DEPTH, D_MODEL)),
        'ln_ffn': gain((DEPTH, D_MODEL)),
        'ln_ple': gain((DEPTH, D_MODEL)),
        'a_w_in': nrm((n_a, D_MODEL, NSA_PROJ), D_MODEL ** -0.5),
        'a_q_norm': gain((n_a, HEAD_DIM)),
        'a_k_norm': gain((n_a, 3, HEAD_DIM)),
        'a_ck_pos': nrm((n_a, CMP_BLOCK, HEAD_DIM), 0.1),
        'a_ck_w1': nrm((n_a, cmp_in, CMP_HIDDEN), cmp_in ** -0.5),
        'a_ck_w2': nrm((n_a, CMP_HIDDEN, HEAD_DIM), CMP_HIDDEN ** -0.5),
        'a_cv_pos': nrm((n_a, CMP_BLOCK, HEAD_DIM), 0.1),
        'a_cv_w1': nrm((n_a, cmp_in, CMP_HIDDEN), cmp_in ** -0.5),
        'a_cv_w2': nrm((n_a, CMP_HIDDEN, HEAD_DIM), CMP_HIDDEN ** -0.5),
        'a_w_out': nrm((n_a, ATT_DIM, D_MODEL), ATT_DIM ** -0.5),
        'kv_norm': gain((D_MODEL,)),
        'w_kv_shared': nrm((D_MODEL, 2 * MOBA_KV_DIM), D_MODEL ** -0.5),
        'k_norm_shared': gain((HEAD_DIM,)),
        'b_w_q': nrm((n_b, D_MODEL, ATT_DIM), D_MODEL ** -0.5),
        'b_q_norm': gain((n_b, HEAD_DIM)),
        'b_w_out': nrm((n_b, ATT_DIM, D_MODEL), ATT_DIM ** -0.5),
        'moe_w_group': nrm((DEPTH, D_MODEL, N_GROUPS), D_MODEL ** -0.5),
        'moe_b_group': nrm((DEPTH, N_GROUPS), 0.01),
        'moe_w_expert': nrm((DEPTH, D_MODEL, N_EXPERTS), D_MODEL ** -0.5),
        'moe_b_expert': nrm((DEPTH, N_EXPERTS), 0.01),
        'moe_w_gate': nrm((DEPTH, N_EXPERTS, D_MODEL, D_EXPERT), D_MODEL ** -0.5),
        'moe_w_up': nrm((DEPTH, N_EXPERTS, D_MODEL, D_EXPERT), D_MODEL ** -0.5),
        'moe_w_down': nrm((DEPTH, N_EXPERTS, D_EXPERT, D_MODEL), D_EXPERT ** -0.5),
        'ple_w_proj': nrm((DEPTH, PLE_DIM, D_MODEL), PLE_DIM ** -0.5),
        'ple_w_gate': nrm((DEPTH, D_MODEL, D_MODEL), D_MODEL ** -0.5),
    }


def reference(x, p, ln_mix, ln_ffn, ln_ple, a_w_in, a_q_norm, a_k_norm, a_ck_pos, a_ck_w1, a_ck_w2,
              a_cv_pos, a_cv_w1, a_cv_w2, a_w_out, kv_norm, w_kv_shared, k_norm_shared, b_w_q, b_q_norm,
              b_w_out, moe_w_group, moe_b_group, moe_w_expert, moe_b_expert, moe_w_gate, moe_w_up,
              moe_w_down, ple_w_proj, ple_w_gate):
    n_a = (DEPTH + 1) // 2
    h = x
    kb = vb = km = None
    for i in range(DEPTH):
        xn = rms_norm(h, ln_mix[i])
        if i < n_a:
            mix = nsa_attention(xn, a_w_in[i], a_q_norm[i], a_k_norm[i], a_ck_pos[i], a_ck_w1[i], a_ck_w2[i],
                                a_cv_pos[i], a_cv_w1[i], a_cv_w2[i], a_w_out[i])
        else:
            if i == n_a:
                kb, vb, km = shared_kv(h, kv_norm, w_kv_shared, k_norm_shared)
            j = i - n_a
            mix = moba_attention(xn, kb, vb, km, b_w_q[j], b_q_norm[j], b_w_out[j])
        h = h + mix.astype(h.dtype)
        h = h + hier_moe(rms_norm(h, ln_ffn[i]), moe_w_group[i], moe_b_group[i], moe_w_expert[i],
                         moe_b_expert[i], moe_w_gate[i], moe_w_up[i], moe_w_down[i]).astype(h.dtype)
        gate = jax.nn.sigmoid(rms_norm(h, ln_ple[i]) @ ple_w_gate[i])
        h = h + (gate * (p[i] @ ple_w_proj[i])).astype(h.dtype)
    return h
```

```cpp
#include <hip/hip_runtime.h>
#include <stdint.h>
#include <math.h>

#define SEQ 4096
#define BATCH 4
#define TTOK 16384
#define DM 1024
#define NPROJ 2608
#define NCMP 255

#define C_Q 0
#define C_KC 1024
#define C_VC 1280
#define C_KS 1536
#define C_VS 1792
#define C_KW 2048
#define C_VW 2304
#define C_GL 2560

__device__ __forceinline__ float wave_sum(float v) {
#pragma unroll
    for (int o = 32; o > 0; o >>= 1) v += __shfl_xor(v, o);
    return v;
}
__device__ __forceinline__ float gelu_tanh(float x) {
    const float c = 0.7978845608028654f;
    float u = c * (x + 0.044715f * x * x * x);
    return 0.5f * x * (1.f + tanhf(u));
}
__device__ __forceinline__ float sigm(float x) { return 1.f / (1.f + expf(-x)); }

__global__ void __launch_bounds__(256) k_rmsnorm(const float* __restrict__ in, const float* __restrict__ gain, float* __restrict__ out) {
    int row = blockIdx.x * 4 + (threadIdx.x >> 6), lane = threadIdx.x & 63;
    const float4* p = (const float4*)(in + (size_t)row * DM);
    const float4* g4 = (const float4*)gain;
    float4 v[4]; float ss = 0.f;
#pragma unroll
    for (int i = 0; i < 4; ++i) { v[i] = p[lane + 64 * i]; ss += v[i].x * v[i].x + v[i].y * v[i].y + v[i].z * v[i].z + v[i].w * v[i].w; }
    ss = wave_sum(ss);
    float r = rsqrtf(ss * (1.f / DM) + 1e-6f);
    float4* o = (float4*)(out + (size_t)row * DM);
#pragma unroll
    for (int i = 0; i < 4; ++i) { float4 g = g4[lane + 64 * i]; float4 w; w.x = v[i].x * r * g.x; w.y = v[i].y * r * g.y; w.z = v[i].z * r * g.z; w.w = v[i].w * r * g.w; o[lane + 64 * i] = w; }
}
__global__ void __launch_bounds__(256) k_combine_rmsnorm(float* __restrict__ h, const float* __restrict__ ys, const float* __restrict__ gain, float* __restrict__ out) {
    int row = blockIdx.x * 4 + (threadIdx.x >> 6), lane = threadIdx.x & 63;
    float4* p = (float4*)(h + (size_t)row * DM);
    const float4* y0 = (const float4*)(ys + (size_t)row * 2 * DM);
    const float4* y1 = y0 + DM / 4;
    const float4* g4 = (const float4*)gain;
    float4 v[4]; float ss = 0.f;
#pragma unroll
    for (int i = 0; i < 4; ++i) {
        float4 a = p[lane + 64 * i], b = y0[lane + 64 * i], c = y1[lane + 64 * i];
        a.x += b.x + c.x; a.y += b.y + c.y; a.z += b.z + c.z; a.w += b.w + c.w;
        v[i] = a; p[lane + 64 * i] = a;
        ss += a.x * a.x + a.y * a.y + a.z * a.z + a.w * a.w;
    }
    ss = wave_sum(ss);
    float r = rsqrtf(ss * (1.f / DM) + 1e-6f);
    float4* o = (float4*)(out + (size_t)row * DM);
#pragma unroll
    for (int i = 0; i < 4; ++i) { float4 g = g4[lane + 64 * i]; float4 w; w.x = v[i].x * r * g.x; w.y = v[i].y * r * g.y; w.z = v[i].z * r * g.z; w.w = v[i].w * r * g.w; o[lane + 64 * i] = w; }
}

struct EpiStore { float* C; long long ldc; __device__ void operator()(int r, int c, float v) const { C[(size_t)r * ldc + c] = v; } };
struct EpiGelu { float* C; long long ldc; __device__ void operator()(int r, int c, float v) const { C[(size_t)r * ldc + c] = gelu_tanh(v); } };
struct EpiSigm { float* C; long long ldc; __device__ void operator()(int r, int c, float v) const { C[(size_t)r * ldc + c] = sigm(v); } };
struct EpiResid { const float* R; float* C; long long ldc; __device__ void operator()(int r, int c, float v) const { C[(size_t)r * ldc + c] = R[(size_t)r * ldc + c] + v; } };
struct EpiPle { const float* G; float* H; long long ldc; __device__ void operator()(int r, int c, float v) const { H[(size_t)r * ldc + c] += G[(size_t)r * ldc + c] * v; } };

template <class Epi>
__global__ void __launch_bounds__(256) k_gemm(const float* __restrict__ A, const float* __restrict__ W, long long lda, long long ldw, int M, int N, int K, int pad_, Epi epi) {
    __shared__ float As[16][68];
    __shared__ float Ws[16][68];
    const int tid = threadIdx.x, tx = tid & 15, ty = tid >> 4;
    const int m0 = blockIdx.y * 64, n0 = blockIdx.x * 64;
    float acc[4][4];
#pragma unroll
    for (int i = 0; i < 4; ++i)
#pragma unroll
        for (int j = 0; j < 4; ++j) acc[i][j] = 0.f;
    const int ar = tid >> 2, ak = (tid & 3) * 4;
    const int wk = tid >> 4, wc = (tid & 15) * 4;
    for (int k0 = 0; k0 < K; k0 += 16) {
        float4 a = make_float4(0.f, 0.f, 0.f, 0.f), w = make_float4(0.f, 0.f, 0.f, 0.f);
        if (m0 + ar < M) a = *(const float4*)(A + (size_t)(m0 + ar) * lda + k0 + ak);
        if (n0 + wc < N) w = *(const float4*)(W + (size_t)(k0 + wk) * ldw + n0 + wc);
        __syncthreads();
        As[ak + 0][ar] = a.x; As[ak + 1][ar] = a.y; As[ak + 2][ar] = a.z; As[ak + 3][ar] = a.w;
        *(float4*)&Ws[wk][wc] = w;
        __syncthreads();
#pragma unroll
        for (int kk = 0; kk < 16; ++kk) {
            float4 av = *(const float4*)&As[kk][ty * 4];
            float4 wv = *(const float4*)&Ws[kk][tx * 4];
            float aa[4] = {av.x, av.y, av.z, av.w}, ww[4] = {wv.x, wv.y, wv.z, wv.w};
#pragma unroll
            for (int i = 0; i < 4; ++i)
#pragma unroll
                for (int j = 0; j < 4; ++j) acc[i][j] += aa[i] * ww[j];
        }
    }
#pragma unroll
    for (int i = 0; i < 4; ++i)
#pragma unroll
        for (int j = 0; j < 4; ++j) {
            int r = m0 + ty * 4 + i, c = n0 + tx * 4 + j;
            if (r < M && c < N) epi(r, c, acc[i][j]);
        }
}

__global__ void __launch_bounds__(256) k_nsa_post(float* __restrict__ proj, const float* __restrict__ qn, const float* __restrict__ kn) {
    int t = blockIdx.x, w = threadIdx.x >> 6, lane = threadIdx.x & 63;
    float* row = proj + (size_t)t * NPROJ;
    for (int s = w; s < 24; s += 4) {
        int col; const float* g; float sc = 1.f;
        if (s < 16) { col = C_Q + s * 64; g = qn; sc = 0.125f; }
        else if (s < 20) { col = C_KS + (s - 16) * 64; g = kn + 64; }
        else { col = C_KW + (s - 20) * 64; g = kn + 128; }
        float v = row[col + lane];
        float ss = wave_sum(v * v);
        row[col + lane] = v * rsqrtf(ss * (1.f / 64.f) + 1e-6f) * g[lane] * sc;
    }
    if (threadIdx.x < 48) row[C_GL + threadIdx.x] = sigm(row[C_GL + threadIdx.x]);
}

__global__ void __launch_bounds__(256) k_im2col(const float* __restrict__ proj, const float* __restrict__ pos, float* __restrict__ blk, int base, int pad_) {
    int rowi = blockIdx.x;
    int bg = rowi / NCMP, n = rowi % NCMP, b = bg >> 2, g = bg & 3;
    for (int e = threadIdx.x; e < 2048; e += 256) {
        int l = e >> 6, d = e & 63;
        blk[(size_t)rowi * 2048 + e] = proj[(size_t)(b * SEQ + 16 * n + l) * NPROJ + base + g * 64 + d] + pos[e];
    }
}
__global__ void __launch_bounds__(256) k_rms64(float* __restrict__ x, const float* __restrict__ g, int rows, int pad_) {
    int r = blockIdx.x * 4 + (threadIdx.x >> 6), lane = threadIdx.x & 63;
    if (r >= rows) return;
    float v = x[(size_t)r * 64 + lane];
    float ss = wave_sum(v * v);
    x[(size_t)r * 64 + lane] = v * rsqrtf(ss * (1.f / 64.f) + 1e-6f) * g[lane];
}

__global__ void __launch_bounds__(256) k_nsa_cmp(const float* __restrict__ proj, const float* __restrict__ kcc, const float* __restrict__ vcc,
                                                float* __restrict__ att, unsigned long long* __restrict__ selmask) {
    __shared__ float imp[64][65];
    __shared__ unsigned int mk[64][2];
    const int c = blockIdx.x, g = blockIdx.y, b = blockIdx.z;
    const int r = threadIdx.x >> 6, q = threadIdx.x & 63;
    const int h = g * 4 + r, t = c * 64 + q;
    const float slope = exp2f(-0.5f * (float)(h + 1));
    for (int e = threadIdx.x; e < 64 * 65; e += 256) (&imp[0][0])[e] = 0.f;
    if (threadIdx.x < 128) (&mk[0][0])[threadIdx.x] = 0u;
    const float* qrow = proj + (size_t)(b * SEQ + t) * NPROJ + C_Q + h * 64;
    float qv[64];
#pragma unroll
    for (int d = 0; d < 64; d += 4) { float4 x = *(const float4*)(qrow + d); qv[d] = x.x; qv[d + 1] = x.y; qv[d + 2] = x.z; qv[d + 3] = x.w; }
    const int nvalid = (t >= 31) ? ((t - 31) / 16 + 1) : 0;
    const int nmax = 4 * c + 3;
    const float* kb = kcc + (size_t)(b * 4 + g) * NCMP * 64;
    const float* vb = vcc + (size_t)(b * 4 + g) * NCMP * 64;
    float m = -INFINITY;
    for (int n = 0; n < nmax; ++n) {
        const float* kr = kb + n * 64;
        float dot = 0.f;
#pragma unroll
        for (int d = 0; d < 64; d += 4) { float4 x = *(const float4*)(kr + d); dot += qv[d] * x.x + qv[d + 1] * x.y + qv[d + 2] * x.z + qv[d + 3] * x.w; }
        float s = dot - slope * (float)(t - (16 * n + 31));
        if (n < nvalid) m = fmaxf(m, s);
    }
    float l = 0.f, o[64];
#pragma unroll
    for (int d = 0; d < 64; ++d) o[d] = 0.f;
    for (int n = 0; n < nmax; ++n) {
        const float* kr = kb + n * 64;
        float dot = 0.f;
#pragma unroll
        for (int d = 0; d < 64; d += 4) { float4 x = *(const float4*)(kr + d); dot += qv[d] * x.x + qv[d + 1] * x.y + qv[d + 2] * x.z + qv[d + 3] * x.w; }
        float s = dot - slope * (float)(t - (16 * n + 31));
        float p = (n < nvalid) ? expf(s - m) : 0.f;
        l += p;
        const float* vr = vb + n * 64;
#pragma unroll
        for (int d = 0; d < 64; d += 4) { float4 x = *(const float4*)(vr + d); o[d] += p * x.x; o[d + 1] += p * x.y; o[d + 2] += p * x.z; o[d + 3] += p * x.w; }
    }
    const float inv = (l > 0.f) ? 1.f / l : 0.f;
    {
        const float g0 = proj[(size_t)(b * SEQ + t) * NPROJ + C_GL + h * 3 + 0] * inv;
        float* orow = att + (size_t)(b * SEQ + t) * DM + h * 64;
#pragma unroll
        for (int d = 0; d < 64; d += 4) { float4 x; x.x = o[d] * g0; x.y = o[d + 1] * g0; x.z = o[d + 2] * g0; x.w = o[d + 3] * g0; *(float4*)(orow + d) = x; }
    }
    __syncthreads();
    for (int rr = 0; rr < 4; ++rr) {
        if (r == rr) {
            for (int n = 0; n < nmax; ++n) {
                const float* kr = kb + n * 64;
                float dot = 0.f;
#pragma unroll
                for (int d = 0; d < 64; d += 4) { float4 x = *(const float4*)(kr + d); dot += qv[d] * x.x + qv[d + 1] * x.y + qv[d + 2] * x.z + qv[d + 3] * x.w; }
                float s = dot - slope * (float)(t - (16 * n + 31));
                if (n < nvalid) {
                    float p = expf(s - m) * inv;
                    int j = n >> 2;
                    if ((n & 3) == 3) { imp[q][j] += 0.5f * p; imp[q][j + 1] += 0.5f * p; }
                    else imp[q][j] += p;
                }
            }
        }
        __syncthreads();
    }
    for (int idx = threadIdx.x; idx < 4096; idx += 256) {
        int qq = idx >> 6, j = idx & 63;
        if (j > c) continue;
        bool fj = (j == 0) || (j == c) || (j == c - 1);
        float vj = fj ? 1e9f : imp[qq][j];
        int rank = 0;
        for (int j2 = 0; j2 <= c; ++j2) {
            bool f2 = (j2 == 0) || (j2 == c) || (j2 == c - 1);
            float v2 = f2 ? 1e9f : imp[qq][j2];
            rank += (v2 > vj || (v2 == vj && j2 < j)) ? 1 : 0;
        }
        if (rank < 16) atomicOr(&mk[qq][j >> 5], 1u << (j & 31));
    }
    __syncthreads();
    if (threadIdx.x < 64) {
        unsigned long long mm = (unsigned long long)mk[threadIdx.x][0] | ((unsigned long long)mk[threadIdx.x][1] << 32);
        selmask[(size_t)(b * 4 + g) * SEQ + c * 64 + threadIdx.x] = mm;
    }
}

__global__ void __launch_bounds__(256) k_nsa_selwin(const float* __restrict__ proj, const unsigned long long* __restrict__ selmask, float* __restrict__ att) {
    const int h = blockIdx.y, b = blockIdx.z, g = h >> 2;
    const int t = blockIdx.x * 256 + threadIdx.x;
    const int c = t >> 6;
    const float slope = exp2f(-0.5f * (float)(h + 1));
    const float* qrow = proj + (size_t)(b * SEQ + t) * NPROJ + C_Q + h * 64;
    float qv[64];
#pragma unroll
    for (int d = 0; d < 64; d += 4) { float4 x = *(const float4*)(qrow + d); qv[d] = x.x; qv[d + 1] = x.y; qv[d + 2] = x.z; qv[d + 3] = x.w; }
    float res[64];
    {
        const unsigned long long mk = selmask[(size_t)(b * 4 + g) * SEQ + t];
        float m = -INFINITY, l = 0.f, o[64];
#pragma unroll
        for (int d = 0; d < 64; ++d) o[d] = 0.f;
        for (int j = 0; j <= c; ++j) {
            const bool bit = (mk >> j) & 1ull;
            if (__ballot(bit) == 0ull) continue;
            for (int li = 0; li < 64; ++li) {
                const int pos = j * 64 + li;
                const float* rowp = proj + (size_t)(b * SEQ + pos) * NPROJ;
                const float* kr = rowp + C_KS + g * 64;
                float dot = 0.f;
#pragma unroll
                for (int d = 0; d < 64; d += 4) { float4 x = *(const float4*)(kr + d); dot += qv[d] * x.x + qv[d + 1] * x.y + qv[d + 2] * x.z + qv[d + 3] * x.w; }
                const float s = dot - slope * (float)(t - pos);
                if (bit && pos <= t) {
                    if (s > m) { float a = expf(m - s); l *= a;
#pragma unroll
                        for (int d = 0; d < 64; ++d) o[d] *= a;
                        m = s; }
                    const float p = expf(s - m);
                    l += p;
                    const float* vr = rowp + C_VS + g * 64;
#pragma unroll
                    for (int d = 0; d < 64; d += 4) { float4 x = *(const float4*)(vr + d); o[d] += p * x.x; o[d + 1] += p * x.y; o[d + 2] += p * x.z; o[d + 3] += p * x.w; }
                }
            }
        }
        const float g1 = proj[(size_t)(b * SEQ + t) * NPROJ + C_GL + h * 3 + 1] / l;
#pragma unroll
        for (int d = 0; d < 64; ++d) res[d] = o[d] * g1;
    }
    {
        float m = -INFINITY, l = 0.f, o[64];
#pragma unroll
        for (int d = 0; d < 64; ++d) o[d] = 0.f;
        int k_lo = c * 64 - 511; if (k_lo < 0) k_lo = 0;
        const int k_hi = c * 64 + 63;
        for (int pos = k_lo; pos <= k_hi; ++pos) {
            const float* rowp = proj + (size_t)(b * SEQ + pos) * NPROJ;
            const float* kr = rowp + C_KW + g * 64;
            float dot = 0.f;
#pragma unroll
            for (int d = 0; d < 64; d += 4) { float4 x = *(const float4*)(kr + d); dot += qv[d] * x.x + qv[d + 1] * x.y + qv[d + 2] * x.z + qv[d + 3] * x.w; }
            const int dist = t - pos;
            const float s = dot - slope * (float)dist;
            if (dist >= 0 && dist < 512) {
                if (s > m) { float a = expf(m - s); l *= a;
#pragma unroll
                    for (int d = 0; d < 64; ++d) o[d] *= a;
                    m = s; }
                const float p = expf(s - m);
                l += p;
                const float* vr = rowp + C_VW + g * 64;
#pragma unroll
                for (int d = 0; d < 64; d += 4) { float4 x = *(const float4*)(vr + d); o[d] += p * x.x; o[d + 1] += p * x.y; o[d + 2] += p * x.z; o[d + 3] += p * x.w; }
            }
        }
        const float g2 = proj[(size_t)(b * SEQ + t) * NPROJ + C_GL + h * 3 + 2] / l;
#pragma unroll
        for (int d = 0; d < 64; ++d) res[d] += o[d] * g2;
    }
    float* orow = att + (size_t)(b * SEQ + t) * DM + h * 64;
#pragma unroll
    for (int d = 0; d < 64; d += 4) { float4 x = *(float4*)(orow + d); x.x += res[d]; x.y += res[d + 1]; x.z += res[d + 2]; x.w += res[d + 3]; *(float4*)(orow + d) = x; }
}

__global__ void __launch_bounds__(256) k_route(const float* __restrict__ xn, const float* __restrict__ wg, const float* __restrict__ bg,
                                              const float* __restrict__ we, const float* __restrict__ be,
                                              int* __restrict__ cnt, int* __restrict__ lslot, float* __restrict__ lw) {
    const int t = blockIdx.x * 4 + (threadIdx.x >> 6), lane = threadIdx.x & 63;
    const float* xr = xn + (size_t)t * DM;
    float acc[36];
#pragma unroll
    for (int i = 0; i < 36; ++i) acc[i] = 0.f;
    for (int i = 0; i < 16; ++i) {
        const int k = lane + 64 * i;
        const float x = xr[k];
        const float4 g4 = *(const float4*)(wg + (size_t)k * 4);
        acc[0] += x * g4.x; acc[1] += x * g4.y; acc[2] += x * g4.z; acc[3] += x * g4.w;
        const float4* e4 = (const float4*)(we + (size_t)k * 32);
#pragma unroll
        for (int j = 0; j < 8; ++j) { float4 w = e4[j]; acc[4 + 4 * j] += x * w.x; acc[5 + 4 * j] += x * w.y; acc[6 + 4 * j] += x * w.z; acc[7 + 4 * j] += x * w.w; }
    }
#pragma unroll
    for (int i = 0; i < 36; ++i) acc[i] = wave_sum(acc[i]);
    if (lane == 0) {
        float gl[4];
#pragma unroll
        for (int i = 0; i < 4; ++i) gl[i] = acc[i] + bg[i];
        int gi = 0; float gm = gl[0];
#pragma unroll
        for (int i = 1; i < 4; ++i) if (gl[i] > gm) { gm = gl[i]; gi = i; }
        float gs = 0.f;
#pragma unroll
        for (int i = 0; i < 4; ++i) gs += expf(gl[i] - gm);
        const float gw = 1.f / gs;
        float el[8];
#pragma unroll
        for (int e = 0; e < 8; ++e) {
            float v = 0.f;
#pragma unroll
            for (int gg = 0; gg < 4; ++gg) v = (gg == gi) ? (acc[4 + gg * 8 + e] + be[gg * 8 + e]) : v;
            el[e] = v;
        }
        int e1 = 0; float m1 = el[0];
#pragma unroll
        for (int e = 1; e < 8; ++e) if (el[e] > m1) { m1 = el[e]; e1 = e; }
        int e2 = -1; float m2 = -INFINITY;
#pragma unroll
        for (int e = 0; e < 8; ++e) if (e != e1 && el[e] > m2) { m2 = el[e]; e2 = e; }
        const float p2 = expf(m2 - m1);
        const float w1 = gw / (1.f + p2), w2 = gw * p2 / (1.f + p2);
        const int x1 = gi * 8 + e1, x2 = gi * 8 + e2;
        int p1 = atomicAdd(&cnt[x1], 1);
        lslot[x1 * TTOK + p1] = t * 2; lw[x1 * TTOK + p1] = w1;
        int pp2 = atomicAdd(&cnt[x2], 1);
        lslot[x2 * TTOK + pp2] = t * 2 + 1; lw[x2 * TTOK + pp2] = w2;
    }
}

__global__ void __launch_bounds__(256) k_moe(const float* __restrict__ xn, const float* __restrict__ wgate, const float* __restrict__ wup, const float* __restrict__ wdown,
                                            const int* __restrict__ cnt, const int* __restrict__ lslot, const float* __restrict__ lw, float* __restrict__ ys) {
    __shared__ float xs[8][1024];
    __shared__ float gu[2][8][128];
    __shared__ float hid[8][128];
    __shared__ int sl[8];
    __shared__ float sw[8];
    const int e = blockIdx.y, chunk = blockIdx.x, tid = threadIdx.x;
    const int n = cnt[e];
    const int base = chunk * 8;
    if (base >= n) return;
    if (tid < 8) { int i = base + tid; bool ok = i < n; sl[tid] = ok ? lslot[e * TTOK + i] : -1; sw[tid] = ok ? lw[e * TTOK + i] : 0.f; }
    __syncthreads();
    for (int i = 0; i < 8; ++i) {
        int s = sl[i];
        float4 v = make_float4(0.f, 0.f, 0.f, 0.f);
        if (s >= 0) v = *(const float4*)(xn + (size_t)(s >> 1) * DM + tid * 4);
        *(float4*)&xs[i][tid * 4] = v;
    }
    __syncthreads();
    {
        const int col = tid & 127, which = tid >> 7;
        const float* W = (which ? wup : wgate) + (size_t)e * 1024 * 128 + col;
        float acc[8];
#pragma unroll
        for (int i = 0; i < 8; ++i) acc[i] = 0.f;
        for (int k = 0; k < 1024; ++k) {
            const float w = W[(size_t)k * 128];
#pragma unroll
            for (int i = 0; i < 8; ++i) acc[i] += xs[i][k] * w;
        }
#pragma unroll
        for (int i = 0; i < 8; ++i) gu[which][i][col] = acc[i];
    }
    __syncthreads();
    for (int idx = tid; idx < 8 * 128; idx += 256) {
        int i = idx >> 7, f = idx & 127;
        float gg = gu[0][i][f], uu = gu[1][i][f];
        hid[i][f] = (gg / (1.f + expf(-gg))) * uu * sw[i];
    }
    __syncthreads();
    {
        const float* W = wdown + (size_t)e * 128 * 1024 + tid * 4;
        float acc[8][4];
#pragma unroll
        for (int i = 0; i < 8; ++i) { acc[i][0] = 0.f; acc[i][1] = 0.f; acc[i][2] = 0.f; acc[i][3] = 0.f; }
        for (int f = 0; f < 128; ++f) {
            const float4 w = *(const float4*)(W + (size_t)f * 1024);
#pragma unroll
            for (int i = 0; i < 8; ++i) { const float hh = hid[i][f]; acc[i][0] += hh * w.x; acc[i][1] += hh * w.y; acc[i][2] += hh * w.z; acc[i][3] += hh * w.w; }
        }
#pragma unroll
        for (int i = 0; i < 8; ++i) {
            int s = sl[i];
            if (s >= 0) *(float4*)(ys + (size_t)s * DM + tid * 4) = make_float4(acc[i][0], acc[i][1], acc[i][2], acc[i][3]);
        }
    }
}

#define LD1 1536
__global__ void __launch_bounds__(256) k_moba_post(float* __restrict__ qkv, const float* __restrict__ qn, const float* __restrict__ kn) {
    int t = blockIdx.x, w = threadIdx.x >> 6, lane = threadIdx.x & 63;
    float* row = qkv + (size_t)t * LD1;
    for (int s = w; s < 20; s += 4) {
        int col; const float* g; float sc = 1.f;
        if (s < 16) { col = 512 + s * 64; g = qn; sc = 0.125f; }
        else { col = (s - 16) * 64; g = kn; }
        float v = row[col + lane];
        float ss = wave_sum(v * v);
        row[col + lane] = v * rsqrtf(ss * (1.f / 64.f) + 1e-6f) * g[lane] * sc;
    }
}
__global__ void __launch_bounds__(256) k_moba_km(const float* __restrict__ qkv, float* __restrict__ km) {
    __shared__ float part[4][64];
    const int nb = blockIdx.x, g = blockIdx.y, b = blockIdx.z;
    const int d = threadIdx.x & 63, pr = threadIdx.x >> 6;
    float s = 0.f;
    for (int i = 0; i < 64; ++i) s += qkv[(size_t)(b * SEQ + nb * 256 + pr * 64 + i) * LD1 + g * 64 + d];
    part[pr][d] = s;
    __syncthreads();
    if (pr == 0) km[((size_t)(b * 4 + g) * 16 + nb) * 64 + d] = (part[0][d] + part[1][d] + part[2][d] + part[3][d]) * (1.f / 256.f);
}
__global__ void __launch_bounds__(256) k_moba_attn(const float* __restrict__ qkv, const float* __restrict__ km, float* __restrict__ att) {
    const int cb = blockIdx.x, h = blockIdx.y, b = blockIdx.z, g = h >> 2;
    const int t = cb * 256 + threadIdx.x;
    const float slope = exp2f(-0.5f * (float)(h + 1));
    const float* qrow = qkv + (size_t)(b * SEQ + t) * LD1 + 512 + h * 64;
    float qv[64];
#pragma unroll
    for (int d = 0; d < 64; d += 4) { float4 x = *(const float4*)(qrow + d); qv[d] = x.x; qv[d + 1] = x.y; qv[d + 2] = x.z; qv[d + 3] = x.w; }
    float sg[16];
#pragma unroll
    for (int n = 0; n < 16; ++n) {
        float dot = -INFINITY;
        if (n < cb) {
            const float* kr = km + ((size_t)(b * 4 + g) * 16 + n) * 64;
            dot = 0.f;
#pragma unroll
            for (int d = 0; d < 64; d += 4) { float4 x = *(const float4*)(kr + d); dot += qv[d] * x.x + qv[d + 1] * x.y + qv[d + 2] * x.z + qv[d + 3] * x.w; }
        }
        sg[n] = dot;
    }
    unsigned mk = 0u;
#pragma unroll
    for (int n = 0; n < 16; ++n) {
        int rank = 0;
#pragma unroll
        for (int n2 = 0; n2 < 16; ++n2) rank += (sg[n2] > sg[n] || (sg[n2] == sg[n] && n2 < n)) ? 1 : 0;
        if (rank < 3 && n < cb) mk |= 1u << n;
    }
    float m = -INFINITY, l = 0.f, o[64];
#pragma unroll
    for (int d = 0; d < 64; ++d) o[d] = 0.f;
    const int wave_tmax = (t | 63);
    for (int n = 0; n <= cb; ++n) {
        const bool bit = (n == cb) ? true : ((mk >> n) & 1u);
        if (__ballot(bit) == 0ull) continue;
        int pend = n * 256 + 255; if (pend > wave_tmax) pend = wave_tmax;
        for (int pos = n * 256; pos <= pend; ++pos) {
            const float* rowp = qkv + (size_t)(b * SEQ + pos) * LD1;
            const float* kr = rowp + g * 64;
            float dot = 0.f;
#pragma unroll
            for (int d = 0; d < 64; d += 4) { float4 x = *(const float4*)(kr + d); dot += qv[d] * x.x + qv[d + 1] * x.y + qv[d + 2] * x.z + qv[d + 3] * x.w; }
            const float s = dot - slope * (float)(t - pos);
            if (bit && pos <= t) {
                if (s > m) { float a = expf(m - s); l *= a;
#pragma unroll
                    for (int d = 0; d < 64; ++d) o[d] *= a;
                    m = s; }
                const float p = expf(s - m);
                l += p;
                const float* vr = rowp + 256 + g * 64;
#pragma unroll
                for (int d = 0; d < 64; d += 4) { float4 x = *(const float4*)(vr + d); o[d] += p * x.x; o[d + 1] += p * x.y; o[d + 2] += p * x.z; o[d + 3] += p * x.w; }
            }
        }
    }
    const float inv = 1.f / l;
    float* orow = att + (size_t)(b * SEQ + t) * DM + h * 64;
#pragma unroll
    for (int d = 0; d < 64; d += 4) { float4 x; x.x = o[d] * inv; x.y = o[d + 1] * inv; x.z = o[d + 2] * inv; x.w = o[d + 3] * inv; *(float4*)(orow + d) = x; }
}

template <class Epi>
static void gemm(hipStream_t s, const float* A, int lda, const float* W, int ldw, int M, int N, int K, Epi epi) {
    dim3 grid((N + 63) / 64, (M + 63) / 64);
    hipLaunchKernelGGL(k_gemm<Epi>, grid, dim3(256), 0, s, A, W, (long long)lda, (long long)ldw, M, N, K, 0, epi);
}

extern "C" void kernel_launch(void* const* d_in, const int* in_sizes, int n_in, void* d_out, int out_size, void* d_ws, size_t ws_size, hipStream_t stream) {
    const float* x = (const float*)d_in[0];
    const float* p = (const float*)d_in[1];
    const float* ln_mix = (const float*)d_in[2];
    const float* ln_ffn = (const float*)d_in[3];
    const float* ln_ple = (const float*)d_in[4];
    const float* a_w_in = (const float*)d_in[5];
    const float* a_q_norm = (const float*)d_in[6];
    const float* a_k_norm = (const float*)d_in[7];
    const float* a_ck_pos = (const float*)d_in[8];
    const float* a_ck_w1 = (const float*)d_in[9];
    const float* a_ck_w2 = (const float*)d_in[10];
    const float* a_cv_pos = (const float*)d_in[11];
    const float* a_cv_w1 = (const float*)d_in[12];
    const float* a_cv_w2 = (const float*)d_in[13];
    const float* a_w_out = (const float*)d_in[14];
    const float* kv_norm = (const float*)d_in[15];
    const float* w_kv = (const float*)d_in[16];
    const float* k_norm_sh = (const float*)d_in[17];
    const float* b_w_q = (const float*)d_in[18];
    const float* b_q_norm = (const float*)d_in[19];
    const float* b_w_out = (const float*)d_in[20];
    const float* moe_w_group = (const float*)d_in[21];
    const float* moe_b_group = (const float*)d_in[22];
    const float* moe_w_expert = (const float*)d_in[23];
    const float* moe_b_expert = (const float*)d_in[24];
    const float* moe_w_gate = (const float*)d_in[25];
    const float* moe_w_up = (const float*)d_in[26];
    const float* moe_w_down = (const float*)d_in[27];
    const float* ple_w_proj = (const float*)d_in[28];
    const float* ple_w_gate = (const float*)d_in[29];
    float* h = (float*)d_out;

    float* ws = (float*)d_ws;
    float* regA = ws;
    float* regB = regA + (size_t)TTOK * NPROJ;
    float* regC = regB + (size_t)TTOK * DM;
    float* hid = regC;
    float* kcc = hid + 4080 * 256;
    float* vcc = kcc + 4080 * 64;
    unsigned long long* selmask = (unsigned long long*)(vcc + 4080 * 64);
    int* cnt = (int*)(selmask + 16 * 4096);
    int* lslot = cnt + 64;
    float* lw = (float*)(lslot + 32 * TTOK);
    float* km = lw + 32 * TTOK;

    float* proj = regA;
    float* xn = regB;
    float* att = regB;
    float* blk = regB;
    float* ys = regA;
    float* gate = regA;
    float* qkv1 = regA;

    hipLaunchKernelGGL(k_rmsnorm, dim3(TTOK / 4), dim3(256), 0, stream, x, ln_mix, xn);
    gemm(stream, xn, DM, a_w_in, NPROJ, TTOK, NPROJ, DM, EpiStore{proj, NPROJ});
    hipLaunchKernelGGL(k_nsa_post, dim3(TTOK), dim3(256), 0, stream, proj, a_q_norm, a_k_norm);
    hipLaunchKernelGGL(k_im2col, dim3(4080), dim3(256), 0, stream, proj, a_ck_pos, blk, C_KC, 0);
    gemm(stream, blk, 2048, a_ck_w1, 256, 4080, 256, 2048, EpiGelu{hid, 256});
    gemm(stream, hid, 256, a_ck_w2, 64, 4080, 64, 256, EpiStore{kcc, 64});
    hipLaunchKernelGGL(k_rms64, dim3(1020), dim3(256), 0, stream, kcc, a_k_norm, 4080, 0);
    hipLaunchKernelGGL(k_im2col, dim3(4080), dim3(256), 0, stream, proj, a_cv_pos, blk, C_VC, 0);
    gemm(stream, blk, 2048, a_cv_w1, 256, 4080, 256, 2048, EpiGelu{hid, 256});
    gemm(stream, hid, 256, a_cv_w2, 64, 4080, 64, 256, EpiStore{vcc, 64});
    hipLaunchKernelGGL(k_nsa_cmp, dim3(64, 4, 4), dim3(256), 0, stream, proj, kcc, vcc, att, selmask);
    hipLaunchKernelGGL(k_nsa_selwin, dim3(16, 16, 4), dim3(256), 0, stream, proj, selmask, att);
    gemm(stream, att, DM, a_w_out, DM, TTOK, DM, DM, EpiResid{x, h, DM});
    for (int layer = 0; layer < 2; ++layer) {
        if (layer == 1) {
            hipLaunchKernelGGL(k_rmsnorm, dim3(TTOK / 4), dim3(256), 0, stream, h, kv_norm, xn);
            gemm(stream, xn, DM, w_kv, 512, TTOK, 512, DM, EpiStore{qkv1, LD1});
            hipLaunchKernelGGL(k_rmsnorm, dim3(TTOK / 4), dim3(256), 0, stream, h, ln_mix + DM, xn);
            gemm(stream, xn, DM, b_w_q, DM, TTOK, DM, DM, EpiStore{qkv1 + 512, LD1});
            hipLaunchKernelGGL(k_moba_post, dim3(TTOK), dim3(256), 0, stream, qkv1, b_q_norm, k_norm_sh);
            hipLaunchKernelGGL(k_moba_km, dim3(16, 4, 4), dim3(256), 0, stream, qkv1, km);
            hipLaunchKernelGGL(k_moba_attn, dim3(16, 16, 4), dim3(256), 0, stream, qkv1, km, att);
            gemm(stream, att, DM, b_w_out, DM, TTOK, DM, DM, EpiResid{h, h, DM});
        }
        hipLaunchKernelGGL(k_rmsnorm, dim3(TTOK / 4), dim3(256), 0, stream, h, ln_ffn + layer * DM, xn);
        (void)hipMemsetAsync(cnt, 0, 64 * sizeof(int), stream);
        hipLaunchKernelGGL(k_route, dim3(TTOK / 4), dim3(256), 0, stream, xn, moe_w_group + (size_t)layer * DM * 4, moe_b_group + layer * 4,
                           moe_w_expert + (size_t)layer * DM * 32, moe_b_expert + layer * 32, cnt, lslot, lw);
        hipLaunchKernelGGL(k_moe, dim3(2048, 32), dim3(256), 0, stream, xn, moe_w_gate + (size_t)layer * 32 * 1024 * 128, moe_w_up + (size_t)layer * 32 * 1024 * 128,
                           moe_w_down + (size_t)layer * 32 * 128 * 1024, cnt, lslot, lw, ys);
        hipLaunchKernelGGL(k_combine_rmsnorm, dim3(TTOK / 4), dim3(256), 0, stream, h, ys, ln_ple + layer * DM, xn);
        gemm(stream, xn, DM, ple_w_gate + (size_t)layer * DM * DM, DM, TTOK, DM, DM, EpiSigm{gate, DM});
        gemm(stream, p + (size_t)layer * TTOK * 256, 256, ple_w_proj + (size_t)layer * 256 * DM, DM, TTOK, DM, 256, EpiPle{gate, h, DM});
    }
}
```

```cpp
#include <hip/hip_runtime.h>
#include <hip/hip_cooperative_groups.h>
namespace cg = cooperative_groups;
#include <stdint.h>
#include <math.h>
#include <stdio.h>

#define SEQ 4096
#define BATCH 4
#define TTOK 16384
#define DM 1024
#define NPROJ 2608
#define NCMP 255

#define C_Q 0
#define C_KC 1024
#define C_VC 1280
#define C_KS 1536
#define C_VS 1792
#define C_KW 2048
#define C_VW 2304
#define C_GL 2560

__device__ __forceinline__ float wave_sum(float v) {
#pragma unroll
    for (int o = 32; o > 0; o >>= 1) v += __shfl_xor(v, o);
    return v;
}
__device__ __forceinline__ float gelu_tanh(float x) {
    const float c = 0.7978845608028654f;
    float u = c * (x + 0.044715f * x * x * x);
    return 0.5f * x * (1.f + tanhf(u));
}
__device__ __forceinline__ float sigm(float x) { return 1.f / (1.f + expf(-x)); }

__device__ __forceinline__ void d_rmsnorm(const float* __restrict__ in, const float* __restrict__ gain, float* __restrict__ out, int bx) {
    int row = bx * 4 + (threadIdx.x >> 6), lane = threadIdx.x & 63;
    const float4* p = (const float4*)(in + (size_t)row * DM);
    const float4* g4 = (const float4*)gain;
    float4 v[4]; float ss = 0.f;
#pragma unroll
    for (int i = 0; i < 4; ++i) { v[i] = p[lane + 64 * i]; ss += v[i].x * v[i].x + v[i].y * v[i].y + v[i].z * v[i].z + v[i].w * v[i].w; }
    ss = wave_sum(ss);
    float r = rsqrtf(ss * (1.f / DM) + 1e-6f);
    float4* o = (float4*)(out + (size_t)row * DM);
#pragma unroll
    for (int i = 0; i < 4; ++i) { float4 g = g4[lane + 64 * i]; float4 w; w.x = v[i].x * r * g.x; w.y = v[i].y * r * g.y; w.z = v[i].z * r * g.z; w.w = v[i].w * r * g.w; o[lane + 64 * i] = w; }
}
__device__ __forceinline__ void d_combine_rmsnorm(float* __restrict__ h, const float* __restrict__ ys, const float* __restrict__ gain, float* __restrict__ out, int bx) {
    int row = bx * 4 + (threadIdx.x >> 6), lane = threadIdx.x & 63;
    float4* p = (float4*)(h + (size_t)row * DM);
    const float4* y0 = (const float4*)(ys + (size_t)row * 2 * DM);
    const float4* y1 = y0 + DM / 4;
    const float4* g4 = (const float4*)gain;
    float4 v[4]; float ss = 0.f;
#pragma unroll
    for (int i = 0; i < 4; ++i) {
        float4 a = p[lane + 64 * i], b = y0[lane + 64 * i], c = y1[lane + 64 * i];
        a.x += b.x + c.x; a.y += b.y + c.y; a.z += b.z + c.z; a.w += b.w + c.w;
        v[i] = a; p[lane + 64 * i] = a;
        ss += a.x * a.x + a.y * a.y + a.z * a.z + a.w * a.w;
    }
    ss = wave_sum(ss);
    float r = rsqrtf(ss * (1.f / DM) + 1e-6f);
    float4* o = (float4*)(out + (size_t)row * DM);
#pragma unroll
    for (int i = 0; i < 4; ++i) { float4 g = g4[lane + 64 * i]; float4 w; w.x = v[i].x * r * g.x; w.y = v[i].y * r * g.y; w.z = v[i].z * r * g.z; w.w = v[i].w * r * g.w; o[lane + 64 * i] = w; }
}

struct EpiStore { float* C; long long ldc; __device__ void operator()(int r, int c, float v) const { C[(size_t)r * ldc + c] = v; } };
struct EpiGelu { float* C; long long ldc; __device__ void operator()(int r, int c, float v) const { C[(size_t)r * ldc + c] = gelu_tanh(v); } };
struct EpiSigm { float* C; long long ldc; __device__ void operator()(int r, int c, float v) const { C[(size_t)r * ldc + c] = sigm(v); } };
struct EpiResid { const float* R; float* C; long long ldc; __device__ void operator()(int r, int c, float v) const { C[(size_t)r * ldc + c] = R[(size_t)r * ldc + c] + v; } };
struct EpiPle { const float* G; float* H; long long ldc; __device__ void operator()(int r, int c, float v) const { H[(size_t)r * ldc + c] += G[(size_t)r * ldc + c] * v; } };

template <class Epi>
__device__ __forceinline__ void d_gemm(const float* __restrict__ A, const float* __restrict__ W, long long lda, long long ldw, int M, int N, int K, Epi epi, int bx, int by, char* smem) {
    float (*As)[68] = (float (*)[68])smem;
    float (*Ws)[68] = (float (*)[68])(smem + 16 * 68 * 4);
    const int tid = threadIdx.x, tx = tid & 15, ty = tid >> 4;
    const int m0 = by * 64, n0 = bx * 64;
    float acc[4][4];
#pragma unroll
    for (int i = 0; i < 4; ++i)
#pragma unroll
        for (int j = 0; j < 4; ++j) acc[i][j] = 0.f;
    const int ar = tid >> 2, ak = (tid & 3) * 4;
    const int wk = tid >> 4, wc = (tid & 15) * 4;
    for (int k0 = 0; k0 < K; k0 += 16) {
        float4 a = make_float4(0.f, 0.f, 0.f, 0.f), w = make_float4(0.f, 0.f, 0.f, 0.f);
        if (m0 + ar < M) a = *(const float4*)(A + (size_t)(m0 + ar) * lda + k0 + ak);
        if (n0 + wc < N) w = *(const float4*)(W + (size_t)(k0 + wk) * ldw + n0 + wc);
        __syncthreads();
        As[ak + 0][ar] = a.x; As[ak + 1][ar] = a.y; As[ak + 2][ar] = a.z; As[ak + 3][ar] = a.w;
        *(float4*)&Ws[wk][wc] = w;
        __syncthreads();
#pragma unroll
        for (int kk = 0; kk < 16; ++kk) {
            float4 av = *(const float4*)&As[kk][ty * 4];
            float4 wv = *(const float4*)&Ws[kk][tx * 4];
            float aa[4] = {av.x, av.y, av.z, av.w}, ww[4] = {wv.x, wv.y, wv.z, wv.w};
#pragma unroll
            for (int i = 0; i < 4; ++i)
#pragma unroll
                for (int j = 0; j < 4; ++j) acc[i][j] += aa[i] * ww[j];
        }
    }
#pragma unroll
    for (int i = 0; i < 4; ++i)
#pragma unroll
        for (int j = 0; j < 4; ++j) {
            int r = m0 + ty * 4 + i, c = n0 + tx * 4 + j;
            if (r < M && c < N) epi(r, c, acc[i][j]);
        }
}

__device__ __forceinline__ void d_nsa_post(float* __restrict__ proj, const float* __restrict__ qn, const float* __restrict__ kn, int bx) {
    int t = bx, w = threadIdx.x >> 6, lane = threadIdx.x & 63;
    float* row = proj + (size_t)t * NPROJ;
    for (int s = w; s < 24; s += 4) {
        int col; const float* g; float sc = 1.f;
        if (s < 16) { col = C_Q + s * 64; g = qn; sc = 0.125f; }
        else if (s < 20) { col = C_KS + (s - 16) * 64; g = kn + 64; }
        else { col = C_KW + (s - 20) * 64; g = kn + 128; }
        float v = row[col + lane];
        float ss = wave_sum(v * v);
        row[col + lane] = v * rsqrtf(ss * (1.f / 64.f) + 1e-6f) * g[lane] * sc;
    }
    if (threadIdx.x < 48) row[C_GL + threadIdx.x] = sigm(row[C_GL + threadIdx.x]);
}

__device__ __forceinline__ void d_im2col(const float* __restrict__ proj, const float* __restrict__ pos, float* __restrict__ blk, int base, int bx) {
    int rowi = bx;
    int bg = rowi / NCMP, n = rowi % NCMP, b = bg >> 2, g = bg & 3;
    for (int e = threadIdx.x; e < 2048; e += 256) {
        int l = e >> 6, d = e & 63;
        blk[(size_t)rowi * 2048 + e] = proj[(size_t)(b * SEQ + 16 * n + l) * NPROJ + base + g * 64 + d] + pos[e];
    }
}
__device__ __forceinline__ void d_rms64(float* __restrict__ x, const float* __restrict__ g, int rows, int bx) {
    int r = bx * 4 + (threadIdx.x >> 6), lane = threadIdx.x & 63;
    if (r >= rows) return;
    float v = x[(size_t)r * 64 + lane];
    float ss = wave_sum(v * v);
    x[(size_t)r * 64 + lane] = v * rsqrtf(ss * (1.f / 64.f) + 1e-6f) * g[lane];
}

__device__ __forceinline__ void d_nsa_cmp(const float* __restrict__ proj, const float* __restrict__ kcc, const float* __restrict__ vcc,
                                                float* __restrict__ att, unsigned long long* __restrict__ selmask, int bx, int by, int bz, char* smem) {
    float (*imp)[65] = (float (*)[65])smem;
    unsigned int (*mk)[2] = (unsigned int (*)[2])(smem + 64 * 65 * 4);
    const int c = bx, g = by, b = bz;
    const int r = threadIdx.x >> 6, q = threadIdx.x & 63;
    const int h = g * 4 + r, t = c * 64 + q;
    const float slope = exp2f(-0.5f * (float)(h + 1));
    for (int e = threadIdx.x; e < 64 * 65; e += 256) (&imp[0][0])[e] = 0.f;
    if (threadIdx.x < 128) (&mk[0][0])[threadIdx.x] = 0u;
    const float* qrow = proj + (size_t)(b * SEQ + t) * NPROJ + C_Q + h * 64;
    float qv[64];
#pragma unroll
    for (int d = 0; d < 64; d += 4) { float4 x = *(const float4*)(qrow + d); qv[d] = x.x; qv[d + 1] = x.y; qv[d + 2] = x.z; qv[d + 3] = x.w; }
    const int nvalid = (t >= 31) ? ((t - 31) / 16 + 1) : 0;
    const int nmax = 4 * c + 3;
    const float* kb = kcc + (size_t)(b * 4 + g) * NCMP * 64;
    const float* vb = vcc + (size_t)(b * 4 + g) * NCMP * 64;
    float m = -INFINITY;
    for (int n = 0; n < nmax; ++n) {
        const float* kr = kb + n * 64;
        float dot = 0.f;
#pragma unroll
        for (int d = 0; d < 64; d += 4) { float4 x = *(const float4*)(kr + d); dot += qv[d] * x.x + qv[d + 1] * x.y + qv[d + 2] * x.z + qv[d + 3] * x.w; }
        float s = dot - slope * (float)(t - (16 * n + 31));
        if (n < nvalid) m = fmaxf(m, s);
    }
    float l = 0.f, o[64];
#pragma unroll
    for (int d = 0; d < 64; ++d) o[d] = 0.f;
    for (int n = 0; n < nmax; ++n) {
        const float* kr = kb + n * 64;
        float dot = 0.f;
#pragma unroll
        for (int d = 0; d < 64; d += 4) { float4 x = *(const float4*)(kr + d); dot += qv[d] * x.x + qv[d + 1] * x.y + qv[d + 2] * x.z + qv[d + 3] * x.w; }
        float s = dot - slope * (float)(t - (16 * n + 31));
        float p = (n < nvalid) ? expf(s - m) : 0.f;
        l += p;
        const float* vr = vb + n * 64;
#pragma unroll
        for (int d = 0; d < 64; d += 4) { float4 x = *(const float4*)(vr + d); o[d] += p * x.x; o[d + 1] += p * x.y; o[d + 2] += p * x.z; o[d + 3] += p * x.w; }
    }
    const float inv = (l > 0.f) ? 1.f / l : 0.f;
    {
        const float g0 = proj[(size_t)(b * SEQ + t) * NPROJ + C_GL + h * 3 + 0] * inv;
        float* orow = att + (size_t)(b * SEQ + t) * DM + h * 64;
#pragma unroll
        for (int d = 0; d < 64; d += 4) { float4 x; x.x = o[d] * g0; x.y = o[d + 1] * g0; x.z = o[d + 2] * g0; x.w = o[d + 3] * g0; *(float4*)(orow + d) = x; }
    }
    __syncthreads();
    for (int rr = 0; rr < 4; ++rr) {
        if (r == rr) {
            for (int n = 0; n < nmax; ++n) {
                const float* kr = kb + n * 64;
                float dot = 0.f;
#pragma unroll
                for (int d = 0; d < 64; d += 4) { float4 x = *(const float4*)(kr + d); dot += qv[d] * x.x + qv[d + 1] * x.y + qv[d + 2] * x.z + qv[d + 3] * x.w; }
                float s = dot - slope * (float)(t - (16 * n + 31));
                if (n < nvalid) {
                    float p = expf(s - m) * inv;
                    int j = n >> 2;
                    if ((n & 3) == 3) { imp[q][j] += 0.5f * p; imp[q][j + 1] += 0.5f * p; }
                    else imp[q][j] += p;
                }
            }
        }
        __syncthreads();
    }
    for (int idx = threadIdx.x; idx < 4096; idx += 256) {
        int qq = idx >> 6, j = idx & 63;
        if (j > c) continue;
        bool fj = (j == 0) || (j == c) || (j == c - 1);
        float vj = fj ? 1e9f : imp[qq][j];
        int rank = 0;
        for (int j2 = 0; j2 <= c; ++j2) {
            bool f2 = (j2 == 0) || (j2 == c) || (j2 == c - 1);
            float v2 = f2 ? 1e9f : imp[qq][j2];
            rank += (v2 > vj || (v2 == vj && j2 < j)) ? 1 : 0;
        }
        if (rank < 16) atomicOr(&mk[qq][j >> 5], 1u << (j & 31));
    }
    __syncthreads();
    if (threadIdx.x < 64) {
        unsigned long long mm = (unsigned long long)mk[threadIdx.x][0] | ((unsigned long long)mk[threadIdx.x][1] << 32);
        selmask[(size_t)(b * 4 + g) * SEQ + c * 64 + threadIdx.x] = mm;
    }
}

__device__ __forceinline__ void d_nsa_selwin(const float* __restrict__ proj, const unsigned long long* __restrict__ selmask, float* __restrict__ att, int bx, int by, int bz) {
    const int h = by, b = bz, g = h >> 2;
    const int t = bx * 256 + threadIdx.x;
    const int c = t >> 6;
    const float slope = exp2f(-0.5f * (float)(h + 1));
    const float* qrow = proj + (size_t)(b * SEQ + t) * NPROJ + C_Q + h * 64;
    float qv[64];
#pragma unroll
    for (int d = 0; d < 64; d += 4) { float4 x = *(const float4*)(qrow + d); qv[d] = x.x; qv[d + 1] = x.y; qv[d + 2] = x.z; qv[d + 3] = x.w; }
    float res[64];
    {
        const unsigned long long mk = selmask[(size_t)(b * 4 + g) * SEQ + t];
        float m = -INFINITY, l = 0.f, o[64];
#pragma unroll
        for (int d = 0; d < 64; ++d) o[d] = 0.f;
        for (int j = 0; j <= c; ++j) {
            const bool bit = (mk >> j) & 1ull;
            if (__ballot(bit) == 0ull) continue;
            for (int li = 0; li < 64; ++li) {
                const int pos = j * 64 + li;
                const float* rowp = proj + (size_t)(b * SEQ + pos) * NPROJ;
                const float* kr = rowp + C_KS + g * 64;
                float dot = 0.f;
#pragma unroll
                for (int d = 0; d < 64; d += 4) { float4 x = *(const float4*)(kr + d); dot += qv[d] * x.x + qv[d + 1] * x.y + qv[d + 2] * x.z + qv[d + 3] * x.w; }
                const float s = dot - slope * (float)(t - pos);
                if (bit && pos <= t) {
                    if (s > m) { float a = expf(m - s); l *= a;
#pragma unroll
                        for (int d = 0; d < 64; ++d) o[d] *= a;
                        m = s; }
                    const float p = expf(s - m);
                    l += p;
                    const float* vr = rowp + C_VS + g * 64;
#pragma unroll
                    for (int d = 0; d < 64; d += 4) { float4 x = *(const float4*)(vr + d); o[d] += p * x.x; o[d + 1] += p * x.y; o[d + 2] += p * x.z; o[d + 3] += p * x.w; }
                }
            }
        }
        const float g1 = proj[(size_t)(b * SEQ + t) * NPROJ + C_GL + h * 3 + 1] / l;
#pragma unroll
        for (int d = 0; d < 64; ++d) res[d] = o[d] * g1;
    }
    {
        float m = -INFINITY, l = 0.f, o[64];
#pragma unroll
        for (int d = 0; d < 64; ++d) o[d] = 0.f;
        int k_lo = c * 64 - 511; if (k_lo < 0) k_lo = 0;
        const int k_hi = c * 64 + 63;
        for (int pos = k_lo; pos <= k_hi; ++pos) {
            const float* rowp = proj + (size_t)(b * SEQ + pos) * NPROJ;
            const float* kr = rowp + C_KW + g * 64;
            float dot = 0.f;
#pragma unroll
            for (int d = 0; d < 64; d += 4) { float4 x = *(const float4*)(kr + d); dot += qv[d] * x.x + qv[d + 1] * x.y + qv[d + 2] * x.z + qv[d + 3] * x.w; }
            const int dist = t - pos;
            const float s = dot - slope * (float)dist;
            if (dist >= 0 && dist < 512) {
                if (s > m) { float a = expf(m - s); l *= a;
#pragma unroll
                    for (int d = 0; d < 64; ++d) o[d] *= a;
                    m = s; }
                const float p = expf(s - m);
                l += p;
                const float* vr = rowp + C_VW + g * 64;
#pragma unroll
                for (int d = 0; d < 64; d += 4) { float4 x = *(const float4*)(vr + d); o[d] += p * x.x; o[d + 1] += p * x.y; o[d + 2] += p * x.z; o[d + 3] += p * x.w; }
            }
        }
        const float g2 = proj[(size_t)(b * SEQ + t) * NPROJ + C_GL + h * 3 + 2] / l;
#pragma unroll
        for (int d = 0; d < 64; ++d) res[d] += o[d] * g2;
    }
    float* orow = att + (size_t)(b * SEQ + t) * DM + h * 64;
#pragma unroll
    for (int d = 0; d < 64; d += 4) { float4 x = *(float4*)(orow + d); x.x += res[d]; x.y += res[d + 1]; x.z += res[d + 2]; x.w += res[d + 3]; *(float4*)(orow + d) = x; }
}

__device__ __forceinline__ void d_route(const float* __restrict__ xn, const float* __restrict__ wg, const float* __restrict__ bg,
                                              const float* __restrict__ we, const float* __restrict__ be,
                                              int* __restrict__ cnt, int* __restrict__ lslot, float* __restrict__ lw, int bx) {
    const int t = bx * 4 + (threadIdx.x >> 6), lane = threadIdx.x & 63;
    const float* xr = xn + (size_t)t * DM;
    float acc[36];
#pragma unroll
    for (int i = 0; i < 36; ++i) acc[i] = 0.f;
    for (int i = 0; i < 16; ++i) {
        const int k = lane + 64 * i;
        const float x = xr[k];
        const float4 g4 = *(const float4*)(wg + (size_t)k * 4);
        acc[0] += x * g4.x; acc[1] += x * g4.y; acc[2] += x * g4.z; acc[3] += x * g4.w;
        const float4* e4 = (const float4*)(we + (size_t)k * 32);
#pragma unroll
        for (int j = 0; j < 8; ++j) { float4 w = e4[j]; acc[4 + 4 * j] += x * w.x; acc[5 + 4 * j] += x * w.y; acc[6 + 4 * j] += x * w.z; acc[7 + 4 * j] += x * w.w; }
    }
#pragma unroll
    for (int i = 0; i < 36; ++i) acc[i] = wave_sum(acc[i]);
    if (lane == 0) {
        float gl[4];
#pragma unroll
        for (int i = 0; i < 4; ++i) gl[i] = acc[i] + bg[i];
        int gi = 0; float gm = gl[0];
#pragma unroll
        for (int i = 1; i < 4; ++i) if (gl[i] > gm) { gm = gl[i]; gi = i; }
        float gs = 0.f;
#pragma unroll
        for (int i = 0; i < 4; ++i) gs += expf(gl[i] - gm);
        const float gw = 1.f / gs;
        float el[8];
#pragma unroll
        for (int e = 0; e < 8; ++e) {
            float v = 0.f;
#pragma unroll
            for (int gg = 0; gg < 4; ++gg) v = (gg == gi) ? (acc[4 + gg * 8 + e] + be[gg * 8 + e]) : v;
            el[e] = v;
        }
        int e1 = 0; float m1 = el[0];
#pragma unroll
        for (int e = 1; e < 8; ++e) if (el[e] > m1) { m1 = el[e]; e1 = e; }
        int e2 = -1; float m2 = -INFINITY;
#pragma unroll
        for (int e = 0; e < 8; ++e) if (e != e1 && el[e] > m2) { m2 = el[e]; e2 = e; }
        const float p2 = expf(m2 - m1);
        const float w1 = gw / (1.f + p2), w2 = gw * p2 / (1.f + p2);
        const int x1 = gi * 8 + e1, x2 = gi * 8 + e2;
        int p1 = atomicAdd(&cnt[x1], 1);
        lslot[x1 * TTOK + p1] = t * 2; lw[x1 * TTOK + p1] = w1;
        int pp2 = atomicAdd(&cnt[x2], 1);
        lslot[x2 * TTOK + pp2] = t * 2 + 1; lw[x2 * TTOK + pp2] = w2;
    }
}

__device__ __forceinline__ void d_moe(const float* __restrict__ xn, const float* __restrict__ wgate, const float* __restrict__ wup, const float* __restrict__ wdown,
                                            const int* __restrict__ cnt, const int* __restrict__ lslot, const float* __restrict__ lw, float* __restrict__ ys, int bx, int by, char* smem) {
    float (*xs)[1024] = (float (*)[1024])smem;
    float (*gu)[8][128] = (float (*)[8][128])(smem + 32768);
    float (*hid)[128] = (float (*)[128])(smem + 32768 + 8192);
    int* sl = (int*)(smem + 32768 + 8192 + 4096);
    float* sw = (float*)(smem + 32768 + 8192 + 4096 + 32);
    const int e = by, chunk = bx, tid = threadIdx.x;
    const int n = cnt[e];
    const int base = chunk * 8;
    if (base >= n) return;
    if (tid < 8) { int i = base + tid; bool ok = i < n; sl[tid] = ok ? lslot[e * TTOK + i] : -1; sw[tid] = ok ? lw[e * TTOK + i] : 0.f; }
    __syncthreads();
    for (int i = 0; i < 8; ++i) {
        int s = sl[i];
        float4 v = make_float4(0.f, 0.f, 0.f, 0.f);
        if (s >= 0) v = *(const float4*)(xn + (size_t)(s >> 1) * DM + tid * 4);
        *(float4*)&xs[i][tid * 4] = v;
    }
    __syncthreads();
    {
        const int col = tid & 127, which = tid >> 7;
        const float* W = (which ? wup : wgate) + (size_t)e * 1024 * 128 + col;
        float acc[8];
#pragma unroll
        for (int i = 0; i < 8; ++i) acc[i] = 0.f;
        for (int k = 0; k < 1024; ++k) {
            const float w = W[(size_t)k * 128];
#pragma unroll
            for (int i = 0; i < 8; ++i) acc[i] += xs[i][k] * w;
        }
#pragma unroll
        for (int i = 0; i < 8; ++i) gu[which][i][col] = acc[i];
    }
    __syncthreads();
    for (int idx = tid; idx < 8 * 128; idx += 256) {
        int i = idx >> 7, f = idx & 127;
        float gg = gu[0][i][f], uu = gu[1][i][f];
        hid[i][f] = (gg / (1.f + expf(-gg))) * uu * sw[i];
    }
    __syncthreads();
    {
        const float* W = wdown + (size_t)e * 128 * 1024 + tid * 4;
        float acc[8][4];
#pragma unroll
        for (int i = 0; i < 8; ++i) { acc[i][0] = 0.f; acc[i][1] = 0.f; acc[i][2] = 0.f; acc[i][3] = 0.f; }
        for (int f = 0; f < 128; ++f) {
            const float4 w = *(const float4*)(W + (size_t)f * 1024);
#pragma unroll
            for (int i = 0; i < 8; ++i) { const float hh = hid[i][f]; acc[i][0] += hh * w.x; acc[i][1] += hh * w.y; acc[i][2] += hh * w.z; acc[i][3] += hh * w.w; }
        }
#pragma unroll
        for (int i = 0; i < 8; ++i) {
            int s = sl[i];
            if (s >= 0) *(float4*)(ys + (size_t)s * DM + tid * 4) = make_float4(acc[i][0], acc[i][1], acc[i][2], acc[i][3]);
        }
    }
}

#define LD1 1536
__device__ __forceinline__ void d_moba_post(float* __restrict__ qkv, const float* __restrict__ qn, const float* __restrict__ kn, int bx) {
    int t = bx, w = threadIdx.x >> 6, lane = threadIdx.x & 63;
    float* row = qkv + (size_t)t * LD1;
    for (int s = w; s < 20; s += 4) {
        int col; const float* g; float sc = 1.f;
        if (s < 16) { col = 512 + s * 64; g = qn; sc = 0.125f; }
        else { col = (s - 16) * 64; g = kn; }
        float v = row[col + lane];
        float ss = wave_sum(v * v);
        row[col + lane] = v * rsqrtf(ss * (1.f / 64.f) + 1e-6f) * g[lane] * sc;
    }
}
__device__ __forceinline__ void d_moba_km(const float* __restrict__ qkv, float* __restrict__ km, int bx, int by, int bz, char* smem) {
    float (*part)[64] = (float (*)[64])smem;
    const int nb = bx, g = by, b = bz;
    const int d = threadIdx.x & 63, pr = threadIdx.x >> 6;
    float s = 0.f;
    for (int i = 0; i < 64; ++i) s += qkv[(size_t)(b * SEQ + nb * 256 + pr * 64 + i) * LD1 + g * 64 + d];
    part[pr][d] = s;
    __syncthreads();
    if (pr == 0) km[((size_t)(b * 4 + g) * 16 + nb) * 64 + d] = (part[0][d] + part[1][d] + part[2][d] + part[3][d]) * (1.f / 256.f);
}
__device__ __forceinline__ void d_moba_attn(const float* __restrict__ qkv, const float* __restrict__ km, float* __restrict__ att, int bx, int by, int bz) {
    const int cb = bx, h = by, b = bz, g = h >> 2;
    const int t = cb * 256 + threadIdx.x;
    const float slope = exp2f(-0.5f * (float)(h + 1));
    const float* qrow = qkv + (size_t)(b * SEQ + t) * LD1 + 512 + h * 64;
    float qv[64];
#pragma unroll
    for (int d = 0; d < 64; d += 4) { float4 x = *(const float4*)(qrow + d); qv[d] = x.x; qv[d + 1] = x.y; qv[d + 2] = x.z; qv[d + 3] = x.w; }
    float sg[16];
#pragma unroll
    for (int n = 0; n < 16; ++n) {
        float dot = -INFINITY;
        if (n < cb) {
            const float* kr = km + ((size_t)(b * 4 + g) * 16 + n) * 64;
            dot = 0.f;
#pragma unroll
            for (int d = 0; d < 64; d += 4) { float4 x = *(const float4*)(kr + d); dot += qv[d] * x.x + qv[d + 1] * x.y + qv[d + 2] * x.z + qv[d + 3] * x.w; }
        }
        sg[n] = dot;
    }
    unsigned mk = 0u;
#pragma unroll
    for (int n = 0; n < 16; ++n) {
        int rank = 0;
#pragma unroll
        for (int n2 = 0; n2 < 16; ++n2) rank += (sg[n2] > sg[n] || (sg[n2] == sg[n] && n2 < n)) ? 1 : 0;
        if (rank < 3 && n < cb) mk |= 1u << n;
    }
    float m = -INFINITY, l = 0.f, o[64];
#pragma unroll
    for (int d = 0; d < 64; ++d) o[d] = 0.f;
    const int wave_tmax = (t | 63);
    for (int n = 0; n <= cb; ++n) {
        const bool bit = (n == cb) ? true : ((mk >> n) & 1u);
        if (__ballot(bit) == 0ull) continue;
        int pend = n * 256 + 255; if (pend > wave_tmax) pend = wave_tmax;
        for (int pos = n * 256; pos <= pend; ++pos) {
            const float* rowp = qkv + (size_t)(b * SEQ + pos) * LD1;
            const float* kr = rowp + g * 64;
            float dot = 0.f;
#pragma unroll
            for (int d = 0; d < 64; d += 4) { float4 x = *(const float4*)(kr + d); dot += qv[d] * x.x + qv[d + 1] * x.y + qv[d + 2] * x.z + qv[d + 3] * x.w; }
            const float s = dot - slope * (float)(t - pos);
            if (bit && pos <= t) {
                if (s > m) { float a = expf(m - s); l *= a;
#pragma unroll
                    for (int d = 0; d < 64; ++d) o[d] *= a;
                    m = s; }
                const float p = expf(s - m);
                l += p;
                const float* vr = rowp + 256 + g * 64;
#pragma unroll
                for (int d = 0; d < 64; d += 4) { float4 x = *(const float4*)(vr + d); o[d] += p * x.x; o[d + 1] += p * x.y; o[d + 2] += p * x.z; o[d + 3] += p * x.w; }
            }
        }
    }
    const float inv = 1.f / l;
    float* orow = att + (size_t)(b * SEQ + t) * DM + h * 64;
#pragma unroll
    for (int d = 0; d < 64; d += 4) { float4 x; x.x = o[d] * inv; x.y = o[d + 1] * inv; x.z = o[d + 2] * inv; x.w = o[d + 3] * inv; *(float4*)(orow + d) = x; }
}


struct Params {
    const float* in[30];
    float* out;
    float* ws;
};
#define SMEM_BYTES 45184

#define PHASE_1D(NB, CALL) do { for (int vb = blockIdx.x; vb < (NB); vb += gridDim.x) { const int bx = vb; __syncthreads(); CALL; } grid.sync(); } while (0)
#define PHASE_2D(NX, NY, CALL) do { for (int vb = blockIdx.x; vb < (NX) * (NY); vb += gridDim.x) { const int bx = vb % (NX), by = vb / (NX); __syncthreads(); CALL; } grid.sync(); } while (0)
#define PHASE_3D(NX, NY, NZ, CALL) do { for (int vb = blockIdx.x; vb < (NX) * (NY) * (NZ); vb += gridDim.x) { const int bx = vb % (NX), by = (vb / (NX)) % (NY), bz = vb / ((NX) * (NY)); __syncthreads(); CALL; } grid.sync(); } while (0)
#define GEMM_PHASE(A, lda, W, ldw, M, N, K, EPI) PHASE_2D(((N) + 63) / 64, ((M) + 63) / 64, d_gemm(A, W, (long long)(lda), (long long)(ldw), M, N, K, EPI, bx, by, smem))

__global__ void __launch_bounds__(256) mega(Params P) {
    cg::grid_group grid = cg::this_grid();
    __shared__ __attribute__((aligned(16))) char smem[SMEM_BYTES];
    const float* x = P.in[0];
    const float* p = P.in[1];
    const float* ln_mix = P.in[2];
    const float* ln_ffn = P.in[3];
    const float* ln_ple = P.in[4];
    const float* a_w_in = P.in[5];
    const float* a_q_norm = P.in[6];
    const float* a_k_norm = P.in[7];
    const float* a_ck_pos = P.in[8];
    const float* a_ck_w1 = P.in[9];
    const float* a_ck_w2 = P.in[10];
    const float* a_cv_pos = P.in[11];
    const float* a_cv_w1 = P.in[12];
    const float* a_cv_w2 = P.in[13];
    const float* a_w_out = P.in[14];
    const float* kv_norm = P.in[15];
    const float* w_kv = P.in[16];
    const float* k_norm_sh = P.in[17];
    const float* b_w_q = P.in[18];
    const float* b_q_norm = P.in[19];
    const float* b_w_out = P.in[20];
    const float* moe_w_group = P.in[21];
    const float* moe_b_group = P.in[22];
    const float* moe_w_expert = P.in[23];
    const float* moe_b_expert = P.in[24];
    const float* moe_w_gate = P.in[25];
    const float* moe_w_up = P.in[26];
    const float* moe_w_down = P.in[27];
    const float* ple_w_proj = P.in[28];
    const float* ple_w_gate = P.in[29];
    float* h = P.out;
    float* ws = P.ws;
    float* regA = ws;
    float* regB = regA + (size_t)TTOK * NPROJ;
    float* regC = regB + (size_t)TTOK * DM;
    float* hid = regC;
    float* kcc = hid + 4080 * 256;
    float* vcc = kcc + 4080 * 64;
    unsigned long long* selmask = (unsigned long long*)(vcc + 4080 * 64);
    int* cnt = (int*)(selmask + 16 * 4096);
    int* lslot = cnt + 64;
    float* lw = (float*)(lslot + 32 * TTOK);
    float* km = lw + 32 * TTOK;
    float* proj = regA;
    float* xn = regB;
    float* att = regB;
    float* blk = regB;
    float* ys = regA;
    float* gate = regA;
    float* qkv1 = regA;

    PHASE_1D(TTOK / 4, d_rmsnorm(x, ln_mix, xn, bx));
    GEMM_PHASE(xn, DM, a_w_in, NPROJ, TTOK, NPROJ, DM, (EpiStore{proj, NPROJ}));
    PHASE_1D(TTOK, d_nsa_post(proj, a_q_norm, a_k_norm, bx));
    PHASE_1D(4080, d_im2col(proj, a_ck_pos, blk, C_KC, bx));
    GEMM_PHASE(blk, 2048, a_ck_w1, 256, 4080, 256, 2048, (EpiGelu{hid, 256}));
    GEMM_PHASE(hid, 256, a_ck_w2, 64, 4080, 64, 256, (EpiStore{kcc, 64}));
    PHASE_1D(1020, d_rms64(kcc, a_k_norm, 4080, bx));
    PHASE_1D(4080, d_im2col(proj, a_cv_pos, blk, C_VC, bx));
    GEMM_PHASE(blk, 2048, a_cv_w1, 256, 4080, 256, 2048, (EpiGelu{hid, 256}));
    GEMM_PHASE(hid, 256, a_cv_w2, 64, 4080, 64, 256, (EpiStore{vcc, 64}));
    PHASE_3D(64, 4, 4, d_nsa_cmp(proj, kcc, vcc, att, selmask, bx, by, bz, smem));
    PHASE_3D(16, 16, 4, d_nsa_selwin(proj, selmask, att, bx, by, bz));
    GEMM_PHASE(att, DM, a_w_out, DM, TTOK, DM, DM, (EpiResid{x, h, DM}));
    for (int layer = 0; layer < 2; ++layer) {
        if (layer == 1) {
            PHASE_1D(TTOK / 4, d_rmsnorm(h, kv_norm, xn, bx));
            GEMM_PHASE(xn, DM, w_kv, 512, TTOK, 512, DM, (EpiStore{qkv1, LD1}));
            PHASE_1D(TTOK / 4, d_rmsnorm(h, ln_mix + DM, xn, bx));
            GEMM_PHASE(xn, DM, b_w_q, DM, TTOK, DM, DM, (EpiStore{qkv1 + 512, LD1}));
            PHASE_1D(TTOK, d_moba_post(qkv1, b_q_norm, k_norm_sh, bx));
            PHASE_3D(16, 4, 4, d_moba_km(qkv1, km, bx, by, bz, smem));
            PHASE_3D(16, 16, 4, d_moba_attn(qkv1, km, att, bx, by, bz));
            GEMM_PHASE(att, DM, b_w_out, DM, TTOK, DM, DM, (EpiResid{h, h, DM}));
        }
        if (blockIdx.x == 0 && threadIdx.x < 64) cnt[threadIdx.x] = 0;
        PHASE_1D(TTOK / 4, d_rmsnorm(h, ln_ffn + layer * DM, xn, bx));
        PHASE_1D(TTOK / 4, d_route(xn, moe_w_group + (size_t)layer * DM * 4, moe_b_group + layer * 4, moe_w_expert + (size_t)layer * DM * 32, moe_b_expert + layer * 32, cnt, lslot, lw, bx));
        PHASE_2D(2048, 32, d_moe(xn, moe_w_gate + (size_t)layer * 32 * 1024 * 128, moe_w_up + (size_t)layer * 32 * 1024 * 128, moe_w_down + (size_t)layer * 32 * 128 * 1024, cnt, lslot, lw, ys, bx, by, smem));
        PHASE_1D(TTOK / 4, d_combine_rmsnorm(h, ys, ln_ple + layer * DM, xn, bx));
        GEMM_PHASE(xn, DM, ple_w_gate + (size_t)layer * DM * DM, DM, TTOK, DM, DM, (EpiSigm{gate, DM}));
        GEMM_PHASE(p + (size_t)layer * TTOK * 256, 256, ple_w_proj + (size_t)layer * 256 * DM, DM, TTOK, DM, 256, (EpiPle{gate, h, DM}));
    }
}

extern "C" void kernel_launch(void* const* d_in, const int* in_sizes, int n_in, void* d_out, int out_size, void* d_ws, size_t ws_size, hipStream_t stream) {
    static int grid_blocks = 0;
    if (!grid_blocks) {
        int dev = 0, cus = 0, per_cu = 0;
        (void)hipGetDevice(&dev);
        (void)hipDeviceGetAttribute(&cus, hipDeviceAttributeMultiprocessorCount, dev);
        (void)hipOccupancyMaxActiveBlocksPerMultiprocessor(&per_cu, (const void*)mega, 256, 0);
        if (per_cu < 1) per_cu = 1;
        if (per_cu > 2) per_cu = 2;
        grid_blocks = cus * per_cu;
    }
    Params P{};
    for (int i = 0; i < 30; ++i) P.in[i] = (const float*)d_in[i];
    P.out = (float*)d_out;
    P.ws = (float*)d_ws;
    void* args[] = {&P};
    hipError_t e = hipLaunchCooperativeKernel((const void*)mega, dim3(grid_blocks), dim3(256), args, 0, stream);
    if (e != hipSuccess) fprintf(stderr, "cooperative launch failed: %s (grid %d)\n", hipGetErrorString(e), grid_blocks);
}
```

```cpp
#include <hip/hip_runtime.h>
#include <hip/hip_cooperative_groups.h>
namespace cg = cooperative_groups;
#include <stdint.h>
#include <math.h>
#include <stdio.h>

#define SEQ 4096
#define BATCH 4
#define TTOK 16384
#define DM 1024
#define NPROJ 2608
#define NCMP 255

#define C_Q 0
#define C_KC 1024
#define C_VC 1280
#define C_KS 1536
#define C_VS 1792
#define C_KW 2048
#define C_VW 2304
#define C_GL 2560

__device__ __forceinline__ float wave_sum(float v) {
#pragma unroll
    for (int o = 32; o > 0; o >>= 1) v += __shfl_xor(v, o);
    return v;
}
__device__ __forceinline__ float gelu_tanh(float x) {
    const float c = 0.7978845608028654f;
    float u = c * (x + 0.044715f * x * x * x);
    return 0.5f * x * (1.f + tanhf(u));
}
__device__ __forceinline__ float sigm(float x) { return 1.f / (1.f + expf(-x)); }

__device__ __forceinline__ void d_rmsnorm(const float* __restrict__ in, const float* __restrict__ gain, float* __restrict__ out, int bx) {
    int row = bx * 4 + (threadIdx.x >> 6), lane = threadIdx.x & 63;
    const float4* p = (const float4*)(in + (size_t)row * DM);
    const float4* g4 = (const float4*)gain;
    float4 v[4]; float ss = 0.f;
#pragma unroll
    for (int i = 0; i < 4; ++i) { v[i] = p[lane + 64 * i]; ss += v[i].x * v[i].x + v[i].y * v[i].y + v[i].z * v[i].z + v[i].w * v[i].w; }
    ss = wave_sum(ss);
    float r = rsqrtf(ss * (1.f / DM) + 1e-6f);
    float4* o = (float4*)(out + (size_t)row * DM);
#pragma unroll
    for (int i = 0; i < 4; ++i) { float4 g = gain ? g4[lane + 64 * i] : make_float4(1.f, 1.f, 1.f, 1.f); float4 w; w.x = v[i].x * r * g.x; w.y = v[i].y * r * g.y; w.z = v[i].z * r * g.z; w.w = v[i].w * r * g.w; o[lane + 64 * i] = w; }
}
__device__ __forceinline__ void d_combine_rmsnorm(float* __restrict__ h, const float* __restrict__ ys, const float* __restrict__ gain, float* __restrict__ out, int bx) {
    int row = bx * 4 + (threadIdx.x >> 6), lane = threadIdx.x & 63;
    float4* p = (float4*)(h + (size_t)row * DM);
    const float4* y0 = (const float4*)(ys + (size_t)row * 2 * DM);
    const float4* y1 = y0 + DM / 4;
    const float4* g4 = (const float4*)gain;
    float4 v[4]; float ss = 0.f;
#pragma unroll
    for (int i = 0; i < 4; ++i) {
        float4 a = p[lane + 64 * i], b = y0[lane + 64 * i], c = y1[lane + 64 * i];
        a.x += b.x + c.x; a.y += b.y + c.y; a.z += b.z + c.z; a.w += b.w + c.w;
        v[i] = a; p[lane + 64 * i] = a;
        ss += a.x * a.x + a.y * a.y + a.z * a.z + a.w * a.w;
    }
    ss = wave_sum(ss);
    float r = rsqrtf(ss * (1.f / DM) + 1e-6f);
    float4* o = (float4*)(out + (size_t)row * DM);
#pragma unroll
    for (int i = 0; i < 4; ++i) { float4 g = g4[lane + 64 * i]; float4 w; w.x = v[i].x * r * g.x; w.y = v[i].y * r * g.y; w.z = v[i].z * r * g.z; w.w = v[i].w * r * g.w; o[lane + 64 * i] = w; }
}

typedef unsigned short bf16_t;
typedef float f32x16 __attribute__((ext_vector_type(16)));
typedef __bf16 bf16x8 __attribute__((ext_vector_type(8)));
typedef __bf16 bf16x2 __attribute__((ext_vector_type(2)));
__device__ __forceinline__ unsigned pk2(float lo, float hi) { bf16x2 v = {(__bf16)lo, (__bf16)hi}; return __builtin_bit_cast(unsigned, v); }
__device__ __forceinline__ uint4 pack8(float4 a, float4 b) { uint4 r; r.x = pk2(a.x, a.y); r.y = pk2(a.z, a.w); r.z = pk2(b.x, b.y); r.w = pk2(b.z, b.w); return r; }

#define LDS_ROW 144
#define TILE_BYTES (128 * LDS_ROW)

template <bool A_F32, class AFn>
__device__ __forceinline__ void gemm_core(AFn afn, const bf16_t* __restrict__ Wt, int ldw, int n0, int K, char* smem, f32x16 (&acc)[2][2]) {
    const int tid = threadIdx.x, lane = tid & 63, wave = tid >> 6;
    const int wn = wave >> 1, wm = wave & 1;
    const int sr = tid >> 3, sc = tid & 7;
    const int c = lane & 31, h = lane >> 5;
    uint4 xa[4], wa[4];
#pragma unroll
    for (int i = 0; i < 2; ++i)
#pragma unroll
        for (int j = 0; j < 2; ++j)
#pragma unroll
            for (int r = 0; r < 16; ++r) acc[i][j][r] = 0.f;
    auto load = [&](int k0) {
#pragma unroll
        for (int i = 0; i < 4; ++i) {
            const int r = sr + 32 * i;
            if (A_F32) {
                const float* p = (const float*)afn(i, r, k0);
                if (p) { float4 f0 = *(const float4*)(p + sc * 8); float4 f1 = *(const float4*)(p + sc * 8 + 4); xa[i] = pack8(f0, f1); }
                else xa[i] = make_uint4(0u, 0u, 0u, 0u);
            } else {
                const bf16_t* p = (const bf16_t*)afn(i, r, k0);
                xa[i] = p ? *(const uint4*)(p + sc * 8) : make_uint4(0u, 0u, 0u, 0u);
            }
            wa[i] = *(const uint4*)(Wt + (size_t)(n0 + r) * ldw + k0 + sc * 8);
        }
    };
    auto store = [&](int buf) {
        char* xb = smem + buf * 2 * TILE_BYTES; char* wb = xb + TILE_BYTES;
#pragma unroll
        for (int i = 0; i < 4; ++i) {
            const int r = sr + 32 * i;
            *(uint4*)(xb + r * LDS_ROW + sc * 16) = xa[i];
            *(uint4*)(wb + r * LDS_ROW + sc * 16) = wa[i];
        }
    };
    const int nk = K >> 6;
    load(0); store(0);
    __syncthreads();
    for (int kt = 0; kt < nk; ++kt) {
        if (kt + 1 < nk) load((kt + 1) * 64);
        const char* xb = smem + (kt & 1) * 2 * TILE_BYTES; const char* wb = xb + TILE_BYTES;
#pragma unroll
        for (int ks = 0; ks < 4; ++ks) {
            bf16x8 wf[2], xf[2];
#pragma unroll
            for (int i = 0; i < 2; ++i) wf[i] = *(const bf16x8*)(wb + (wn * 64 + 32 * i + c) * LDS_ROW + ks * 32 + h * 16);
#pragma unroll
            for (int j = 0; j < 2; ++j) xf[j] = *(const bf16x8*)(xb + (wm * 64 + 32 * j + c) * LDS_ROW + ks * 32 + h * 16);
#pragma unroll
            for (int i = 0; i < 2; ++i)
#pragma unroll
                for (int j = 0; j < 2; ++j) acc[i][j] = __builtin_amdgcn_mfma_f32_32x32x16_bf16(wf[i], xf[j], acc[i][j], 0, 0, 0);
        }
        if (kt + 1 < nk) store((kt + 1) & 1);
        __syncthreads();
    }
}
template <class F>
__device__ __forceinline__ void epi_foreach(const f32x16 (&acc)[2][2], int m0, int n0, F f) {
    const int lane = threadIdx.x & 63, wave = threadIdx.x >> 6;
    const int wn = wave >> 1, wm = wave & 1, c = lane & 31, h = lane >> 5;
#pragma unroll
    for (int i = 0; i < 2; ++i)
#pragma unroll
        for (int j = 0; j < 2; ++j)
#pragma unroll
            for (int q = 0; q < 4; ++q) {
                const int n = n0 + wn * 64 + 32 * i + 8 * q + 4 * h, m = m0 + wm * 64 + 32 * j + c;
                f(m, n, make_float4(acc[i][j][4 * q], acc[i][j][4 * q + 1], acc[i][j][4 * q + 2], acc[i][j][4 * q + 3]));
            }
}
struct EpiStore { float* C; long long ldc; __device__ void operator()(int r, int c, float4 v) const { *(float4*)(C + (size_t)r * ldc + c) = v; } };
struct EpiGelu { float* C; long long ldc; __device__ void operator()(int r, int c, float4 v) const { *(float4*)(C + (size_t)r * ldc + c) = make_float4(gelu_tanh(v.x), gelu_tanh(v.y), gelu_tanh(v.z), gelu_tanh(v.w)); } };
struct EpiSigm { float* C; long long ldc; __device__ void operator()(int r, int c, float4 v) const { *(float4*)(C + (size_t)r * ldc + c) = make_float4(sigm(v.x), sigm(v.y), sigm(v.z), sigm(v.w)); } };
struct EpiResid { const float* R; float* C; long long ldc; __device__ void operator()(int r, int c, float4 v) const { float4 a = *(const float4*)(R + (size_t)r * ldc + c); *(float4*)(C + (size_t)r * ldc + c) = make_float4(a.x + v.x, a.y + v.y, a.z + v.z, a.w + v.w); } };
struct EpiPle { const float* G; float* H; long long ldc; __device__ void operator()(int r, int c, float4 v) const { float4 g = *(const float4*)(G + (size_t)r * ldc + c); float4 a = *(const float4*)(H + (size_t)r * ldc + c); *(float4*)(H + (size_t)r * ldc + c) = make_float4(a.x + g.x * v.x, a.y + g.y * v.y, a.z + g.z * v.z, a.w + g.w * v.w); } };

template <bool A_F32, class Epi>
__device__ __forceinline__ void d_gemm(const void* __restrict__ A, const bf16_t* __restrict__ Wt, long long lda, int M, int N, int K, Epi epi, int bx, int by, char* smem) {
    const int m0 = by * 128, n0 = bx * 128;
    f32x16 acc[2][2];
    gemm_core<A_F32>([&](int i, int r, int k0) -> const void* {
        if (m0 + r >= M) return nullptr;
        return A_F32 ? (const void*)((const float*)A + (size_t)(m0 + r) * lda + k0) : (const void*)((const bf16_t*)A + (size_t)(m0 + r) * lda + k0); }, Wt, K, n0, K, smem, acc);
    epi_foreach(acc, m0, n0, [&](int m, int n, float4 v) { if (m < M && n < N) epi(m, n, v); });
}

struct WJob { const float* src; bf16_t* dst; const float* gain; long long sbs, dbs; int K, N, Npad, batch; };
#define NJOBS 12
__device__ __forceinline__ void wconv_item(const WJob& J, int item, float* lds) {
    const int tid = threadIdx.x, lane = tid & 63;
    const int nt = J.Npad >> 6, kt = J.K >> 6;
    const int bi = item / (nt * kt), rem = item % (nt * kt), kb = rem / nt, nb = rem % nt;
    const float* W = J.src + (size_t)bi * J.sbs;
    bf16_t* D = J.dst + (size_t)bi * J.dbs;
    const int k0 = kb * 64, n0 = nb * 64;
    __syncthreads();
#pragma unroll 4
    for (int p = 0; p < 16; ++p) {
        const int k = p * 4 + (tid >> 6), n = n0 + lane;
        float v = 0.f;
        if (n < J.N) { v = W[(size_t)(k0 + k) * J.N + n]; if (J.gain) v *= J.gain[k0 + k]; }
        lds[k * 65 + lane] = v;
    }
    __syncthreads();
    const int n = tid >> 2, kq = (tid & 3) * 16;
    float f[16];
#pragma unroll
    for (int i = 0; i < 16; ++i) f[i] = lds[(kq + i) * 65 + n];
    uint4 o0, o1;
    o0.x = pk2(f[0], f[1]); o0.y = pk2(f[2], f[3]); o0.z = pk2(f[4], f[5]); o0.w = pk2(f[6], f[7]);
    o1.x = pk2(f[8], f[9]); o1.y = pk2(f[10], f[11]); o1.z = pk2(f[12], f[13]); o1.w = pk2(f[14], f[15]);
    uint4* dp = (uint4*)(D + (size_t)(n0 + n) * J.K + k0 + kq);
    dp[0] = o0; dp[1] = o1;
}

#define LOG2E 1.4426950408889634f
struct L0Bufs { bf16_t *q, *kcr, *vcr, *ks, *vst, *kw, *vwt; float* gates; bf16_t *hidc, *kc, *vct; float* bias1; };

__device__ __forceinline__ float wave_max(float v) {
#pragma unroll
    for (int o = 32; o > 0; o >>= 1) v = fmaxf(v, __shfl_xor(v, o));
    return v;
}

__device__ __forceinline__ void p1_item(const float* __restrict__ xn, const bf16_t* __restrict__ t_w_in, const float* __restrict__ qn, const float* __restrict__ kn,
                                        const L0Bufs& B, int bx, int by, char* smem) {
    const int m0 = by * 128, n0 = bx * 128;
    f32x16 acc[2][2];
    gemm_core<true>([&](int i, int r, int k0) -> const void* { return (const void*)(xn + (size_t)(m0 + r) * DM + k0); }, t_w_in, DM, n0, DM, smem, acc);
    const int lane = threadIdx.x & 63, wave = threadIdx.x >> 6;
    const int wn = wave >> 1, wm = wave & 1, c = lane & 31, h = lane >> 5;
    const int ch = (n0 >> 6) + wn;
#pragma unroll
    for (int j = 0; j < 2; ++j) {
        const int m = m0 + wm * 64 + 32 * j + c;
        const int b = m >> 12, t = m & 4095;
        if (ch < 16 || (ch >= 24 && ch < 28) || (ch >= 32 && ch < 36)) {
            float ss = 0.f;
#pragma unroll
            for (int i = 0; i < 2; ++i)
#pragma unroll
                for (int r = 0; r < 16; ++r) ss += acc[i][j][r] * acc[i][j][r];
            ss += __shfl_xor(ss, 32);
            float rs = rsqrtf(ss * (1.f / 64.f) + 1e-6f);
            const float* g; bf16_t* dst;
            if (ch < 16) { g = qn; rs *= 0.125f * LOG2E; dst = B.q + (size_t)m * 1024 + ch * 64; }
            else if (ch < 28) { g = kn + 64; dst = B.ks + (size_t)m * 256 + (ch - 24) * 64; }
            else { g = kn + 128; dst = B.kw + (size_t)m * 256 + (ch - 32) * 64; }
#pragma unroll
            for (int i = 0; i < 2; ++i)
#pragma unroll
                for (int q4 = 0; q4 < 4; ++q4) {
                    const int nl = 32 * i + 8 * q4 + 4 * h;
                    const float4 gg = *(const float4*)(g + nl);
                    uint2 o;
                    o.x = pk2(acc[i][j][4 * q4] * rs * gg.x, acc[i][j][4 * q4 + 1] * rs * gg.y);
                    o.y = pk2(acc[i][j][4 * q4 + 2] * rs * gg.z, acc[i][j][4 * q4 + 3] * rs * gg.w);
                    *(uint2*)(dst + nl) = o;
                }
        } else if (ch >= 16 && ch < 24) {
            bf16_t* dst = (ch < 20) ? (B.kcr + (size_t)m * 256 + (ch - 16) * 64) : (B.vcr + (size_t)m * 256 + (ch - 20) * 64);
#pragma unroll
            for (int i = 0; i < 2; ++i)
#pragma unroll
                for (int q4 = 0; q4 < 4; ++q4) {
                    const int nl = 32 * i + 8 * q4 + 4 * h;
                    uint2 o;
                    o.x = pk2(acc[i][j][4 * q4], acc[i][j][4 * q4 + 1]);
                    o.y = pk2(acc[i][j][4 * q4 + 2], acc[i][j][4 * q4 + 3]);
                    *(uint2*)(dst + nl) = o;
                }
        } else if ((ch >= 28 && ch < 32) || (ch >= 36 && ch < 40)) {
            const int g = (ch < 32) ? (ch - 28) : (ch - 36);
            bf16_t* dst = ((ch < 32) ? B.vst : B.vwt) + ((size_t)(b * 4 + g) * 64) * SEQ + t;
#pragma unroll
            for (int i = 0; i < 2; ++i)
#pragma unroll
                for (int r = 0; r < 16; ++r) {
                    const int d = 32 * i + (r & 3) + 8 * (r >> 2) + 4 * h;
                    dst[(size_t)d * SEQ] = (bf16_t)(pk2(acc[i][j][r], 0.f) & 0xffffu);
                }
        } else if (ch == 40) {
#pragma unroll
            for (int i = 0; i < 2; ++i)
#pragma unroll
                for (int q4 = 0; q4 < 4; ++q4) {
                    const int nl = 32 * i + 8 * q4 + 4 * h;
                    if (nl < 48) *(float4*)(B.gates + (size_t)m * 48 + nl) = make_float4(sigm(acc[i][j][4 * q4]), sigm(acc[i][j][4 * q4 + 1]), sigm(acc[i][j][4 * q4 + 2]), sigm(acc[i][j][4 * q4 + 3]));
                }
        }
    }
}

__device__ __forceinline__ void p2a_item(const L0Bufs& B, const bf16_t* __restrict__ w1t, int which, int mt, int nt, char* smem) {
    const bf16_t* raw = which ? B.vcr : B.kcr;
    const int sr = threadIdx.x >> 3;
    auto rowbase = [&](int i) -> const bf16_t* {
        const int m = mt * 128 + sr + 32 * i;
        if (m >= 4080) return nullptr;
        const int bg = m / NCMP, n = m - bg * NCMP;
        return raw + ((size_t)((bg >> 2) * SEQ + 16 * n)) * 256 + (bg & 3) * 64;
    };
    const bf16_t* rb0 = rowbase(0); const bf16_t* rb1 = rowbase(1); const bf16_t* rb2 = rowbase(2); const bf16_t* rb3 = rowbase(3);
    f32x16 acc[2][2];
    gemm_core<false>([&](int i, int r, int k0) -> const void* { const bf16_t* rbi = (i == 0) ? rb0 : (i == 1) ? rb1 : (i == 2) ? rb2 : rb3; return rbi ? (const void*)(rbi + (size_t)(k0 >> 6) * 256) : nullptr; }, w1t, 2048, nt * 128, 2048, smem, acc);
    const float* bias = B.bias1 + which * 256;
    bf16_t* hid = B.hidc + (size_t)which * 4096 * 256;
    epi_foreach(acc, mt * 128, nt * 128, [&](int m, int n, float4 v) {
        const float4 bb = *(const float4*)(bias + n);
        uint2 o; o.x = pk2(gelu_tanh(v.x + bb.x), gelu_tanh(v.y + bb.y)); o.y = pk2(gelu_tanh(v.z + bb.z), gelu_tanh(v.w + bb.w));
        *(uint2*)(hid + (size_t)m * 256 + n) = o;
    });
}
__device__ __forceinline__ void p2b_item(const L0Bufs& B, const bf16_t* __restrict__ w2t, const float* __restrict__ kn, int which, int mt, char* smem) {
    const bf16_t* hid = B.hidc + (size_t)which * 4096 * 256;
    f32x16 acc[2][2];
    gemm_core<false>([&](int i, int r, int k0) -> const void* { return (const void*)(hid + (size_t)(mt * 128 + r) * 256 + k0); }, w2t, 256, 0, 256, smem, acc);
    const int lane = threadIdx.x & 63, wave = threadIdx.x >> 6;
    const int wn = wave >> 1, wm = wave & 1, c = lane & 31, h = lane >> 5;
    if (wn != 0) return;
#pragma unroll
    for (int j = 0; j < 2; ++j) {
        const int m = mt * 128 + wm * 64 + 32 * j + c;
        const bool ok = m < 4080;
        const int bg = m / NCMP, n = m - bg * NCMP;
        if (which == 0) {
            float ss = 0.f;
#pragma unroll
            for (int i = 0; i < 2; ++i)
#pragma unroll
                for (int r = 0; r < 16; ++r) ss += acc[i][j][r] * acc[i][j][r];
            ss += __shfl_xor(ss, 32);
            const float rs = rsqrtf(ss * (1.f / 64.f) + 1e-6f);
            if (ok) {
                bf16_t* dst = B.kc + ((size_t)bg * 256 + n) * 64;
#pragma unroll
                for (int i = 0; i < 2; ++i)
#pragma unroll
                    for (int q4 = 0; q4 < 4; ++q4) {
                        const int nl = 32 * i + 8 * q4 + 4 * h;
                        const float4 gg = *(const float4*)(kn + nl);
                        uint2 o;
                        o.x = pk2(acc[i][j][4 * q4] * rs * gg.x, acc[i][j][4 * q4 + 1] * rs * gg.y);
                        o.y = pk2(acc[i][j][4 * q4 + 2] * rs * gg.z, acc[i][j][4 * q4 + 3] * rs * gg.w);
                        *(uint2*)(dst + nl) = o;
                    }
            }
        } else if (ok) {
            bf16_t* dst = B.vct + ((size_t)bg * 64) * 256 + n;
#pragma unroll
            for (int i = 0; i < 2; ++i)
#pragma unroll
                for (int r = 0; r < 16; ++r) {
                    const int d = 32 * i + (r & 3) + 8 * (r >> 2) + 4 * h;
                    dst[(size_t)d * 256] = (bf16_t)(pk2(acc[i][j][r], 0.f) & 0xffffu);
                }
        }
    }
}

#define KROW 144
#define VROW 136
#define KT_BYTES (64 * KROW)
#define ABUF (KT_BYTES + 64 * VROW)
#define ATT_IMP_OFF (2 * ABUF)
#define ATT_MASK_OFF (ATT_IMP_OFF + 32 * 65 * 4)
#define ATT_MISC_OFF (ATT_MASK_OFF + 32 * 8)

struct KVRegs { uint4 k0, k1, v0, v1; };
__device__ __forceinline__ KVRegs attn_load_tile(const bf16_t* K, const bf16_t* VT, int kstride, int vstride, int j) {
    const int row = threadIdx.x >> 2, cq = threadIdx.x & 3;
    KVRegs R;
    const bf16_t* kp = K + (size_t)(j * 64 + row) * kstride + cq * 16;
    R.k0 = *(const uint4*)kp; R.k1 = *(const uint4*)(kp + 8);
    const bf16_t* vp = VT + (size_t)row * vstride + j * 64 + cq * 16;
    R.v0 = *(const uint4*)vp; R.v1 = *(const uint4*)(vp + 8);
    return R;
}
__device__ __forceinline__ void attn_store_tile(char* buf, const KVRegs R) {
    const int row = threadIdx.x >> 2, cq = threadIdx.x & 3;
    char* kd = buf + row * KROW + cq * 32;
    *(uint4*)kd = R.k0; *(uint4*)(kd + 16) = R.k1;
    char* vd = buf + KT_BYTES + row * VROW + cq * 32;
    *(uint2*)vd = make_uint2(R.v0.x, R.v0.y); *(uint2*)(vd + 8) = make_uint2(R.v0.z, R.v0.w);
    *(uint2*)(vd + 16) = make_uint2(R.v1.x, R.v1.y); *(uint2*)(vd + 24) = make_uint2(R.v1.z, R.v1.w);
}
__device__ __forceinline__ void attn_qk(const char* buf, const bf16x8 (&qf)[4], f32x16 (&st)[2]) {
    const int lane = threadIdx.x & 63, cl = lane & 31, hh = lane >> 5;
#pragma unroll
    for (int i = 0; i < 2; ++i) {
#pragma unroll
        for (int r = 0; r < 16; ++r) st[i][r] = 0.f;
#pragma unroll
        for (int ks = 0; ks < 4; ++ks) {
            const bf16x8 kf = *(const bf16x8*)(buf + (32 * i + cl) * KROW + ks * 32 + hh * 16);
            st[i] = __builtin_amdgcn_mfma_f32_32x32x16_bf16(kf, qf[ks], st[i], 0, 0, 0);
        }
    }
}
template <bool MASKED, int PSC>
__device__ __forceinline__ void attn_exp(f32x16 (&st)[2], bf16x8 (&pf)[2][2], float slope2k, float tb, int pos0, int tq, int wlim, float& l) {
#pragma unroll
    for (int i = 0; i < 2; ++i) {
#pragma unroll
        for (int r = 0; r < 16; ++r) {
            const int kl = 32 * i + (r & 3) + 8 * (r >> 2);
            float e = fmaf(slope2k, (float)kl, st[i][r]) + tb;
            if (MASKED) { const int dist = tq - (pos0 + PSC * kl); e = (dist >= 0 && dist < wlim) ? e : -INFINITY; }
            const float p = __builtin_amdgcn_exp2f(e);
            l += p;
            st[i][r] = p;
        }
#pragma unroll
        for (int s = 0; s < 2; ++s) {
            uint4 u;
            u.x = pk2(st[i][8 * s + 0], st[i][8 * s + 1]); u.y = pk2(st[i][8 * s + 2], st[i][8 * s + 3]);
            u.z = pk2(st[i][8 * s + 4], st[i][8 * s + 5]); u.w = pk2(st[i][8 * s + 6], st[i][8 * s + 7]);
            pf[i][s] = __builtin_bit_cast(bf16x8, u);
        }
    }
}
__device__ __forceinline__ void attn_pv(const char* buf, const bf16x8 (&pf)[2][2], f32x16 (&ot)[2]) {
    const int lane = threadIdx.x & 63, cl = lane & 31, hh = lane >> 5;
#pragma unroll
    for (int dt = 0; dt < 2; ++dt)
#pragma unroll
        for (int i = 0; i < 2; ++i)
#pragma unroll
            for (int s = 0; s < 2; ++s) {
                const char* a = buf + KT_BYTES + (32 * dt + cl) * VROW + (32 * i + 16 * s + 4 * hh) * 2;
                const uint2 v0 = *(const uint2*)a, v1 = *(const uint2*)(a + 16);
                const bf16x8 vf = __builtin_bit_cast(bf16x8, make_uint4(v0.x, v0.y, v1.x, v1.y));
                ot[dt] = __builtin_amdgcn_mfma_f32_32x32x16_bf16(vf, pf[i][s], ot[dt], 0, 0, 0);
            }
}

template <int PSC, int POFF>
__device__ __forceinline__ void attn_branch(const bf16_t* SK, const bf16_t* SVT, int kstride, int vstride, unsigned long long tiles, unsigned long long maskbits, unsigned long long lane_mask,
                                            const bf16x8 (&qf)[4], float slope2, float tb0, int tq, int wlim, char* smem, f32x16 (&ot)[2], float& l) {
    const int hh = (threadIdx.x & 63) >> 5;
#pragma unroll
    for (int dt = 0; dt < 2; ++dt)
#pragma unroll
        for (int r = 0; r < 16; ++r) ot[dt][r] = 0.f;
    l = 0.f;
    if (tiles == 0ull) return;
    int j = __builtin_ctzll(tiles); tiles &= tiles - 1;
    KVRegs R = attn_load_tile(SK, SVT, kstride, vstride, j);
    __syncthreads();
    attn_store_tile(smem, R);
    __syncthreads();
    int cur = 0;
    for (;;) {
        const bool more = tiles != 0ull;
        int jn = 0;
        if (more) { jn = __builtin_ctzll(tiles); tiles &= tiles - 1; R = attn_load_tile(SK, SVT, kstride, vstride, jn); }
        const char* buf = smem + cur * ABUF;
        f32x16 st[2]; bf16x8 pf[2][2];
        attn_qk(buf, qf, st);
        const int pos0 = PSC * (64 * j + 4 * hh) + POFF;
        float tb = fmaf(slope2, (float)pos0, tb0);
        if (!((lane_mask >> j) & 1ull)) tb = -INFINITY;
        if ((maskbits >> j) & 1ull) attn_exp<true, PSC>(st, pf, slope2 * (float)PSC, tb, pos0, tq, wlim, l);
        else attn_exp<false, PSC>(st, pf, slope2 * (float)PSC, tb, pos0, tq, wlim, l);
        attn_pv(buf, pf, ot);
        if (more) attn_store_tile(smem + (cur ^ 1) * ABUF, R);
        __syncthreads();
        if (!more) break;
        j = jn; cur ^= 1;
    }
}

__device__ __forceinline__ void nsa_attn_item(const L0Bufs& B, const float* __restrict__ qn, const float* __restrict__ kn, bf16_t* __restrict__ att, int bg, int qb, char* smem) {
    const int tid = threadIdx.x, lane = tid & 63, wave = tid >> 6, cl = lane & 31, hh = lane >> 5;
    const int b = bg >> 2, g = bg & 3, hd = g * 4 + wave;
    const int t0 = qb * 32, c = qb >> 1, tq = t0 + cl;
    const float slope2 = exp2f(-0.5f * (float)(hd + 1)) * LOG2E;
    float* imp = (float*)(smem + ATT_IMP_OFF);
    uint2* msk = (uint2*)(smem + ATT_MASK_OFF);
    const float gq = wave_max(fabsf(qn[lane]));
    const float m2c = (8.f * gq * wave_max(fabsf(kn[lane])) * 1.02f + 0.5f) * LOG2E;
    const float m2s = (8.f * gq * wave_max(fabsf(kn[64 + lane])) * 1.02f + 0.5f) * LOG2E;
    const float m2w = (8.f * gq * wave_max(fabsf(kn[128 + lane])) * 1.02f + 0.5f) * LOG2E;
    bf16x8 qf[4];
    {
        const bf16_t* qp = B.q + (size_t)(b * SEQ + tq) * 1024 + hd * 64 + 8 * hh;
#pragma unroll
        for (int ks = 0; ks < 4; ++ks) qf[ks] = *(const bf16x8*)(qp + ks * 16);
    }
    const float* gp = B.gates + (size_t)(b * SEQ + tq) * 48 + hd * 3;
    const float g0 = gp[0], g1 = gp[1], g2 = gp[2];
    f32x16 res[2], ot[2];
    float l;
    for (int e = tid; e < 32 * 65; e += 256) imp[e] = 0.f;
    const int ntc = (qb >> 5) + 1;
    const unsigned long long ctiles = (1ull << ntc) - 1ull;
    const bf16_t* SCK = B.kc + (size_t)bg * 256 * 64;
    const bf16_t* SCV = B.vct + (size_t)bg * 64 * 256;
    const float tbc = -(slope2 * (float)tq) - m2c;
    attn_branch<16, 31>(SCK, SCV, 64, 256, ctiles, ctiles, ~0ull, qf, slope2, tbc, tq, 1 << 30, smem, ot, l);
    const float lc = l + __shfl_xor(l, 32);
    const float invc = (lc > 0.f) ? 1.f / lc : 0.f;
    {
        const float f = g0 * invc;
#pragma unroll
        for (int dt = 0; dt < 2; ++dt)
#pragma unroll
            for (int r = 0; r < 16; ++r) res[dt][r] = ot[dt][r] * f;
    }
    float wv[4][8], cr[4][8];
#pragma unroll
    for (int jt = 0; jt < 4; ++jt) {
#pragma unroll
        for (int u = 0; u < 8; ++u) { wv[jt][u] = 0.f; cr[jt][u] = 0.f; }
        if (jt < ntc) {
            {
                const int row = tid >> 2, cq = tid & 3;
                const bf16_t* kp = SCK + (size_t)(jt * 64 + row) * 64 + cq * 16;
                const uint4 ka = *(const uint4*)kp, kb = *(const uint4*)(kp + 8);
                __syncthreads();
                char* kd = smem + row * KROW + cq * 32;
                *(uint4*)kd = ka; *(uint4*)(kd + 16) = kb;
                __syncthreads();
            }
            f32x16 st[2];
            attn_qk(smem, qf, st);
            const int pos0 = 16 * (64 * jt + 4 * hh) + 31;
            const float tb = fmaf(slope2, (float)pos0, tbc);
#pragma unroll
            for (int i = 0; i < 2; ++i)
#pragma unroll
                for (int gq4 = 0; gq4 < 4; ++gq4) {
                    float p[4];
#pragma unroll
                    for (int e4 = 0; e4 < 4; ++e4) {
                        const int r = 4 * gq4 + e4;
                        const int kl = 32 * i + (r & 3) + 8 * (r >> 2);
                        float e = fmaf(slope2 * 16.f, (float)kl, st[i][r]) + tb;
                        e = (tq - (pos0 + 16 * kl) >= 0) ? e : -INFINITY;
                        p[e4] = __builtin_amdgcn_exp2f(e) * invc;
                    }
                    wv[jt][i * 4 + gq4] = p[0] + p[1] + p[2] + 0.5f * p[3];
                    cr[jt][i * 4 + gq4] = 0.5f * p[3];
                }
        }
    }
    for (int w = 0; w < 4; ++w) {
        __syncthreads();
        if (wave == w) {
            float* row = imp + cl * 65;
#pragma unroll
            for (int jt = 0; jt < 4; ++jt)
                if (jt < ntc) {
#pragma unroll
                    for (int u = 0; u < 8; ++u) { const int js = 16 * jt + 8 * (u >> 2) + 2 * (u & 3) + hh; row[js] += wv[jt][u]; }
#pragma unroll
                    for (int u = 0; u < 8; ++u) { const int js = 16 * jt + 8 * (u >> 2) + 2 * (u & 3) + hh; row[js + 1] += cr[jt][u]; }
                }
        }
    }
    __syncthreads();
    {
        const int q = tid >> 3, part = tid & 7;
        const float* row = imp + q * 65;
        float myv[8]; int rank[8];
#pragma unroll
        for (int u = 0; u < 8; ++u) { const int j = part * 8 + u; const bool f = (j == 0) || (j == c) || (j == c - 1); myv[u] = f ? 1e9f : row[j]; rank[u] = 0; }
        for (int j2 = 0; j2 <= c; ++j2) {
            const bool f2 = (j2 == 0) || (j2 == c) || (j2 == c - 1);
            const float v2 = f2 ? 1e9f : row[j2];
#pragma unroll
            for (int u = 0; u < 8; ++u) { const int j = part * 8 + u; rank[u] += (v2 > myv[u] || (v2 == myv[u] && j2 < j)) ? 1 : 0; }
        }
        unsigned bits = 0u;
#pragma unroll
        for (int u = 0; u < 8; ++u) { const int j = part * 8 + u; if (j <= c && rank[u] < 16) bits |= 1u << u; }
        unsigned lo = (part < 4) ? (bits << (8 * part)) : 0u, hi = (part >= 4) ? (bits << (8 * (part - 4))) : 0u;
#pragma unroll
        for (int o = 1; o < 8; o <<= 1) { lo |= __shfl_xor(lo, o); hi |= __shfl_xor(hi, o); }
        if (part == 0) msk[q] = make_uint2(lo, hi);
    }
    __syncthreads();
    const uint2 mm = msk[cl];
    const unsigned long long mymask = (unsigned long long)mm.x | ((unsigned long long)mm.y << 32);
    unsigned ulo = mm.x, uhi = mm.y;
#pragma unroll
    for (int o = 1; o < 32; o <<= 1) { ulo |= __shfl_xor(ulo, o); uhi |= __shfl_xor(uhi, o); }
    const unsigned long long U = (unsigned long long)__builtin_amdgcn_readfirstlane(ulo) | ((unsigned long long)__builtin_amdgcn_readfirstlane(uhi) << 32);
    {
        const float tbs = -(slope2 * (float)tq) - m2s;
        attn_branch<1, 0>(B.ks + (size_t)(b * SEQ) * 256 + g * 64, B.vst + (size_t)bg * 64 * SEQ, 256, SEQ, U, 1ull << c, mymask, qf, slope2, tbs, tq, 1 << 30, smem, ot, l);
        const float ls = l + __shfl_xor(l, 32);
        const float f = g1 / ls;
#pragma unroll
        for (int dt = 0; dt < 2; ++dt)
#pragma unroll
            for (int r = 0; r < 16; ++r) res[dt][r] += ot[dt][r] * f;
    }
    {
        const float tbw = -(slope2 * (float)tq) - m2w;
        const int lo_pos = t0 - 511;
        const int jlo = lo_pos > 0 ? (lo_pos >> 6) : 0;
        unsigned long long wt = 0ull, wm = 0ull;
        for (int j = jlo; j <= c; ++j) { wt |= 1ull << j; if (j == c || 64 * j < t0 + 31 - 511) wm |= 1ull << j; }
        attn_branch<1, 0>(B.kw + (size_t)(b * SEQ) * 256 + g * 64, B.vwt + (size_t)bg * 64 * SEQ, 256, SEQ, wt, wm, ~0ull, qf, slope2, tbw, tq, 512, smem, ot, l);
        const float lw_ = l + __shfl_xor(l, 32);
        const float f = g2 / lw_;
#pragma unroll
        for (int dt = 0; dt < 2; ++dt)
#pragma unroll
            for (int r = 0; r < 16; ++r) res[dt][r] += ot[dt][r] * f;
    }
    {
        bf16_t* dst = att + (size_t)(b * SEQ + tq) * 1024 + hd * 64;
#pragma unroll
        for (int dt = 0; dt < 2; ++dt)
#pragma unroll
            for (int q4 = 0; q4 < 4; ++q4) {
                const int d = 32 * dt + 8 * q4 + 4 * hh;
                uint2 o; o.x = pk2(res[dt][4 * q4], res[dt][4 * q4 + 1]); o.y = pk2(res[dt][4 * q4 + 2], res[dt][4 * q4 + 3]);
                *(uint2*)(dst + d) = o;
            }
    }
}

__device__ __forceinline__ void d_route(const float* __restrict__ xn, const float* __restrict__ wg, const float* __restrict__ bg,
                                              const float* __restrict__ we, const float* __restrict__ be,
                                              int* __restrict__ cnt, int* __restrict__ lslot, float* __restrict__ lw, int bx) {
    const int t = bx * 4 + (threadIdx.x >> 6), lane = threadIdx.x & 63;
    const float* xr = xn + (size_t)t * DM;
    float acc[36];
#pragma unroll
    for (int i = 0; i < 36; ++i) acc[i] = 0.f;
    for (int i = 0; i < 16; ++i) {
        const int k = lane + 64 * i;
        const float x = xr[k];
        const float4 g4 = *(const float4*)(wg + (size_t)k * 4);
        acc[0] += x * g4.x; acc[1] += x * g4.y; acc[2] += x * g4.z; acc[3] += x * g4.w;
        const float4* e4 = (const float4*)(we + (size_t)k * 32);
#pragma unroll
        for (int j = 0; j < 8; ++j) { float4 w = e4[j]; acc[4 + 4 * j] += x * w.x; acc[5 + 4 * j] += x * w.y; acc[6 + 4 * j] += x * w.z; acc[7 + 4 * j] += x * w.w; }
    }
#pragma unroll
    for (int i = 0; i < 36; ++i) acc[i] = wave_sum(acc[i]);
    if (lane == 0) {
        float gl[4];
#pragma unroll
        for (int i = 0; i < 4; ++i) gl[i] = acc[i] + bg[i];
        int gi = 0; float gm = gl[0];
#pragma unroll
        for (int i = 1; i < 4; ++i) if (gl[i] > gm) { gm = gl[i]; gi = i; }
        float gs = 0.f;
#pragma unroll
        for (int i = 0; i < 4; ++i) gs += expf(gl[i] - gm);
        const float gw = 1.f / gs;
        float el[8];
#pragma unroll
        for (int e = 0; e < 8; ++e) {
            float v = 0.f;
#pragma unroll
            for (int gg = 0; gg < 4; ++gg) v = (gg == gi) ? (acc[4 + gg * 8 + e] + be[gg * 8 + e]) : v;
            el[e] = v;
        }
        int e1 = 0; float m1 = el[0];
#pragma unroll
        for (int e = 1; e < 8; ++e) if (el[e] > m1) { m1 = el[e]; e1 = e; }
        int e2 = -1; float m2 = -INFINITY;
#pragma unroll
        for (int e = 0; e < 8; ++e) if (e != e1 && el[e] > m2) { m2 = el[e]; e2 = e; }
        const float p2 = expf(m2 - m1);
        const float w1 = gw / (1.f + p2), w2 = gw * p2 / (1.f + p2);
        const int x1 = gi * 8 + e1, x2 = gi * 8 + e2;
        int p1 = atomicAdd(&cnt[x1], 1);
        lslot[x1 * TTOK + p1] = t * 2; lw[x1 * TTOK + p1] = w1;
        int pp2 = atomicAdd(&cnt[x2], 1);
        lslot[x2 * TTOK + pp2] = t * 2 + 1; lw[x2 * TTOK + pp2] = w2;
    }
}

__device__ __forceinline__ void d_moe(const float* __restrict__ xn, const float* __restrict__ wgate, const float* __restrict__ wup, const float* __restrict__ wdown,
                                            const int* __restrict__ cnt, const int* __restrict__ lslot, const float* __restrict__ lw, float* __restrict__ ys, int bx, int by, char* smem) {
    float (*xs)[1024] = (float (*)[1024])smem;
    float (*gu)[8][128] = (float (*)[8][128])(smem + 32768);
    float (*hid)[128] = (float (*)[128])(smem + 32768 + 8192);
    int* sl = (int*)(smem + 32768 + 8192 + 4096);
    float* sw = (float*)(smem + 32768 + 8192 + 4096 + 32);
    const int e = by, chunk = bx, tid = threadIdx.x;
    const int n = cnt[e];
    const int base = chunk * 8;
    if (base >= n) return;
    if (tid < 8) { int i = base + tid; bool ok = i < n; sl[tid] = ok ? lslot[e * TTOK + i] : -1; sw[tid] = ok ? lw[e * TTOK + i] : 0.f; }
    __syncthreads();
    for (int i = 0; i < 8; ++i) {
        int s = sl[i];
        float4 v = make_float4(0.f, 0.f, 0.f, 0.f);
        if (s >= 0) v = *(const float4*)(xn + (size_t)(s >> 1) * DM + tid * 4);
        *(float4*)&xs[i][tid * 4] = v;
    }
    __syncthreads();
    {
        const int col = tid & 127, which = tid >> 7;
        const float* W = (which ? wup : wgate) + (size_t)e * 1024 * 128 + col;
        float acc[8];
#pragma unroll
        for (int i = 0; i < 8; ++i) acc[i] = 0.f;
        for (int k = 0; k < 1024; ++k) {
            const float w = W[(size_t)k * 128];
#pragma unroll
            for (int i = 0; i < 8; ++i) acc[i] += xs[i][k] * w;
        }
#pragma unroll
        for (int i = 0; i < 8; ++i) gu[which][i][col] = acc[i];
    }
    __syncthreads();
    for (int idx = tid; idx < 8 * 128; idx += 256) {
        int i = idx >> 7, f = idx & 127;
        float gg = gu[0][i][f], uu = gu[1][i][f];
        hid[i][f] = (gg / (1.f + expf(-gg))) * uu * sw[i];
    }
    __syncthreads();
    {
        const float* W = wdown + (size_t)e * 128 * 1024 + tid * 4;
        float acc[8][4];
#pragma unroll
        for (int i = 0; i < 8; ++i) { acc[i][0] = 0.f; acc[i][1] = 0.f; acc[i][2] = 0.f; acc[i][3] = 0.f; }
        for (int f = 0; f < 128; ++f) {
            const float4 w = *(const float4*)(W + (size_t)f * 1024);
#pragma unroll
            for (int i = 0; i < 8; ++i) { const float hh = hid[i][f]; acc[i][0] += hh * w.x; acc[i][1] += hh * w.y; acc[i][2] += hh * w.z; acc[i][3] += hh * w.w; }
        }
#pragma unroll
        for (int i = 0; i < 8; ++i) {
            int s = sl[i];
            if (s >= 0) *(float4*)(ys + (size_t)s * DM + tid * 4) = make_float4(acc[i][0], acc[i][1], acc[i][2], acc[i][3]);
        }
    }
}

struct L1Bufs { bf16_t *q, *k, *vt; float* kmpart; };

__device__ __forceinline__ void p7_item(const float* __restrict__ xn, const bf16_t* __restrict__ wt, const float* __restrict__ qn, const float* __restrict__ kn,
                                        const L1Bufs& B, int bx, int by, char* smem) {
    const int m0 = by * 128, n0 = bx * 128;
    f32x16 acc[2][2];
    gemm_core<true>([&](int i, int r, int k0) -> const void* { return (const void*)(xn + (size_t)(m0 + r) * DM + k0); }, wt, DM, n0, DM, smem, acc);
    const int lane = threadIdx.x & 63, wave = threadIdx.x >> 6;
    const int wn = wave >> 1, wm = wave & 1, c = lane & 31, h = lane >> 5;
    const int ch = (n0 >> 6) + wn;
    if (ch < 4 || ch >= 8) {
        const float* g = (ch < 4) ? kn : qn;
        float nv[2][2][16];
#pragma unroll
        for (int j = 0; j < 2; ++j) {
            const int m = m0 + wm * 64 + 32 * j + c;
            float ss = 0.f;
#pragma unroll
            for (int i = 0; i < 2; ++i)
#pragma unroll
                for (int r = 0; r < 16; ++r) ss += acc[i][j][r] * acc[i][j][r];
            ss += __shfl_xor(ss, 32);
            float rs = rsqrtf(ss * (1.f / 64.f) + 1e-6f);
            if (ch >= 8) rs *= 0.125f * LOG2E;
            bf16_t* dst = (ch < 4) ? (B.k + (size_t)m * 256 + ch * 64) : (B.q + (size_t)m * 1024 + (ch - 8) * 64);
#pragma unroll
            for (int i = 0; i < 2; ++i)
#pragma unroll
                for (int q4 = 0; q4 < 4; ++q4) {
                    const int nl = 32 * i + 8 * q4 + 4 * h;
                    const float4 gg = *(const float4*)(g + nl);
                    const float v0 = acc[i][j][4 * q4] * rs * gg.x, v1 = acc[i][j][4 * q4 + 1] * rs * gg.y, v2 = acc[i][j][4 * q4 + 2] * rs * gg.z, v3 = acc[i][j][4 * q4 + 3] * rs * gg.w;
                    nv[i][j][4 * q4] = v0; nv[i][j][4 * q4 + 1] = v1; nv[i][j][4 * q4 + 2] = v2; nv[i][j][4 * q4 + 3] = v3;
                    uint2 o; o.x = pk2(v0, v1); o.y = pk2(v2, v3);
                    *(uint2*)(dst + nl) = o;
                }
        }
        if (ch < 4) {
            const int mb = m0 + wm * 64, b = mb >> 12, grp = (mb & 4095) >> 6;
            float* dst = B.kmpart + ((size_t)(b * 4 + ch) * 64 + grp) * 64;
#pragma unroll
            for (int i = 0; i < 2; ++i)
#pragma unroll
                for (int r = 0; r < 16; ++r) {
                    float s = nv[i][0][r] + nv[i][1][r];
#pragma unroll
                    for (int o = 1; o < 32; o <<= 1) s += __shfl_xor(s, o);
                    if (c == 0) dst[32 * i + (r & 3) + 8 * (r >> 2) + 4 * h] = s;
                }
        }
    } else {
        const int g = ch - 4;
#pragma unroll
        for (int j = 0; j < 2; ++j) {
            const int m = m0 + wm * 64 + 32 * j + c;
            const int b = m >> 12, t = m & 4095;
            bf16_t* dst = B.vt + ((size_t)(b * 4 + g) * 64) * SEQ + t;
#pragma unroll
            for (int i = 0; i < 2; ++i)
#pragma unroll
                for (int r = 0; r < 16; ++r) {
                    const int d = 32 * i + (r & 3) + 8 * (r >> 2) + 4 * h;
                    dst[(size_t)d * SEQ] = (bf16_t)(pk2(acc[i][j][r], 0.f) & 0xffffu);
                }
        }
    }
}

__device__ __forceinline__ void moba_attn_item(const L1Bufs& B, const float* __restrict__ qn, const float* __restrict__ kn, bf16_t* __restrict__ att, int bg, int qb, char* smem) {
    const int tid = threadIdx.x, lane = tid & 63, wave = tid >> 6, cl = lane & 31, hh = lane >> 5;
    const int b = bg >> 2, g = bg & 3, hd = g * 4 + wave;
    const int t0 = qb * 32, c = qb >> 1, cb = qb >> 3, tq = t0 + cl;
    const float slope2 = exp2f(-0.5f * (float)(hd + 1)) * LOG2E;
    float* kms = (float*)(smem + ATT_IMP_OFF);
    unsigned* um = (unsigned*)(smem + ATT_MASK_OFF);
    const float m2 = (8.f * wave_max(fabsf(qn[lane])) * wave_max(fabsf(kn[lane])) * 1.02f + 0.5f) * LOG2E;
    __syncthreads();
    {
        const int n = tid >> 4, d4 = (tid & 15) * 4;
        float4 a = make_float4(0.f, 0.f, 0.f, 0.f);
        if (n < cb) {
            const float* p = B.kmpart + ((size_t)bg * 64 + n * 4) * 64 + d4;
#pragma unroll
            for (int u = 0; u < 4; ++u) { const float4 x = *(const float4*)(p + u * 64); a.x += x.x; a.y += x.y; a.z += x.z; a.w += x.w; }
        }
        const float sc = 1.f / 256.f;
        *(float4*)(kms + n * 64 + d4) = make_float4(a.x * sc, a.y * sc, a.z * sc, a.w * sc);
        if (tid == 0) um[0] = 0u;
    }
    bf16x8 qf[4];
    {
        const bf16_t* qp = B.q + (size_t)(b * SEQ + tq) * 1024 + hd * 64 + 8 * hh;
#pragma unroll
        for (int ks = 0; ks < 4; ++ks) qf[ks] = *(const bf16x8*)(qp + ks * 16);
    }
    __syncthreads();
    float sg[16];
    {
        float qv[32];
#pragma unroll
        for (int ks = 0; ks < 4; ++ks) {
            const uint4 u = __builtin_bit_cast(uint4, qf[ks]);
            qv[ks * 8 + 0] = __uint_as_float(u.x << 16); qv[ks * 8 + 1] = __uint_as_float(u.x & 0xffff0000u);
            qv[ks * 8 + 2] = __uint_as_float(u.y << 16); qv[ks * 8 + 3] = __uint_as_float(u.y & 0xffff0000u);
            qv[ks * 8 + 4] = __uint_as_float(u.z << 16); qv[ks * 8 + 5] = __uint_as_float(u.z & 0xffff0000u);
            qv[ks * 8 + 6] = __uint_as_float(u.w << 16); qv[ks * 8 + 7] = __uint_as_float(u.w & 0xffff0000u);
        }
#pragma unroll
        for (int n = 0; n < 16; ++n) {
            float s = 0.f;
            if (n < cb) {
#pragma unroll
                for (int ks = 0; ks < 4; ++ks) {
                    const float4 k0 = *(const float4*)(kms + n * 64 + ks * 16 + 8 * hh), k1 = *(const float4*)(kms + n * 64 + ks * 16 + 8 * hh + 4);
                    s += qv[ks * 8 + 0] * k0.x + qv[ks * 8 + 1] * k0.y + qv[ks * 8 + 2] * k0.z + qv[ks * 8 + 3] * k0.w
                       + qv[ks * 8 + 4] * k1.x + qv[ks * 8 + 5] * k1.y + qv[ks * 8 + 6] * k1.z + qv[ks * 8 + 7] * k1.w;
                }
                s += __shfl_xor(s, 32);
            } else s = -INFINITY;
            sg[n] = s;
        }
    }
    unsigned bm = 0u;
#pragma unroll
    for (int n = 0; n < 16; ++n) {
        int rank = 0;
#pragma unroll
        for (int n2 = 0; n2 < 16; ++n2) rank += (sg[n2] > sg[n] || (sg[n2] == sg[n] && n2 < n)) ? 1 : 0;
        if (rank < 3 && n < cb) bm |= 1u << n;
    }
    unsigned long long mytiles = 0ull;
#pragma unroll
    for (int n = 0; n < 16; ++n) if ((bm >> n) & 1u) mytiles |= 0xFull << (4 * n);
    unsigned long long own = 0ull;
    for (int j = 4 * cb; j <= c; ++j) own |= 1ull << j;
    mytiles |= own;
    unsigned wb = bm;
#pragma unroll
    for (int o = 1; o < 64; o <<= 1) wb |= __shfl_xor(wb, o);
    if (lane == 0) atomicOr(um, wb);
    __syncthreads();
    const unsigned ub = um[0];
    unsigned long long U = own;
    for (int n = 0; n < 16; ++n) if ((ub >> n) & 1u) U |= 0xFull << (4 * n);
    f32x16 ot[2]; float l;
    const float tb0 = -(slope2 * (float)tq) - m2;
    attn_branch<1, 0>(B.k + (size_t)(b * SEQ) * 256 + g * 64, B.vt + (size_t)bg * 64 * SEQ, 256, SEQ, U, 1ull << c, mytiles, qf, slope2, tb0, tq, 1 << 30, smem, ot, l);
    const float lt = l + __shfl_xor(l, 32);
    const float f = 1.f / lt;
    bf16_t* dst = att + (size_t)(b * SEQ + tq) * 1024 + hd * 64;
#pragma unroll
    for (int dt = 0; dt < 2; ++dt)
#pragma unroll
        for (int q4 = 0; q4 < 4; ++q4) {
            const int d = 32 * dt + 8 * q4 + 4 * hh;
            uint2 o; o.x = pk2(ot[dt][4 * q4] * f, ot[dt][4 * q4 + 1] * f); o.y = pk2(ot[dt][4 * q4 + 2] * f, ot[dt][4 * q4 + 3] * f);
            *(uint2*)(dst + d) = o;
        }
}

struct Params {
    const float* in[30];
    float* out;
    float* ws;
    WJob jobs[NJOBS];
};
#define SMEM_BYTES 73728

#define PHASE_1D(NB, CALL) do { for (int vb = blockIdx.x; vb < (NB); vb += gridDim.x) { const int bx = vb; __syncthreads(); CALL; } grid.sync(); } while (0)
#define PHASE_2D(NX, NY, CALL) do { for (int vb = blockIdx.x; vb < (NX) * (NY); vb += gridDim.x) { const int bx = vb % (NX), by = vb / (NX); __syncthreads(); CALL; } grid.sync(); } while (0)
#define PHASE_3D(NX, NY, NZ, CALL) do { for (int vb = blockIdx.x; vb < (NX) * (NY) * (NZ); vb += gridDim.x) { const int bx = vb % (NX), by = (vb / (NX)) % (NY), bz = vb / ((NX) * (NY)); __syncthreads(); CALL; } grid.sync(); } while (0)
#define GEMM_PHASE(A, lda, WT, M, N, K, EPI) PHASE_2D(((N) + 127) / 128, ((M) + 127) / 128, (d_gemm<true>(A, WT, (long long)(lda), M, N, K, EPI, bx, by, smem)))
#define GEMM_PHASE_B(A, lda, WT, M, N, K, EPI) PHASE_2D(((N) + 127) / 128, ((M) + 127) / 128, (d_gemm<false>(A, WT, (long long)(lda), M, N, K, EPI, bx, by, smem)))

__global__ void __launch_bounds__(256) mega(Params P) {
    cg::grid_group grid = cg::this_grid();
    __shared__ __attribute__((aligned(16))) char smem[SMEM_BYTES];
    const float* x = P.in[0];
    const float* p = P.in[1];
    const float* ln_mix = P.in[2];
    const float* ln_ffn = P.in[3];
    const float* ln_ple = P.in[4];
    const float* a_w_in = P.in[5];
    const float* a_q_norm = P.in[6];
    const float* a_k_norm = P.in[7];
    const float* a_ck_pos = P.in[8];
    const float* a_ck_w1 = P.in[9];
    const float* a_ck_w2 = P.in[10];
    const float* a_cv_pos = P.in[11];
    const float* a_cv_w1 = P.in[12];
    const float* a_cv_w2 = P.in[13];
    const float* a_w_out = P.in[14];
    const float* kv_norm = P.in[15];
    const float* w_kv = P.in[16];
    const float* k_norm_sh = P.in[17];
    const float* b_w_q = P.in[18];
    const float* b_q_norm = P.in[19];
    const float* b_w_out = P.in[20];
    const float* moe_w_group = P.in[21];
    const float* moe_b_group = P.in[22];
    const float* moe_w_expert = P.in[23];
    const float* moe_b_expert = P.in[24];
    const float* moe_w_gate = P.in[25];
    const float* moe_w_up = P.in[26];
    const float* moe_w_down = P.in[27];
    const float* ple_w_proj = P.in[28];
    const float* ple_w_gate = P.in[29];
    float* h = P.out;
    float* ws = P.ws;
    const bf16_t* t_w_in = P.jobs[0].dst;
    const bf16_t* t_ck_w1 = P.jobs[1].dst;
    const bf16_t* t_ck_w2 = P.jobs[2].dst;
    const bf16_t* t_cv_w1 = P.jobs[3].dst;
    const bf16_t* t_cv_w2 = P.jobs[4].dst;
    const bf16_t* t_a_w_out = P.jobs[5].dst;
    const bf16_t* t_w_kv = P.jobs[6].dst;
    const bf16_t* t_b_w_q = P.jobs[7].dst;
    const bf16_t* t_b_w_out = P.jobs[8].dst;
    const bf16_t* t_ple_gate = P.jobs[9].dst;
    const bf16_t* t_ple_proj = P.jobs[10].dst;
    char* wsb = (char*)ws;
    float* regA = ws;
    float* regB = regA + (size_t)TTOK * NPROJ;
    char* regC = (char*)(regB + (size_t)TTOK * DM);
    L0Bufs LB;
    LB.q = (bf16_t*)wsb;
    LB.kcr = (bf16_t*)(wsb + 33554432);
    LB.vcr = LB.kcr + (size_t)TTOK * 256;
    LB.ks = LB.vcr + (size_t)TTOK * 256;
    LB.vst = LB.ks + (size_t)TTOK * 256;
    LB.kw = LB.vst + (size_t)TTOK * 256;
    LB.vwt = LB.kw + (size_t)TTOK * 256;
    LB.gates = (float*)(LB.vwt + (size_t)TTOK * 256);
    LB.hidc = (bf16_t*)((char*)regB + 35651584);
    LB.kc = (bf16_t*)regC;
    LB.vct = (bf16_t*)(regC + 524288);
    LB.bias1 = (float*)(regC + 1048576);
    int* qctr = (int*)(regC + 1050624);
    int* cnt = (int*)(regC + 1050880);
    int* lslot = (int*)(regC + 1051136);
    float* lw = (float*)(regC + 3148288);
    L1Bufs L1B;
    L1B.q = (bf16_t*)wsb;
    L1B.k = (bf16_t*)(wsb + 33554432);
    L1B.vt = L1B.k + (size_t)TTOK * 256;
    L1B.kmpart = (float*)(regC + 5245440);
    float* xn = regB;
    bf16_t* attb = (bf16_t*)regB;
    float* ys = regA;
    float* gate = regA;

    {
        int base = 0;
        for (int j = 0; j < NJOBS; ++j) {
            const WJob& J = P.jobs[j];
            if (J.src == nullptr) continue;
            const int cntj = J.batch * (J.Npad >> 6) * (J.K >> 6);
            int first = ((int)blockIdx.x - base) % (int)gridDim.x; if (first < 0) first += gridDim.x;
            for (int it = first; it < cntj; it += gridDim.x) wconv_item(J, it, (float*)smem);
            base += cntj;
        }
        if ((int)blockIdx.x >= (int)gridDim.x - 2) {
            const int which = (int)gridDim.x - 1 - (int)blockIdx.x;
            const float* pos = which ? a_cv_pos : a_ck_pos;
            const float* w1 = which ? a_cv_w1 : a_ck_w1;
            float a = 0.f;
            for (int k = 0; k < 2048; ++k) a += pos[k] * w1[(size_t)k * 256 + threadIdx.x];
            LB.bias1[which * 256 + threadIdx.x] = a;
        }
        if (blockIdx.x == 0 && threadIdx.x < 64) qctr[threadIdx.x] = 0;
        grid.sync();
    }
    PHASE_1D(TTOK / 4, d_rmsnorm(x, ln_mix, xn, bx));
    PHASE_2D(21, 128, p1_item(xn, t_w_in, a_q_norm, a_k_norm, LB, bx, by, smem));
    PHASE_1D(128, p2a_item(LB, (bx >> 6) ? t_cv_w1 : t_ck_w1, bx >> 6, (bx >> 1) & 31, bx & 1, smem));
    PHASE_1D(64, p2b_item(LB, (bx >> 5) ? t_cv_w2 : t_ck_w2, a_k_norm, bx >> 5, bx & 31, smem));
    {
        int* misc = (int*)(smem + ATT_MISC_OFF);
        for (;;) {
            __syncthreads();
            if (threadIdx.x == 0) misc[0] = atomicAdd(&qctr[0], 1);
            __syncthreads();
            const int id = misc[0];
            if (id >= 2048) break;
            nsa_attn_item(LB, a_q_norm, a_k_norm, attb, id & 15, 127 - (id >> 4), smem);
        }
        grid.sync();
    }
    GEMM_PHASE_B(attb, DM, t_a_w_out, TTOK, DM, DM, (EpiResid{x, h, DM}));
    for (int layer = 0; layer < 2; ++layer) {
        if (layer == 1) {
            PHASE_1D(TTOK / 4, d_rmsnorm(h, nullptr, xn, bx));
            PHASE_2D(12, 128, p7_item(xn, t_w_kv, b_q_norm, k_norm_sh, L1B, bx, by, smem));
            {
                int* misc = (int*)(smem + ATT_MISC_OFF);
                for (;;) {
                    __syncthreads();
                    if (threadIdx.x == 0) misc[0] = atomicAdd(&qctr[1], 1);
                    __syncthreads();
                    const int id = misc[0];
                    if (id >= 2048) break;
                    moba_attn_item(L1B, b_q_norm, k_norm_sh, attb, id & 15, 127 - (id >> 4), smem);
                }
                grid.sync();
            }
            GEMM_PHASE_B(attb, DM, t_b_w_out, TTOK, DM, DM, (EpiResid{h, h, DM}));
        }
        if (blockIdx.x == 0 && threadIdx.x < 64) cnt[threadIdx.x] = 0;
        PHASE_1D(TTOK / 4, d_rmsnorm(h, ln_ffn + layer * DM, xn, bx));
        PHASE_1D(TTOK / 4, d_route(xn, moe_w_group + (size_t)layer * DM * 4, moe_b_group + layer * 4, moe_w_expert + (size_t)layer * DM * 32, moe_b_expert + layer * 32, cnt, lslot, lw, bx));
        PHASE_2D(2048, 32, d_moe(xn, moe_w_gate + (size_t)layer * 32 * 1024 * 128, moe_w_up + (size_t)layer * 32 * 1024 * 128, moe_w_down + (size_t)layer * 32 * 128 * 1024, cnt, lslot, lw, ys, bx, by, smem));
        PHASE_1D(TTOK / 4, d_combine_rmsnorm(h, ys, ln_ple + layer * DM, xn, bx));
        GEMM_PHASE(xn, DM, t_ple_gate + (size_t)layer * DM * DM, TTOK, DM, DM, (EpiSigm{gate, DM}));
        GEMM_PHASE(p + (size_t)layer * TTOK * 256, 256, t_ple_proj + (size_t)layer * 256 * DM, TTOK, DM, 256, (EpiPle{gate, h, DM}));
    }
}

extern "C" void kernel_launch(void* const* d_in, const int* in_sizes, int n_in, void* d_out, int out_size, void* d_ws, size_t ws_size, hipStream_t stream) {
    static int grid_blocks = 0;
    if (!grid_blocks) {
        int dev = 0, cus = 0, per_cu = 0;
        (void)hipGetDevice(&dev);
        (void)hipDeviceGetAttribute(&cus, hipDeviceAttributeMultiprocessorCount, dev);
        (void)hipOccupancyMaxActiveBlocksPerMultiprocessor(&per_cu, (const void*)mega, 256, 0);
        if (per_cu < 1) per_cu = 1;
        if (per_cu > 2) per_cu = 2;
        grid_blocks = cus * per_cu;
    }
    Params P{};
    for (int i = 0; i < 30; ++i) P.in[i] = (const float*)d_in[i];
    P.out = (float*)d_out;
    P.ws = (float*)d_ws;
    {
        size_t off = ((size_t)TTOK * NPROJ + (size_t)TTOK * DM) * 4 + (size_t)8 * 1024 * 1024;
        char* wbase = (char*)d_ws + off;
        size_t wo = 0;
        auto add = [&](int j, const void* src, int K, int N, int Npad, int batch, const float* gain) {
            WJob& J = P.jobs[j];
            J.src = (const float*)src; J.dst = (bf16_t*)(wbase + wo); J.gain = gain;
            J.sbs = (long long)K * N; J.dbs = (long long)Npad * K; J.K = K; J.N = N; J.Npad = Npad; J.batch = batch;
            wo += (size_t)batch * Npad * K * 2;
        };
        add(0, d_in[5], 1024, 2608, 2688, 1, nullptr);
        add(1, d_in[9], 2048, 256, 256, 1, nullptr);
        add(2, d_in[10], 256, 64, 128, 1, nullptr);
        add(3, d_in[12], 2048, 256, 256, 1, nullptr);
        add(4, d_in[13], 256, 64, 128, 1, nullptr);
        add(5, d_in[14], 1024, 1024, 1024, 1, nullptr);
        add(6, d_in[16], 1024, 512, 512, 1, (const float*)d_in[15]);
        add(7, d_in[18], 1024, 1024, 1024, 1, (const float*)d_in[2] + 1024);
        add(8, d_in[20], 1024, 1024, 1024, 1, nullptr);
        add(9, d_in[29], 1024, 1024, 1024, 2, nullptr);
        add(10, d_in[28], 256, 1024, 1024, 2, nullptr);
        if (off + wo > ws_size) { fprintf(stderr, "workspace too small: need %zu have %zu\n", off + wo, ws_size); return; }
    }
    void* args[] = {&P};
    hipError_t e = hipLaunchCooperativeKernel((const void*)mega, dim3(grid_blocks), dim3(256), args, 0, stream);
    if (e != hipSuccess) fprintf(stderr, "cooperative launch failed: %s (grid %d)\n", hipGetErrorString(e), grid_blocks);
}
```

```cpp
#include <hip/hip_runtime.h>
#include <hip/hip_cooperative_groups.h>
namespace cg = cooperative_groups;
#include <stdint.h>
#include <math.h>
#include <stdio.h>

#define SEQ 4096
#define BATCH 4
#define TTOK 16384
#define DM 1024
#define NPROJ 2608
#define NCMP 255

#define C_Q 0
#define C_KC 1024
#define C_VC 1280
#define C_KS 1536
#define C_VS 1792
#define C_KW 2048
#define C_VW 2304
#define C_GL 2560

__device__ __forceinline__ float wave_sum(float v) {
#pragma unroll
    for (int o = 32; o > 0; o >>= 1) v += __shfl_xor(v, o);
    return v;
}
__device__ __forceinline__ int opq_tid() { int t = threadIdx.x; asm volatile("" : "+v"(t)); return t; }
__device__ __forceinline__ float gelu_tanh(float x) {
    const float c = 0.7978845608028654f;
    float u = c * (x + 0.044715f * x * x * x);
    return 0.5f * x * (1.f + tanhf(u));
}
__device__ __forceinline__ float sigm(float x) { return 1.f / (1.f + expf(-x)); }

typedef unsigned short bf16_t;
typedef float f32x16 __attribute__((ext_vector_type(16)));
typedef __bf16 bf16x8 __attribute__((ext_vector_type(8)));
typedef __bf16 bf16x2 __attribute__((ext_vector_type(2)));
__device__ __forceinline__ unsigned pk2(float lo, float hi) { bf16x2 v = {(__bf16)lo, (__bf16)hi}; return __builtin_bit_cast(unsigned, v); }
__device__ __forceinline__ uint4 pack8(float4 a, float4 b) { uint4 r; r.x = pk2(a.x, a.y); r.y = pk2(a.z, a.w); r.z = pk2(b.x, b.y); r.w = pk2(b.z, b.w); return r; }

#define LDS_ROW 144
#define TILE_BYTES (128 * LDS_ROW)

template <bool A_F32, class AFn>
__device__ __forceinline__ void gemm_core(AFn afn, const bf16_t* __restrict__ Wt, int ldw, int n0, int K, char* smem, f32x16 (&acc)[2][2]) {
    const int tid = opq_tid(), lane = tid & 63, wave = tid >> 6;
    const int wn = wave >> 1, wm = wave & 1;
    const int sr = tid >> 3, sc = tid & 7;
    const int c = lane & 31, h = lane >> 5;
    uint4 xa[4], wa[4];
#pragma unroll
    for (int i = 0; i < 2; ++i)
#pragma unroll
        for (int j = 0; j < 2; ++j)
#pragma unroll
            for (int r = 0; r < 16; ++r) acc[i][j][r] = 0.f;
    auto load = [&](int k0) {
#pragma unroll
        for (int i = 0; i < 4; ++i) {
            const int r = sr + 32 * i;
            if (A_F32) {
                const float* p = (const float*)afn(i, r, k0);
                if (p) { float4 f0 = *(const float4*)(p + sc * 8); float4 f1 = *(const float4*)(p + sc * 8 + 4); xa[i] = pack8(f0, f1); }
                else xa[i] = make_uint4(0u, 0u, 0u, 0u);
            } else {
                const bf16_t* p = (const bf16_t*)afn(i, r, k0);
                xa[i] = p ? *(const uint4*)(p + sc * 8) : make_uint4(0u, 0u, 0u, 0u);
            }
            wa[i] = *(const uint4*)(Wt + (size_t)(n0 + r) * ldw + k0 + sc * 8);
        }
    };
    auto store = [&](int buf) {
        char* xb = smem + buf * 2 * TILE_BYTES; char* wb = xb + TILE_BYTES;
#pragma unroll
        for (int i = 0; i < 4; ++i) {
            const int r = sr + 32 * i;
            *(uint4*)(xb + r * LDS_ROW + sc * 16) = xa[i];
            *(uint4*)(wb + r * LDS_ROW + sc * 16) = wa[i];
        }
    };
    const int nk = K >> 6;
    load(0); store(0);
    __syncthreads();
    for (int kt = 0; kt < nk; ++kt) {
        if (kt + 1 < nk) load((kt + 1) * 64);
        const char* xb = smem + (kt & 1) * 2 * TILE_BYTES; const char* wb = xb + TILE_BYTES;
#pragma unroll
        for (int ks = 0; ks < 4; ++ks) {
            bf16x8 wf[2], xf[2];
#pragma unroll
            for (int i = 0; i < 2; ++i) wf[i] = *(const bf16x8*)(wb + (wn * 64 + 32 * i + c) * LDS_ROW + ks * 32 + h * 16);
#pragma unroll
            for (int j = 0; j < 2; ++j) xf[j] = *(const bf16x8*)(xb + (wm * 64 + 32 * j + c) * LDS_ROW + ks * 32 + h * 16);
#pragma unroll
            for (int i = 0; i < 2; ++i)
#pragma unroll
                for (int j = 0; j < 2; ++j) acc[i][j] = __builtin_amdgcn_mfma_f32_32x32x16_bf16(wf[i], xf[j], acc[i][j], 0, 0, 0);
        }
        if (kt + 1 < nk) store((kt + 1) & 1);
        __syncthreads();
    }
}
template <class F>
__device__ __forceinline__ void epi_foreach(const f32x16 (&acc)[2][2], int m0, int n0, F f) {
    const int tid_ = opq_tid(), lane = tid_ & 63, wave = tid_ >> 6;
    const int wn = wave >> 1, wm = wave & 1, c = lane & 31, h = lane >> 5;
#pragma unroll
    for (int i = 0; i < 2; ++i)
#pragma unroll
        for (int j = 0; j < 2; ++j)
#pragma unroll
            for (int q = 0; q < 4; ++q) {
                const int n = n0 + wn * 64 + 32 * i + 8 * q + 4 * h, m = m0 + wm * 64 + 32 * j + c;
                f(m, n, make_float4(acc[i][j][4 * q], acc[i][j][4 * q + 1], acc[i][j][4 * q + 2], acc[i][j][4 * q + 3]));
            }
}
struct EpiStore { float* C; long long ldc; __device__ void operator()(int r, int c, float4 v) const { *(float4*)(C + (size_t)r * ldc + c) = v; } };
struct EpiGelu { float* C; long long ldc; __device__ void operator()(int r, int c, float4 v) const { *(float4*)(C + (size_t)r * ldc + c) = make_float4(gelu_tanh(v.x), gelu_tanh(v.y), gelu_tanh(v.z), gelu_tanh(v.w)); } };
struct EpiSigm { float* C; long long ldc; __device__ void operator()(int r, int c, float4 v) const { *(float4*)(C + (size_t)r * ldc + c) = make_float4(sigm(v.x), sigm(v.y), sigm(v.z), sigm(v.w)); } };
struct EpiResid { const float* R; float* C; long long ldc; __device__ void operator()(int r, int c, float4 v) const { float4 a = *(const float4*)(R + (size_t)r * ldc + c); *(float4*)(C + (size_t)r * ldc + c) = make_float4(a.x + v.x, a.y + v.y, a.z + v.z, a.w + v.w); } };
struct EpiPle { const float* G; float* H; long long ldc; __device__ void operator()(int r, int c, float4 v) const { float4 g = *(const float4*)(G + (size_t)r * ldc + c); float4 a = *(const float4*)(H + (size_t)r * ldc + c); *(float4*)(H + (size_t)r * ldc + c) = make_float4(a.x + g.x * v.x, a.y + g.y * v.y, a.z + g.z * v.z, a.w + g.w * v.w); } };

template <bool A_F32, class Epi>
__device__ __forceinline__ void d_gemm(const void* __restrict__ A, const bf16_t* __restrict__ Wt, long long lda, int M, int N, int K, Epi epi, int bx, int by, char* smem) {
    const int m0 = by * 128, n0 = bx * 128;
    f32x16 acc[2][2];
    gemm_core<A_F32>([&](int i, int r, int k0) -> const void* {
        if (m0 + r >= M) return nullptr;
        return A_F32 ? (const void*)((const float*)A + (size_t)(m0 + r) * lda + k0) : (const void*)((const bf16_t*)A + (size_t)(m0 + r) * lda + k0); }, Wt, K, n0, K, smem, acc);
    epi_foreach(acc, m0, n0, [&](int m, int n, float4 v) { if (m < M && n < N) epi(m, n, v); });
}

struct WJob { const float* src; bf16_t* dst; const float* gain; long long sbs, dbs; int K, N, Npad, batch, perm, gbs; };
#define NJOBS 20
__device__ __forceinline__ void wconv_item(const WJob& J, int item, float* lds) {
    const int tid = opq_tid(), lane = tid & 63;
    const int nt = J.Npad >> 6, kt = J.K >> 6;
    const int bi = item / (nt * kt), rem = item % (nt * kt), kb = rem / nt, nb = rem % nt;
    const float* W = J.src + (size_t)bi * J.sbs;
    bf16_t* D = J.dst + (size_t)bi * J.dbs;
    const int k0 = kb * 64, n0 = nb * 64;
    __syncthreads();
#pragma unroll 4
    for (int p = 0; p < 16; ++p) {
        const int k = p * 4 + (tid >> 6), n = n0 + lane;
        float v = 0.f;
        if (n < J.N) { v = W[(size_t)(k0 + k) * J.N + n]; if (J.gain) v *= J.gain[(size_t)bi * J.gbs + k0 + k]; }
        lds[k * 65 + lane] = v;
    }
    __syncthreads();
    const int n = tid >> 2, kq = (tid & 3) * 16;
    float f[16];
#pragma unroll
    for (int i = 0; i < 16; ++i) f[i] = lds[(kq + i) * 65 + n];
    uint4 o0, o1;
    o0.x = pk2(f[0], f[1]); o0.y = pk2(f[2], f[3]); o0.z = pk2(f[4], f[5]); o0.w = pk2(f[6], f[7]);
    o1.x = pk2(f[8], f[9]); o1.y = pk2(f[10], f[11]); o1.z = pk2(f[12], f[13]); o1.w = pk2(f[14], f[15]);
    int drow = n0 + n;
    if (J.perm) drow = (drow >> 5) * 64 + (J.perm - 1) * 32 + (drow & 31);
    uint4* dp = (uint4*)(D + (size_t)drow * J.K + k0 + kq);
    dp[0] = o0; dp[1] = o1;
}

#define LOG2E 1.4426950408889634f
struct L0Bufs { bf16_t *q, *kcr, *vcr, *ks, *vst, *kw, *vwt; float* gates; bf16_t *hidc, *kc, *vct; float* bias1; };

__device__ __forceinline__ float wave_max(float v) {
#pragma unroll
    for (int o = 32; o > 0; o >>= 1) v = fmaxf(v, __shfl_xor(v, o));
    return v;
}

__device__ __forceinline__ void p1_item(const bf16_t* __restrict__ xn, const bf16_t* __restrict__ t_w_in, const float* __restrict__ qn, const float* __restrict__ kn,
                                        const L0Bufs& B, int bx, int by, char* smem) {
    const int m0 = by * 128, n0 = bx * 128;
    f32x16 acc[2][2];
    gemm_core<false>([&](int i, int r, int k0) -> const void* { return (const void*)(xn + (size_t)(m0 + r) * DM + k0); }, t_w_in, DM, n0, DM, smem, acc);
    const int tid_ = opq_tid(), lane = tid_ & 63, wave = tid_ >> 6;
    const int wn = wave >> 1, wm = wave & 1, c = lane & 31, h = lane >> 5;
    const int ch = (n0 >> 6) + wn;
#pragma unroll
    for (int j = 0; j < 2; ++j) {
        const int m = m0 + wm * 64 + 32 * j + c;
        const int b = m >> 12, t = m & 4095;
        if (ch < 16 || (ch >= 24 && ch < 28) || (ch >= 32 && ch < 36)) {
            float ss = 0.f;
#pragma unroll
            for (int i = 0; i < 2; ++i)
#pragma unroll
                for (int r = 0; r < 16; ++r) ss += acc[i][j][r] * acc[i][j][r];
            ss += __shfl_xor(ss, 32);
            float rs = rsqrtf(ss * (1.f / 64.f) + 1e-6f);
            const float* g; bf16_t* dst;
            if (ch < 16) { g = qn; rs *= 0.125f * LOG2E; dst = B.q + (size_t)m * 1024 + ch * 64; }
            else if (ch < 28) { g = kn + 64; dst = B.ks + (size_t)m * 256 + (ch - 24) * 64; }
            else { g = kn + 128; dst = B.kw + (size_t)m * 256 + (ch - 32) * 64; }
#pragma unroll
            for (int i = 0; i < 2; ++i)
#pragma unroll
                for (int q4 = 0; q4 < 4; ++q4) {
                    const int nl = 32 * i + 8 * q4 + 4 * h;
                    const float4 gg = *(const float4*)(g + nl);
                    uint2 o;
                    o.x = pk2(acc[i][j][4 * q4] * rs * gg.x, acc[i][j][4 * q4 + 1] * rs * gg.y);
                    o.y = pk2(acc[i][j][4 * q4 + 2] * rs * gg.z, acc[i][j][4 * q4 + 3] * rs * gg.w);
                    *(uint2*)(dst + nl) = o;
                }
        } else if (ch >= 16 && ch < 24) {
            bf16_t* dst = (ch < 20) ? (B.kcr + (size_t)m * 256 + (ch - 16) * 64) : (B.vcr + (size_t)m * 256 + (ch - 20) * 64);
#pragma unroll
            for (int i = 0; i < 2; ++i)
#pragma unroll
                for (int q4 = 0; q4 < 4; ++q4) {
                    const int nl = 32 * i + 8 * q4 + 4 * h;
                    uint2 o;
                    o.x = pk2(acc[i][j][4 * q4], acc[i][j][4 * q4 + 1]);
                    o.y = pk2(acc[i][j][4 * q4 + 2], acc[i][j][4 * q4 + 3]);
                    *(uint2*)(dst + nl) = o;
                }
        } else if ((ch >= 28 && ch < 32) || (ch >= 36 && ch < 40)) {
            const int g = (ch < 32) ? (ch - 28) : (ch - 36);
            bf16_t* dst = ((ch < 32) ? B.vst : B.vwt) + ((size_t)(b * 4 + g) * 64) * SEQ + t;
#pragma unroll
            for (int i = 0; i < 2; ++i)
#pragma unroll
                for (int r = 0; r < 16; ++r) {
                    const int d = 32 * i + (r & 3) + 8 * (r >> 2) + 4 * h;
                    dst[(size_t)d * SEQ] = (bf16_t)(pk2(acc[i][j][r], 0.f) & 0xffffu);
                }
        } else if (ch == 40) {
#pragma unroll
            for (int i = 0; i < 2; ++i)
#pragma unroll
                for (int q4 = 0; q4 < 4; ++q4) {
                    const int nl = 32 * i + 8 * q4 + 4 * h;
                    if (nl < 48) *(float4*)(B.gates + (size_t)m * 48 + nl) = make_float4(sigm(acc[i][j][4 * q4]), sigm(acc[i][j][4 * q4 + 1]), sigm(acc[i][j][4 * q4 + 2]), sigm(acc[i][j][4 * q4 + 3]));
                }
        }
    }
}

__device__ __forceinline__ void p2a_item(const L0Bufs& B, const bf16_t* __restrict__ w1t, int which, int mt, int nt, char* smem) {
    const bf16_t* raw = which ? B.vcr : B.kcr;
    const int sr = opq_tid() >> 3;
    auto rowbase = [&](int i) -> const bf16_t* {
        const int m = mt * 128 + sr + 32 * i;
        if (m >= 4080) return nullptr;
        const int bg = m / NCMP, n = m - bg * NCMP;
        return raw + ((size_t)((bg >> 2) * SEQ + 16 * n)) * 256 + (bg & 3) * 64;
    };
    const bf16_t* rb0 = rowbase(0); const bf16_t* rb1 = rowbase(1); const bf16_t* rb2 = rowbase(2); const bf16_t* rb3 = rowbase(3);
    f32x16 acc[2][2];
    gemm_core<false>([&](int i, int r, int k0) -> const void* { const bf16_t* rbi = (i == 0) ? rb0 : (i == 1) ? rb1 : (i == 2) ? rb2 : rb3; return rbi ? (const void*)(rbi + (size_t)(k0 >> 6) * 256) : nullptr; }, w1t, 2048, nt * 128, 2048, smem, acc);
    const float* bias = B.bias1 + which * 256;
    bf16_t* hid = B.hidc + (size_t)which * 4096 * 256;
    epi_foreach(acc, mt * 128, nt * 128, [&](int m, int n, float4 v) {
        const float4 bb = *(const float4*)(bias + n);
        uint2 o; o.x = pk2(gelu_tanh(v.x + bb.x), gelu_tanh(v.y + bb.y)); o.y = pk2(gelu_tanh(v.z + bb.z), gelu_tanh(v.w + bb.w));
        *(uint2*)(hid + (size_t)m * 256 + n) = o;
    });
}
__device__ __forceinline__ void p2b_item(const L0Bufs& B, const bf16_t* __restrict__ w2t, const float* __restrict__ kn, int which, int mt, char* smem) {
    const bf16_t* hid = B.hidc + (size_t)which * 4096 * 256;
    f32x16 acc[2][2];
    gemm_core<false>([&](int i, int r, int k0) -> const void* { return (const void*)(hid + (size_t)(mt * 128 + r) * 256 + k0); }, w2t, 256, 0, 256, smem, acc);
    const int tid_ = opq_tid(), lane = tid_ & 63, wave = tid_ >> 6;
    const int wn = wave >> 1, wm = wave & 1, c = lane & 31, h = lane >> 5;
    if (wn != 0) return;
#pragma unroll
    for (int j = 0; j < 2; ++j) {
        const int m = mt * 128 + wm * 64 + 32 * j + c;
        const bool ok = m < 4080;
        const int bg = m / NCMP, n = m - bg * NCMP;
        if (which == 0) {
            float ss = 0.f;
#pragma unroll
            for (int i = 0; i < 2; ++i)
#pragma unroll
                for (int r = 0; r < 16; ++r) ss += acc[i][j][r] * acc[i][j][r];
            ss += __shfl_xor(ss, 32);
            const float rs = rsqrtf(ss * (1.f / 64.f) + 1e-6f);
            if (ok) {
                bf16_t* dst = B.kc + ((size_t)bg * 256 + n) * 64;
#pragma unroll
                for (int i = 0; i < 2; ++i)
#pragma unroll
                    for (int q4 = 0; q4 < 4; ++q4) {
                        const int nl = 32 * i + 8 * q4 + 4 * h;
                        const float4 gg = *(const float4*)(kn + nl);
                        uint2 o;
                        o.x = pk2(acc[i][j][4 * q4] * rs * gg.x, acc[i][j][4 * q4 + 1] * rs * gg.y);
                        o.y = pk2(acc[i][j][4 * q4 + 2] * rs * gg.z, acc[i][j][4 * q4 + 3] * rs * gg.w);
                        *(uint2*)(dst + nl) = o;
                    }
            }
        } else if (ok) {
            bf16_t* dst = B.vct + ((size_t)bg * 64) * 256 + n;
#pragma unroll
            for (int i = 0; i < 2; ++i)
#pragma unroll
                for (int r = 0; r < 16; ++r) {
                    const int d = 32 * i + (r & 3) + 8 * (r >> 2) + 4 * h;
                    dst[(size_t)d * 256] = (bf16_t)(pk2(acc[i][j][r], 0.f) & 0xffffu);
                }
        }
    }
}

#define KROW 144
#define VROW 136
#define KT_BYTES (64 * KROW)
#define ABUF (KT_BYTES + 64 * VROW)
#define ATT_IMP_OFF (2 * ABUF)
#define ATT_MASK_OFF (ATT_IMP_OFF + 4 * 32 * 65 * 4)
#define ATT_MISC_OFF (ATT_MASK_OFF + 32 * 8)

struct KVRegs { uint4 k0, k1, v0, v1; };
typedef unsigned int u32x4 __attribute__((ext_vector_type(4)));
__device__ __forceinline__ uint4 bload16(__amdgpu_buffer_rsrc_t r, unsigned voff, unsigned soff) { const u32x4 v = __builtin_amdgcn_raw_buffer_load_b128(r, voff, soff, 0); return make_uint4(v.x, v.y, v.z, v.w); }
__device__ __forceinline__ KVRegs attn_load_tile(__amdgpu_buffer_rsrc_t rK, __amdgpu_buffer_rsrc_t rV, unsigned koff, unsigned voff, int kstride, int j) {
    KVRegs R;
    const unsigned ks = (unsigned)j * 128u * (unsigned)kstride, vs = (unsigned)j * 128u;
    R.k0 = bload16(rK, koff, ks); R.k1 = bload16(rK, koff + 16u, ks);
    R.v0 = bload16(rV, voff, vs); R.v1 = bload16(rV, voff + 16u, vs);
    return R;
}
__device__ __forceinline__ void attn_store_tile(char* buf, const KVRegs R, int tid) {
    const int row = tid >> 2, cq = tid & 3;
    char* kd = buf + row * KROW + cq * 32;
    *(uint4*)kd = R.k0; *(uint4*)(kd + 16) = R.k1;
    char* vd = buf + KT_BYTES + row * VROW + cq * 32;
    *(uint2*)vd = make_uint2(R.v0.x, R.v0.y); *(uint2*)(vd + 8) = make_uint2(R.v0.z, R.v0.w);
    *(uint2*)(vd + 16) = make_uint2(R.v1.x, R.v1.y); *(uint2*)(vd + 24) = make_uint2(R.v1.z, R.v1.w);
}
__device__ __forceinline__ void attn_qk(const char* buf, const bf16x8 (&qf)[4], f32x16 (&st)[2], int tid) {
    const int lane = tid & 63, cl = lane & 31, hh = lane >> 5;
#pragma unroll
    for (int i = 0; i < 2; ++i) {
#pragma unroll
        for (int r = 0; r < 16; ++r) st[i][r] = 0.f;
#pragma unroll
        for (int ks = 0; ks < 4; ++ks) {
            const bf16x8 kf = *(const bf16x8*)(buf + (32 * i + cl) * KROW + ks * 32 + hh * 16);
            st[i] = __builtin_amdgcn_mfma_f32_32x32x16_bf16(kf, qf[ks], st[i], 0, 0, 0);
        }
    }
}
template <bool MASKED, int PSC>
__device__ __forceinline__ void attn_exp(f32x16 (&st)[2], bf16x8 (&pf)[2][2], float slope2k, float tb, int pos0, int tq, int wlim, float& l) {
#pragma unroll
    for (int i = 0; i < 2; ++i) {
#pragma unroll
        for (int r = 0; r < 16; ++r) {
            const int kl = 32 * i + (r & 3) + 8 * (r >> 2);
            float e = fmaf(slope2k, (float)kl, st[i][r]) + tb;
            if (MASKED) { const int dist = tq - (pos0 + PSC * kl); e = (dist >= 0 && dist < wlim) ? e : -INFINITY; }
            const float p = __builtin_amdgcn_exp2f(e);
            l += p;
            st[i][r] = p;
        }
#pragma unroll
        for (int s = 0; s < 2; ++s) {
            uint4 u;
            u.x = pk2(st[i][8 * s + 0], st[i][8 * s + 1]); u.y = pk2(st[i][8 * s + 2], st[i][8 * s + 3]);
            u.z = pk2(st[i][8 * s + 4], st[i][8 * s + 5]); u.w = pk2(st[i][8 * s + 6], st[i][8 * s + 7]);
            pf[i][s] = __builtin_bit_cast(bf16x8, u);
        }
    }
}
__device__ __forceinline__ void attn_pv(const char* buf, const bf16x8 (&pf)[2][2], f32x16 (&ot)[2], int tid) {
    const int lane = tid & 63, cl = lane & 31, hh = lane >> 5;
#pragma unroll
    for (int dt = 0; dt < 2; ++dt)
#pragma unroll
        for (int i = 0; i < 2; ++i)
#pragma unroll
            for (int s = 0; s < 2; ++s) {
                const char* a = buf + KT_BYTES + (32 * dt + cl) * VROW + (32 * i + 16 * s + 4 * hh) * 2;
                const uint2 v0 = *(const uint2*)a, v1 = *(const uint2*)(a + 16);
                const bf16x8 vf = __builtin_bit_cast(bf16x8, make_uint4(v0.x, v0.y, v1.x, v1.y));
                ot[dt] = __builtin_amdgcn_mfma_f32_32x32x16_bf16(vf, pf[i][s], ot[dt], 0, 0, 0);
            }
}

template <int PSC, int POFF>
__device__ __forceinline__ void attn_branch(const bf16_t* SK, const bf16_t* SVT, int kstride, int vstride, unsigned long long tiles, unsigned long long maskbits, unsigned long long lane_mask,
                                            const bf16x8 (&qf)[4], float slope2, float tb0, int tq, int wlim, char* smem, f32x16 (&ot)[2], float& l, int tid) {
    const int hh = (tid & 63) >> 5;
#pragma unroll
    for (int dt = 0; dt < 2; ++dt)
#pragma unroll
        for (int r = 0; r < 16; ++r) ot[dt][r] = 0.f;
    l = 0.f;
    if (tiles == 0ull) return;
    const __amdgpu_buffer_rsrc_t rK = __builtin_amdgcn_make_buffer_rsrc((void*)SK, 0, 0x7fffffff, 0x00020000);
    const __amdgpu_buffer_rsrc_t rV = __builtin_amdgcn_make_buffer_rsrc((void*)SVT, 0, 0x7fffffff, 0x00020000);
    const unsigned koff = (((unsigned)tid >> 2) * (unsigned)kstride + ((unsigned)tid & 3) * 16u) * 2u, voff = (((unsigned)tid >> 2) * (unsigned)vstride + ((unsigned)tid & 3) * 16u) * 2u;
    int j = __builtin_ctzll(tiles); tiles &= tiles - 1;
    KVRegs R = attn_load_tile(rK, rV, koff, voff, kstride, j);
    __syncthreads();
    attn_store_tile(smem, R, tid);
    __syncthreads();
    int cur = 0;
    for (;;) {
        const bool more = tiles != 0ull;
        int jn = 0;
        if (more) { jn = __builtin_ctzll(tiles); tiles &= tiles - 1; R = attn_load_tile(rK, rV, koff, voff, kstride, jn); }
        const char* buf = smem + cur * ABUF;
        f32x16 st[2]; bf16x8 pf[2][2];
        attn_qk(buf, qf, st, tid);
        const int pos0 = PSC * (64 * j + 4 * hh) + POFF;
        float tb = fmaf(slope2, (float)pos0, tb0);
        if (!((lane_mask >> j) & 1ull)) tb = -INFINITY;
        if ((maskbits >> j) & 1ull) attn_exp<true, PSC>(st, pf, slope2 * (float)PSC, tb, pos0, tq, wlim, l);
        else attn_exp<false, PSC>(st, pf, slope2 * (float)PSC, tb, pos0, tq, wlim, l);
        attn_pv(buf, pf, ot, tid);
        if (more) attn_store_tile(smem + (cur ^ 1) * ABUF, R, tid);
        __syncthreads();
        if (!more) break;
        j = jn; cur ^= 1;
    }
}

__device__ __forceinline__ void nsa_attn_item(const L0Bufs& B, const float* __restrict__ qn, const float* __restrict__ kn, bf16_t* __restrict__ att, int bg, int qb, char* smem) {
    const int tid = opq_tid();
    const int lane = tid & 63, wave = tid >> 6, cl = lane & 31, hh = lane >> 5;
    const int b = bg >> 2, g = bg & 3, hd = g * 4 + wave;
    const int t0 = qb * 32, c = qb >> 1, tq = t0 + cl;
    const float slope2 = exp2f(-0.5f * (float)(hd + 1)) * LOG2E;
    float* imp = (float*)(smem + ATT_IMP_OFF);
    uint2* msk = (uint2*)(smem + ATT_MASK_OFF);
    const float gq = wave_max(fabsf(qn[lane]));
    const float m2c = (8.f * gq * wave_max(fabsf(kn[lane])) * 1.02f + 0.5f) * LOG2E;
    const float m2s = (8.f * gq * wave_max(fabsf(kn[64 + lane])) * 1.02f + 0.5f) * LOG2E;
    const float m2w = (8.f * gq * wave_max(fabsf(kn[128 + lane])) * 1.02f + 0.5f) * LOG2E;
    bf16x8 qf[4];
    {
        const bf16_t* qp = B.q + (size_t)(b * SEQ + tq) * 1024 + hd * 64 + 8 * hh;
#pragma unroll
        for (int ks = 0; ks < 4; ++ks) qf[ks] = *(const bf16x8*)(qp + ks * 16);
    }
    const float* gp = B.gates + (size_t)(b * SEQ + tq) * 48 + hd * 3;
    const float g0 = gp[0], g1 = gp[1], g2 = gp[2];
    f32x16 res[2], ot[2];
    float l;
    for (int e = tid; e < 4 * 32 * 65; e += 256) imp[e] = 0.f;
    const int ntc = (qb >> 5) + 1;
    const unsigned long long ctiles = (1ull << ntc) - 1ull;
    const bf16_t* SCK = B.kc + (size_t)bg * 256 * 64;
    const bf16_t* SCV = B.vct + (size_t)bg * 64 * 256;
    const float tbc = -(slope2 * (float)tq) - m2c;
    attn_branch<16, 31>(SCK, SCV, 64, 256, ctiles, ctiles, ~0ull, qf, slope2, tbc, tq, 1 << 30, smem, ot, l, tid);
    const float lc = l + __shfl_xor(l, 32);
    const float invc = (lc > 0.f) ? 1.f / lc : 0.f;
    {
        const float f = g0 * invc;
#pragma unroll
        for (int dt = 0; dt < 2; ++dt)
#pragma unroll
            for (int r = 0; r < 16; ++r) res[dt][r] = ot[dt][r] * f;
    }
    {
        float* row = imp + wave * (32 * 65) + cl * 65;
        for (int jt = 0; jt < ntc; ++jt) {
            {
                const int rowi = tid >> 2, cq = tid & 3;
                const bf16_t* kp = SCK + (size_t)(jt * 64 + rowi) * 64 + cq * 16;
                const uint4 ka = *(const uint4*)kp, kb = *(const uint4*)(kp + 8);
                __syncthreads();
                char* kd = smem + rowi * KROW + cq * 32;
                *(uint4*)kd = ka; *(uint4*)(kd + 16) = kb;
                __syncthreads();
            }
            f32x16 st[2];
            attn_qk(smem, qf, st, tid);
            const int pos0 = 16 * (64 * jt + 4 * hh) + 31;
            const float tb = fmaf(slope2, (float)pos0, tbc);
#pragma unroll
            for (int i = 0; i < 2; ++i)
#pragma unroll
                for (int gq4 = 0; gq4 < 4; ++gq4) {
                    float p[4];
#pragma unroll
                    for (int e4 = 0; e4 < 4; ++e4) {
                        const int r = 4 * gq4 + e4;
                        const int kl = 32 * i + (r & 3) + 8 * (r >> 2);
                        float e = fmaf(slope2 * 16.f, (float)kl, st[i][r]) + tb;
                        e = (tq - (pos0 + 16 * kl) >= 0) ? e : -INFINITY;
                        p[e4] = __builtin_amdgcn_exp2f(e) * invc;
                    }
                    const int js = 16 * jt + 8 * i + 2 * gq4 + hh;
                    row[js] += p[0] + p[1] + p[2] + 0.5f * p[3];
                    st[i][4 * gq4] = 0.5f * p[3];
                }
            __builtin_amdgcn_s_waitcnt(0xc07f);
#pragma unroll
            for (int i = 0; i < 2; ++i)
#pragma unroll
                for (int gq4 = 0; gq4 < 4; ++gq4) { const int js = 16 * jt + 8 * i + 2 * gq4 + hh; row[js + 1] += st[i][4 * gq4]; }
        }
    }
    __syncthreads();
    {
        const int q = tid >> 3, part = tid & 7;
        const float* row = imp + q * 65;
        auto impv = [&](int j) -> float { return ((row[j] + row[j + 32 * 65]) + row[j + 2 * 32 * 65]) + row[j + 3 * 32 * 65]; };
        float myv[8]; int rank[8];
#pragma unroll
        for (int u = 0; u < 8; ++u) { const int j = part * 8 + u; const bool f = (j == 0) || (j == c) || (j == c - 1); myv[u] = f ? 1e9f : impv(j); rank[u] = 0; }
        for (int j2 = 0; j2 <= c; ++j2) {
            const bool f2 = (j2 == 0) || (j2 == c) || (j2 == c - 1);
            const float v2 = f2 ? 1e9f : impv(j2);
#pragma unroll
            for (int u = 0; u < 8; ++u) { const int j = part * 8 + u; rank[u] += (v2 > myv[u] || (v2 == myv[u] && j2 < j)) ? 1 : 0; }
        }
        unsigned bits = 0u;
#pragma unroll
        for (int u = 0; u < 8; ++u) { const int j = part * 8 + u; if (j <= c && rank[u] < 16) bits |= 1u << u; }
        unsigned lo = (part < 4) ? (bits << (8 * part)) : 0u, hi = (part >= 4) ? (bits << (8 * (part - 4))) : 0u;
#pragma unroll
        for (int o = 1; o < 8; o <<= 1) { lo |= __shfl_xor(lo, o); hi |= __shfl_xor(hi, o); }
        if (part == 0) msk[q] = make_uint2(lo, hi);
    }
    __syncthreads();
    const uint2 mm = msk[cl];
    const unsigned long long mymask = (unsigned long long)mm.x | ((unsigned long long)mm.y << 32);
    unsigned ulo = mm.x, uhi = mm.y;
#pragma unroll
    for (int o = 1; o < 32; o <<= 1) { ulo |= __shfl_xor(ulo, o); uhi |= __shfl_xor(uhi, o); }
    const unsigned long long U = (unsigned long long)__builtin_amdgcn_readfirstlane(ulo) | ((unsigned long long)__builtin_amdgcn_readfirstlane(uhi) << 32);
    {
        const float tbs = -(slope2 * (float)tq) - m2s;
        attn_branch<1, 0>(B.ks + (size_t)(b * SEQ) * 256 + g * 64, B.vst + (size_t)bg * 64 * SEQ, 256, SEQ, U, 1ull << c, mymask, qf, slope2, tbs, tq, 1 << 30, smem, ot, l, tid);
        const float ls = l + __shfl_xor(l, 32);
        const float f = g1 / ls;
#pragma unroll
        for (int dt = 0; dt < 2; ++dt)
#pragma unroll
            for (int r = 0; r < 16; ++r) res[dt][r] += ot[dt][r] * f;
    }
    {
        const float tbw = -(slope2 * (float)tq) - m2w;
        const int lo_pos = t0 - 511;
        const int jlo = lo_pos > 0 ? (lo_pos >> 6) : 0;
        unsigned long long wt = 0ull, wm = 0ull;
        for (int j = jlo; j <= c; ++j) { wt |= 1ull << j; if (j == c || 64 * j < t0 + 31 - 511) wm |= 1ull << j; }
        attn_branch<1, 0>(B.kw + (size_t)(b * SEQ) * 256 + g * 64, B.vwt + (size_t)bg * 64 * SEQ, 256, SEQ, wt, wm, ~0ull, qf, slope2, tbw, tq, 512, smem, ot, l, tid);
        const float lw_ = l + __shfl_xor(l, 32);
        const float f = g2 / lw_;
#pragma unroll
        for (int dt = 0; dt < 2; ++dt)
#pragma unroll
            for (int r = 0; r < 16; ++r) res[dt][r] += ot[dt][r] * f;
    }
    {
        const int tid2 = opq_tid();
        bf16_t* dst = att + (size_t)(b * SEQ + t0 + (tid2 & 31)) * 1024 + (g * 4 + (tid2 >> 6)) * 64;
#pragma unroll
        for (int dt = 0; dt < 2; ++dt)
#pragma unroll
            for (int q4 = 0; q4 < 4; ++q4) {
                const int d = 32 * dt + 8 * q4 + 4 * hh;
                uint2 o; o.x = pk2(res[dt][4 * q4], res[dt][4 * q4 + 1]); o.y = pk2(res[dt][4 * q4 + 2], res[dt][4 * q4 + 3]);
                *(uint2*)(dst + d) = o;
            }
    }
}

__device__ __forceinline__ float bf16_lo_f(unsigned u) { return __uint_as_float(u << 16); }
__device__ __forceinline__ float bf16_hi_f(unsigned u) { return __uint_as_float(u & 0xffff0000u); }

template <bool COMBINE, bool LO>
__device__ __forceinline__ void rp_row(const float* __restrict__ in_row, float* __restrict__ hw_row, const bf16_t* __restrict__ ys_row, bf16_t* __restrict__ hi_row, bf16_t* __restrict__ lo_row) {
    const int lane = opq_tid() & 63;
    const float4* p = (const float4*)in_row;
    float4 v[4]; float ss = 0.f;
#pragma unroll
    for (int i = 0; i < 4; ++i) {
        float4 a = p[lane + 64 * i];
        if (COMBINE) {
            const uint2 b = ((const uint2*)ys_row)[lane + 64 * i], c = ((const uint2*)(ys_row + DM))[lane + 64 * i];
            a.x += bf16_lo_f(b.x) + bf16_lo_f(c.x); a.y += bf16_hi_f(b.x) + bf16_hi_f(c.x);
            a.z += bf16_lo_f(b.y) + bf16_lo_f(c.y); a.w += bf16_hi_f(b.y) + bf16_hi_f(c.y);
            ((float4*)hw_row)[lane + 64 * i] = a;
        }
        v[i] = a;
        ss += a.x * a.x + a.y * a.y + a.z * a.z + a.w * a.w;
    }
    ss = wave_sum(ss);
    const float r = rsqrtf(ss * (1.f / DM) + 1e-6f);
#pragma unroll
    for (int i = 0; i < 4; ++i) {
        const float a0 = v[i].x * r, a1 = v[i].y * r, a2 = v[i].z * r, a3 = v[i].w * r;
        uint2 o; o.x = pk2(a0, a1); o.y = pk2(a2, a3);
        ((uint2*)hi_row)[lane + 64 * i] = o;
        if (LO) {
            uint2 q; q.x = pk2(a0 - bf16_lo_f(o.x), a1 - bf16_hi_f(o.x)); q.y = pk2(a2 - bf16_lo_f(o.y), a3 - bf16_hi_f(o.y));
            ((uint2*)lo_row)[lane + 64 * i] = q;
        }
    }
}

__device__ __forceinline__ void rw_build(const float* __restrict__ wg, const float* __restrict__ we, const float* __restrict__ gain, bf16_t* __restrict__ dst, int start, int stride) {
    for (int idx = start; idx < 128 * 1024; idx += stride) {
        const int n = idx >> 10, k = idx & 1023;
        float v = 0.f;
        if (n < 4) v = wg[k * 4 + n] * gain[k];
        else if (n < 36) v = we[k * 32 + (n - 4)] * gain[k];
        const unsigned hi = pk2(v, 0.f) & 0xffffu;
        const unsigned lo = pk2(v - bf16_lo_f(hi), 0.f) & 0xffffu;
        dst[(size_t)n * 3072 + k] = (bf16_t)hi; dst[(size_t)n * 3072 + 1024 + k] = (bf16_t)lo; dst[(size_t)n * 3072 + 2048 + k] = (bf16_t)hi;
    }
}

__device__ __forceinline__ void route_item(const float* __restrict__ h, bf16_t* __restrict__ xhi, bf16_t* __restrict__ xlo, const bf16_t* __restrict__ wr,
                                           const float* __restrict__ bgp, const float* __restrict__ bep, float* __restrict__ rlog,
                                           int* __restrict__ cnt, int* __restrict__ lslot, float* __restrict__ lw, int mt, char* smem) {
    const int tid = opq_tid(), wave = tid >> 6;
    const int m0 = mt * 128;
    for (int r = 0; r < 32; ++r) {
        const size_t row = (size_t)(m0 + wave * 32 + r);
        rp_row<false, true>(h + row * DM, nullptr, nullptr, xhi + row * DM, xlo + row * DM);
    }
    __syncthreads();
    f32x16 acc[2][2];
    gemm_core<false>([&](int i, int r, int k0) -> const void* {
        const size_t row = (size_t)(m0 + r) * DM;
        return (k0 < 2048) ? (const void*)(xhi + row + (k0 & 1023)) : (const void*)(xlo + row + (k0 - 2048)); }, wr, 3072, 0, 3072, smem, acc);
    epi_foreach(acc, m0, 0, [&](int m, int n, float4 v) { if (n < 64) *(float4*)(rlog + (size_t)m * 64 + n) = v; });
    __syncthreads();
    if (tid < 128) {
        const int t = m0 + tid;
        const float* lg = rlog + (size_t)t * 64;
        float gl[4];
#pragma unroll
        for (int i = 0; i < 4; ++i) gl[i] = lg[i] + bgp[i];
        int gi = 0; float gm = gl[0];
#pragma unroll
        for (int i = 1; i < 4; ++i) if (gl[i] > gm) { gm = gl[i]; gi = i; }
        float gs = 0.f;
#pragma unroll
        for (int i = 0; i < 4; ++i) gs += expf(gl[i] - gm);
        const float gw = 1.f / gs;
        float el[8];
#pragma unroll
        for (int e = 0; e < 8; ++e) el[e] = lg[4 + gi * 8 + e] + bep[gi * 8 + e];
        int e1 = 0; float m1 = el[0];
#pragma unroll
        for (int e = 1; e < 8; ++e) if (el[e] > m1) { m1 = el[e]; e1 = e; }
        int e2 = -1; float m2 = -INFINITY;
#pragma unroll
        for (int e = 0; e < 8; ++e) if (e != e1 && el[e] > m2) { m2 = el[e]; e2 = e; }
        const float p2 = expf(m2 - m1);
        const float w1 = gw / (1.f + p2), w2 = gw * p2 / (1.f + p2);
        const int x1 = gi * 8 + e1, x2 = gi * 8 + e2;
        const int p1 = atomicAdd(&cnt[x1], 1);
        lslot[x1 * TTOK + p1] = t * 2; lw[x1 * TTOK + p1] = w1;
        const int pp2 = atomicAdd(&cnt[x2], 1);
        lslot[x2 * TTOK + pp2] = t * 2 + 1; lw[x2 * TTOK + pp2] = w2;
    }
}

__device__ __forceinline__ void ple_item(const bf16_t* __restrict__ xhat, const bf16_t* __restrict__ wg, const float* __restrict__ pin, const bf16_t* __restrict__ wp,
                                         float* __restrict__ h, int bx, int by, char* smem) {
    const int m0 = by * 128, n0 = bx * 128;
    unsigned gp[2][2][8];
    {
        f32x16 acc[2][2];
        gemm_core<false>([&](int i, int r, int k0) -> const void* { return (const void*)(xhat + (size_t)(m0 + r) * DM + k0); }, wg, DM, n0, DM, smem, acc);
#pragma unroll
        for (int i = 0; i < 2; ++i)
#pragma unroll
            for (int j = 0; j < 2; ++j)
#pragma unroll
                for (int r2 = 0; r2 < 8; ++r2) gp[i][j][r2] = pk2(1.f / (1.f + __expf(-acc[i][j][2 * r2])), 1.f / (1.f + __expf(-acc[i][j][2 * r2 + 1])));
    }
    f32x16 acc[2][2];
    gemm_core<true>([&](int i, int r, int k0) -> const void* { return (const void*)(pin + (size_t)(m0 + r) * 256 + k0); }, wp, 256, n0, 256, smem, acc);
    const int tid_ = opq_tid(), lane = tid_ & 63, wave = tid_ >> 6;
    const int wn = wave >> 1, wm = wave & 1, c = lane & 31, hh = lane >> 5;
#pragma unroll
    for (int i = 0; i < 2; ++i)
#pragma unroll
        for (int j = 0; j < 2; ++j)
#pragma unroll
            for (int q4 = 0; q4 < 4; ++q4) {
                const int n = n0 + wn * 64 + 32 * i + 8 * q4 + 4 * hh, m = m0 + wm * 64 + 32 * j + c;
                float4* hp = (float4*)(h + (size_t)m * DM + n);
                float4 a = *hp;
                const unsigned g0 = gp[i][j][2 * q4], g1 = gp[i][j][2 * q4 + 1];
                a.x += bf16_lo_f(g0) * acc[i][j][4 * q4]; a.y += bf16_hi_f(g0) * acc[i][j][4 * q4 + 1];
                a.z += bf16_lo_f(g1) * acc[i][j][4 * q4 + 2]; a.w += bf16_hi_f(g1) * acc[i][j][4 * q4 + 3];
                *hp = a;
            }
}

#define HROW 272
#define MOE_W_OFF 36864
template <bool A_F32>
__device__ __forceinline__ void moe_item(const void* __restrict__ xn, const bf16_t* __restrict__ wgu, const bf16_t* __restrict__ wd,
                                         const int* __restrict__ slots, const float* __restrict__ wts, int nvalid, bf16_t* __restrict__ ys, char* smem) {
    const int tid = opq_tid(), lane = tid & 63, wave = tid >> 6;
    const int wn = wave >> 1, wm = wave & 1, c = lane & 31, h = lane >> 5;
    const int sr = tid >> 3, sc = tid & 7;
    auto rowp = [&](int i) -> const char* {
        const int idx = sr + 32 * i;
        if (idx >= nvalid) return nullptr;
        const int tok = slots[idx] >> 1;
        return (const char*)xn + (size_t)tok * 1024 * (A_F32 ? 4 : 2);
    };
    const char* rp0 = rowp(0); const char* rp1 = rowp(1); const char* rp2 = rowp(2); const char* rp3 = rowp(3);
    float cw[2]; int myslot[2];
#pragma unroll
    for (int j = 0; j < 2; ++j) {
        const int idx = wm * 64 + 32 * j + c;
        const bool ok = idx < nvalid;
        cw[j] = ok ? wts[idx] : 0.f;
        myslot[j] = ok ? slots[idx] : -1;
    }
    unsigned hp[2][2][8];
#pragma unroll
    for (int pass = 0; pass < 2; ++pass) {
        f32x16 acc[2][2];
        gemm_core<A_F32>([&](int i, int r, int k0) -> const void* {
            const char* p = (i == 0) ? rp0 : (i == 1) ? rp1 : (i == 2) ? rp2 : rp3;
            return p ? (const void*)(p + (size_t)k0 * (A_F32 ? 4 : 2)) : nullptr; }, wgu, 1024, pass * 128, 1024, smem, acc);
#pragma unroll
        for (int j = 0; j < 2; ++j)
#pragma unroll
            for (int r2 = 0; r2 < 8; ++r2) {
                const float g0 = acc[0][j][2 * r2], g1 = acc[0][j][2 * r2 + 1];
                const float u0 = acc[1][j][2 * r2], u1 = acc[1][j][2 * r2 + 1];
                const float h0 = g0 / (1.f + __expf(-g0)) * u0 * cw[j], h1 = g1 / (1.f + __expf(-g1)) * u1 * cw[j];
                hp[pass][j][r2] = pk2(h0, h1);
            }
    }
#pragma unroll
    for (int pass = 0; pass < 2; ++pass)
#pragma unroll
        for (int j = 0; j < 2; ++j)
#pragma unroll
            for (int q4 = 0; q4 < 4; ++q4) {
                const int m = wm * 64 + 32 * j + c, f = pass * 64 + wn * 32 + 8 * q4 + 4 * h;
                *(uint2*)(smem + m * HROW + f * 2) = make_uint2(hp[pass][j][2 * q4], hp[pass][j][2 * q4 + 1]);
            }
    uint4 wa0, wa1, wa2, wa3;
    auto wload = [&](int s) {
        const int nt = s >> 1, kt = s & 1;
        const bf16_t* p = wd + (size_t)(nt * 128 + sr) * 128 + kt * 64 + sc * 8;
        wa0 = *(const uint4*)p; wa1 = *(const uint4*)(p + 32 * 128); wa2 = *(const uint4*)(p + 64 * 128); wa3 = *(const uint4*)(p + 96 * 128);
    };
    auto wstore = [&](int buf) {
        char* wb = smem + MOE_W_OFF + buf * TILE_BYTES + sr * LDS_ROW + sc * 16;
        *(uint4*)wb = wa0; *(uint4*)(wb + 32 * LDS_ROW) = wa1; *(uint4*)(wb + 64 * LDS_ROW) = wa2; *(uint4*)(wb + 96 * LDS_ROW) = wa3;
    };
    wload(0); wstore(0);
    __syncthreads();
    f32x16 acc[2][2];
    for (int s = 0; s < 16; ++s) {
        const int kt = s & 1;
        if (kt == 0) {
#pragma unroll
            for (int i = 0; i < 2; ++i)
#pragma unroll
                for (int j = 0; j < 2; ++j)
#pragma unroll
                    for (int r = 0; r < 16; ++r) acc[i][j][r] = 0.f;
        }
        if (s + 1 < 16) wload(s + 1);
        const char* wb = smem + MOE_W_OFF + (s & 1) * TILE_BYTES;
#pragma unroll
        for (int ks = 0; ks < 4; ++ks) {
            bf16x8 wf[2], xf[2];
#pragma unroll
            for (int i = 0; i < 2; ++i) wf[i] = *(const bf16x8*)(wb + (wn * 64 + 32 * i + c) * LDS_ROW + ks * 32 + h * 16);
#pragma unroll
            for (int j = 0; j < 2; ++j) xf[j] = *(const bf16x8*)(smem + (wm * 64 + 32 * j + c) * HROW + kt * 128 + ks * 32 + h * 16);
#pragma unroll
            for (int i = 0; i < 2; ++i)
#pragma unroll
                for (int j = 0; j < 2; ++j) acc[i][j] = __builtin_amdgcn_mfma_f32_32x32x16_bf16(wf[i], xf[j], acc[i][j], 0, 0, 0);
        }
        if (s + 1 < 16) wstore((s + 1) & 1);
        if (kt == 1) {
            const int nt = s >> 1;
#pragma unroll
            for (int j = 0; j < 2; ++j) {
                if (myslot[j] >= 0) {
                    bf16_t* dst = ys + (size_t)myslot[j] * 1024 + nt * 128 + wn * 64;
#pragma unroll
                    for (int i = 0; i < 2; ++i)
#pragma unroll
                        for (int q4 = 0; q4 < 4; ++q4) {
                            uint2 o; o.x = pk2(acc[i][j][4 * q4], acc[i][j][4 * q4 + 1]); o.y = pk2(acc[i][j][4 * q4 + 2], acc[i][j][4 * q4 + 3]);
                            *(uint2*)(dst + 32 * i + 8 * q4 + 4 * h) = o;
                        }
                }
            }
        }
        __syncthreads();
    }
}

struct L1Bufs { bf16_t *q, *k, *vt; float* kmpart; };

__device__ __forceinline__ void p7_item(const bf16_t* __restrict__ xn, const bf16_t* __restrict__ wt, const float* __restrict__ qn, const float* __restrict__ kn,
                                        const L1Bufs& B, int bx, int by, char* smem) {
    const int m0 = by * 128, n0 = bx * 128;
    f32x16 acc[2][2];
    gemm_core<false>([&](int i, int r, int k0) -> const void* { return (const void*)(xn + (size_t)(m0 + r) * DM + k0); }, wt, DM, n0, DM, smem, acc);
    const int tid_ = opq_tid(), lane = tid_ & 63, wave = tid_ >> 6;
    const int wn = wave >> 1, wm = wave & 1, c = lane & 31, h = lane >> 5;
    const int ch = (n0 >> 6) + wn;
    if (ch < 4 || ch >= 8) {
        const float* g = (ch < 4) ? kn : qn;
        float nv[2][2][16];
#pragma unroll
        for (int j = 0; j < 2; ++j) {
            const int m = m0 + wm * 64 + 32 * j + c;
            float ss = 0.f;
#pragma unroll
            for (int i = 0; i < 2; ++i)
#pragma unroll
                for (int r = 0; r < 16; ++r) ss += acc[i][j][r] * acc[i][j][r];
            ss += __shfl_xor(ss, 32);
            float rs = rsqrtf(ss * (1.f / 64.f) + 1e-6f);
            if (ch >= 8) rs *= 0.125f * LOG2E;
            bf16_t* dst = (ch < 4) ? (B.k + (size_t)m * 256 + ch * 64) : (B.q + (size_t)m * 1024 + (ch - 8) * 64);
#pragma unroll
            for (int i = 0; i < 2; ++i)
#pragma unroll
                for (int q4 = 0; q4 < 4; ++q4) {
                    const int nl = 32 * i + 8 * q4 + 4 * h;
                    const float4 gg = *(const float4*)(g + nl);
                    const float v0 = acc[i][j][4 * q4] * rs * gg.x, v1 = acc[i][j][4 * q4 + 1] * rs * gg.y, v2 = acc[i][j][4 * q4 + 2] * rs * gg.z, v3 = acc[i][j][4 * q4 + 3] * rs * gg.w;
                    nv[i][j][4 * q4] = v0; nv[i][j][4 * q4 + 1] = v1; nv[i][j][4 * q4 + 2] = v2; nv[i][j][4 * q4 + 3] = v3;
                    uint2 o; o.x = pk2(v0, v1); o.y = pk2(v2, v3);
                    *(uint2*)(dst + nl) = o;
                }
        }
        if (ch < 4) {
            const int mb = m0 + wm * 64, b = mb >> 12, grp = (mb & 4095) >> 6;
            float* dst = B.kmpart + ((size_t)(b * 4 + ch) * 64 + grp) * 64;
#pragma unroll
            for (int i = 0; i < 2; ++i)
#pragma unroll
                for (int r = 0; r < 16; ++r) {
                    float s = nv[i][0][r] + nv[i][1][r];
#pragma unroll
                    for (int o = 1; o < 32; o <<= 1) s += __shfl_xor(s, o);
                    if (c == 0) dst[32 * i + (r & 3) + 8 * (r >> 2) + 4 * h] = s;
                }
        }
    } else {
        const int g = ch - 4;
#pragma unroll
        for (int j = 0; j < 2; ++j) {
            const int m = m0 + wm * 64 + 32 * j + c;
            const int b = m >> 12, t = m & 4095;
            bf16_t* dst = B.vt + ((size_t)(b * 4 + g) * 64) * SEQ + t;
#pragma unroll
            for (int i = 0; i < 2; ++i)
#pragma unroll
                for (int r = 0; r < 16; ++r) {
                    const int d = 32 * i + (r & 3) + 8 * (r >> 2) + 4 * h;
                    dst[(size_t)d * SEQ] = (bf16_t)(pk2(acc[i][j][r], 0.f) & 0xffffu);
                }
        }
    }
}

__device__ __forceinline__ void moba_attn_item(const L1Bufs& B, const float* __restrict__ qn, const float* __restrict__ kn, bf16_t* __restrict__ att, int bg, int qb, char* smem) {
    const int tid = opq_tid();
    const int lane = tid & 63, wave = tid >> 6, cl = lane & 31, hh = lane >> 5;
    const int b = bg >> 2, g = bg & 3, hd = g * 4 + wave;
    const int t0 = qb * 32, c = qb >> 1, cb = qb >> 3, tq = t0 + cl;
    const float slope2 = exp2f(-0.5f * (float)(hd + 1)) * LOG2E;
    float* kms = (float*)(smem + ATT_IMP_OFF);
    unsigned* um = (unsigned*)(smem + ATT_MASK_OFF);
    const float m2 = (8.f * wave_max(fabsf(qn[lane])) * wave_max(fabsf(kn[lane])) * 1.02f + 0.5f) * LOG2E;
    __syncthreads();
    {
        const int n = tid >> 4, d4 = (tid & 15) * 4;
        float4 a = make_float4(0.f, 0.f, 0.f, 0.f);
        if (n < cb) {
            const float* p = B.kmpart + ((size_t)bg * 64 + n * 4) * 64 + d4;
#pragma unroll
            for (int u = 0; u < 4; ++u) { const float4 x = *(const float4*)(p + u * 64); a.x += x.x; a.y += x.y; a.z += x.z; a.w += x.w; }
        }
        const float sc = 1.f / 256.f;
        *(float4*)(kms + n * 64 + d4) = make_float4(a.x * sc, a.y * sc, a.z * sc, a.w * sc);
        if (tid == 0) um[0] = 0u;
    }
    bf16x8 qf[4];
    {
        const bf16_t* qp = B.q + (size_t)(b * SEQ + tq) * 1024 + hd * 64 + 8 * hh;
#pragma unroll
        for (int ks = 0; ks < 4; ++ks) qf[ks] = *(const bf16x8*)(qp + ks * 16);
    }
    __syncthreads();
    float sg[16];
    {
        float qv[32];
#pragma unroll
        for (int ks = 0; ks < 4; ++ks) {
            const uint4 u = __builtin_bit_cast(uint4, qf[ks]);
            qv[ks * 8 + 0] = __uint_as_float(u.x << 16); qv[ks * 8 + 1] = __uint_as_float(u.x & 0xffff0000u);
            qv[ks * 8 + 2] = __uint_as_float(u.y << 16); qv[ks * 8 + 3] = __uint_as_float(u.y & 0xffff0000u);
            qv[ks * 8 + 4] = __uint_as_float(u.z << 16); qv[ks * 8 + 5] = __uint_as_float(u.z & 0xffff0000u);
            qv[ks * 8 + 6] = __uint_as_float(u.w << 16); qv[ks * 8 + 7] = __uint_as_float(u.w & 0xffff0000u);
        }
#pragma unroll
        for (int n = 0; n < 16; ++n) {
            float s = 0.f;
            if (n < cb) {
#pragma unroll
                for (int ks = 0; ks < 4; ++ks) {
                    const float4 k0 = *(const float4*)(kms + n * 64 + ks * 16 + 8 * hh), k1 = *(const float4*)(kms + n * 64 + ks * 16 + 8 * hh + 4);
                    s += qv[ks * 8 + 0] * k0.x + qv[ks * 8 + 1] * k0.y + qv[ks * 8 + 2] * k0.z + qv[ks * 8 + 3] * k0.w
                       + qv[ks * 8 + 4] * k1.x + qv[ks * 8 + 5] * k1.y + qv[ks * 8 + 6] * k1.z + qv[ks * 8 + 7] * k1.w;
                }
                s += __shfl_xor(s, 32);
            } else s = -INFINITY;
            sg[n] = s;
        }
    }
    unsigned bm = 0u;
#pragma unroll
    for (int n = 0; n < 16; ++n) {
        int rank = 0;
#pragma unroll
        for (int n2 = 0; n2 < 16; ++n2) rank += (sg[n2] > sg[n] || (sg[n2] == sg[n] && n2 < n)) ? 1 : 0;
        if (rank < 3 && n < cb) bm |= 1u << n;
    }
    unsigned long long mytiles = 0ull;
#pragma unroll
    for (int n = 0; n < 16; ++n) if ((bm >> n) & 1u) mytiles |= 0xFull << (4 * n);
    unsigned long long own = 0ull;
    for (int j = 4 * cb; j <= c; ++j) own |= 1ull << j;
    mytiles |= own;
    unsigned wb = bm;
#pragma unroll
    for (int o = 1; o < 64; o <<= 1) wb |= __shfl_xor(wb, o);
    if (lane == 0) atomicOr(um, wb);
    __syncthreads();
    const unsigned ub = um[0];
    unsigned long long U = own;
    for (int n = 0; n < 16; ++n) if ((ub >> n) & 1u) U |= 0xFull << (4 * n);
    f32x16 ot[2]; float l;
    const float tb0 = -(slope2 * (float)tq) - m2;
    attn_branch<1, 0>(B.k + (size_t)(b * SEQ) * 256 + g * 64, B.vt + (size_t)bg * 64 * SEQ, 256, SEQ, U, 1ull << c, mytiles, qf, slope2, tb0, tq, 1 << 30, smem, ot, l, tid);
    const float lt = l + __shfl_xor(l, 32);
    const float f = 1.f / lt;
    bf16_t* dst = att + (size_t)(b * SEQ + tq) * 1024 + hd * 64;
#pragma unroll
    for (int dt = 0; dt < 2; ++dt)
#pragma unroll
        for (int q4 = 0; q4 < 4; ++q4) {
            const int d = 32 * dt + 8 * q4 + 4 * hh;
            uint2 o; o.x = pk2(ot[dt][4 * q4] * f, ot[dt][4 * q4 + 1] * f); o.y = pk2(ot[dt][4 * q4 + 2] * f, ot[dt][4 * q4 + 3] * f);
            *(uint2*)(dst + d) = o;
        }
}


#define XB_TMO      128
#define XB_XCNT(j)  (256  + 64 * (j))
#define XB_XSUB(j)  (1280 + 64 * (j))
#define XB_XGEN(j)  (2304 + 64 * (j))
#define XB_TOP      3328
#define XB_TOPGEN   3392
#define XCD_BAR_WORDS 3456
#define XB_SPIN_CAP (1u << 22)
#define LAS __attribute__((address_space(3)))
__device__ __forceinline__ unsigned xb_ld(unsigned* p)              { return __hip_atomic_load(p, __ATOMIC_RELAXED, __HIP_MEMORY_SCOPE_AGENT); }
__device__ __forceinline__ unsigned xb_add(unsigned* p, unsigned v) { return __hip_atomic_fetch_add(p, v, __ATOMIC_RELAXED, __HIP_MEMORY_SCOPE_AGENT); }
__device__ __forceinline__ unsigned xb_xcc_id() { return (unsigned)__builtin_amdgcn_s_getreg((3 << 11) | 20) & 0xFu; }
#define XB_SPIN(cond, bar) do { unsigned _sp = 0; while (cond) { __builtin_amdgcn_s_sleep(1); \
    if ((++_sp & 255u) == 0u) { if (xb_ld(&(bar)[XB_TMO])) break; if (_sp > XB_SPIN_CAP) { atomicAdd(&(bar)[XB_TMO], 1u); break; } } } } while (0)
struct XcdBarrier { unsigned* bar; unsigned x; volatile LAS unsigned* st; };
__device__ __forceinline__ XcdBarrier xcd_barrier_post(unsigned* bar, volatile LAS unsigned* st) {
    XcdBarrier b; b.bar = bar; b.x = xb_xcc_id(); b.st = st;
    if (threadIdx.x == 0) (void)xb_add(&bar[XB_XCNT(b.x)], 1u);
    return b;
}
__device__ __forceinline__ void xcd_barrier_complete(unsigned* bar, unsigned x, unsigned& nloc, unsigned& nx) {
    const unsigned G = gridDim.x * gridDim.y * gridDim.z;
    unsigned sum, cnt, mine, sp = 0u;
    for (;;) {
        sum = 0u; cnt = 0u; mine = 0u;
#pragma unroll
        for (unsigned j = 0; j < 16; ++j) { const unsigned c = xb_ld(&bar[XB_XCNT(j)]); sum += c; cnt += (c > 0u) ? 1u : 0u; mine = (j == x) ? c : mine; }
        if (sum == G) break;
        __builtin_amdgcn_s_sleep(1);
        if ((++sp & 255u) == 0u) { if (xb_ld(&bar[XB_TMO])) break; if (sp > XB_SPIN_CAP) { atomicAdd(&bar[XB_TMO], 1u); break; } }
    }
    nloc = mine > 0u ? mine : 1u; nx = cnt > 0u ? cnt : 1u;
}
__device__ __forceinline__ void xcd_barrier(const XcdBarrier& b) {
    asm volatile("s_waitcnt vmcnt(0)" ::: "memory");
    __syncthreads();
    if (threadIdx.x == 0) {
        unsigned* bar = b.bar;
        __builtin_amdgcn_s_waitcnt(0);
        unsigned nloc = b.st[0], nx = b.st[1];
        if (nloc == 0u) { xcd_barrier_complete(bar, b.x, nloc, nx); b.st[0] = nloc; b.st[1] = nx; }
        const unsigned old = xb_add(&bar[XB_XSUB(b.x)], 1u);
        const unsigned gen = old / nloc;
        if (old + 1u == (gen + 1u) * nloc) {
            __builtin_amdgcn_fence(__ATOMIC_RELEASE, "agent");
            asm volatile("s_waitcnt vmcnt(0)" ::: "memory");
            const unsigned og = xb_add(&bar[XB_TOP], 1u);
            const unsigned tg = og / nx;
            if (og + 1u == (tg + 1u) * nx) xb_add(&bar[XB_TOPGEN], 1u);
            else XB_SPIN(xb_ld(&bar[XB_TOPGEN]) == tg, bar);
            __builtin_amdgcn_fence(__ATOMIC_ACQUIRE, "agent");
            xb_add(&bar[XB_XGEN(b.x)], 1u);
            asm volatile("s_waitcnt vmcnt(0)" ::: "memory");
        } else {
            XB_SPIN(xb_ld(&bar[XB_XGEN(b.x)]) == gen, bar);
            __builtin_amdgcn_fence(__ATOMIC_ACQUIRE, "agent");
            asm volatile("s_waitcnt vmcnt(0)" ::: "memory");
        }
    }
    __syncthreads();
}

struct Params {
    const float* in[30];
    float* out;
    float* ws;
    WJob jobs[NJOBS];
};
#define SMEM_BYTES 73744

#define PHASE_1D(NB, CALL) do { for (int vb = blockIdx.x; vb < (NB); vb += gridDim.x) { const int bx = vb; __syncthreads(); CALL; } GRID_SYNC(); } while (0)
#define PHASE_2D(NX, NY, CALL) do { for (int vb = blockIdx.x; vb < (NX) * (NY); vb += gridDim.x) { const int bx = vb % (NX), by = vb / (NX); __syncthreads(); CALL; } GRID_SYNC(); } while (0)
#define PHASE_3D(NX, NY, NZ, CALL) do { for (int vb = blockIdx.x; vb < (NX) * (NY) * (NZ); vb += gridDim.x) { const int bx = vb % (NX), by = (vb / (NX)) % (NY), bz = vb / ((NX) * (NY)); __syncthreads(); CALL; } GRID_SYNC(); } while (0)
#define GEMM_PHASE(A, lda, WT, M, N, K, EPI) PHASE_2D(((N) + 127) / 128, ((M) + 127) / 128, (d_gemm<true>(A, WT, (long long)(lda), M, N, K, EPI, bx, by, smem)))
#define GEMM_PHASE_B(A, lda, WT, M, N, K, EPI) PHASE_2D(((N) + 127) / 128, ((M) + 127) / 128, (d_gemm<false>(A, WT, (long long)(lda), M, N, K, EPI, bx, by, smem)))

__global__ void __launch_bounds__(256, 2) mega(Params P) {
    __shared__ __attribute__((aligned(16))) char smem[SMEM_BYTES];
    if (threadIdx.x == 0) *(uint4*)(smem + 73728) = make_uint4(0u, 0u, 0u, 0u);
    __syncthreads();
    const XcdBarrier xbar = xcd_barrier_post((unsigned*)((char*)P.ws + (size_t)166 * 1048576), (volatile LAS unsigned*)(smem + 73728));
#define GRID_SYNC() xcd_barrier(xbar)
    const float* x = P.in[0];
    const float* p = P.in[1];
    const float* ln_mix = P.in[2];
    const float* ln_ffn = P.in[3];
    const float* ln_ple = P.in[4];
    const float* a_w_in = P.in[5];
    const float* a_q_norm = P.in[6];
    const float* a_k_norm = P.in[7];
    const float* a_ck_pos = P.in[8];
    const float* a_ck_w1 = P.in[9];
    const float* a_ck_w2 = P.in[10];
    const float* a_cv_pos = P.in[11];
    const float* a_cv_w1 = P.in[12];
    const float* a_cv_w2 = P.in[13];
    const float* a_w_out = P.in[14];
    const float* kv_norm = P.in[15];
    const float* w_kv = P.in[16];
    const float* k_norm_sh = P.in[17];
    const float* b_w_q = P.in[18];
    const float* b_q_norm = P.in[19];
    const float* b_w_out = P.in[20];
    const float* moe_w_group = P.in[21];
    const float* moe_b_group = P.in[22];
    const float* moe_w_expert = P.in[23];
    const float* moe_b_expert = P.in[24];
    const float* moe_w_gate = P.in[25];
    const float* moe_w_up = P.in[26];
    const float* moe_w_down = P.in[27];
    const float* ple_w_proj = P.in[28];
    const float* ple_w_gate = P.in[29];
    float* h = P.out;
    float* ws = P.ws;
    const bf16_t* t_w_in = P.jobs[0].dst;
    const bf16_t* t_ck_w1 = P.jobs[1].dst;
    const bf16_t* t_ck_w2 = P.jobs[2].dst;
    const bf16_t* t_cv_w1 = P.jobs[3].dst;
    const bf16_t* t_cv_w2 = P.jobs[4].dst;
    const bf16_t* t_a_w_out = P.jobs[5].dst;
    const bf16_t* t_w_kv = P.jobs[6].dst;
    const bf16_t* t_b_w_q = P.jobs[7].dst;
    const bf16_t* t_b_w_out = P.jobs[8].dst;
    const bf16_t* t_ple_gate = P.jobs[9].dst;
    const bf16_t* t_ple_proj = P.jobs[10].dst;
    char* wsb = (char*)ws;
    char* regC = wsb + (size_t)160 * 1048576;
    L0Bufs LB;
    LB.q = (bf16_t*)wsb;
    LB.kcr = (bf16_t*)(wsb + 33554432);
    LB.vcr = LB.kcr + (size_t)TTOK * 256;
    LB.ks = LB.vcr + (size_t)TTOK * 256;
    LB.vst = LB.ks + (size_t)TTOK * 256;
    LB.kw = LB.vst + (size_t)TTOK * 256;
    LB.vwt = LB.kw + (size_t)TTOK * 256;
    LB.gates = (float*)(LB.vwt + (size_t)TTOK * 256);
    LB.hidc = (bf16_t*)(wsb + 92274688);
    float* rlog = (float*)(wsb + 92274688);
    LB.kc = (bf16_t*)regC;
    LB.vct = (bf16_t*)(regC + 524288);
    LB.bias1 = (float*)(regC + 1048576);
    int* qctr = (int*)(regC + 1050624);
    int* cnt = (int*)(regC + 1050880);
    int* lslot = (int*)(regC + 1051136);
    float* lw = (float*)(regC + 3148288);
    L1Bufs L1B;
    L1B.q = (bf16_t*)wsb;
    L1B.k = (bf16_t*)(wsb + 33554432);
    L1B.vt = L1B.k + (size_t)TTOK * 256;
    L1B.kmpart = (float*)(regC + 5245440);
    bf16_t* XA = (bf16_t*)(wsb + (size_t)96 * 1048576);
    bf16_t* XB = (bf16_t*)(wsb + (size_t)128 * 1048576);
    bf16_t* ysb = (bf16_t*)wsb;
    bf16_t* t_route = P.jobs[17].dst;
    const int nwave = (int)gridDim.x * 4;
#define GWAVE ((int)blockIdx.x * 4 + (opq_tid() >> 6))

    {
        int base = 0;
        for (int j = 0; j < 17; ++j) {
            const WJob& J = P.jobs[j];
            if (J.src == nullptr) continue;
            const int cntj = J.batch * (J.Npad >> 6) * (J.K >> 6);
            int first = ((int)blockIdx.x - base) % (int)gridDim.x; if (first < 0) first += gridDim.x;
            for (int it = first; it < cntj; it += gridDim.x) wconv_item(J, it, (float*)smem);
            base += cntj;
        }
        for (int layer = 0; layer < 2; ++layer)
            rw_build(moe_w_group + (size_t)layer * DM * 4, moe_w_expert + (size_t)layer * DM * 32, ln_ffn + layer * DM, t_route + (size_t)layer * 128 * 3072,
                     (int)(blockIdx.x * 256 + threadIdx.x), (int)(gridDim.x * 256));
        for (int row = GWAVE; row < TTOK; row += nwave) rp_row<false, false>(x + (size_t)row * DM, nullptr, nullptr, XA + (size_t)row * DM, nullptr);
        if ((int)blockIdx.x >= (int)gridDim.x - 2) {
            const int which = (int)gridDim.x - 1 - (int)blockIdx.x;
            const float* pos = which ? a_cv_pos : a_ck_pos;
            const float* w1 = which ? a_cv_w1 : a_ck_w1;
            float a = 0.f;
            for (int k = 0; k < 2048; ++k) a += pos[k] * w1[(size_t)k * 256 + threadIdx.x];
            LB.bias1[which * 256 + threadIdx.x] = a;
        }
        if (blockIdx.x == 0 && threadIdx.x < 128) qctr[threadIdx.x] = 0;
        GRID_SYNC();
    }
    PHASE_2D(21, 128, p1_item(XA, t_w_in, a_q_norm, a_k_norm, LB, bx, by, smem));
    PHASE_1D(128, p2a_item(LB, (bx >> 6) ? t_cv_w1 : t_ck_w1, bx >> 6, (bx >> 1) & 31, bx & 1, smem));
    PHASE_1D(64, p2b_item(LB, (bx >> 5) ? t_cv_w2 : t_ck_w2, a_k_norm, bx >> 5, bx & 31, smem));
    {
        int* misc = (int*)(smem + ATT_MISC_OFF);
        for (;;) {
            __syncthreads();
            if (threadIdx.x == 0) misc[0] = atomicAdd(&qctr[0], 1);
            __syncthreads();
            const int id = __builtin_amdgcn_readfirstlane(misc[0]);
            if (id >= 2048) break;
            nsa_attn_item(LB, a_q_norm, a_k_norm, XB, id & 15, 127 - (id >> 4), smem);
        }
        GRID_SYNC();
    }
    GEMM_PHASE_B(XB, DM, t_a_w_out, TTOK, DM, DM, (EpiResid{x, h, DM}));
    auto layer_tail = [&](const int layer) {
        int* cntl = cnt + layer * 32;
        PHASE_1D(128, route_item(h, XA, XB, t_route + (size_t)layer * 128 * 3072, moe_b_group + layer * 4, moe_b_expert + layer * 32, rlog, cntl, lslot, lw, bx, smem));
        {
            const bf16_t* wgu_l = P.jobs[11 + 3 * layer].dst;
            const bf16_t* wd_l = P.jobs[13 + 3 * layer].dst;
            int it = blockIdx.x;
            int e = 0, basei = 0;
            for (;;) {
                int nch = 0;
                while (e < 32) { nch = (cntl[e] + 127) >> 7; if (it < basei + nch) break; basei += nch; ++e; }
                if (e >= 32) break;
                const int chunk = it - basei;
                const int nvalid = min(128, cntl[e] - chunk * 128);
                __syncthreads();
                moe_item<false>(XA, wgu_l + (size_t)e * 256 * 1024, wd_l + (size_t)e * 1024 * 128, lslot + e * TTOK + chunk * 128, lw + e * TTOK + chunk * 128, nvalid, ysb, smem);
                it += gridDim.x;
            }
            GRID_SYNC();
        }
        for (int row = GWAVE; row < TTOK; row += nwave) rp_row<true, false>(h + (size_t)row * DM, h + (size_t)row * DM, ysb + (size_t)row * 2 * DM, XB + (size_t)row * DM, nullptr);
        GRID_SYNC();
        PHASE_2D(8, 128, ple_item(XB, t_ple_gate + (size_t)layer * DM * DM, p + (size_t)layer * TTOK * 256, t_ple_proj + (size_t)layer * 256 * DM, h, bx, by, smem));
        if (layer == 0) {
            for (int row = GWAVE; row < TTOK; row += nwave) rp_row<false, false>(h + (size_t)row * DM, nullptr, nullptr, XA + (size_t)row * DM, nullptr);
            GRID_SYNC();
        }
    };
    layer_tail(0);
        PHASE_2D(12, 128, p7_item(XA, t_w_kv, b_q_norm, k_norm_sh, L1B, bx, by, smem));
        {
            int* misc = (int*)(smem + ATT_MISC_OFF);
            for (;;) {
                __syncthreads();
                if (threadIdx.x == 0) misc[0] = atomicAdd(&qctr[1], 1);
                __syncthreads();
                const int id = __builtin_amdgcn_readfirstlane(misc[0]);
                if (id >= 2048) break;
                moba_attn_item(L1B, b_q_norm, k_norm_sh, XB, id & 15, 127 - (id >> 4), smem);
            }
            GRID_SYNC();
        }
        GEMM_PHASE_B(XB, DM, t_b_w_out, TTOK, DM, DM, (EpiResid{h, h, DM}));

    layer_tail(1);
}

extern "C" void kernel_launch(void* const* d_in, const int* in_sizes, int n_in, void* d_out, int out_size, void* d_ws, size_t ws_size, hipStream_t stream) {
    static int grid_blocks = 0;
    if (!grid_blocks) {
        int dev = 0, cus = 0, per_cu = 0;
        (void)hipGetDevice(&dev);
        (void)hipDeviceGetAttribute(&cus, hipDeviceAttributeMultiprocessorCount, dev);
        (void)hipOccupancyMaxActiveBlocksPerMultiprocessor(&per_cu, (const void*)mega, 256, 0);
        if (per_cu < 1) per_cu = 1;
        if (per_cu > 2) per_cu = 2;
        grid_blocks = cus * per_cu;
    }
    Params P{};
    for (int i = 0; i < 30; ++i) P.in[i] = (const float*)d_in[i];
    P.out = (float*)d_out;
    P.ws = (float*)d_ws;
    {
        size_t off = (size_t)168 * 1048576;
        char* wbase = (char*)d_ws + off;
        size_t wo = 0;
        auto add = [&](int j, const void* src, int K, int N, int Npad, int batch, const float* gain) {
            WJob& J = P.jobs[j];
            J.src = (const float*)src; J.dst = (bf16_t*)(wbase + wo); J.gain = gain;
            J.sbs = (long long)K * N; J.dbs = (long long)Npad * K; J.K = K; J.N = N; J.Npad = Npad; J.batch = batch; J.perm = 0; J.gbs = 0;
            wo += (size_t)batch * Npad * K * 2;
        };
        add(0, d_in[5], 1024, 2608, 2688, 1, (const float*)d_in[2]);
        add(1, d_in[9], 2048, 256, 256, 1, nullptr);
        add(2, d_in[10], 256, 64, 128, 1, nullptr);
        add(3, d_in[12], 2048, 256, 256, 1, nullptr);
        add(4, d_in[13], 256, 64, 128, 1, nullptr);
        add(5, d_in[14], 1024, 1024, 1024, 1, nullptr);
        add(6, d_in[16], 1024, 512, 512, 1, (const float*)d_in[15]);
        add(7, d_in[18], 1024, 1024, 1024, 1, (const float*)d_in[2] + 1024);
        add(8, d_in[20], 1024, 1024, 1024, 1, nullptr);
        add(9, d_in[29], 1024, 1024, 1024, 2, (const float*)d_in[4]); P.jobs[9].gbs = 1024;
        add(10, d_in[28], 256, 1024, 1024, 2, nullptr);
        for (int layer = 0; layer < 2; ++layer) {
            WJob& G = P.jobs[11 + 3 * layer]; WJob& U = P.jobs[12 + 3 * layer];
            G.src = (const float*)d_in[25] + (size_t)layer * 32 * 1024 * 128; G.dst = (bf16_t*)(wbase + wo); G.gain = (const float*)d_in[3] + layer * 1024;
            G.sbs = 1024 * 128; G.dbs = 256 * 1024; G.K = 1024; G.N = 128; G.Npad = 128; G.batch = 32; G.perm = 1; G.gbs = 0;
            U = G; U.src = (const float*)d_in[26] + (size_t)layer * 32 * 1024 * 128; U.perm = 2;
            wo += (size_t)32 * 256 * 1024 * 2;
            add(13 + 3 * layer, (const float*)d_in[27] + (size_t)layer * 32 * 128 * 1024, 128, 1024, 1024, 32, nullptr);
        }
        P.jobs[17].dst = (bf16_t*)(wbase + wo); wo += (size_t)2 * 128 * 3072 * 2;
        if (off + wo > ws_size) { fprintf(stderr, "workspace too small: need %zu have %zu\n", off + wo, ws_size); return; }
    }
    (void)hipMemsetAsync((char*)d_ws + (size_t)166 * 1048576, 0, XCD_BAR_WORDS * 4, stream);
    void* args[] = {&P};
    hipError_t e = hipLaunchCooperativeKernel((const void*)mega, dim3(grid_blocks), dim3(256), args, 0, stream);
    if (e != hipSuccess) fprintf(stderr, "cooperative launch failed: %s (grid %d)\n", hipGetErrorString(e), grid_blocks);
}
```

```cpp
#include <hip/hip_runtime.h>
#include <hip/hip_cooperative_groups.h>
namespace cg = cooperative_groups;
#include <stdint.h>
#include <math.h>
#include <stdio.h>

#define SEQ 4096
#define BATCH 4
#define TTOK 16384
#define DM 1024
#define NPROJ 2608
#define NCMP 255

#define C_Q 0
#define C_KC 1024
#define C_VC 1280
#define C_KS 1536
#define C_VS 1792
#define C_KW 2048
#define C_VW 2304
#define C_GL 2560

template <int M> __device__ __forceinline__ float fx(float v) { return __int_as_float(__builtin_amdgcn_ds_swizzle(__float_as_int(v), (M << 10) | 0x1f)); }
template <int M> __device__ __forceinline__ unsigned ux(unsigned v) { return (unsigned)__builtin_amdgcn_ds_swizzle((int)v, (M << 10) | 0x1f); }
__device__ __forceinline__ float sum32(float v) { const auto r = __builtin_amdgcn_permlane32_swap(__float_as_uint(v), __float_as_uint(v), false, false); return __uint_as_float(r[0]) + __uint_as_float(r[1]); }
__device__ __forceinline__ float max32(float v) { const auto r = __builtin_amdgcn_permlane32_swap(__float_as_uint(v), __float_as_uint(v), false, false); return fmaxf(__uint_as_float(r[0]), __uint_as_float(r[1])); }
__device__ __forceinline__ unsigned or32(unsigned v) { const auto r = __builtin_amdgcn_permlane32_swap(v, v, false, false); return r[0] | r[1]; }
__device__ __forceinline__ float sum_lo32(float v) { v += fx<1>(v); v += fx<2>(v); v += fx<4>(v); v += fx<8>(v); v += fx<16>(v); return v; }
__device__ __forceinline__ unsigned or_lo32(unsigned v) { v |= ux<1>(v); v |= ux<2>(v); v |= ux<4>(v); v |= ux<8>(v); v |= ux<16>(v); return v; }
__device__ __forceinline__ float wave_sum(float v) { return sum32(sum_lo32(v)); }
__device__ __forceinline__ int opq_tid() { int t = threadIdx.x; asm volatile("" : "+v"(t)); return t; }
__device__ __forceinline__ float gelu_tanh(float x) {
    const float c = 0.7978845608028654f;
    float u = c * (x + 0.044715f * x * x * x);
    return 0.5f * x * (1.f + tanhf(u));
}
__device__ __forceinline__ float sigm(float x) { return 1.f / (1.f + expf(-x)); }

typedef unsigned short bf16_t;
typedef float f32x16 __attribute__((ext_vector_type(16)));
typedef __bf16 bf16x8 __attribute__((ext_vector_type(8)));
typedef __bf16 bf16x2 __attribute__((ext_vector_type(2)));
__device__ __forceinline__ unsigned pk2(float lo, float hi) { bf16x2 v = {(__bf16)lo, (__bf16)hi}; return __builtin_bit_cast(unsigned, v); }
__device__ __forceinline__ uint4 pack8(float4 a, float4 b) { uint4 r; r.x = pk2(a.x, a.y); r.y = pk2(a.z, a.w); r.z = pk2(b.x, b.y); r.w = pk2(b.z, b.w); return r; }

__device__ __forceinline__ float bf16_lo_f(unsigned u) { return __uint_as_float(u << 16); }
__device__ __forceinline__ float bf16_hi_f(unsigned u) { return __uint_as_float(u & 0xffff0000u); }
#define LDS_ROW 144
#define TILE_BYTES (128 * LDS_ROW)

template <bool A_F32, class AFn>
__device__ __forceinline__ void gemm_core(AFn afn, const bf16_t* __restrict__ Wt, int ldw, int n0, int K, char* smem, f32x16 (&acc)[2][2]) {
    const int tid = opq_tid(), lane = tid & 63, wave = tid >> 6;
    const int wn = wave >> 1, wm = wave & 1;
    const int sr = tid >> 3, sc = tid & 7;
    const int c = lane & 31, h = lane >> 5;
    struct Stage { uint4 x0, x1, x2, x3, w0, w1, w2, w3; };
#pragma unroll
    for (int i = 0; i < 2; ++i)
#pragma unroll
        for (int j = 0; j < 2; ++j)
#pragma unroll
            for (int r = 0; r < 16; ++r) acc[i][j][r] = 0.f;
    auto loadx = [&](int i, int k0) -> uint4 {
        const int r = sr + 32 * i;
        if (A_F32) {
            const float* p = (const float*)afn(i, r, k0);
            if (p) { float4 f0 = *(const float4*)(p + sc * 8); float4 f1 = *(const float4*)(p + sc * 8 + 4); return pack8(f0, f1); }
            return make_uint4(0u, 0u, 0u, 0u);
        } else {
            const bf16_t* p = (const bf16_t*)afn(i, r, k0);
            return p ? *(const uint4*)(p + sc * 8) : make_uint4(0u, 0u, 0u, 0u);
        }
    };
    auto load = [&](int k0) -> Stage {
        Stage S;
        S.x0 = loadx(0, k0); S.x1 = loadx(1, k0); S.x2 = loadx(2, k0); S.x3 = loadx(3, k0);
        const bf16_t* wp = Wt + (size_t)(n0 + sr) * ldw + k0 + sc * 8;
        S.w0 = *(const uint4*)wp; S.w1 = *(const uint4*)(wp + (size_t)32 * ldw); S.w2 = *(const uint4*)(wp + (size_t)64 * ldw); S.w3 = *(const uint4*)(wp + (size_t)96 * ldw);
        return S;
    };
    auto store = [&](const Stage S, int buf) {
        char* xb = smem + buf * 2 * TILE_BYTES + sr * LDS_ROW + sc * 16; char* wb = xb + TILE_BYTES;
        *(uint4*)xb = S.x0; *(uint4*)(xb + 32 * LDS_ROW) = S.x1; *(uint4*)(xb + 64 * LDS_ROW) = S.x2; *(uint4*)(xb + 96 * LDS_ROW) = S.x3;
        *(uint4*)wb = S.w0; *(uint4*)(wb + 32 * LDS_ROW) = S.w1; *(uint4*)(wb + 64 * LDS_ROW) = S.w2; *(uint4*)(wb + 96 * LDS_ROW) = S.w3;
    };
    auto compute = [&](int buf) {
        const char* xb = smem + buf * 2 * TILE_BYTES; const char* wb = xb + TILE_BYTES;
        const char* wp0 = wb + (wn * 64 + c) * LDS_ROW + h * 16;
        const char* xp0 = xb + (wm * 64 + c) * LDS_ROW + h * 16;
        bf16x8 wfa0 = *(const bf16x8*)(wp0), wfa1 = *(const bf16x8*)(wp0 + 32 * LDS_ROW), xfa0 = *(const bf16x8*)(xp0), xfa1 = *(const bf16x8*)(xp0 + 32 * LDS_ROW);
#pragma unroll
        for (int ks = 0; ks < 4; ++ks) {
            bf16x8 wfb0, wfb1, xfb0, xfb1;
            if (ks < 3) {
                wfb0 = *(const bf16x8*)(wp0 + (ks + 1) * 32); wfb1 = *(const bf16x8*)(wp0 + 32 * LDS_ROW + (ks + 1) * 32);
                xfb0 = *(const bf16x8*)(xp0 + (ks + 1) * 32); xfb1 = *(const bf16x8*)(xp0 + 32 * LDS_ROW + (ks + 1) * 32);
            }
            acc[0][0] = __builtin_amdgcn_mfma_f32_32x32x16_bf16(wfa0, xfa0, acc[0][0], 0, 0, 0);
            acc[0][1] = __builtin_amdgcn_mfma_f32_32x32x16_bf16(wfa0, xfa1, acc[0][1], 0, 0, 0);
            acc[1][0] = __builtin_amdgcn_mfma_f32_32x32x16_bf16(wfa1, xfa0, acc[1][0], 0, 0, 0);
            acc[1][1] = __builtin_amdgcn_mfma_f32_32x32x16_bf16(wfa1, xfa1, acc[1][1], 0, 0, 0);
            __builtin_amdgcn_sched_barrier(0);
            if (ks < 3) { wfa0 = wfb0; wfa1 = wfb1; xfa0 = xfb0; xfa1 = xfb1; }
        }
    };
    const int nk = K >> 6;
    Stage S0 = load(0), S1 = S0;
    if (nk > 1) S1 = load(64);
    store(S0, 0);
    __syncthreads();
    for (int kt = 0; kt < nk; kt += 2) {
        if (kt + 2 < nk) S0 = load((kt + 2) * 64);
        compute(0);
        if (kt + 1 < nk) store(S1, 1);
        __syncthreads();
        if (kt + 1 >= nk) break;
        if (kt + 3 < nk) S1 = load((kt + 3) * 64);
        compute(1);
        if (kt + 2 < nk) store(S0, 0);
        __syncthreads();
    }
}
template <class F>
__device__ __forceinline__ void epi_foreach(const f32x16 (&acc)[2][2], int m0, int n0, F f) {
    const int tid_ = opq_tid(), lane = tid_ & 63, wave = tid_ >> 6;
    const int wn = wave >> 1, wm = wave & 1, c = lane & 31, h = lane >> 5;
#pragma unroll
    for (int i = 0; i < 2; ++i)
#pragma unroll
        for (int j = 0; j < 2; ++j)
#pragma unroll
            for (int q = 0; q < 4; ++q) {
                const int n = n0 + wn * 64 + 32 * i + 8 * q + 4 * h, m = m0 + wm * 64 + 32 * j + c;
                f(m, n, make_float4(acc[i][j][4 * q], acc[i][j][4 * q + 1], acc[i][j][4 * q + 2], acc[i][j][4 * q + 3]));
            }
}
struct EpiStore { float* C; long long ldc; __device__ void operator()(int r, int c, float4 v) const { *(float4*)(C + (size_t)r * ldc + c) = v; } };
struct EpiGelu { float* C; long long ldc; __device__ void operator()(int r, int c, float4 v) const { *(float4*)(C + (size_t)r * ldc + c) = make_float4(gelu_tanh(v.x), gelu_tanh(v.y), gelu_tanh(v.z), gelu_tanh(v.w)); } };
struct EpiSigm { float* C; long long ldc; __device__ void operator()(int r, int c, float4 v) const { *(float4*)(C + (size_t)r * ldc + c) = make_float4(sigm(v.x), sigm(v.y), sigm(v.z), sigm(v.w)); } };
struct EpiResid { const float* R; float* C; long long ldc; __device__ void operator()(int r, int c, float4 v) const { float4 a = *(const float4*)(R + (size_t)r * ldc + c); *(float4*)(C + (size_t)r * ldc + c) = make_float4(a.x + v.x, a.y + v.y, a.z + v.z, a.w + v.w); } };
struct EpiPle { const float* G; float* H; long long ldc; __device__ void operator()(int r, int c, float4 v) const { float4 g = *(const float4*)(G + (size_t)r * ldc + c); float4 a = *(const float4*)(H + (size_t)r * ldc + c); *(float4*)(H + (size_t)r * ldc + c) = make_float4(a.x + g.x * v.x, a.y + g.y * v.y, a.z + g.z * v.z, a.w + g.w * v.w); } };

template <bool A_F32, class Epi>
__device__ __forceinline__ void d_gemm(const void* __restrict__ A, const bf16_t* __restrict__ Wt, long long lda, int M, int N, int K, Epi epi, int bx, int by, char* smem) {
    const int m0 = by * 128, n0 = bx * 128;
    f32x16 acc[2][2];
    gemm_core<A_F32>([&](int i, int r, int k0) -> const void* {
        if (m0 + r >= M) return nullptr;
        return A_F32 ? (const void*)((const float*)A + (size_t)(m0 + r) * lda + k0) : (const void*)((const bf16_t*)A + (size_t)(m0 + r) * lda + k0); }, Wt, K, n0, K, smem, acc);
    epi_foreach(acc, m0, n0, [&](int m, int n, float4 v) { if (m < M && n < N) epi(m, n, v); });
}

struct WJob { const float* src; bf16_t* dst; const float* gain; long long sbs, dbs; int K, N, Npad, batch, perm, gbs; };
#define NJOBS 20
__device__ __forceinline__ void wconv_item(const WJob& J, int item, float* lds) {
    const int tid = opq_tid(), lane = tid & 63;
    const int nt = J.Npad >> 6, kt = J.K >> 6;
    const int bi = item / (nt * kt), rem = item % (nt * kt), kb = rem / nt, nb = rem % nt;
    const float* W = J.src + (size_t)bi * J.sbs;
    bf16_t* D = J.dst + (size_t)bi * J.dbs;
    const int k0 = kb * 64, n0 = nb * 64;
    __syncthreads();
    {
        float vv[16];
        const int n = n0 + lane;
#pragma unroll
        for (int p = 0; p < 16; ++p) {
            const int k = p * 4 + (tid >> 6);
            vv[p] = (n < J.N) ? W[(size_t)(k0 + k) * J.N + n] : 0.f;
        }
        if (J.gain) {
#pragma unroll
            for (int p = 0; p < 16; ++p) vv[p] *= J.gain[(size_t)bi * J.gbs + k0 + p * 4 + (tid >> 6)];
        }
#pragma unroll
        for (int p = 0; p < 16; ++p) lds[(p * 4 + (tid >> 6)) * 65 + lane] = vv[p];
    }
    __syncthreads();
    const int n = tid >> 2, kq = (tid & 3) * 16;
    float f[16];
#pragma unroll
    for (int i = 0; i < 16; ++i) f[i] = lds[(kq + i) * 65 + n];
    uint4 o0, o1;
    o0.x = pk2(f[0], f[1]); o0.y = pk2(f[2], f[3]); o0.z = pk2(f[4], f[5]); o0.w = pk2(f[6], f[7]);
    o1.x = pk2(f[8], f[9]); o1.y = pk2(f[10], f[11]); o1.z = pk2(f[12], f[13]); o1.w = pk2(f[14], f[15]);
    int drow = n0 + n;
    if (J.perm) drow = (drow >> 5) * 64 + (J.perm - 1) * 32 + (drow & 31);
    uint4* dp = (uint4*)(D + (size_t)drow * J.K + k0 + kq);
    dp[0] = o0; dp[1] = o1;
}

#define LOG2E 1.4426950408889634f
#define CNT_STRIDE 64
struct L0Bufs { bf16_t *q, *kcr, *vcr, *ks, *vst, *kw, *vwt; float* gates; bf16_t *hidc, *kc, *vct; float* bias1; };

__device__ __forceinline__ float wave_max(float v) { v = fmaxf(v, fx<1>(v)); v = fmaxf(v, fx<2>(v)); v = fmaxf(v, fx<4>(v)); v = fmaxf(v, fx<8>(v)); v = fmaxf(v, fx<16>(v)); return max32(v); }

__device__ __forceinline__ void p1_item(const bf16_t* __restrict__ xn, const bf16_t* __restrict__ t_w_in, const float* __restrict__ qn, const float* __restrict__ kn,
                                        const L0Bufs& B, int bx, int by, char* smem) {
    const int m0 = by * 128, n0 = bx * 128;
    f32x16 acc[2][2];
    gemm_core<false>([&](int i, int r, int k0) -> const void* { return (const void*)(xn + (size_t)(m0 + r) * DM + k0); }, t_w_in, DM, n0, DM, smem, acc);
    const int tid_ = opq_tid(), lane = tid_ & 63, wave = tid_ >> 6;
    const int wn = wave >> 1, wm = wave & 1, c = lane & 31, h = lane >> 5;
    const int ch = (n0 >> 6) + wn;
#pragma unroll
    for (int j = 0; j < 2; ++j) {
        const int m = m0 + wm * 64 + 32 * j + c;
        const int b = m >> 12, t = m & 4095;
        if (ch < 16 || (ch >= 24 && ch < 28) || (ch >= 32 && ch < 36)) {
            float ss = 0.f;
#pragma unroll
            for (int i = 0; i < 2; ++i)
#pragma unroll
                for (int r = 0; r < 16; ++r) ss += acc[i][j][r] * acc[i][j][r];
            ss = sum32(ss);
            float rs = rsqrtf(ss * (1.f / 64.f) + 1e-6f);
            const float* g; bf16_t* dst;
            if (ch < 16) { g = qn; rs *= 0.125f * LOG2E; dst = B.q + (size_t)m * 1024 + ch * 64; }
            else if (ch < 28) { g = kn + 64; dst = B.ks + (size_t)m * 256 + (ch - 24) * 64; }
            else { g = kn + 128; dst = B.kw + (size_t)m * 256 + (ch - 32) * 64; }
#pragma unroll
            for (int i = 0; i < 2; ++i)
#pragma unroll
                for (int q4 = 0; q4 < 4; ++q4) {
                    const int nl = 32 * i + 8 * q4 + 4 * h;
                    const float4 gg = *(const float4*)(g + nl);
                    uint2 o;
                    o.x = pk2(acc[i][j][4 * q4] * rs * gg.x, acc[i][j][4 * q4 + 1] * rs * gg.y);
                    o.y = pk2(acc[i][j][4 * q4 + 2] * rs * gg.z, acc[i][j][4 * q4 + 3] * rs * gg.w);
                    *(uint2*)(dst + nl) = o;
                }
        } else if (ch >= 16 && ch < 24) {
            bf16_t* dst = (ch < 20) ? (B.kcr + (size_t)m * 256 + (ch - 16) * 64) : (B.vcr + (size_t)m * 256 + (ch - 20) * 64);
#pragma unroll
            for (int i = 0; i < 2; ++i)
#pragma unroll
                for (int q4 = 0; q4 < 4; ++q4) {
                    const int nl = 32 * i + 8 * q4 + 4 * h;
                    uint2 o;
                    o.x = pk2(acc[i][j][4 * q4], acc[i][j][4 * q4 + 1]);
                    o.y = pk2(acc[i][j][4 * q4 + 2], acc[i][j][4 * q4 + 3]);
                    *(uint2*)(dst + nl) = o;
                }
        } else if ((ch >= 28 && ch < 32) || (ch >= 36 && ch < 40)) {
            const int g = (ch < 32) ? (ch - 28) : (ch - 36);
            bf16_t* dst = ((ch < 32) ? B.vst : B.vwt) + ((size_t)(b * 4 + g) * 64) * SEQ + t;
#pragma unroll
            for (int i = 0; i < 2; ++i)
#pragma unroll
                for (int r = 0; r < 16; ++r) {
                    const int d = 32 * i + (r & 3) + 8 * (r >> 2) + 4 * h;
                    dst[(size_t)d * SEQ] = (bf16_t)(pk2(acc[i][j][r], 0.f) & 0xffffu);
                }
        } else if (ch == 40) {
#pragma unroll
            for (int i = 0; i < 2; ++i)
#pragma unroll
                for (int q4 = 0; q4 < 4; ++q4) {
                    const int nl = 32 * i + 8 * q4 + 4 * h;
                    if (nl < 48) *(float4*)(B.gates + (size_t)m * 48 + nl) = make_float4(sigm(acc[i][j][4 * q4]), sigm(acc[i][j][4 * q4 + 1]), sigm(acc[i][j][4 * q4 + 2]), sigm(acc[i][j][4 * q4 + 3]));
                }
        }
    }
}

__device__ __forceinline__ void p2a_item(const L0Bufs& B, const bf16_t* __restrict__ w1t, int which, int mt, int nt, char* smem) {
    const bf16_t* raw = which ? B.vcr : B.kcr;
    const int sr = opq_tid() >> 3;
    auto rowbase = [&](int i) -> const bf16_t* {
        const int m = mt * 128 + sr + 32 * i;
        if (m >= 4080) return nullptr;
        const int bg = m / NCMP, n = m - bg * NCMP;
        return raw + ((size_t)((bg >> 2) * SEQ + 16 * n)) * 256 + (bg & 3) * 64;
    };
    const bf16_t* rb0 = rowbase(0); const bf16_t* rb1 = rowbase(1); const bf16_t* rb2 = rowbase(2); const bf16_t* rb3 = rowbase(3);
    f32x16 acc[2][2];
    gemm_core<false>([&](int i, int r, int k0) -> const void* { const bf16_t* rbi = (i == 0) ? rb0 : (i == 1) ? rb1 : (i == 2) ? rb2 : rb3; return rbi ? (const void*)(rbi + (size_t)(k0 >> 6) * 256) : nullptr; }, w1t, 2048, nt * 128, 2048, smem, acc);
    const float* bias = B.bias1 + which * 256;
    bf16_t* hid = B.hidc + (size_t)which * 4096 * 256;
    epi_foreach(acc, mt * 128, nt * 128, [&](int m, int n, float4 v) {
        const float4 bb = *(const float4*)(bias + n);
        uint2 o; o.x = pk2(gelu_tanh(v.x + bb.x), gelu_tanh(v.y + bb.y)); o.y = pk2(gelu_tanh(v.z + bb.z), gelu_tanh(v.w + bb.w));
        *(uint2*)(hid + (size_t)m * 256 + n) = o;
    });
}
__device__ __forceinline__ void p2b_item(const L0Bufs& B, const bf16_t* __restrict__ w2t, const float* __restrict__ kn, int which, int mt, char* smem) {
    const bf16_t* hid = B.hidc + (size_t)which * 4096 * 256;
    f32x16 acc[2][2];
    gemm_core<false>([&](int i, int r, int k0) -> const void* { return (const void*)(hid + (size_t)(mt * 128 + r) * 256 + k0); }, w2t, 256, 0, 256, smem, acc);
    const int tid_ = opq_tid(), lane = tid_ & 63, wave = tid_ >> 6;
    const int wn = wave >> 1, wm = wave & 1, c = lane & 31, h = lane >> 5;
    if (wn != 0) return;
#pragma unroll
    for (int j = 0; j < 2; ++j) {
        const int m = mt * 128 + wm * 64 + 32 * j + c;
        const bool ok = m < 4080;
        const int bg = m / NCMP, n = m - bg * NCMP;
        if (which == 0) {
            float ss = 0.f;
#pragma unroll
            for (int i = 0; i < 2; ++i)
#pragma unroll
                for (int r = 0; r < 16; ++r) ss += acc[i][j][r] * acc[i][j][r];
            ss = sum32(ss);
            const float rs = rsqrtf(ss * (1.f / 64.f) + 1e-6f);
            if (ok) {
                bf16_t* dst = B.kc + ((size_t)bg * 256 + n) * 64;
#pragma unroll
                for (int i = 0; i < 2; ++i)
#pragma unroll
                    for (int q4 = 0; q4 < 4; ++q4) {
                        const int nl = 32 * i + 8 * q4 + 4 * h;
                        const float4 gg = *(const float4*)(kn + nl);
                        uint2 o;
                        o.x = pk2(acc[i][j][4 * q4] * rs * gg.x, acc[i][j][4 * q4 + 1] * rs * gg.y);
                        o.y = pk2(acc[i][j][4 * q4 + 2] * rs * gg.z, acc[i][j][4 * q4 + 3] * rs * gg.w);
                        *(uint2*)(dst + nl) = o;
                    }
            }
        } else if (ok) {
            bf16_t* dst = B.vct + ((size_t)bg * 64) * 256 + n;
#pragma unroll
            for (int i = 0; i < 2; ++i)
#pragma unroll
                for (int r = 0; r < 16; ++r) {
                    const int d = 32 * i + (r & 3) + 8 * (r >> 2) + 4 * h;
                    dst[(size_t)d * 256] = (bf16_t)(pk2(acc[i][j][r], 0.f) & 0xffffu);
                }
        }
    }
}

#define KROW 144
#define VROW 136
#define KT_BYTES (64 * KROW)
#define ABUF (KT_BYTES + 64 * VROW)
#define ATT_IMP_OFF (2 * ABUF)
#define ATT_MASK_OFF (ATT_IMP_OFF + 4 * 32 * 65 * 4)
#define ATT_MISC_OFF (ATT_MASK_OFF + 32 * 8)

struct KVRegs { uint4 k0, k1, v0, v1; };
typedef unsigned int u32x4 __attribute__((ext_vector_type(4)));
__device__ __forceinline__ uint4 bload16(__amdgpu_buffer_rsrc_t r, unsigned voff, unsigned soff) { const u32x4 v = __builtin_amdgcn_raw_buffer_load_b128(r, voff, soff, 0); return make_uint4(v.x, v.y, v.z, v.w); }
__device__ __forceinline__ KVRegs attn_load_tile(__amdgpu_buffer_rsrc_t rK, __amdgpu_buffer_rsrc_t rV, unsigned koff, unsigned voff, int kstride, int j) {
    KVRegs R;
    const unsigned ks = (unsigned)j * 128u * (unsigned)kstride, vs = (unsigned)j * 128u;
    R.k0 = bload16(rK, koff, ks); R.k1 = bload16(rK, koff + 16u, ks);
    R.v0 = bload16(rV, voff, vs); R.v1 = bload16(rV, voff + 16u, vs);
    return R;
}
__device__ __forceinline__ void attn_store_tile(char* buf, const KVRegs R, int tid) {
    const int row = tid >> 2, cq = tid & 3;
    char* kd = buf + row * KROW + cq * 32;
    *(uint4*)kd = R.k0; *(uint4*)(kd + 16) = R.k1;
    char* vd = buf + KT_BYTES + row * VROW + cq * 32;
    *(uint2*)vd = make_uint2(R.v0.x, R.v0.y); *(uint2*)(vd + 8) = make_uint2(R.v0.z, R.v0.w);
    *(uint2*)(vd + 16) = make_uint2(R.v1.x, R.v1.y); *(uint2*)(vd + 24) = make_uint2(R.v1.z, R.v1.w);
}
template <bool AUG>
__device__ __forceinline__ void attn_qk(const char* buf, const bf16x8 (&qf)[4], f32x16 (&st)[2], int tid, const bf16x8 (&kaug)[2], const bf16x8 qaug) {
    const int lane = tid & 63, cl = lane & 31, hh = lane >> 5;
    const char* kp = buf + cl * KROW + hh * 16;
    const bf16x8 k00 = *(const bf16x8*)(kp), k01 = *(const bf16x8*)(kp + 32), k02 = *(const bf16x8*)(kp + 64), k03 = *(const bf16x8*)(kp + 96);
    const bf16x8 k10 = *(const bf16x8*)(kp + 32 * KROW), k11 = *(const bf16x8*)(kp + 32 * KROW + 32), k12 = *(const bf16x8*)(kp + 32 * KROW + 64), k13 = *(const bf16x8*)(kp + 32 * KROW + 96);
    __builtin_amdgcn_sched_barrier(0);
#pragma unroll
    for (int r = 0; r < 16; ++r) { st[0][r] = 0.f; st[1][r] = 0.f; }
    st[0] = __builtin_amdgcn_mfma_f32_32x32x16_bf16(k00, qf[0], st[0], 0, 0, 0);
    st[1] = __builtin_amdgcn_mfma_f32_32x32x16_bf16(k10, qf[0], st[1], 0, 0, 0);
    st[0] = __builtin_amdgcn_mfma_f32_32x32x16_bf16(k01, qf[1], st[0], 0, 0, 0);
    st[1] = __builtin_amdgcn_mfma_f32_32x32x16_bf16(k11, qf[1], st[1], 0, 0, 0);
    st[0] = __builtin_amdgcn_mfma_f32_32x32x16_bf16(k02, qf[2], st[0], 0, 0, 0);
    st[1] = __builtin_amdgcn_mfma_f32_32x32x16_bf16(k12, qf[2], st[1], 0, 0, 0);
    st[0] = __builtin_amdgcn_mfma_f32_32x32x16_bf16(k03, qf[3], st[0], 0, 0, 0);
    st[1] = __builtin_amdgcn_mfma_f32_32x32x16_bf16(k13, qf[3], st[1], 0, 0, 0);
    if (AUG) {
        st[0] = __builtin_amdgcn_mfma_f32_32x32x16_bf16(kaug[0], qaug, st[0], 0, 0, 0);
        st[1] = __builtin_amdgcn_mfma_f32_32x32x16_bf16(kaug[1], qaug, st[1], 0, 0, 0);
    }
}
template <bool MASKED, int PSC>
__device__ __forceinline__ void attn_exp(f32x16 (&st)[2], bf16x8 (&pf)[2][2], int pos0, int tq, int wlim, float& l) {
    float l0 = 0.f, l1 = 0.f;
#pragma unroll
    for (int i = 0; i < 2; ++i) {
#pragma unroll
        for (int r = 0; r < 16; ++r) {
            float e = st[i][r];
            if (MASKED) { const int kl = 32 * i + (r & 3) + 8 * (r >> 2); const int dist = tq - (pos0 + PSC * kl); e = (dist >= 0 && dist < wlim) ? e : -INFINITY; }
            const float p = __builtin_amdgcn_exp2f(e);
            if (r & 1) l1 += p; else l0 += p;
            st[i][r] = p;
        }
#pragma unroll
        for (int s = 0; s < 2; ++s) {
            uint4 u;
            u.x = pk2(st[i][8 * s + 0], st[i][8 * s + 1]); u.y = pk2(st[i][8 * s + 2], st[i][8 * s + 3]);
            u.z = pk2(st[i][8 * s + 4], st[i][8 * s + 5]); u.w = pk2(st[i][8 * s + 6], st[i][8 * s + 7]);
            pf[i][s] = __builtin_bit_cast(bf16x8, u);
        }
    }
    l += l0 + l1;
}
struct VFrags { uint2 a[8]; };
__device__ __forceinline__ bf16x8 vjoin(uint2 v0, uint2 v1) { return __builtin_bit_cast(bf16x8, make_uint4(v0.x, v0.y, v1.x, v1.y)); }
#define VADDR(buf, dt, i, s) ((buf) + KT_BYTES + (32 * (dt) + cl) * VROW + (32 * (i) + 16 * (s) + 4 * hh) * 2)
__device__ __forceinline__ void attn_pv(const char* buf, const bf16x8 (&pf)[2][2], f32x16 (&ot)[2], int tid) {
    const int lane = tid & 63, cl = lane & 31, hh = lane >> 5;
    const char* a00 = VADDR(buf, 0, 0, 0);
    const uint2 p0 = *(const uint2*)(a00), p1 = *(const uint2*)(a00 + 16), p2 = *(const uint2*)(a00 + 32), p3 = *(const uint2*)(a00 + 48);
    const uint2 p4 = *(const uint2*)(a00 + 64), p5 = *(const uint2*)(a00 + 80), p6 = *(const uint2*)(a00 + 96), p7 = *(const uint2*)(a00 + 112);
    const char* a10 = a00 + 32 * VROW;
    const uint2 q0 = *(const uint2*)(a10), q1 = *(const uint2*)(a10 + 16), q2 = *(const uint2*)(a10 + 32), q3 = *(const uint2*)(a10 + 48);
    const uint2 q4 = *(const uint2*)(a10 + 64), q5 = *(const uint2*)(a10 + 80), q6 = *(const uint2*)(a10 + 96), q7 = *(const uint2*)(a10 + 112);
    __builtin_amdgcn_sched_barrier(0);
    ot[0] = __builtin_amdgcn_mfma_f32_32x32x16_bf16(vjoin(p0, p1), pf[0][0], ot[0], 0, 0, 0);
    ot[1] = __builtin_amdgcn_mfma_f32_32x32x16_bf16(vjoin(q0, q1), pf[0][0], ot[1], 0, 0, 0);
    ot[0] = __builtin_amdgcn_mfma_f32_32x32x16_bf16(vjoin(p2, p3), pf[0][1], ot[0], 0, 0, 0);
    ot[1] = __builtin_amdgcn_mfma_f32_32x32x16_bf16(vjoin(q2, q3), pf[0][1], ot[1], 0, 0, 0);
    ot[0] = __builtin_amdgcn_mfma_f32_32x32x16_bf16(vjoin(p4, p5), pf[1][0], ot[0], 0, 0, 0);
    ot[1] = __builtin_amdgcn_mfma_f32_32x32x16_bf16(vjoin(q4, q5), pf[1][0], ot[1], 0, 0, 0);
    ot[0] = __builtin_amdgcn_mfma_f32_32x32x16_bf16(vjoin(p6, p7), pf[1][1], ot[0], 0, 0, 0);
    ot[1] = __builtin_amdgcn_mfma_f32_32x32x16_bf16(vjoin(q6, q7), pf[1][1], ot[1], 0, 0, 0);
}

template <int PSC, int POFF>
__device__ __forceinline__ void attn_branch(const bf16_t* SK, const bf16_t* SVT, int kstride, int vstride, unsigned long long tiles, unsigned long long maskbits, unsigned long long lane_mask,
                                            const bf16x8 (&qf)[4], float slope2, float tb0, int tq, int wlim, char* smem, f32x16 (&ot)[2], float& l, int tid) {
    const int hh = (tid & 63) >> 5;
#pragma unroll
    for (int dt = 0; dt < 2; ++dt)
#pragma unroll
        for (int r = 0; r < 16; ++r) ot[dt][r] = 0.f;
    l = 0.f;
    if (tiles == 0ull) return;
    const __amdgpu_buffer_rsrc_t rK = __builtin_amdgcn_make_buffer_rsrc((void*)SK, 0, 0x7fffffff, 0x00020000);
    const __amdgpu_buffer_rsrc_t rV = __builtin_amdgcn_make_buffer_rsrc((void*)SVT, 0, 0x7fffffff, 0x00020000);
    const unsigned koff = (((unsigned)tid >> 2) * (unsigned)kstride + ((unsigned)tid & 3) * 16u) * 2u, voff = (((unsigned)tid >> 2) * (unsigned)vstride + ((unsigned)tid & 3) * 16u) * 2u;
    bf16x8 kaug[2];
    const float sk = slope2 * (float)PSC;
    const unsigned s_hi = pk2(sk, 0.f) & 0xffffu, s_lo = pk2(sk - bf16_lo_f(s_hi), 0.f) & 0xffffu;
    {
        const int cl = tid & 31;
#pragma unroll
        for (int i = 0; i < 2; ++i) {
            const float klf = (float)(32 * i + cl);
            uint4 u = make_uint4(pk2(klf, klf), 0x3f803f80u, 0x00003f80u, 0u);
            if (hh) u = make_uint4(0u, 0u, 0u, 0u);
            kaug[i] = __builtin_bit_cast(bf16x8, u);
        }
    }
    auto compute = [&](const char* buf, int j) {
        f32x16 st[2]; bf16x8 pf[2][2];
        const float t = fmaf(slope2, (float)(PSC * 64 * j + POFF), tb0);
        const bool on = (lane_mask >> j) & 1ull;
        const unsigned t_hi = on ? (pk2(t, 0.f) & 0xffffu) : 0xff80u;
        const float r1 = on ? (t - bf16_lo_f(t_hi)) : 0.f;
        const unsigned t_lo = pk2(r1, 0.f) & 0xffffu;
        const unsigned t_l2 = pk2(r1 - bf16_lo_f(t_lo), 0.f) & 0xffffu;
        uint4 qu = make_uint4(s_hi | (s_lo << 16), t_hi | (t_lo << 16), t_l2, 0u);
        if (hh) qu = make_uint4(0u, 0u, 0u, 0u);
        attn_qk<true>(buf, qf, st, tid, kaug, __builtin_bit_cast(bf16x8, qu));
        const int pos0 = PSC * (64 * j + 4 * hh) + POFF;
        if ((maskbits >> j) & 1ull) attn_exp<true, PSC>(st, pf, pos0, tq, wlim, l);
        else attn_exp<false, PSC>(st, pf, pos0, tq, wlim, l);
        attn_pv(buf, pf, ot, tid);
    };
    int j = __builtin_ctzll(tiles); tiles &= tiles - 1;
    KVRegs R = attn_load_tile(rK, rV, koff, voff, kstride, j);
    __syncthreads();
    attn_store_tile(smem, R, tid);
    __syncthreads();
    int cur = 0;
    for (;;) {
        const bool more = tiles != 0ull;
        int jn = 0;
        if (more) { jn = __builtin_ctzll(tiles); tiles &= tiles - 1; R = attn_load_tile(rK, rV, koff, voff, kstride, jn); }
        compute(smem + cur * ABUF, j);
        if (more) attn_store_tile(smem + (cur ^ 1) * ABUF, R, tid);
        __syncthreads();
        if (!more) break;
        j = jn; cur ^= 1;
    }
}

__device__ __forceinline__ void nsa_attn_item(const L0Bufs& B, const float* __restrict__ qn, const float* __restrict__ kn, bf16_t* __restrict__ att, int bg, int qb, char* smem) {
    const int tid = opq_tid();
    const int lane = tid & 63, wave = tid >> 6, cl = lane & 31, hh = lane >> 5;
    const int b = bg >> 2, g = bg & 3, hd = g * 4 + wave;
    const int t0 = qb * 32, c = qb >> 1, tq = t0 + cl;
    const float slope2 = exp2f(-0.5f * (float)(hd + 1)) * LOG2E;
    float* imp = (float*)(smem + ATT_IMP_OFF);
    uint2* msk = (uint2*)(smem + ATT_MASK_OFF);
    const float gq = wave_max(fabsf(qn[lane]));
    const float m2c = (8.f * gq * wave_max(fabsf(kn[lane])) * 1.02f + 0.5f) * LOG2E;
    const float m2s = (8.f * gq * wave_max(fabsf(kn[64 + lane])) * 1.02f + 0.5f) * LOG2E;
    const float m2w = (8.f * gq * wave_max(fabsf(kn[128 + lane])) * 1.02f + 0.5f) * LOG2E;
    bf16x8 qf[4];
    {
        const bf16_t* qp = B.q + (size_t)(b * SEQ + tq) * 1024 + hd * 64 + 8 * hh;
#pragma unroll
        for (int ks = 0; ks < 4; ++ks) qf[ks] = *(const bf16x8*)(qp + ks * 16);
    }
#define NSA_GATE(idx, dep) ({ int t_ = threadIdx.x; asm volatile("" : "+v"(t_) : "v"(dep)); B.gates[(size_t)(b * SEQ + t0 + (t_ & 31)) * 48 + (g * 4 + (t_ >> 6)) * 3 + (idx)]; })
    f32x16 res[2], ot[2];
    float l;
    for (int e = tid; e < 4 * 32 * 65; e += 256) imp[e] = 0.f;
    const int ntc = (qb >> 5) + 1;
    const unsigned long long ctiles = (1ull << ntc) - 1ull;
    const bf16_t* SCK = B.kc + (size_t)bg * 256 * 64;
    const bf16_t* SCV = B.vct + (size_t)bg * 64 * 256;
    const float tbc = -(slope2 * (float)tq) - m2c;
    attn_branch<16, 31>(SCK, SCV, 64, 256, ctiles, ctiles, ~0ull, qf, slope2, tbc, tq, 1 << 30, smem, ot, l, tid);
    const float lc = sum32(l);
    const float invc = (lc > 0.f) ? 1.f / lc : 0.f;
    {
        const float f = NSA_GATE(0, invc) * invc;
#pragma unroll
        for (int dt = 0; dt < 2; ++dt)
#pragma unroll
            for (int r = 0; r < 16; ++r) res[dt][r] = ot[dt][r] * f;
    }
    {
        float* row = imp + wave * (32 * 65) + cl * 65;
        for (int jt = 0; jt < ntc; ++jt) {
            {
                const int rowi = tid >> 2, cq = tid & 3;
                const bf16_t* kp = SCK + (size_t)(jt * 64 + rowi) * 64 + cq * 16;
                const uint4 ka = *(const uint4*)kp, kb = *(const uint4*)(kp + 8);
                __syncthreads();
                char* kd = smem + rowi * KROW + cq * 32;
                *(uint4*)kd = ka; *(uint4*)(kd + 16) = kb;
                __syncthreads();
            }
            f32x16 st[2];
            { bf16x8 kz[2]; kz[0] = __builtin_bit_cast(bf16x8, make_uint4(0u, 0u, 0u, 0u)); kz[1] = kz[0]; attn_qk<false>(smem, qf, st, tid, kz, kz[0]); }
            const int pos0 = 16 * (64 * jt + 4 * hh) + 31;
            const float tb = fmaf(slope2, (float)pos0, tbc);
#pragma unroll
            for (int i = 0; i < 2; ++i)
#pragma unroll
                for (int gq4 = 0; gq4 < 4; ++gq4) {
                    float p[4];
#pragma unroll
                    for (int e4 = 0; e4 < 4; ++e4) {
                        const int r = 4 * gq4 + e4;
                        const int kl = 32 * i + (r & 3) + 8 * (r >> 2);
                        float e = fmaf(slope2 * 16.f, (float)kl, st[i][r]) + tb;
                        e = (tq - (pos0 + 16 * kl) >= 0) ? e : -INFINITY;
                        p[e4] = __builtin_amdgcn_exp2f(e) * invc;
                    }
                    const int js = 16 * jt + 8 * i + 2 * gq4 + hh;
                    row[js] += p[0] + p[1] + p[2] + 0.5f * p[3];
                    st[i][4 * gq4] = 0.5f * p[3];
                }
            __builtin_amdgcn_s_waitcnt(0xc07f);
#pragma unroll
            for (int i = 0; i < 2; ++i)
#pragma unroll
                for (int gq4 = 0; gq4 < 4; ++gq4) { const int js = 16 * jt + 8 * i + 2 * gq4 + hh; row[js + 1] += st[i][4 * gq4]; }
        }
    }
    __syncthreads();
    {
        const int q = tid >> 3, part = tid & 7;
        const float* row = imp + q * 65;
        auto impv = [&](int j) -> float { return ((row[j] + row[j + 32 * 65]) + row[j + 2 * 32 * 65]) + row[j + 3 * 32 * 65]; };
        float myv[8]; int rank[8];
#pragma unroll
        for (int u = 0; u < 8; ++u) { const int j = part * 8 + u; const bool f = (j == 0) || (j == c) || (j == c - 1); myv[u] = f ? 1e9f : impv(j); rank[u] = 0; }
        for (int j2 = 0; j2 <= c; ++j2) {
            const bool f2 = (j2 == 0) || (j2 == c) || (j2 == c - 1);
            const float v2 = f2 ? 1e9f : impv(j2);
#pragma unroll
            for (int u = 0; u < 8; ++u) { const int j = part * 8 + u; rank[u] += (v2 > myv[u] || (v2 == myv[u] && j2 < j)) ? 1 : 0; }
        }
        unsigned bits = 0u;
#pragma unroll
        for (int u = 0; u < 8; ++u) { const int j = part * 8 + u; if (j <= c && rank[u] < 16) bits |= 1u << u; }
        unsigned lo = (part < 4) ? (bits << (8 * part)) : 0u, hi = (part >= 4) ? (bits << (8 * (part - 4))) : 0u;
        lo |= ux<1>(lo); lo |= ux<2>(lo); lo |= ux<4>(lo); hi |= ux<1>(hi); hi |= ux<2>(hi); hi |= ux<4>(hi);
        if (part == 0) msk[q] = make_uint2(lo, hi);
    }
    __syncthreads();
    const uint2 mm = msk[cl];
    const unsigned long long mymask = (unsigned long long)mm.x | ((unsigned long long)mm.y << 32);
    const unsigned ulo = or_lo32(mm.x), uhi = or_lo32(mm.y);
    const unsigned long long U = (unsigned long long)__builtin_amdgcn_readfirstlane(ulo) | ((unsigned long long)__builtin_amdgcn_readfirstlane(uhi) << 32);
    {
        const float tbs = -(slope2 * (float)tq) - m2s;
        attn_branch<1, 0>(B.ks + (size_t)(b * SEQ) * 256 + g * 64, B.vst + (size_t)bg * 64 * SEQ, 256, SEQ, U, 1ull << c, mymask, qf, slope2, tbs, tq, 1 << 30, smem, ot, l, tid);
        const float ls = sum32(l);
        const float f = NSA_GATE(1, ls) / ls;
#pragma unroll
        for (int dt = 0; dt < 2; ++dt)
#pragma unroll
            for (int r = 0; r < 16; ++r) res[dt][r] += ot[dt][r] * f;
    }
    {
        const float tbw = -(slope2 * (float)tq) - m2w;
        const int lo_pos = t0 - 511;
        const int jlo = lo_pos > 0 ? (lo_pos >> 6) : 0;
        unsigned long long wt = 0ull, wm = 0ull;
        for (int j = jlo; j <= c; ++j) { wt |= 1ull << j; if (j == c || 64 * j < t0 + 31 - 511) wm |= 1ull << j; }
        attn_branch<1, 0>(B.kw + (size_t)(b * SEQ) * 256 + g * 64, B.vwt + (size_t)bg * 64 * SEQ, 256, SEQ, wt, wm, ~0ull, qf, slope2, tbw, tq, 512, smem, ot, l, tid);
        const float lw_ = sum32(l);
        const float f = NSA_GATE(2, lw_) / lw_;
#pragma unroll
        for (int dt = 0; dt < 2; ++dt)
#pragma unroll
            for (int r = 0; r < 16; ++r) res[dt][r] += ot[dt][r] * f;
    }
    {
        const int tid2 = opq_tid();
        bf16_t* dst = att + (size_t)(b * SEQ + t0 + (tid2 & 31)) * 1024 + (g * 4 + (tid2 >> 6)) * 64;
#pragma unroll
        for (int dt = 0; dt < 2; ++dt)
#pragma unroll
            for (int q4 = 0; q4 < 4; ++q4) {
                const int d = 32 * dt + 8 * q4 + 4 * hh;
                uint2 o; o.x = pk2(res[dt][4 * q4], res[dt][4 * q4 + 1]); o.y = pk2(res[dt][4 * q4 + 2], res[dt][4 * q4 + 3]);
                *(uint2*)(dst + d) = o;
            }
    }
}


template <bool COMBINE, int R>
__device__ __forceinline__ void rp_rows(const float* __restrict__ in, float* __restrict__ hw, const bf16_t* __restrict__ ys, bf16_t* __restrict__ hi, int row0, int rstride, int nrows_valid, float* rs_out) {
    const int lane = opq_tid() & 63;
    float4 v[R][4]; float ss[R];
#pragma unroll
    for (int r = 0; r < R; ++r) {
        const size_t row = (size_t)(row0 + r * rstride);
        ss[r] = 0.f;
        if (r < nrows_valid) {
#pragma unroll
            for (int i = 0; i < 4; ++i) v[r][i] = ((const float4*)(in + row * DM))[lane + 64 * i];
        }
    }
    if (COMBINE) {
#pragma unroll
        for (int r = 0; r < R; ++r) {
            const size_t row = (size_t)(row0 + r * rstride);
            if (r < nrows_valid) {
#pragma unroll
                for (int i = 0; i < 4; ++i) {
                    const uint2 b = ((const uint2*)(ys + row * 2 * DM))[lane + 64 * i], c = ((const uint2*)(ys + row * 2 * DM + DM))[lane + 64 * i];
                    float4 a = v[r][i];
                    a.x += bf16_lo_f(b.x) + bf16_lo_f(c.x); a.y += bf16_hi_f(b.x) + bf16_hi_f(c.x);
                    a.z += bf16_lo_f(b.y) + bf16_lo_f(c.y); a.w += bf16_hi_f(b.y) + bf16_hi_f(c.y);
                    v[r][i] = a;
                    ((float4*)(hw + row * DM))[lane + 64 * i] = a;
                }
            }
        }
    }
#pragma unroll
    for (int r = 0; r < R; ++r) {
        if (r < nrows_valid) {
#pragma unroll
            for (int i = 0; i < 4; ++i) ss[r] += v[r][i].x * v[r][i].x + v[r][i].y * v[r][i].y + v[r][i].z * v[r][i].z + v[r][i].w * v[r][i].w;
        }
    }
#pragma unroll
    for (int r = 0; r < R; ++r) ss[r] = wave_sum(ss[r]);
#pragma unroll
    for (int r = 0; r < R; ++r) {
        const size_t row = (size_t)(row0 + r * rstride);
        if (r < nrows_valid) {
            const float rr = rsqrtf(ss[r] * (1.f / DM) + 1e-6f);
            if (rs_out && lane == 0) rs_out[r] = rr;
#pragma unroll
            for (int i = 0; i < 4; ++i) {
                uint2 o; o.x = pk2(v[r][i].x * rr, v[r][i].y * rr); o.y = pk2(v[r][i].z * rr, v[r][i].w * rr);
                ((uint2*)(hi + row * DM))[lane + 64 * i] = o;
            }
        }
    }
}

__device__ __forceinline__ void rw_build(const float* __restrict__ wg, const float* __restrict__ we, const float* __restrict__ gain, float* __restrict__ dst, int start, int stride) {
    for (int idx = start; idx < 1024 * 36; idx += stride) {
        const int k = idx / 36, n = idx - k * 36;
        dst[idx] = ((n < 4) ? wg[k * 4 + n] : we[k * 32 + (n - 4)]) * gain[k];
    }
}
__device__ __forceinline__ void route_select(const float (&lg)[36], const float* __restrict__ bgp, const float* __restrict__ bep, int t,
                                             int* __restrict__ cnt, int* __restrict__ lslot, float* __restrict__ lw) {
    float gl[4];
#pragma unroll
    for (int i = 0; i < 4; ++i) gl[i] = lg[i] + bgp[i];
    int gi = 0; float gm = gl[0];
#pragma unroll
    for (int i = 1; i < 4; ++i) if (gl[i] > gm) { gm = gl[i]; gi = i; }
    float gs = 0.f;
#pragma unroll
    for (int i = 0; i < 4; ++i) gs += expf(gl[i] - gm);
    const float gw = 1.f / gs;
    float el[8];
#pragma unroll
    for (int e = 0; e < 8; ++e) {
        float v = 0.f;
#pragma unroll
        for (int gg = 0; gg < 4; ++gg) v = (gg == gi) ? (lg[4 + gg * 8 + e] + bep[gg * 8 + e]) : v;
        el[e] = v;
    }
    int e1 = 0; float m1 = el[0];
#pragma unroll
    for (int e = 1; e < 8; ++e) if (el[e] > m1) { m1 = el[e]; e1 = e; }
    int e2 = -1; float m2 = -INFINITY;
#pragma unroll
    for (int e = 0; e < 8; ++e) if (e != e1 && el[e] > m2) { m2 = el[e]; e2 = e; }
    const float p2 = expf(m2 - m1);
    const float w1 = gw / (1.f + p2), w2 = gw * p2 / (1.f + p2);
    const int x1 = gi * 8 + e1, x2 = gi * 8 + e2;
    const int p1 = atomicAdd(&cnt[x1 * CNT_STRIDE], 1);
    lslot[x1 * TTOK + p1] = t * 2; lw[x1 * TTOK + p1] = w1;
    const int pp2 = atomicAdd(&cnt[x2 * CNT_STRIDE], 1);
    lslot[x2 * TTOK + pp2] = t * 2 + 1; lw[x2 * TTOK + pp2] = w2;
}
__device__ __forceinline__ void route_item(const float* __restrict__ h, bf16_t* __restrict__ xhi, const float* __restrict__ wr32,
                                           const float* __restrict__ bgp, const float* __restrict__ bep,
                                           int* __restrict__ cnt, int* __restrict__ lslot, float* __restrict__ lw, int it, char* smem) {
    const int tid = opq_tid(), wave = tid >> 6, lane = tid & 63;
    const int m0 = it * 32;
    float* wch = (float*)smem;
    float* rs = (float*)(smem + 36864);
    rp_rows<false, 4>(h, nullptr, nullptr, xhi, m0 + wave * 8, 1, 4, rs + wave * 8);
    rp_rows<false, 4>(h, nullptr, nullptr, xhi, m0 + wave * 8 + 4, 1, 4, rs + wave * 8 + 4);
    const int tp = tid >> 4, part = tid & 15;
    float a0[36], a1[36];
#pragma unroll
    for (int n = 0; n < 36; ++n) { a0[n] = 0.f; a1[n] = 0.f; }
    float* xch = (float*)(smem + 36864 + 128);
    for (int ch = 0; ch < 4; ++ch) {
        __syncthreads();
#pragma unroll
        for (int i = 0; i < 9; ++i) ((float4*)wch)[tid + 256 * i] = ((const float4*)(wr32 + (size_t)ch * 256 * 36))[tid + 256 * i];
#pragma unroll
        for (int i = 0; i < 8; ++i) { const int e = tid + 256 * i, r = e >> 6, c4 = e & 63; *(float4*)(xch + r * 260 + c4 * 4) = *(const float4*)(h + (size_t)(m0 + r) * DM + ch * 256 + c4 * 4); }
        __syncthreads();
        const float* xr0 = xch + (2 * tp) * 260 + part;
#pragma unroll 2
        for (int kk = 0; kk < 16; ++kk) {
            const float v0 = xr0[kk * 16], v1 = xr0[260 + kk * 16];
            const float4* wrow = (const float4*)(wch + (kk * 16 + part) * 36);
#pragma unroll
            for (int q = 0; q < 9; ++q) {
                const float4 w = wrow[q];
                a0[4 * q] += v0 * w.x; a0[4 * q + 1] += v0 * w.y; a0[4 * q + 2] += v0 * w.z; a0[4 * q + 3] += v0 * w.w;
                a1[4 * q] += v1 * w.x; a1[4 * q + 1] += v1 * w.y; a1[4 * q + 2] += v1 * w.z; a1[4 * q + 3] += v1 * w.w;
            }
        }
    }
    const float r0 = rs[2 * tp], r1 = rs[2 * tp + 1];
#pragma unroll
    for (int n = 0; n < 36; ++n) {
        float s0 = a0[n], s1 = a1[n];
        s0 += fx<1>(s0); s0 += fx<2>(s0); s0 += fx<4>(s0); s0 += fx<8>(s0);
        s1 += fx<1>(s1); s1 += fx<2>(s1); s1 += fx<4>(s1); s1 += fx<8>(s1);
        a0[n] = s0 * r0; a1[n] = s1 * r1;
    }
    if (part == 0) {
        route_select(a0, bgp, bep, m0 + 2 * tp, cnt, lslot, lw);
        route_select(a1, bgp, bep, m0 + 2 * tp + 1, cnt, lslot, lw);
    }
}

struct EpiStoreB { bf16_t* C; long long ldc; __device__ void operator()(int r, int c, float4 v) const { uint2 o; o.x = pk2(v.x, v.y); o.y = pk2(v.z, v.w); *(uint2*)(C + (size_t)r * ldc + c) = o; } };
struct EpiPleB { const bf16_t* Pj; float* H; long long ldc; __device__ void operator()(int r, int c, float4 v) const {
    const uint2 p = *(const uint2*)(Pj + (size_t)r * ldc + c); float4 a = *(const float4*)(H + (size_t)r * ldc + c);
    a.x += bf16_lo_f(p.x) / (1.f + __expf(-v.x)); a.y += bf16_hi_f(p.x) / (1.f + __expf(-v.y)); a.z += bf16_lo_f(p.y) / (1.f + __expf(-v.z)); a.w += bf16_hi_f(p.y) / (1.f + __expf(-v.w));
    *(float4*)(H + (size_t)r * ldc + c) = a; } };
__device__ __forceinline__ void ple_proj_item(const float* __restrict__ pin, const bf16_t* __restrict__ wp, bf16_t* __restrict__ pj, int bx, int by, char* smem) {
    d_gemm<true>(pin, wp, 256, TTOK, DM, 256, EpiStoreB{pj, DM}, bx, by, smem);
}
__device__ __forceinline__ void ple_item(const bf16_t* __restrict__ xhat, const bf16_t* __restrict__ wg, const bf16_t* __restrict__ pj, float* __restrict__ h, int bx, int by, char* smem) {
    d_gemm<false>(xhat, wg, DM, TTOK, DM, DM, EpiPleB{pj, h, DM}, bx, by, smem);
}

#define HROW 272
#define MOE_W_OFF 36864
template <bool A_F32>
__device__ __forceinline__ void moe_item(const void* __restrict__ xn, const bf16_t* __restrict__ wgu, const bf16_t* __restrict__ wd,
                                         const int* __restrict__ slots, const float* __restrict__ wts, int nvalid, bf16_t* __restrict__ ys, char* smem) {
    const int tid = opq_tid(), lane = tid & 63, wave = tid >> 6;
    const int wn = wave >> 1, wm = wave & 1, c = lane & 31, h = lane >> 5;
    const int sr = tid >> 3, sc = tid & 7;
    auto rowp = [&](int i) -> const char* {
        const int idx = sr + 32 * i;
        if (idx >= nvalid) return nullptr;
        const int tok = slots[idx] >> 1;
        return (const char*)xn + (size_t)tok * 1024 * (A_F32 ? 4 : 2);
    };
    const char* rp0 = rowp(0); const char* rp1 = rowp(1); const char* rp2 = rowp(2); const char* rp3 = rowp(3);
    float cw[2]; int myslot[2];
#pragma unroll
    for (int j = 0; j < 2; ++j) {
        const int idx = wm * 64 + 32 * j + c;
        const bool ok = idx < nvalid;
        cw[j] = ok ? wts[idx] : 0.f;
        myslot[j] = ok ? slots[idx] : -1;
    }
    unsigned hp[2][2][8];
#pragma unroll
    for (int pass = 0; pass < 2; ++pass) {
        f32x16 acc[2][2];
        gemm_core<A_F32>([&](int i, int r, int k0) -> const void* {
            const char* p = (i == 0) ? rp0 : (i == 1) ? rp1 : (i == 2) ? rp2 : rp3;
            return p ? (const void*)(p + (size_t)k0 * (A_F32 ? 4 : 2)) : nullptr; }, wgu, 1024, pass * 128, 1024, smem, acc);
#pragma unroll
        for (int j = 0; j < 2; ++j)
#pragma unroll
            for (int r2 = 0; r2 < 8; ++r2) {
                const float g0 = acc[0][j][2 * r2], g1 = acc[0][j][2 * r2 + 1];
                const float u0 = acc[1][j][2 * r2], u1 = acc[1][j][2 * r2 + 1];
                const float h0 = g0 / (1.f + __expf(-g0)) * u0 * cw[j], h1 = g1 / (1.f + __expf(-g1)) * u1 * cw[j];
                hp[pass][j][r2] = pk2(h0, h1);
            }
    }
#pragma unroll
    for (int pass = 0; pass < 2; ++pass)
#pragma unroll
        for (int j = 0; j < 2; ++j)
#pragma unroll
            for (int q4 = 0; q4 < 4; ++q4) {
                const int m = wm * 64 + 32 * j + c, f = pass * 64 + wn * 32 + 8 * q4 + 4 * h;
                *(uint2*)(smem + m * HROW + f * 2) = make_uint2(hp[pass][j][2 * q4], hp[pass][j][2 * q4 + 1]);
            }
    uint4 wa0, wa1, wa2, wa3;
    auto wload = [&](int s) {
        const int nt = s >> 1, kt = s & 1;
        const bf16_t* p = wd + (size_t)(nt * 128 + sr) * 128 + kt * 64 + sc * 8;
        wa0 = *(const uint4*)p; wa1 = *(const uint4*)(p + 32 * 128); wa2 = *(const uint4*)(p + 64 * 128); wa3 = *(const uint4*)(p + 96 * 128);
    };
    auto wstore = [&](int buf) {
        char* wb = smem + MOE_W_OFF + buf * TILE_BYTES + sr * LDS_ROW + sc * 16;
        *(uint4*)wb = wa0; *(uint4*)(wb + 32 * LDS_ROW) = wa1; *(uint4*)(wb + 64 * LDS_ROW) = wa2; *(uint4*)(wb + 96 * LDS_ROW) = wa3;
    };
    wload(0); wstore(0);
    __syncthreads();
    f32x16 acc[2][2];
    for (int s = 0; s < 16; ++s) {
        const int kt = s & 1;
        if (kt == 0) {
#pragma unroll
            for (int i = 0; i < 2; ++i)
#pragma unroll
                for (int j = 0; j < 2; ++j)
#pragma unroll
                    for (int r = 0; r < 16; ++r) acc[i][j][r] = 0.f;
        }
        if (s + 1 < 16) wload(s + 1);
        const char* wb = smem + MOE_W_OFF + (s & 1) * TILE_BYTES;
        {
            const char* wp0 = wb + (wn * 64 + c) * LDS_ROW + h * 16;
            const char* xp0 = smem + (wm * 64 + c) * HROW + kt * 128 + h * 16;
            bf16x8 wfa0 = *(const bf16x8*)(wp0), wfa1 = *(const bf16x8*)(wp0 + 32 * LDS_ROW), xfa0 = *(const bf16x8*)(xp0), xfa1 = *(const bf16x8*)(xp0 + 32 * HROW);
#pragma unroll
            for (int ks = 0; ks < 4; ++ks) {
                bf16x8 wfb0, wfb1, xfb0, xfb1;
                if (ks < 3) {
                    wfb0 = *(const bf16x8*)(wp0 + (ks + 1) * 32); wfb1 = *(const bf16x8*)(wp0 + 32 * LDS_ROW + (ks + 1) * 32);
                    xfb0 = *(const bf16x8*)(xp0 + (ks + 1) * 32); xfb1 = *(const bf16x8*)(xp0 + 32 * HROW + (ks + 1) * 32);
                }
                acc[0][0] = __builtin_amdgcn_mfma_f32_32x32x16_bf16(wfa0, xfa0, acc[0][0], 0, 0, 0);
                acc[0][1] = __builtin_amdgcn_mfma_f32_32x32x16_bf16(wfa0, xfa1, acc[0][1], 0, 0, 0);
                acc[1][0] = __builtin_amdgcn_mfma_f32_32x32x16_bf16(wfa1, xfa0, acc[1][0], 0, 0, 0);
                acc[1][1] = __builtin_amdgcn_mfma_f32_32x32x16_bf16(wfa1, xfa1, acc[1][1], 0, 0, 0);
                __builtin_amdgcn_sched_barrier(0);
                if (ks < 3) { wfa0 = wfb0; wfa1 = wfb1; xfa0 = xfb0; xfa1 = xfb1; }
            }
        }
        if (s + 1 < 16) wstore((s + 1) & 1);
        if (kt == 1) {
            const int nt = s >> 1;
#pragma unroll
            for (int j = 0; j < 2; ++j) {
                if (myslot[j] >= 0) {
                    bf16_t* dst = ys + (size_t)myslot[j] * 1024 + nt * 128 + wn * 64;
#pragma unroll
                    for (int i = 0; i < 2; ++i)
#pragma unroll
                        for (int q4 = 0; q4 < 4; ++q4) {
                            uint2 o; o.x = pk2(acc[i][j][4 * q4], acc[i][j][4 * q4 + 1]); o.y = pk2(acc[i][j][4 * q4 + 2], acc[i][j][4 * q4 + 3]);
                            *(uint2*)(dst + 32 * i + 8 * q4 + 4 * h) = o;
                        }
                }
            }
        }
        __syncthreads();
    }
}

struct L1Bufs { bf16_t *q, *k, *vt; float* kmpart; };

__device__ __forceinline__ void p7_item(const bf16_t* __restrict__ xn, const bf16_t* __restrict__ wt, const float* __restrict__ qn, const float* __restrict__ kn,
                                        const L1Bufs& B, int bx, int by, char* smem) {
    const int m0 = by * 128, n0 = bx * 128;
    f32x16 acc[2][2];
    gemm_core<false>([&](int i, int r, int k0) -> const void* { return (const void*)(xn + (size_t)(m0 + r) * DM + k0); }, wt, DM, n0, DM, smem, acc);
    const int tid_ = opq_tid(), lane = tid_ & 63, wave = tid_ >> 6;
    const int wn = wave >> 1, wm = wave & 1, c = lane & 31, h = lane >> 5;
    const int ch = (n0 >> 6) + wn;
    if (ch < 4 || ch >= 8) {
        const float* g = (ch < 4) ? kn : qn;
        float nv[2][2][16];
#pragma unroll
        for (int j = 0; j < 2; ++j) {
            const int m = m0 + wm * 64 + 32 * j + c;
            float ss = 0.f;
#pragma unroll
            for (int i = 0; i < 2; ++i)
#pragma unroll
                for (int r = 0; r < 16; ++r) ss += acc[i][j][r] * acc[i][j][r];
            ss = sum32(ss);
            float rs = rsqrtf(ss * (1.f / 64.f) + 1e-6f);
            if (ch >= 8) rs *= 0.125f * LOG2E;
            bf16_t* dst = (ch < 4) ? (B.k + (size_t)m * 256 + ch * 64) : (B.q + (size_t)m * 1024 + (ch - 8) * 64);
#pragma unroll
            for (int i = 0; i < 2; ++i)
#pragma unroll
                for (int q4 = 0; q4 < 4; ++q4) {
                    const int nl = 32 * i + 8 * q4 + 4 * h;
                    const float4 gg = *(const float4*)(g + nl);
                    const float v0 = acc[i][j][4 * q4] * rs * gg.x, v1 = acc[i][j][4 * q4 + 1] * rs * gg.y, v2 = acc[i][j][4 * q4 + 2] * rs * gg.z, v3 = acc[i][j][4 * q4 + 3] * rs * gg.w;
                    nv[i][j][4 * q4] = v0; nv[i][j][4 * q4 + 1] = v1; nv[i][j][4 * q4 + 2] = v2; nv[i][j][4 * q4 + 3] = v3;
                    uint2 o; o.x = pk2(v0, v1); o.y = pk2(v2, v3);
                    *(uint2*)(dst + nl) = o;
                }
        }
        if (ch < 4) {
            const int mb = m0 + wm * 64, b = mb >> 12, grp = (mb & 4095) >> 6;
            float* dst = B.kmpart + ((size_t)(b * 4 + ch) * 64 + grp) * 64;
#pragma unroll
            for (int i = 0; i < 2; ++i)
#pragma unroll
                for (int r = 0; r < 16; ++r) {
                    float s = sum_lo32(nv[i][0][r] + nv[i][1][r]);
                    if (c == 0) dst[32 * i + (r & 3) + 8 * (r >> 2) + 4 * h] = s;
                }
        }
    } else {
        const int g = ch - 4;
#pragma unroll
        for (int j = 0; j < 2; ++j) {
            const int m = m0 + wm * 64 + 32 * j + c;
            const int b = m >> 12, t = m & 4095;
            bf16_t* dst = B.vt + ((size_t)(b * 4 + g) * 64) * SEQ + t;
#pragma unroll
            for (int i = 0; i < 2; ++i)
#pragma unroll
                for (int r = 0; r < 16; ++r) {
                    const int d = 32 * i + (r & 3) + 8 * (r >> 2) + 4 * h;
                    dst[(size_t)d * SEQ] = (bf16_t)(pk2(acc[i][j][r], 0.f) & 0xffffu);
                }
        }
    }
}

__device__ __forceinline__ void moba_attn_item(const L1Bufs& B, const float* __restrict__ qn, const float* __restrict__ kn, bf16_t* __restrict__ att, int bg, int qb, char* smem) {
    const int tid = opq_tid();
    const int lane = tid & 63, wave = tid >> 6, cl = lane & 31, hh = lane >> 5;
    const int b = bg >> 2, g = bg & 3, hd = g * 4 + wave;
    const int t0 = qb * 32, c = qb >> 1, cb = qb >> 3, tq = t0 + cl;
    const float slope2 = exp2f(-0.5f * (float)(hd + 1)) * LOG2E;
    float* kms = (float*)(smem + ATT_IMP_OFF);
    unsigned* um = (unsigned*)(smem + ATT_MASK_OFF);
    const float m2 = (8.f * wave_max(fabsf(qn[lane])) * wave_max(fabsf(kn[lane])) * 1.02f + 0.5f) * LOG2E;
    __syncthreads();
    {
        const int n = tid >> 4, d4 = (tid & 15) * 4;
        float4 a = make_float4(0.f, 0.f, 0.f, 0.f);
        if (n < cb) {
            const float* p = B.kmpart + ((size_t)bg * 64 + n * 4) * 64 + d4;
#pragma unroll
            for (int u = 0; u < 4; ++u) { const float4 x = *(const float4*)(p + u * 64); a.x += x.x; a.y += x.y; a.z += x.z; a.w += x.w; }
        }
        const float sc = 1.f / 256.f;
        *(float4*)(kms + n * 64 + d4) = make_float4(a.x * sc, a.y * sc, a.z * sc, a.w * sc);
        if (tid == 0) um[0] = 0u;
    }
    bf16x8 qf[4];
    {
        const bf16_t* qp = B.q + (size_t)(b * SEQ + tq) * 1024 + hd * 64 + 8 * hh;
#pragma unroll
        for (int ks = 0; ks < 4; ++ks) qf[ks] = *(const bf16x8*)(qp + ks * 16);
    }
    __syncthreads();
    float sg[16];
    {
        float qv[32];
#pragma unroll
        for (int ks = 0; ks < 4; ++ks) {
            const uint4 u = __builtin_bit_cast(uint4, qf[ks]);
            qv[ks * 8 + 0] = __uint_as_float(u.x << 16); qv[ks * 8 + 1] = __uint_as_float(u.x & 0xffff0000u);
            qv[ks * 8 + 2] = __uint_as_float(u.y << 16); qv[ks * 8 + 3] = __uint_as_float(u.y & 0xffff0000u);
            qv[ks * 8 + 4] = __uint_as_float(u.z << 16); qv[ks * 8 + 5] = __uint_as_float(u.z & 0xffff0000u);
            qv[ks * 8 + 6] = __uint_as_float(u.w << 16); qv[ks * 8 + 7] = __uint_as_float(u.w & 0xffff0000u);
        }
#pragma unroll
        for (int n = 0; n < 16; ++n) {
            float s = 0.f;
            if (n < cb) {
#pragma unroll
                for (int ks = 0; ks < 4; ++ks) {
                    const float4 k0 = *(const float4*)(kms + n * 64 + ks * 16 + 8 * hh), k1 = *(const float4*)(kms + n * 64 + ks * 16 + 8 * hh + 4);
                    s += qv[ks * 8 + 0] * k0.x + qv[ks * 8 + 1] * k0.y + qv[ks * 8 + 2] * k0.z + qv[ks * 8 + 3] * k0.w
                       + qv[ks * 8 + 4] * k1.x + qv[ks * 8 + 5] * k1.y + qv[ks * 8 + 6] * k1.z + qv[ks * 8 + 7] * k1.w;
                }
                s = sum32(s);
            } else s = -INFINITY;
            sg[n] = s;
        }
    }
    unsigned bm = 0u;
#pragma unroll
    for (int n = 0; n < 16; ++n) {
        int rank = 0;
#pragma unroll
        for (int n2 = 0; n2 < 16; ++n2) rank += (sg[n2] > sg[n] || (sg[n2] == sg[n] && n2 < n)) ? 1 : 0;
        if (rank < 3 && n < cb) bm |= 1u << n;
    }
    unsigned long long mytiles = 0ull;
#pragma unroll
    for (int n = 0; n < 16; ++n) if ((bm >> n) & 1u) mytiles |= 0xFull << (4 * n);
    unsigned long long own = 0ull;
    for (int j = 4 * cb; j <= c; ++j) own |= 1ull << j;
    mytiles |= own;
    const unsigned wb = or32(or_lo32(bm));
    if (lane == 0) atomicOr(um, wb);
    __syncthreads();
    const unsigned ub = um[0];
    unsigned long long U = own;
    for (int n = 0; n < 16; ++n) if ((ub >> n) & 1u) U |= 0xFull << (4 * n);
    f32x16 ot[2]; float l;
    const float tb0 = -(slope2 * (float)tq) - m2;
    attn_branch<1, 0>(B.k + (size_t)(b * SEQ) * 256 + g * 64, B.vt + (size_t)bg * 64 * SEQ, 256, SEQ, U, 1ull << c, mytiles, qf, slope2, tb0, tq, 1 << 30, smem, ot, l, tid);
    const float lt = sum32(l);
    const float f = 1.f / lt;
    bf16_t* dst = att + (size_t)(b * SEQ + tq) * 1024 + hd * 64;
#pragma unroll
    for (int dt = 0; dt < 2; ++dt)
#pragma unroll
        for (int q4 = 0; q4 < 4; ++q4) {
            const int d = 32 * dt + 8 * q4 + 4 * hh;
            uint2 o; o.x = pk2(ot[dt][4 * q4] * f, ot[dt][4 * q4 + 1] * f); o.y = pk2(ot[dt][4 * q4 + 2] * f, ot[dt][4 * q4 + 3] * f);
            *(uint2*)(dst + d) = o;
        }
}


#define XB_TMO      128
#define XB_XCNT(j)  (256  + 64 * (j))
#define XB_XSUB(j)  (1280 + 64 * (j))
#define XB_XGEN(j)  (2304 + 64 * (j))
#define XB_TOP      3328
#define XB_TOPGEN   3392
#define XCD_BAR_WORDS 3456
#define XB_SPIN_CAP (1u << 22)
#define LAS __attribute__((address_space(3)))
__device__ __forceinline__ unsigned xb_ld(unsigned* p)              { return __hip_atomic_load(p, __ATOMIC_RELAXED, __HIP_MEMORY_SCOPE_AGENT); }
__device__ __forceinline__ unsigned xb_add(unsigned* p, unsigned v) { return __hip_atomic_fetch_add(p, v, __ATOMIC_RELAXED, __HIP_MEMORY_SCOPE_AGENT); }
__device__ __forceinline__ unsigned xb_xcc_id() { return (unsigned)__builtin_amdgcn_s_getreg((3 << 11) | 20) & 0xFu; }
#define XB_SPIN(cond, bar) do { unsigned _sp = 0; while (cond) { __builtin_amdgcn_s_sleep(1); \
    if ((++_sp & 255u) == 0u) { if (xb_ld(&(bar)[XB_TMO])) break; if (_sp > XB_SPIN_CAP) { atomicAdd(&(bar)[XB_TMO], 1u); break; } } } } while (0)
struct XcdBarrier { unsigned* bar; unsigned x; volatile LAS unsigned* st; };
__device__ __forceinline__ XcdBarrier xcd_barrier_post(unsigned* bar, volatile LAS unsigned* st) {
    XcdBarrier b; b.bar = bar; b.x = xb_xcc_id(); b.st = st;
    if (threadIdx.x == 0) (void)xb_add(&bar[XB_XCNT(b.x)], 1u);
    return b;
}
__device__ __forceinline__ void xcd_barrier_complete(unsigned* bar, unsigned x, unsigned& nloc, unsigned& nx) {
    const unsigned G = gridDim.x * gridDim.y * gridDim.z;
    unsigned sum, cnt, mine, sp = 0u;
    for (;;) {
        sum = 0u; cnt = 0u; mine = 0u;
#pragma unroll
        for (unsigned j = 0; j < 16; ++j) { const unsigned c = xb_ld(&bar[XB_XCNT(j)]); sum += c; cnt += (c > 0u) ? 1u : 0u; mine = (j == x) ? c : mine; }
        if (sum == G) break;
        __builtin_amdgcn_s_sleep(1);
        if ((++sp & 255u) == 0u) { if (xb_ld(&bar[XB_TMO])) break; if (sp > XB_SPIN_CAP) { atomicAdd(&bar[XB_TMO], 1u); break; } }
    }
    nloc = mine > 0u ? mine : 1u; nx = cnt > 0u ? cnt : 1u;
}
__device__ __forceinline__ void xcd_barrier(const XcdBarrier& b) {
    asm volatile("s_waitcnt vmcnt(0)" ::: "memory");
    __syncthreads();
    if (threadIdx.x == 0) {
        unsigned* bar = b.bar;
        __builtin_amdgcn_s_waitcnt(0);
        unsigned nloc = b.st[0], nx = b.st[1];
        if (nloc == 0u) { xcd_barrier_complete(bar, b.x, nloc, nx); b.st[0] = nloc; b.st[1] = nx; }
        const unsigned old = xb_add(&bar[XB_XSUB(b.x)], 1u);
        const unsigned gen = old / nloc;
        if (old + 1u == (gen + 1u) * nloc) {
            __builtin_amdgcn_fence(__ATOMIC_RELEASE, "agent");
            asm volatile("s_waitcnt vmcnt(0)" ::: "memory");
            const unsigned og = xb_add(&bar[XB_TOP], 1u);
            const unsigned tg = og / nx;
            if (og + 1u == (tg + 1u) * nx) xb_add(&bar[XB_TOPGEN], 1u);
            else XB_SPIN(xb_ld(&bar[XB_TOPGEN]) == tg, bar);
            __builtin_amdgcn_fence(__ATOMIC_ACQUIRE, "agent");
            xb_add(&bar[XB_XGEN(b.x)], 1u);
            asm volatile("s_waitcnt vmcnt(0)" ::: "memory");
        } else {
            XB_SPIN(xb_ld(&bar[XB_XGEN(b.x)]) == gen, bar);
            __builtin_amdgcn_fence(__ATOMIC_ACQUIRE, "agent");
            asm volatile("s_waitcnt vmcnt(0)" ::: "memory");
        }
    }
    __syncthreads();
}

struct Params {
    const float* in[30];
    float* out;
    float* ws;
    WJob jobs[NJOBS];
};

#define SMEM_TOTAL 73744
__shared__ __attribute__((aligned(16))) char g_smem[SMEM_TOTAL];
typedef const Params __attribute__((address_space(4)))* PPtr;
#define PP() ({ PPtr _p = (PPtr)__builtin_amdgcn_kernarg_segment_ptr(); asm volatile("" : "+s"(_p)); _p; })
__device__ __forceinline__ WJob load_job(PPtr pp, int j) { WJob J; J.src = pp->jobs[j].src; J.dst = pp->jobs[j].dst; J.gain = pp->jobs[j].gain; J.sbs = pp->jobs[j].sbs; J.dbs = pp->jobs[j].dbs; J.K = pp->jobs[j].K; J.N = pp->jobs[j].N; J.Npad = pp->jobs[j].Npad; J.batch = pp->jobs[j].batch; J.perm = pp->jobs[j].perm; J.gbs = pp->jobs[j].gbs; return J; }
__device__ __forceinline__ void grid_sync() {
    XcdBarrier xb; xb.bar = (unsigned*)((char*)PP()->ws + (size_t)166 * 1048576); xb.x = xb_xcc_id(); xb.st = (volatile LAS unsigned*)(g_smem + 73728);
    xcd_barrier(xb);
}
#define GRID_SYNC() grid_sync()
#define PHASE_1D(NB, CALL) do { for (int vb = blockIdx.x; vb < (NB); vb += gridDim.x) { const int bx = vb; __syncthreads(); CALL; } GRID_SYNC(); } while (0)
#define PHASE_2D(NX, NY, CW, CALL) do { \
    const int xcd_ = blockIdx.x & 7, slot_ = blockIdx.x >> 3, nslot_ = gridDim.x >> 3, RY_ = (NY) >> 3; \
    for (int li = slot_; li < (NX) * RY_; li += nslot_) { \
        const int cs_ = li / (RY_ * (CW)), rem_ = li - cs_ * (RY_ * (CW)); \
        const int bx = cs_ * (CW) + rem_ % (CW), by = xcd_ + 8 * (rem_ / (CW)); \
        __syncthreads(); CALL; } \
    GRID_SYNC(); } while (0)
#define GWAVE ((int)blockIdx.x * 4 + (opq_tid() >> 6))
#define NWAVE ((int)gridDim.x * 4)

__device__ __forceinline__ L0Bufs make_l0(char* wsb) {
    L0Bufs LB;
    LB.q = (bf16_t*)wsb;
    LB.kcr = (bf16_t*)(wsb + 33554432);
    LB.vcr = LB.kcr + (size_t)TTOK * 256;
    LB.ks = LB.vcr + (size_t)TTOK * 256;
    LB.vst = LB.ks + (size_t)TTOK * 256;
    LB.kw = LB.vst + (size_t)TTOK * 256;
    LB.vwt = LB.kw + (size_t)TTOK * 256;
    LB.gates = (float*)(LB.vwt + (size_t)TTOK * 256);
    LB.hidc = (bf16_t*)(wsb + 92274688);
    char* regC = wsb + (size_t)160 * 1048576;
    LB.kc = (bf16_t*)regC;
    LB.vct = (bf16_t*)(regC + 524288);
    LB.bias1 = (float*)(regC + 1048576);
    return LB;
}
__device__ __forceinline__ L1Bufs make_l1(char* wsb) {
    L1Bufs B;
    B.q = (bf16_t*)wsb;
    B.k = (bf16_t*)(wsb + 33554432);
    B.vt = B.k + (size_t)TTOK * 256;
    B.kmpart = (float*)(wsb + (size_t)160 * 1048576 + 5245440);
    return B;
}
#define WS_RLOG(wsb) ((float*)((wsb) + 92274688))
#define WS_QCTR(wsb) ((int*)((wsb) + (size_t)160 * 1048576 + 5586944))
#define WS_CNT(wsb) ((int*)((wsb) + (size_t)160 * 1048576 + 5570560))
#define WS_LSLOT(wsb) ((int*)((wsb) + (size_t)160 * 1048576 + 1051136))
#define WS_LW(wsb) ((float*)((wsb) + (size_t)160 * 1048576 + 3148288))
#define WS_PJ(wsb) ((bf16_t*)((wsb) + (size_t)64 * 1048576))
#define WS_XA(wsb) ((bf16_t*)((wsb) + (size_t)96 * 1048576))
#define WS_XB(wsb) ((bf16_t*)((wsb) + (size_t)128 * 1048576))

__device__ __forceinline__ void ph_prologue() {
    char* smem = g_smem;
    const PPtr pp = PP();
    char* wsb = (char*)pp->ws;
    int base = 0;
    for (int j = 0; j < 17; ++j) {
        if (j >= 11 && j < 14) continue;
        const WJob J = load_job(pp, j);
        if (J.src == nullptr) continue;
        const int cntj = J.batch * (J.Npad >> 6) * (J.K >> 6);
        int first = ((int)blockIdx.x - base) % (int)gridDim.x; if (first < 0) first += gridDim.x;
        for (int it = first; it < cntj; it += gridDim.x) wconv_item(J, it, (float*)smem);
        base += cntj;
    }
    for (int layer = 0; layer < 2; ++layer)
        rw_build(pp->in[21] + (size_t)layer * DM * 4, pp->in[23] + (size_t)layer * DM * 32, pp->in[3] + layer * DM, (float*)pp->jobs[17].dst + (size_t)layer * 1024 * 36,
                 (int)(blockIdx.x * 256 + threadIdx.x), (int)(gridDim.x * 256));
    {
        const float* x = pp->in[0]; bf16_t* XA = WS_XA(wsb);
        for (int row = GWAVE; row < TTOK; row += 4 * NWAVE) rp_rows<false, 4>(x, nullptr, nullptr, XA, row, NWAVE, (TTOK - row + NWAVE - 1) / NWAVE, nullptr);
    }
    if ((int)blockIdx.x >= (int)gridDim.x - 32) {
        const int q = (int)gridDim.x - 1 - (int)blockIdx.x, which = q >> 4, kb = q & 15;
        const float* pos = (which ? pp->in[11] : pp->in[8]) + kb * 128;
        const float* w1 = (which ? pp->in[12] : pp->in[9]) + (size_t)kb * 128 * 256;
        float a = 0.f;
#pragma unroll 16
        for (int kk = 0; kk < 128; ++kk) a += pos[kk] * w1[(size_t)kk * 256 + threadIdx.x];
        WS_RLOG(wsb)[(which * 16 + kb) * 256 + threadIdx.x] = a;
    }
    if (blockIdx.x == 0) { for (int i = threadIdx.x; i < 4 * 8 * 64; i += 256) WS_QCTR(wsb)[i] = 0; for (int i = threadIdx.x; i < 2 * 32 * CNT_STRIDE; i += 256) WS_CNT(wsb)[i] = 0; }
    GRID_SYNC();
}
__device__ __forceinline__ void ph_p1() {
    char* smem = g_smem;
    const PPtr pp = PP(); char* wsb = (char*)pp->ws;
    const L0Bufs LB = make_l0(wsb);
    const bf16_t* XA = WS_XA(wsb); const bf16_t* w = pp->jobs[0].dst; const float* qn = pp->in[6]; const float* kn = pp->in[7];
    if (blockIdx.x < 2) {
        const float* part = WS_RLOG(wsb) + (size_t)blockIdx.x * 16 * 256 + threadIdx.x;
        float a = 0.f;
#pragma unroll
        for (int kb = 0; kb < 16; ++kb) a += part[kb * 256];
        LB.bias1[blockIdx.x * 256 + threadIdx.x] = a;
    }
    PHASE_2D(21, 128, 7, p1_item(XA, w, qn, kn, LB, bx, by, smem));
}
__device__ __forceinline__ void ph_p2a() {
    char* smem = g_smem;
    const PPtr pp = PP(); char* wsb = (char*)pp->ws;
    const L0Bufs LB = make_l0(wsb);
    const bf16_t* wk = pp->jobs[1].dst; const bf16_t* wv = pp->jobs[3].dst;
    const int nb = (int)gridDim.x;
    const bool split = nb > 128;
    if (!split || (int)blockIdx.x < 128) {
        for (int vb = blockIdx.x; vb < 128; vb += split ? 128 : nb) { const int bx = vb; __syncthreads(); p2a_item(LB, (bx >> 6) ? wv : wk, bx >> 6, (bx >> 1) & 31, bx & 1, smem); }
    }
    if (!split || (int)blockIdx.x >= 128) {
        const int wid = split ? (int)blockIdx.x - 128 : (int)blockIdx.x, nw = split ? nb - 128 : nb;
        int base = 0;
        for (int j = 11; j < 14; ++j) {
            const WJob J = load_job(pp, j);
            if (J.src == nullptr) continue;
            const int cntj = J.batch * (J.Npad >> 6) * (J.K >> 6);
            int first = (wid - base) % nw; if (first < 0) first += nw;
            for (int it = first; it < cntj; it += nw) wconv_item(J, it, (float*)smem);
            base += cntj;
        }
    }
    GRID_SYNC();
}
__device__ __forceinline__ void ph_p2b() {
    char* smem = g_smem;
    const PPtr pp = PP(); char* wsb = (char*)pp->ws;
    const L0Bufs LB = make_l0(wsb);
    const bf16_t* wk = pp->jobs[2].dst; const bf16_t* wv = pp->jobs[4].dst; const float* kn = pp->in[7];
    PHASE_1D(64, p2b_item(LB, (bx >> 5) ? wv : wk, kn, bx >> 5, bx & 31, smem));
}
__device__ __forceinline__ void ph_nsa() {
    char* smem = g_smem;
    const PPtr pp = PP(); char* wsb = (char*)pp->ws;
    const L0Bufs LB = make_l0(wsb);
    const float* qn = pp->in[6]; const float* kn = pp->in[7]; bf16_t* XB = WS_XB(wsb); int* qctr = WS_QCTR(wsb);
    int* misc = (int*)(smem + ATT_MISC_OFF);
    const int myx = (int)xb_xcc_id() & 7;
    for (int dx = 0; dx < 8; ++dx) {
        const int x = (myx + dx) & 7;
        for (;;) {
            __syncthreads();
            if (threadIdx.x == 0) misc[0] = atomicAdd(&qctr[x * 64], 1);
            __syncthreads();
            const int id = __builtin_amdgcn_readfirstlane(misc[0]);
            if (id >= 256) break;
            nsa_attn_item(LB, qn, kn, XB, x + 8 * (id >> 7), 127 - (id & 127), smem);
        }
    }
    GRID_SYNC();
}
__device__ __forceinline__ void ph_outproj(int layer) {
    char* smem = g_smem;
    const PPtr pp = PP(); char* wsb = (char*)pp->ws;
    const bf16_t* XB = WS_XB(wsb); const bf16_t* w = pp->jobs[layer ? 8 : 5].dst; const float* r = layer ? pp->out : pp->in[0]; float* h = pp->out;
    PHASE_2D(8, 128, 8, (d_gemm<false>(XB, w, (long long)DM, TTOK, DM, DM, EpiResid{r, h, DM}, bx, by, smem)));
}
__device__ __forceinline__ void ph_route(int layer) {
    char* smem = g_smem;
    const PPtr pp = PP(); char* wsb = (char*)pp->ws;
    const float* h = pp->out; bf16_t* XA = WS_XA(wsb);
    const float* wr = (const float*)pp->jobs[17].dst + (size_t)layer * 1024 * 36;
    const float* bgp = pp->in[22] + layer * 4; const float* bep = pp->in[24] + layer * 32;
    int* cntl = WS_CNT(wsb) + layer * 32 * CNT_STRIDE; int* lslot = WS_LSLOT(wsb); float* lw = WS_LW(wsb);
    PHASE_1D(512, route_item(h, XA, wr, bgp, bep, cntl, lslot, lw, bx, smem));
}
__device__ __forceinline__ void ph_moe(int layer) {
    char* smem = g_smem;
    const PPtr pp = PP(); char* wsb = (char*)pp->ws;
    const bf16_t* wgu_l = pp->jobs[11 + 3 * layer].dst;
    const bf16_t* wd_l = pp->jobs[13 + 3 * layer].dst;
    const bf16_t* XA = WS_XA(wsb); bf16_t* ysb = (bf16_t*)wsb;
    const int* cntl = WS_CNT(wsb) + layer * 32 * CNT_STRIDE; const int* lslot = WS_LSLOT(wsb); const float* lw = WS_LW(wsb);
    const int xcd = blockIdx.x & 7, nslot = gridDim.x >> 3;
    int it = blockIdx.x >> 3;
    int q = 0, basei = 0;
    for (;;) {
        int nch = 0, e = 0;
        while (q < 4) { e = xcd + 8 * q; nch = (cntl[e * CNT_STRIDE] + 127) >> 7; if (it < basei + nch) break; basei += nch; ++q; }
        if (q >= 4) break;
        const int chunk = it - basei;
        const int nvalid = min(128, cntl[e * CNT_STRIDE] - chunk * 128);
        __syncthreads();
        moe_item<false>(XA, wgu_l + (size_t)e * 256 * 1024, wd_l + (size_t)e * 1024 * 128, lslot + e * TTOK + chunk * 128, lw + e * TTOK + chunk * 128, nvalid, ysb, smem);
        it += nslot;
    }
    {
        const float* pin = pp->in[1] + (size_t)layer * TTOK * 256; const bf16_t* wp = pp->jobs[10].dst + (size_t)layer * 256 * DM; bf16_t* pj = WS_PJ(wsb);
        int* qp = WS_QCTR(wsb) + 1024 + layer * 512;
        int* misc = (int*)(smem + 73712);
        for (int dx = 0; dx < 8; ++dx) {
            const int x = (xcd + dx) & 7;
            for (;;) {
                __syncthreads();
                if (threadIdx.x == 0) misc[0] = atomicAdd(&qp[x * 64], 1);
                __syncthreads();
                const int id = __builtin_amdgcn_readfirstlane(misc[0]);
                if (id >= 128) break;
                ple_proj_item(pin, wp, pj, id & 7, x + 8 * (id >> 3), smem);
            }
        }
    }
    GRID_SYNC();
}
__device__ __forceinline__ void ph_combine() {
    const PPtr pp = PP(); char* wsb = (char*)pp->ws;
    float* h = pp->out; const bf16_t* ysb = (const bf16_t*)wsb; bf16_t* XB = WS_XB(wsb);
    for (int row = GWAVE; row < TTOK; row += 2 * NWAVE) rp_rows<true, 2>(h, h, ysb, XB, row, NWAVE, (TTOK - row + NWAVE - 1) / NWAVE, nullptr);
    GRID_SYNC();
}
__device__ __forceinline__ void ph_ple(int layer) {
    char* smem = g_smem;
    const PPtr pp = PP(); char* wsb = (char*)pp->ws;
    float* h = pp->out; const bf16_t* XB = WS_XB(wsb);
    const bf16_t* wg = pp->jobs[9].dst + (size_t)layer * DM * DM;
    const bf16_t* pj = WS_PJ(wsb);
    PHASE_2D(8, 128, 8, ple_item(XB, wg, pj, h, bx, by, smem));
}
__device__ __forceinline__ void ph_norm() {
    const PPtr pp = PP(); char* wsb = (char*)pp->ws;
    const float* h = pp->out; bf16_t* XA = WS_XA(wsb);
    for (int row = GWAVE; row < TTOK; row += 4 * NWAVE) rp_rows<false, 4>(h, nullptr, nullptr, XA, row, NWAVE, (TTOK - row + NWAVE - 1) / NWAVE, nullptr);
    GRID_SYNC();
}
__device__ __forceinline__ void ph_p7() {
    char* smem = g_smem;
    const PPtr pp = PP(); char* wsb = (char*)pp->ws;
    const L1Bufs L1B = make_l1(wsb);
    const bf16_t* XA = WS_XA(wsb); const bf16_t* w = pp->jobs[6].dst; const float* qn = pp->in[19]; const float* kn = pp->in[17];
    PHASE_2D(12, 128, 6, p7_item(XA, w, qn, kn, L1B, bx, by, smem));
}
__device__ __forceinline__ void ph_moba() {
    char* smem = g_smem;
    const PPtr pp = PP(); char* wsb = (char*)pp->ws;
    const L1Bufs L1B = make_l1(wsb);
    const float* qn = pp->in[19]; const float* kn = pp->in[17]; bf16_t* XB = WS_XB(wsb); int* qctr = WS_QCTR(wsb);
    int* misc = (int*)(smem + ATT_MISC_OFF);
    const int myx = (int)xb_xcc_id() & 7;
    for (int dx = 0; dx < 8; ++dx) {
        const int x = (myx + dx) & 7;
        for (;;) {
            __syncthreads();
            if (threadIdx.x == 0) misc[0] = atomicAdd(&qctr[512 + x * 64], 1);
            __syncthreads();
            const int id = __builtin_amdgcn_readfirstlane(misc[0]);
            if (id >= 256) break;
            moba_attn_item(L1B, qn, kn, XB, x + 8 * (id >> 7), 127 - (id & 127), smem);
        }
    }
    GRID_SYNC();
}

#ifndef PROBE_PHASE
#define PROBE_PHASE -1
#endif
#define PH(id, CALL) do { if (PROBE_PHASE == (id) && blockIdx.x == 0) pt0 = __builtin_amdgcn_s_memrealtime(); CALL; if (PROBE_PHASE == (id) && blockIdx.x == 0) pt1 = __builtin_amdgcn_s_memrealtime(); } while (0)

__global__ void __launch_bounds__(256, 2) mega(Params Pdummy) {
    if (threadIdx.x == 0) *(uint4*)(g_smem + 73728) = make_uint4(0u, 0u, 0u, 0u);
    __syncthreads();
    if (threadIdx.x == 0) (void)xb_add(&((unsigned*)((char*)PP()->ws + (size_t)166 * 1048576))[XB_XCNT(xb_xcc_id())], 1u);
    unsigned long long pt0 = 0ull, pt1 = 0ull;
    PH(0, ph_prologue());
    PH(1, ph_p1());
    PH(2, { ph_p2a(); ph_p2b(); });
    PH(3, ph_nsa());
    PH(4, ph_outproj(0));
    PH(5, ph_route(0));
    PH(6, ph_moe(0));
    PH(7, ph_combine());
    PH(8, ph_ple(0));
    PH(9, ph_norm());
    PH(11, ph_p7());
    PH(12, ph_moba());
    PH(13, ph_outproj(1));
    PH(15, ph_route(1));
    PH(16, ph_moe(1));
    PH(17, ph_combine());
    PH(18, ph_ple(1));
    if (PROBE_PHASE >= 0 && blockIdx.x == 0) {
        const unsigned long long span = pt1 - pt0, t2 = __builtin_amdgcn_s_memrealtime();
        while (__builtin_amdgcn_s_memrealtime() - t2 < span) __builtin_amdgcn_s_sleep(16);
    }
}

extern "C" void kernel_launch(void* const* d_in, const int* in_sizes, int n_in, void* d_out, int out_size, void* d_ws, size_t ws_size, hipStream_t stream) {
    static int grid_blocks = 0;
    if (!grid_blocks) {
        int dev = 0, cus = 0, per_cu = 0;
        (void)hipGetDevice(&dev);
        (void)hipDeviceGetAttribute(&cus, hipDeviceAttributeMultiprocessorCount, dev);
        (void)hipOccupancyMaxActiveBlocksPerMultiprocessor(&per_cu, (const void*)mega, 256, 0);
        if (per_cu < 1) per_cu = 1;
        if (per_cu > 2) per_cu = 2;
        grid_blocks = cus * per_cu;
    }
    Params P{};
    for (int i = 0; i < 30; ++i) P.in[i] = (const float*)d_in[i];
    P.out = (float*)d_out;
    P.ws = (float*)d_ws;
    {
        size_t off = (size_t)168 * 1048576;
        char* wbase = (char*)d_ws + off;
        size_t wo = 0;
        auto add = [&](int j, const void* src, int K, int N, int Npad, int batch, const float* gain) {
            WJob& J = P.jobs[j];
            J.src = (const float*)src; J.dst = (bf16_t*)(wbase + wo); J.gain = gain;
            J.sbs = (long long)K * N; J.dbs = (long long)Npad * K; J.K = K; J.N = N; J.Npad = Npad; J.batch = batch; J.perm = 0; J.gbs = 0;
            wo += (size_t)batch * Npad * K * 2;
        };
        add(0, d_in[5], 1024, 2608, 2688, 1, (const float*)d_in[2]);
        add(1, d_in[9], 2048, 256, 256, 1, nullptr);
        add(2, d_in[10], 256, 64, 128, 1, nullptr);
        add(3, d_in[12], 2048, 256, 256, 1, nullptr);
        add(4, d_in[13], 256, 64, 128, 1, nullptr);
        add(5, d_in[14], 1024, 1024, 1024, 1, nullptr);
        add(6, d_in[16], 1024, 512, 512, 1, (const float*)d_in[15]);
        add(7, d_in[18], 1024, 1024, 1024, 1, (const float*)d_in[2] + 1024);
        add(8, d_in[20], 1024, 1024, 1024, 1, nullptr);
        add(9, d_in[29], 1024, 1024, 1024, 2, (const float*)d_in[4]); P.jobs[9].gbs = 1024;
        add(10, d_in[28], 256, 1024, 1024, 2, nullptr);
        for (int layer = 0; layer < 2; ++layer) {
            WJob& G = P.jobs[11 + 3 * layer]; WJob& U = P.jobs[12 + 3 * layer];
            G.src = (const float*)d_in[25] + (size_t)layer * 32 * 1024 * 128; G.dst = (bf16_t*)(wbase + wo); G.gain = (const float*)d_in[3] + layer * 1024;
            G.sbs = 1024 * 128; G.dbs = 256 * 1024; G.K = 1024; G.N = 128; G.Npad = 128; G.batch = 32; G.perm = 1; G.gbs = 0;
            U = G; U.src = (const float*)d_in[26] + (size_t)layer * 32 * 1024 * 128; U.perm = 2;
            wo += (size_t)32 * 256 * 1024 * 2;
            add(13 + 3 * layer, (const float*)d_in[27] + (size_t)layer * 32 * 128 * 1024, 128, 1024, 1024, 32, nullptr);
        }
        P.jobs[17].dst = (bf16_t*)(wbase + wo); wo += (size_t)2 * 128 * 3072 * 2;
        if (off + wo > ws_size) { fprintf(stderr, "workspace too small: need %zu have %zu\n", off + wo, ws_size); return; }
    }
    (void)hipMemsetAsync((char*)d_ws + (size_t)166 * 1048576, 0, XCD_BAR_WORDS * 4, stream);
    void* args[] = {&P};
    hipError_t e = hipLaunchCooperativeKernel((const void*)mega, dim3(grid_blocks), dim3(256), args, 0, stream);
    if (e != hipSuccess) fprintf(stderr, "cooperative launch failed: %s (grid %d)\n", hipGetErrorString(e), grid_blocks);
}
```

```cpp
#include <hip/hip_runtime.h>
#include <hip/hip_cooperative_groups.h>
namespace cg = cooperative_groups;
#include <stdint.h>
#include <math.h>
#include <stdio.h>

#define SEQ 4096
#define BATCH 4
#define TTOK 16384
#define DM 1024
#define NPROJ 2608
#define NCMP 255

#define C_Q 0
#define C_KC 1024
#define C_VC 1280
#define C_KS 1536
#define C_VS 1792
#define C_KW 2048
#define C_VW 2304
#define C_GL 2560

template <int M> __device__ __forceinline__ float fx(float v) { return __int_as_float(__builtin_amdgcn_ds_swizzle(__float_as_int(v), (M << 10) | 0x1f)); }
template <int M> __device__ __forceinline__ unsigned ux(unsigned v) { return (unsigned)__builtin_amdgcn_ds_swizzle((int)v, (M << 10) | 0x1f); }
__device__ __forceinline__ float sum32(float v) { const auto r = __builtin_amdgcn_permlane32_swap(__float_as_uint(v), __float_as_uint(v), false, false); return __uint_as_float(r[0]) + __uint_as_float(r[1]); }
__device__ __forceinline__ float max32(float v) { const auto r = __builtin_amdgcn_permlane32_swap(__float_as_uint(v), __float_as_uint(v), false, false); return fmaxf(__uint_as_float(r[0]), __uint_as_float(r[1])); }
__device__ __forceinline__ unsigned or32(unsigned v) { const auto r = __builtin_amdgcn_permlane32_swap(v, v, false, false); return r[0] | r[1]; }
__device__ __forceinline__ float sum_lo32(float v) { v += fx<1>(v); v += fx<2>(v); v += fx<4>(v); v += fx<8>(v); v += fx<16>(v); return v; }
__device__ __forceinline__ unsigned or_lo32(unsigned v) { v |= ux<1>(v); v |= ux<2>(v); v |= ux<4>(v); v |= ux<8>(v); v |= ux<16>(v); return v; }
__device__ __forceinline__ float wave_sum(float v) { return sum32(sum_lo32(v)); }
__device__ __forceinline__ int opq_tid() { int t = threadIdx.x; asm volatile("" : "+v"(t)); return t; }
__device__ __forceinline__ float gelu_tanh(float x) {
    const float c = 0.7978845608028654f;
    float u = c * (x + 0.044715f * x * x * x);
    return 0.5f * x * (1.f + tanhf(u));
}
__device__ __forceinline__ float sigm(float x) { return 1.f / (1.f + expf(-x)); }

typedef unsigned short bf16_t;
typedef float f32x16 __attribute__((ext_vector_type(16)));
typedef __bf16 bf16x8 __attribute__((ext_vector_type(8)));
typedef __bf16 bf16x2 __attribute__((ext_vector_type(2)));
__device__ __forceinline__ unsigned pk2(float lo, float hi) { bf16x2 v = {(__bf16)lo, (__bf16)hi}; return __builtin_bit_cast(unsigned, v); }
__device__ __forceinline__ uint4 pack8(float4 a, float4 b) { uint4 r; r.x = pk2(a.x, a.y); r.y = pk2(a.z, a.w); r.z = pk2(b.x, b.y); r.w = pk2(b.z, b.w); return r; }

__device__ __forceinline__ float bf16_lo_f(unsigned u) { return __uint_as_float(u << 16); }
__device__ __forceinline__ float bf16_hi_f(unsigned u) { return __uint_as_float(u & 0xffff0000u); }
#define LDS_ROW 144
#define TILE_BYTES (128 * LDS_ROW)

template <bool A_F32, class AFn>
__device__ __forceinline__ void gemm_core(AFn afn, const bf16_t* __restrict__ Wt, int ldw, int n0, int K, char* smem, f32x16 (&acc)[2][2]) {
    const int tid = opq_tid(), lane = tid & 63, wave = tid >> 6;
    const int wn = wave >> 1, wm = wave & 1;
    const int sr = tid >> 3, sc = tid & 7;
    const int c = lane & 31, h = lane >> 5;
    struct Stage { uint4 x0, x1, x2, x3, w0, w1, w2, w3; };
#pragma unroll
    for (int i = 0; i < 2; ++i)
#pragma unroll
        for (int j = 0; j < 2; ++j)
#pragma unroll
            for (int r = 0; r < 16; ++r) acc[i][j][r] = 0.f;
    auto loadx = [&](int i, int k0) -> uint4 {
        const int r = sr + 32 * i;
        if (A_F32) {
            const float* p = (const float*)afn(i, r, k0);
            if (p) { float4 f0 = *(const float4*)(p + sc * 8); float4 f1 = *(const float4*)(p + sc * 8 + 4); return pack8(f0, f1); }
            return make_uint4(0u, 0u, 0u, 0u);
        } else {
            const bf16_t* p = (const bf16_t*)afn(i, r, k0);
            return p ? *(const uint4*)(p + sc * 8) : make_uint4(0u, 0u, 0u, 0u);
        }
    };
    auto load = [&](int k0) -> Stage {
        Stage S;
        S.x0 = loadx(0, k0); S.x1 = loadx(1, k0); S.x2 = loadx(2, k0); S.x3 = loadx(3, k0);
        const bf16_t* wp = Wt + (size_t)(n0 + sr) * ldw + k0 + sc * 8;
        S.w0 = *(const uint4*)wp; S.w1 = *(const uint4*)(wp + (size_t)32 * ldw); S.w2 = *(const uint4*)(wp + (size_t)64 * ldw); S.w3 = *(const uint4*)(wp + (size_t)96 * ldw);
        return S;
    };
    auto store = [&](const Stage S, int buf) {
        char* xb = smem + buf * 2 * TILE_BYTES + sr * LDS_ROW + sc * 16; char* wb = xb + TILE_BYTES;
        *(uint4*)xb = S.x0; *(uint4*)(xb + 32 * LDS_ROW) = S.x1; *(uint4*)(xb + 64 * LDS_ROW) = S.x2; *(uint4*)(xb + 96 * LDS_ROW) = S.x3;
        *(uint4*)wb = S.w0; *(uint4*)(wb + 32 * LDS_ROW) = S.w1; *(uint4*)(wb + 64 * LDS_ROW) = S.w2; *(uint4*)(wb + 96 * LDS_ROW) = S.w3;
    };
    auto compute = [&](int buf) {
        const char* xb = smem + buf * 2 * TILE_BYTES; const char* wb = xb + TILE_BYTES;
        const char* wp0 = wb + (wn * 64 + c) * LDS_ROW + h * 16;
        const char* xp0 = xb + (wm * 64 + c) * LDS_ROW + h * 16;
        bf16x8 wfa0 = *(const bf16x8*)(wp0), wfa1 = *(const bf16x8*)(wp0 + 32 * LDS_ROW), xfa0 = *(const bf16x8*)(xp0), xfa1 = *(const bf16x8*)(xp0 + 32 * LDS_ROW);
#pragma unroll
        for (int ks = 0; ks < 4; ++ks) {
            bf16x8 wfb0, wfb1, xfb0, xfb1;
            if (ks < 3) {
                wfb0 = *(const bf16x8*)(wp0 + (ks + 1) * 32); wfb1 = *(const bf16x8*)(wp0 + 32 * LDS_ROW + (ks + 1) * 32);
                xfb0 = *(const bf16x8*)(xp0 + (ks + 1) * 32); xfb1 = *(const bf16x8*)(xp0 + 32 * LDS_ROW + (ks + 1) * 32);
            }
            acc[0][0] = __builtin_amdgcn_mfma_f32_32x32x16_bf16(wfa0, xfa0, acc[0][0], 0, 0, 0);
            acc[0][1] = __builtin_amdgcn_mfma_f32_32x32x16_bf16(wfa0, xfa1, acc[0][1], 0, 0, 0);
            acc[1][0] = __builtin_amdgcn_mfma_f32_32x32x16_bf16(wfa1, xfa0, acc[1][0], 0, 0, 0);
            acc[1][1] = __builtin_amdgcn_mfma_f32_32x32x16_bf16(wfa1, xfa1, acc[1][1], 0, 0, 0);
            __builtin_amdgcn_sched_barrier(0);
            if (ks < 3) { wfa0 = wfb0; wfa1 = wfb1; xfa0 = xfb0; xfa1 = xfb1; }
        }
    };
    const int nk = K >> 6;
    Stage S0 = load(0), S1 = S0;
    if (nk > 1) S1 = load(64);
    store(S0, 0);
    __syncthreads();
    for (int kt = 0; kt < nk; kt += 2) {
        if (kt + 2 < nk) S0 = load((kt + 2) * 64);
        compute(0);
        if (kt + 1 < nk) store(S1, 1);
        __syncthreads();
        if (kt + 1 >= nk) break;
        if (kt + 3 < nk) S1 = load((kt + 3) * 64);
        compute(1);
        if (kt + 2 < nk) store(S0, 0);
        __syncthreads();
    }
}
#define GT_BYTES 16384
template <class AFn>
__device__ __forceinline__ void gemm_core_glds(AFn afn, const bf16_t* __restrict__ Wt, int ldw, int n0, int K, char* smem, f32x16 (&acc)[2][2]) {
    const int tid = opq_tid(), lane = tid & 63, wave = tid >> 6;
    const int wn = wave >> 1, wm = wave & 1;
    const int sr = tid >> 3, sc = tid & 7;
    const int c = lane & 31, h = lane >> 5;
#pragma unroll
    for (int i = 0; i < 2; ++i)
#pragma unroll
        for (int j = 0; j < 2; ++j)
#pragma unroll
            for (int r = 0; r < 16; ++r) acc[i][j][r] = 0.f;
    auto issue = [&](int k0, int buf) {
        char* xb = smem + buf * 2 * GT_BYTES; char* wb = xb + GT_BYTES;
#pragma unroll
        for (int i = 0; i < 4; ++i) {
            const int r = sr + 32 * i;
            const int cs = sc ^ ((r >> 1) & 7);
            const char* xp = (const char*)afn(i, r, k0) + cs * 16;
            const char* wp = (const char*)(Wt + (size_t)(n0 + r) * ldw + k0) + cs * 16;
            __builtin_amdgcn_global_load_lds((const __attribute__((address_space(1))) void*)xp, (__attribute__((address_space(3))) void*)(xb + (32 * i + 8 * wave) * 128), 16, 0, 0);
            __builtin_amdgcn_global_load_lds((const __attribute__((address_space(1))) void*)wp, (__attribute__((address_space(3))) void*)(wb + (32 * i + 8 * wave) * 128), 16, 0, 0);
        }
    };
    auto compute = [&](int buf) {
        const char* xb = smem + buf * 2 * GT_BYTES; const char* wb = xb + GT_BYTES;
        const int rw0 = wn * 64 + c, rx0 = wm * 64 + c;
        const int kw = (rw0 >> 1) & 7, kx = (rx0 >> 1) & 7;
        const char* wp0 = wb + rw0 * 128; const char* xp0 = xb + rx0 * 128;
#define FRAG(base, key, ks) (*(const bf16x8*)((base) + (((2 * (ks) + h) ^ (key)) << 4)))
        bf16x8 wfa0 = FRAG(wp0, kw, 0), wfa1 = FRAG(wp0 + 32 * 128, kw, 0), xfa0 = FRAG(xp0, kx, 0), xfa1 = FRAG(xp0 + 32 * 128, kx, 0);
#pragma unroll
        for (int ks = 0; ks < 4; ++ks) {
            bf16x8 wfb0, wfb1, xfb0, xfb1;
            if (ks < 3) { wfb0 = FRAG(wp0, kw, ks + 1); wfb1 = FRAG(wp0 + 32 * 128, kw, ks + 1); xfb0 = FRAG(xp0, kx, ks + 1); xfb1 = FRAG(xp0 + 32 * 128, kx, ks + 1); }
            acc[0][0] = __builtin_amdgcn_mfma_f32_32x32x16_bf16(wfa0, xfa0, acc[0][0], 0, 0, 0);
            acc[0][1] = __builtin_amdgcn_mfma_f32_32x32x16_bf16(wfa0, xfa1, acc[0][1], 0, 0, 0);
            acc[1][0] = __builtin_amdgcn_mfma_f32_32x32x16_bf16(wfa1, xfa0, acc[1][0], 0, 0, 0);
            acc[1][1] = __builtin_amdgcn_mfma_f32_32x32x16_bf16(wfa1, xfa1, acc[1][1], 0, 0, 0);
            __builtin_amdgcn_sched_barrier(0);
            if (ks < 3) { wfa0 = wfb0; wfa1 = wfb1; xfa0 = xfb0; xfa1 = xfb1; }
        }
#undef FRAG
    };
    const int nk = K >> 6;
    issue(0, 0);
    __syncthreads();
    for (int kt = 0; kt < nk; ++kt) {
        if (kt + 1 < nk) issue((kt + 1) * 64, (kt + 1) & 1);
        compute(kt & 1);
        __syncthreads();
    }
}
template <class F>
__device__ __forceinline__ void epi_foreach(const f32x16 (&acc)[2][2], int m0, int n0, F f) {
    const int tid_ = opq_tid(), lane = tid_ & 63, wave = tid_ >> 6;
    const int wn = wave >> 1, wm = wave & 1, c = lane & 31, h = lane >> 5;
#pragma unroll
    for (int i = 0; i < 2; ++i)
#pragma unroll
        for (int j = 0; j < 2; ++j)
#pragma unroll
            for (int q = 0; q < 4; ++q) {
                const int n = n0 + wn * 64 + 32 * i + 8 * q + 4 * h, m = m0 + wm * 64 + 32 * j + c;
                f(m, n, make_float4(acc[i][j][4 * q], acc[i][j][4 * q + 1], acc[i][j][4 * q + 2], acc[i][j][4 * q + 3]));
            }
}
struct EpiStore { float* C; long long ldc; __device__ void operator()(int r, int c, float4 v) const { *(float4*)(C + (size_t)r * ldc + c) = v; } };
struct EpiGelu { float* C; long long ldc; __device__ void operator()(int r, int c, float4 v) const { *(float4*)(C + (size_t)r * ldc + c) = make_float4(gelu_tanh(v.x), gelu_tanh(v.y), gelu_tanh(v.z), gelu_tanh(v.w)); } };
struct EpiSigm { float* C; long long ldc; __device__ void operator()(int r, int c, float4 v) const { *(float4*)(C + (size_t)r * ldc + c) = make_float4(sigm(v.x), sigm(v.y), sigm(v.z), sigm(v.w)); } };
struct EpiResid { const float* R; float* C; long long ldc; __device__ void operator()(int r, int c, float4 v) const { float4 a = *(const float4*)(R + (size_t)r * ldc + c); *(float4*)(C + (size_t)r * ldc + c) = make_float4(a.x + v.x, a.y + v.y, a.z + v.z, a.w + v.w); } };
struct EpiPle { const float* G; float* H; long long ldc; __device__ void operator()(int r, int c, float4 v) const { float4 g = *(const float4*)(G + (size_t)r * ldc + c); float4 a = *(const float4*)(H + (size_t)r * ldc + c); *(float4*)(H + (size_t)r * ldc + c) = make_float4(a.x + g.x * v.x, a.y + g.y * v.y, a.z + g.z * v.z, a.w + g.w * v.w); } };

template <bool A_F32, class Epi>
__device__ __forceinline__ void d_gemm(const void* __restrict__ A, const bf16_t* __restrict__ Wt, long long lda, int M, int N, int K, Epi epi, int bx, int by, char* smem) {
    const int m0 = by * 128, n0 = bx * 128;
    f32x16 acc[2][2];
    if constexpr (A_F32) {
        gemm_core<true>([&](int i, int r, int k0) -> const void* {
            if (m0 + r >= M) return nullptr;
            return (const void*)((const float*)A + (size_t)(m0 + r) * lda + k0); }, Wt, K, n0, K, smem, acc);
    } else {
        gemm_core_glds([&](int i, int r, int k0) -> const void* {
            const int rr = (m0 + r < M) ? (m0 + r) : 0;
            return (const void*)((const bf16_t*)A + (size_t)rr * lda + k0); }, Wt, K, n0, K, smem, acc);
    }
    epi_foreach(acc, m0, n0, [&](int m, int n, float4 v) { if (m < M && n < N) epi(m, n, v); });
}

struct WJob { const float* src; bf16_t* dst; const float* gain; long long sbs, dbs; int K, N, Npad, batch, perm, gbs; };
#define NJOBS 20
__device__ __forceinline__ void wconv_item(const WJob& J, int item, float* lds) {
    const int tid = opq_tid(), lane = tid & 63;
    const int nt = J.Npad >> 6, kt = J.K >> 6;
    const int bi = item / (nt * kt), rem = item % (nt * kt), kb = rem / nt, nb = rem % nt;
    const float* W = J.src + (size_t)bi * J.sbs;
    bf16_t* D = J.dst + (size_t)bi * J.dbs;
    const int k0 = kb * 64, n0 = nb * 64;
    __syncthreads();
    {
        float vv[16];
        const int n = n0 + lane;
#pragma unroll
        for (int p = 0; p < 16; ++p) {
            const int k = p * 4 + (tid >> 6);
            vv[p] = (n < J.N) ? W[(size_t)(k0 + k) * J.N + n] : 0.f;
        }
        if (J.gain) {
#pragma unroll
            for (int p = 0; p < 16; ++p) vv[p] *= J.gain[(size_t)bi * J.gbs + k0 + p * 4 + (tid >> 6)];
        }
#pragma unroll
        for (int p = 0; p < 16; ++p) lds[(p * 4 + (tid >> 6)) * 65 + lane] = vv[p];
    }
    __syncthreads();
    const int n = tid >> 2, kq = (tid & 3) * 16;
    float f[16];
#pragma unroll
    for (int i = 0; i < 16; ++i) f[i] = lds[(kq + i) * 65 + n];
    uint4 o0, o1;
    o0.x = pk2(f[0], f[1]); o0.y = pk2(f[2], f[3]); o0.z = pk2(f[4], f[5]); o0.w = pk2(f[6], f[7]);
    o1.x = pk2(f[8], f[9]); o1.y = pk2(f[10], f[11]); o1.z = pk2(f[12], f[13]); o1.w = pk2(f[14], f[15]);
    int drow = n0 + n;
    if (J.perm) drow = (drow >> 5) * 64 + (J.perm - 1) * 32 + (drow & 31);
    uint4* dp = (uint4*)(D + (size_t)drow * J.K + k0 + kq);
    dp[0] = o0; dp[1] = o1;
}

#define LOG2E 1.4426950408889634f
#define CNT_STRIDE 64
struct L0Bufs { bf16_t *q, *kcr, *vcr, *ks, *vst, *kw, *vwt; float* gates; bf16_t *hidc, *kc, *vct; float* bias1; };

__device__ __forceinline__ float wave_max(float v) { v = fmaxf(v, fx<1>(v)); v = fmaxf(v, fx<2>(v)); v = fmaxf(v, fx<4>(v)); v = fmaxf(v, fx<8>(v)); v = fmaxf(v, fx<16>(v)); return max32(v); }

__device__ __forceinline__ void p1_item(const bf16_t* __restrict__ xn, const bf16_t* __restrict__ t_w_in, const float* __restrict__ qn, const float* __restrict__ kn,
                                        const L0Bufs& B, int bx, int by, char* smem) {
    const int m0 = by * 128, n0 = bx * 128;
    f32x16 acc[2][2];
    gemm_core_glds([&](int i, int r, int k0) -> const void* { return (const void*)(xn + (size_t)(m0 + r) * DM + k0); }, t_w_in, DM, n0, DM, smem, acc);
    const int tid_ = opq_tid(), lane = tid_ & 63, wave = tid_ >> 6;
    const int wn = wave >> 1, wm = wave & 1, c = lane & 31, h = lane >> 5;
    const int ch = (n0 >> 6) + wn;
#pragma unroll
    for (int j = 0; j < 2; ++j) {
        const int m = m0 + wm * 64 + 32 * j + c;
        const int b = m >> 12, t = m & 4095;
        if (ch < 16 || (ch >= 24 && ch < 28) || (ch >= 32 && ch < 36)) {
            float ss = 0.f;
#pragma unroll
            for (int i = 0; i < 2; ++i)
#pragma unroll
                for (int r = 0; r < 16; ++r) ss += acc[i][j][r] * acc[i][j][r];
            ss = sum32(ss);
            float rs = rsqrtf(ss * (1.f / 64.f) + 1e-6f);
            const float* g; bf16_t* dst;
            if (ch < 16) { g = qn; rs *= 0.125f * LOG2E; dst = B.q + (size_t)m * 1024 + ch * 64; }
            else if (ch < 28) { g = kn + 64; dst = B.ks + (size_t)m * 256 + (ch - 24) * 64; }
            else { g = kn + 128; dst = B.kw + (size_t)m * 256 + (ch - 32) * 64; }
#pragma unroll
            for (int i = 0; i < 2; ++i)
#pragma unroll
                for (int q4 = 0; q4 < 4; ++q4) {
                    const int nl = 32 * i + 8 * q4 + 4 * h;
                    const float4 gg = *(const float4*)(g + nl);
                    uint2 o;
                    o.x = pk2(acc[i][j][4 * q4] * rs * gg.x, acc[i][j][4 * q4 + 1] * rs * gg.y);
                    o.y = pk2(acc[i][j][4 * q4 + 2] * rs * gg.z, acc[i][j][4 * q4 + 3] * rs * gg.w);
                    *(uint2*)(dst + nl) = o;
                }
        } else if (ch >= 16 && ch < 24) {
            bf16_t* dst = (ch < 20) ? (B.kcr + (size_t)m * 256 + (ch - 16) * 64) : (B.vcr + (size_t)m * 256 + (ch - 20) * 64);
#pragma unroll
            for (int i = 0; i < 2; ++i)
#pragma unroll
                for (int q4 = 0; q4 < 4; ++q4) {
                    const int nl = 32 * i + 8 * q4 + 4 * h;
                    uint2 o;
                    o.x = pk2(acc[i][j][4 * q4], acc[i][j][4 * q4 + 1]);
                    o.y = pk2(acc[i][j][4 * q4 + 2], acc[i][j][4 * q4 + 3]);
                    *(uint2*)(dst + nl) = o;
                }
        } else if ((ch >= 28 && ch < 32) || (ch >= 36 && ch < 40)) {
            const int g = (ch < 32) ? (ch - 28) : (ch - 36);
            bf16_t* dst = ((ch < 32) ? B.vst : B.vwt) + ((size_t)(b * 4 + g) * 64) * SEQ + t;
#pragma unroll
            for (int i = 0; i < 2; ++i)
#pragma unroll
                for (int r = 0; r < 16; ++r) {
                    const int d = 32 * i + (r & 3) + 8 * (r >> 2) + 4 * h;
                    dst[(size_t)d * SEQ] = (bf16_t)(pk2(acc[i][j][r], 0.f) & 0xffffu);
                }
        } else if (ch == 40) {
#pragma unroll
            for (int i = 0; i < 2; ++i)
#pragma unroll
                for (int q4 = 0; q4 < 4; ++q4) {
                    const int nl = 32 * i + 8 * q4 + 4 * h;
                    if (nl < 48) *(float4*)(B.gates + (size_t)m * 48 + nl) = make_float4(sigm(acc[i][j][4 * q4]), sigm(acc[i][j][4 * q4 + 1]), sigm(acc[i][j][4 * q4 + 2]), sigm(acc[i][j][4 * q4 + 3]));
                }
        }
    }
}

__device__ __forceinline__ void p2a_item(const L0Bufs& B, const bf16_t* __restrict__ w1t, int which, int mt, int nt, char* smem) {
    const bf16_t* raw = which ? B.vcr : B.kcr;
    const int sr = opq_tid() >> 3;
    auto rowbase = [&](int i) -> const bf16_t* {
        const int m = mt * 128 + sr + 32 * i;
        if (m >= 4080) return nullptr;
        const int bg = m / NCMP, n = m - bg * NCMP;
        return raw + ((size_t)((bg >> 2) * SEQ + 16 * n)) * 256 + (bg & 3) * 64;
    };
    const bf16_t* rb0 = rowbase(0); const bf16_t* rb1 = rowbase(1); const bf16_t* rb2 = rowbase(2); const bf16_t* rb3 = rowbase(3);
    f32x16 acc[2][2];
    gemm_core_glds([&](int i, int r, int k0) -> const void* { const bf16_t* rbi = (i == 0) ? rb0 : (i == 1) ? rb1 : (i == 2) ? rb2 : rb3; return (const void*)((rbi ? rbi : raw) + (size_t)(k0 >> 6) * 256); }, w1t, 2048, nt * 128, 2048, smem, acc);
    const float* bias = B.bias1 + which * 256;
    bf16_t* hid = B.hidc + (size_t)which * 4096 * 256;
    epi_foreach(acc, mt * 128, nt * 128, [&](int m, int n, float4 v) {
        const float4 bb = *(const float4*)(bias + n);
        uint2 o; o.x = pk2(gelu_tanh(v.x + bb.x), gelu_tanh(v.y + bb.y)); o.y = pk2(gelu_tanh(v.z + bb.z), gelu_tanh(v.w + bb.w));
        *(uint2*)(hid + (size_t)m * 256 + n) = o;
    });
}
__device__ __forceinline__ void p2b_item(const L0Bufs& B, const bf16_t* __restrict__ w2t, const float* __restrict__ kn, int which, int mt, char* smem) {
    const bf16_t* hid = B.hidc + (size_t)which * 4096 * 256;
    f32x16 acc[2][2];
    gemm_core_glds([&](int i, int r, int k0) -> const void* { return (const void*)(hid + (size_t)(mt * 128 + r) * 256 + k0); }, w2t, 256, 0, 256, smem, acc);
    const int tid_ = opq_tid(), lane = tid_ & 63, wave = tid_ >> 6;
    const int wn = wave >> 1, wm = wave & 1, c = lane & 31, h = lane >> 5;
    if (wn != 0) return;
#pragma unroll
    for (int j = 0; j < 2; ++j) {
        const int m = mt * 128 + wm * 64 + 32 * j + c;
        const bool ok = m < 4080;
        const int bg = m / NCMP, n = m - bg * NCMP;
        if (which == 0) {
            float ss = 0.f;
#pragma unroll
            for (int i = 0; i < 2; ++i)
#pragma unroll
                for (int r = 0; r < 16; ++r) ss += acc[i][j][r] * acc[i][j][r];
            ss = sum32(ss);
            const float rs = rsqrtf(ss * (1.f / 64.f) + 1e-6f);
            if (ok) {
                bf16_t* dst = B.kc + ((size_t)bg * 256 + n) * 64;
#pragma unroll
                for (int i = 0; i < 2; ++i)
#pragma unroll
                    for (int q4 = 0; q4 < 4; ++q4) {
                        const int nl = 32 * i + 8 * q4 + 4 * h;
                        const float4 gg = *(const float4*)(kn + nl);
                        uint2 o;
                        o.x = pk2(acc[i][j][4 * q4] * rs * gg.x, acc[i][j][4 * q4 + 1] * rs * gg.y);
                        o.y = pk2(acc[i][j][4 * q4 + 2] * rs * gg.z, acc[i][j][4 * q4 + 3] * rs * gg.w);
                        *(uint2*)(dst + nl) = o;
                    }
            }
        } else if (ok) {
            bf16_t* dst = B.vct + ((size_t)bg * 64) * 256 + n;
#pragma unroll
            for (int i = 0; i < 2; ++i)
#pragma unroll
                for (int r = 0; r < 16; ++r) {
                    const int d = 32 * i + (r & 3) + 8 * (r >> 2) + 4 * h;
                    dst[(size_t)d * 256] = (bf16_t)(pk2(acc[i][j][r], 0.f) & 0xffffu);
                }
        }
    }
}

#define KROW 144
#define VROW 136
#define KT_BYTES (64 * KROW)
#define ABUF (KT_BYTES + 64 * VROW)
#define ATT_IMP_OFF (2 * ABUF)
#define ATT_MASK_OFF (ATT_IMP_OFF + 4 * 32 * 65 * 4)
#define ATT_MISC_OFF (ATT_MASK_OFF + 32 * 8)

struct KVRegs { uint4 k0, k1, v0, v1; };
typedef unsigned int u32x4 __attribute__((ext_vector_type(4)));
__device__ __forceinline__ uint4 bload16(__amdgpu_buffer_rsrc_t r, unsigned voff, unsigned soff) { const u32x4 v = __builtin_amdgcn_raw_buffer_load_b128(r, voff, soff, 0); return make_uint4(v.x, v.y, v.z, v.w); }
__device__ __forceinline__ KVRegs attn_load_tile(__amdgpu_buffer_rsrc_t rK, __amdgpu_buffer_rsrc_t rV, unsigned koff, unsigned voff, int kstride, int j) {
    KVRegs R;
    const unsigned ks = (unsigned)j * 128u * (unsigned)kstride, vs = (unsigned)j * 128u;
    R.k0 = bload16(rK, koff, ks); R.k1 = bload16(rK, koff + 16u, ks);
    R.v0 = bload16(rV, voff, vs); R.v1 = bload16(rV, voff + 16u, vs);
    return R;
}
__device__ __forceinline__ void attn_store_tile(char* buf, const KVRegs R, int tid) {
    const int row = tid >> 2, cq = tid & 3;
    char* kd = buf + row * KROW + cq * 32;
    *(uint4*)kd = R.k0; *(uint4*)(kd + 16) = R.k1;
    char* vd = buf + KT_BYTES + row * VROW + cq * 32;
    *(uint2*)vd = make_uint2(R.v0.x, R.v0.y); *(uint2*)(vd + 8) = make_uint2(R.v0.z, R.v0.w);
    *(uint2*)(vd + 16) = make_uint2(R.v1.x, R.v1.y); *(uint2*)(vd + 24) = make_uint2(R.v1.z, R.v1.w);
}
template <bool AUG>
__device__ __forceinline__ void attn_qk(const char* buf, const bf16x8 (&qf)[4], f32x16 (&st)[2], int tid, const bf16x8 (&kaug)[2], const bf16x8 qaug) {
    const int lane = tid & 63, cl = lane & 31, hh = lane >> 5;
    const char* kp = buf + cl * KROW + hh * 16;
    const bf16x8 k00 = *(const bf16x8*)(kp), k01 = *(const bf16x8*)(kp + 32), k02 = *(const bf16x8*)(kp + 64), k03 = *(const bf16x8*)(kp + 96);
    const bf16x8 k10 = *(const bf16x8*)(kp + 32 * KROW), k11 = *(const bf16x8*)(kp + 32 * KROW + 32), k12 = *(const bf16x8*)(kp + 32 * KROW + 64), k13 = *(const bf16x8*)(kp + 32 * KROW + 96);
    __builtin_amdgcn_sched_barrier(0);
#pragma unroll
    for (int r = 0; r < 16; ++r) { st[0][r] = 0.f; st[1][r] = 0.f; }
    st[0] = __builtin_amdgcn_mfma_f32_32x32x16_bf16(k00, qf[0], st[0], 0, 0, 0);
    st[1] = __builtin_amdgcn_mfma_f32_32x32x16_bf16(k10, qf[0], st[1], 0, 0, 0);
    st[0] = __builtin_amdgcn_mfma_f32_32x32x16_bf16(k01, qf[1], st[0], 0, 0, 0);
    st[1] = __builtin_amdgcn_mfma_f32_32x32x16_bf16(k11, qf[1], st[1], 0, 0, 0);
    st[0] = __builtin_amdgcn_mfma_f32_32x32x16_bf16(k02, qf[2], st[0], 0, 0, 0);
    st[1] = __builtin_amdgcn_mfma_f32_32x32x16_bf16(k12, qf[2], st[1], 0, 0, 0);
    st[0] = __builtin_amdgcn_mfma_f32_32x32x16_bf16(k03, qf[3], st[0], 0, 0, 0);
    st[1] = __builtin_amdgcn_mfma_f32_32x32x16_bf16(k13, qf[3], st[1], 0, 0, 0);
    if (AUG) {
        st[0] = __builtin_amdgcn_mfma_f32_32x32x16_bf16(kaug[0], qaug, st[0], 0, 0, 0);
        st[1] = __builtin_amdgcn_mfma_f32_32x32x16_bf16(kaug[1], qaug, st[1], 0, 0, 0);
    }
}
template <bool MASKED, int PSC>
__device__ __forceinline__ void attn_exp(f32x16 (&st)[2], bf16x8 (&pf)[2][2], int pos0, int tq, int wlim, float& l) {
    float l0 = 0.f, l1 = 0.f;
#pragma unroll
    for (int i = 0; i < 2; ++i) {
#pragma unroll
        for (int r = 0; r < 16; ++r) {
            float e = st[i][r];
            if (MASKED) { const int kl = 32 * i + (r & 3) + 8 * (r >> 2); const int dist = tq - (pos0 + PSC * kl); e = (dist >= 0 && dist < wlim) ? e : -INFINITY; }
            const float p = __builtin_amdgcn_exp2f(e);
            if (r & 1) l1 += p; else l0 += p;
            st[i][r] = p;
        }
#pragma unroll
        for (int s = 0; s < 2; ++s) {
            uint4 u;
            u.x = pk2(st[i][8 * s + 0], st[i][8 * s + 1]); u.y = pk2(st[i][8 * s + 2], st[i][8 * s + 3]);
            u.z = pk2(st[i][8 * s + 4], st[i][8 * s + 5]); u.w = pk2(st[i][8 * s + 6], st[i][8 * s + 7]);
            pf[i][s] = __builtin_bit_cast(bf16x8, u);
        }
    }
    l += l0 + l1;
}
struct VFrags { uint2 a[8]; };
__device__ __forceinline__ bf16x8 vjoin(uint2 v0, uint2 v1) { return __builtin_bit_cast(bf16x8, make_uint4(v0.x, v0.y, v1.x, v1.y)); }
#define VADDR(buf, dt, i, s) ((buf) + KT_BYTES + (32 * (dt) + cl) * VROW + (32 * (i) + 16 * (s) + 4 * hh) * 2)
__device__ __forceinline__ void attn_pv(const char* buf, const bf16x8 (&pf)[2][2], f32x16 (&ot)[2], int tid) {
    const int lane = tid & 63, cl = lane & 31, hh = lane >> 5;
    const char* a00 = VADDR(buf, 0, 0, 0);
    const uint2 p0 = *(const uint2*)(a00), p1 = *(const uint2*)(a00 + 16), p2 = *(const uint2*)(a00 + 32), p3 = *(const uint2*)(a00 + 48);
    const uint2 p4 = *(const uint2*)(a00 + 64), p5 = *(const uint2*)(a00 + 80), p6 = *(const uint2*)(a00 + 96), p7 = *(const uint2*)(a00 + 112);
    const char* a10 = a00 + 32 * VROW;
    const uint2 q0 = *(const uint2*)(a10), q1 = *(const uint2*)(a10 + 16), q2 = *(const uint2*)(a10 + 32), q3 = *(const uint2*)(a10 + 48);
    const uint2 q4 = *(const uint2*)(a10 + 64), q5 = *(const uint2*)(a10 + 80), q6 = *(const uint2*)(a10 + 96), q7 = *(const uint2*)(a10 + 112);
    __builtin_amdgcn_sched_barrier(0);
    ot[0] = __builtin_amdgcn_mfma_f32_32x32x16_bf16(vjoin(p0, p1), pf[0][0], ot[0], 0, 0, 0);
    ot[1] = __builtin_amdgcn_mfma_f32_32x32x16_bf16(vjoin(q0, q1), pf[0][0], ot[1], 0, 0, 0);
    ot[0] = __builtin_amdgcn_mfma_f32_32x32x16_bf16(vjoin(p2, p3), pf[0][1], ot[0], 0, 0, 0);
    ot[1] = __builtin_amdgcn_mfma_f32_32x32x16_bf16(vjoin(q2, q3), pf[0][1], ot[1], 0, 0, 0);
    ot[0] = __builtin_amdgcn_mfma_f32_32x32x16_bf16(vjoin(p4, p5), pf[1][0], ot[0], 0, 0, 0);
    ot[1] = __builtin_amdgcn_mfma_f32_32x32x16_bf16(vjoin(q4, q5), pf[1][0], ot[1], 0, 0, 0);
    ot[0] = __builtin_amdgcn_mfma_f32_32x32x16_bf16(vjoin(p6, p7), pf[1][1], ot[0], 0, 0, 0);
    ot[1] = __builtin_amdgcn_mfma_f32_32x32x16_bf16(vjoin(q6, q7), pf[1][1], ot[1], 0, 0, 0);
}

template <int PSC, int POFF>
__device__ __forceinline__ void attn_branch(const bf16_t* SK, const bf16_t* SVT, int kstride, int vstride, unsigned long long tiles, unsigned long long maskbits, unsigned long long lane_mask,
                                            const bf16x8 (&qf)[4], float slope2, float tb0, int tq, int wlim, char* smem, f32x16 (&ot)[2], float& l, int tid) {
    const int hh = (tid & 63) >> 5;
#pragma unroll
    for (int dt = 0; dt < 2; ++dt)
#pragma unroll
        for (int r = 0; r < 16; ++r) ot[dt][r] = 0.f;
    l = 0.f;
    if (tiles == 0ull) return;
    const __amdgpu_buffer_rsrc_t rK = __builtin_amdgcn_make_buffer_rsrc((void*)SK, 0, 0x7fffffff, 0x00020000);
    const __amdgpu_buffer_rsrc_t rV = __builtin_amdgcn_make_buffer_rsrc((void*)SVT, 0, 0x7fffffff, 0x00020000);
    const unsigned koff = (((unsigned)tid >> 2) * (unsigned)kstride + ((unsigned)tid & 3) * 16u) * 2u, voff = (((unsigned)tid >> 2) * (unsigned)vstride + ((unsigned)tid & 3) * 16u) * 2u;
    bf16x8 kaug[2];
    const float sk = slope2 * (float)PSC;
    const unsigned s_hi = pk2(sk, 0.f) & 0xffffu, s_lo = pk2(sk - bf16_lo_f(s_hi), 0.f) & 0xffffu;
    {
        const int cl = tid & 31;
#pragma unroll
        for (int i = 0; i < 2; ++i) {
            const float klf = (float)(32 * i + cl);
            uint4 u = make_uint4(pk2(klf, klf), 0x3f803f80u, 0x00003f80u, 0u);
            if (hh) u = make_uint4(0u, 0u, 0u, 0u);
            kaug[i] = __builtin_bit_cast(bf16x8, u);
        }
    }
    auto compute = [&](const char* buf, int j) {
        f32x16 st[2]; bf16x8 pf[2][2];
        const float t = fmaf(slope2, (float)(PSC * 64 * j + POFF), tb0);
        const bool on = (lane_mask >> j) & 1ull;
        const unsigned t_hi = on ? (pk2(t, 0.f) & 0xffffu) : 0xff80u;
        const float r1 = on ? (t - bf16_lo_f(t_hi)) : 0.f;
        const unsigned t_lo = pk2(r1, 0.f) & 0xffffu;
        const unsigned t_l2 = pk2(r1 - bf16_lo_f(t_lo), 0.f) & 0xffffu;
        uint4 qu = make_uint4(s_hi | (s_lo << 16), t_hi | (t_lo << 16), t_l2, 0u);
        if (hh) qu = make_uint4(0u, 0u, 0u, 0u);
        attn_qk<true>(buf, qf, st, tid, kaug, __builtin_bit_cast(bf16x8, qu));
        const int pos0 = PSC * (64 * j + 4 * hh) + POFF;
        if ((maskbits >> j) & 1ull) attn_exp<true, PSC>(st, pf, pos0, tq, wlim, l);
        else attn_exp<false, PSC>(st, pf, pos0, tq, wlim, l);
        attn_pv(buf, pf, ot, tid);
    };
    int j = __builtin_ctzll(tiles); tiles &= tiles - 1;
    KVRegs R = attn_load_tile(rK, rV, koff, voff, kstride, j);
    __syncthreads();
    attn_store_tile(smem, R, tid);
    __syncthreads();
    int cur = 0;
    for (;;) {
        const bool more = tiles != 0ull;
        int jn = 0;
        if (more) { jn = __builtin_ctzll(tiles); tiles &= tiles - 1; R = attn_load_tile(rK, rV, koff, voff, kstride, jn); }
        compute(smem + cur * ABUF, j);
        if (more) attn_store_tile(smem + (cur ^ 1) * ABUF, R, tid);
        __syncthreads();
        if (!more) break;
        j = jn; cur ^= 1;
    }
}

__device__ __forceinline__ void nsa_attn_item(const L0Bufs& B, float m2c, float m2s, float m2w, bf16_t* __restrict__ att, int bg, int qb, char* smem) {
    const int tid = opq_tid();
    const int lane = tid & 63, wave = tid >> 6, cl = lane & 31, hh = lane >> 5;
    const int b = bg >> 2, g = bg & 3, hd = g * 4 + wave;
    const int t0 = qb * 32, c = qb >> 1, tq = t0 + cl;
    const float slope2 = exp2f(-0.5f * (float)(hd + 1)) * LOG2E;
    float* imp = (float*)(smem + ATT_IMP_OFF);
    uint2* msk = (uint2*)(smem + ATT_MASK_OFF);
    bf16x8 qf[4];
    {
        const bf16_t* qp = B.q + (size_t)(b * SEQ + tq) * 1024 + hd * 64 + 8 * hh;
#pragma unroll
        for (int ks = 0; ks < 4; ++ks) qf[ks] = *(const bf16x8*)(qp + ks * 16);
    }
#define NSA_GATE(idx, dep) ({ int t_ = threadIdx.x; asm volatile("" : "+v"(t_) : "v"(dep)); B.gates[(size_t)(b * SEQ + t0 + (t_ & 31)) * 48 + (g * 4 + (t_ >> 6)) * 3 + (idx)]; })
    f32x16 res[2], ot[2];
    float l;
    for (int e = tid; e < 4 * 32 * 65; e += 256) imp[e] = 0.f;
    const int ntc = (qb >> 5) + 1;
    const unsigned long long ctiles = (1ull << ntc) - 1ull;
    const bf16_t* SCK = B.kc + (size_t)bg * 256 * 64;
    const bf16_t* SCV = B.vct + (size_t)bg * 64 * 256;
    const float tbc = -(slope2 * (float)tq) - m2c;
    attn_branch<16, 31>(SCK, SCV, 64, 256, ctiles, ctiles, ~0ull, qf, slope2, tbc, tq, 1 << 30, smem, ot, l, tid);
    const float lc = sum32(l);
    const float invc = (lc > 0.f) ? 1.f / lc : 0.f;
    {
        const float f = NSA_GATE(0, invc) * invc;
#pragma unroll
        for (int dt = 0; dt < 2; ++dt)
#pragma unroll
            for (int r = 0; r < 16; ++r) res[dt][r] = ot[dt][r] * f;
    }
    {
        float* row = imp + wave * (32 * 65) + cl * 65;
        for (int jt = 0; jt < ntc; ++jt) {
            {
                const int rowi = tid >> 2, cq = tid & 3;
                const bf16_t* kp = SCK + (size_t)(jt * 64 + rowi) * 64 + cq * 16;
                const uint4 ka = *(const uint4*)kp, kb = *(const uint4*)(kp + 8);
                __syncthreads();
                char* kd = smem + rowi * KROW + cq * 32;
                *(uint4*)kd = ka; *(uint4*)(kd + 16) = kb;
                __syncthreads();
            }
            f32x16 st[2];
            { bf16x8 kz[2]; kz[0] = __builtin_bit_cast(bf16x8, make_uint4(0u, 0u, 0u, 0u)); kz[1] = kz[0]; attn_qk<false>(smem, qf, st, tid, kz, kz[0]); }
            const int pos0 = 16 * (64 * jt + 4 * hh) + 31;
            const float tb = fmaf(slope2, (float)pos0, tbc);
#pragma unroll
            for (int i = 0; i < 2; ++i)
#pragma unroll
                for (int gq4 = 0; gq4 < 4; ++gq4) {
                    float p[4];
#pragma unroll
                    for (int e4 = 0; e4 < 4; ++e4) {
                        const int r = 4 * gq4 + e4;
                        const int kl = 32 * i + (r & 3) + 8 * (r >> 2);
                        float e = fmaf(slope2 * 16.f, (float)kl, st[i][r]) + tb;
                        e = (tq - (pos0 + 16 * kl) >= 0) ? e : -INFINITY;
                        p[e4] = __builtin_amdgcn_exp2f(e) * invc;
                    }
                    const int js = 16 * jt + 8 * i + 2 * gq4 + hh;
                    row[js] += p[0] + p[1] + p[2] + 0.5f * p[3];
                    st[i][4 * gq4] = 0.5f * p[3];
                }
            __builtin_amdgcn_s_waitcnt(0xc07f);
#pragma unroll
            for (int i = 0; i < 2; ++i)
#pragma unroll
                for (int gq4 = 0; gq4 < 4; ++gq4) { const int js = 16 * jt + 8 * i + 2 * gq4 + hh; row[js + 1] += st[i][4 * gq4]; }
        }
    }
    __syncthreads();
    {
        const int q = tid >> 3, part = tid & 7;
        const float* row = imp + q * 65;
        auto impv = [&](int j) -> float { return ((row[j] + row[j + 32 * 65]) + row[j + 2 * 32 * 65]) + row[j + 3 * 32 * 65]; };
        float myv[8]; int rank[8];
#pragma unroll
        for (int u = 0; u < 8; ++u) { const int j = part * 8 + u; const bool f = (j == 0) || (j == c) || (j == c - 1); myv[u] = f ? 1e9f : impv(j); rank[u] = 0; }
        for (int j2 = 0; j2 <= c; ++j2) {
            const bool f2 = (j2 == 0) || (j2 == c) || (j2 == c - 1);
            const float v2 = f2 ? 1e9f : impv(j2);
#pragma unroll
            for (int u = 0; u < 8; ++u) { const int j = part * 8 + u; rank[u] += (v2 > myv[u] || (v2 == myv[u] && j2 < j)) ? 1 : 0; }
        }
        unsigned bits = 0u;
#pragma unroll
        for (int u = 0; u < 8; ++u) { const int j = part * 8 + u; if (j <= c && rank[u] < 16) bits |= 1u << u; }
        unsigned lo = (part < 4) ? (bits << (8 * part)) : 0u, hi = (part >= 4) ? (bits << (8 * (part - 4))) : 0u;
        lo |= ux<1>(lo); lo |= ux<2>(lo); lo |= ux<4>(lo); hi |= ux<1>(hi); hi |= ux<2>(hi); hi |= ux<4>(hi);
        if (part == 0) msk[q] = make_uint2(lo, hi);
    }
    __syncthreads();
    const uint2 mm = msk[cl];
    const unsigned long long mymask = (unsigned long long)mm.x | ((unsigned long long)mm.y << 32);
    const unsigned ulo = or_lo32(mm.x), uhi = or_lo32(mm.y);
    const unsigned long long U = (unsigned long long)__builtin_amdgcn_readfirstlane(ulo) | ((unsigned long long)__builtin_amdgcn_readfirstlane(uhi) << 32);
    {
        const float tbs = -(slope2 * (float)tq) - m2s;
        attn_branch<1, 0>(B.ks + (size_t)(b * SEQ) * 256 + g * 64, B.vst + (size_t)bg * 64 * SEQ, 256, SEQ, U, 1ull << c, mymask, qf, slope2, tbs, tq, 1 << 30, smem, ot, l, tid);
        const float ls = sum32(l);
        const float f = NSA_GATE(1, ls) / ls;
#pragma unroll
        for (int dt = 0; dt < 2; ++dt)
#pragma unroll
            for (int r = 0; r < 16; ++r) res[dt][r] += ot[dt][r] * f;
    }
    {
        const float tbw = -(slope2 * (float)tq) - m2w;
        const int lo_pos = t0 - 511;
        const int jlo = lo_pos > 0 ? (lo_pos >> 6) : 0;
        unsigned long long wt = 0ull, wm = 0ull;
        for (int j = jlo; j <= c; ++j) { wt |= 1ull << j; if (j == c || 64 * j < t0 + 31 - 511) wm |= 1ull << j; }
        attn_branch<1, 0>(B.kw + (size_t)(b * SEQ) * 256 + g * 64, B.vwt + (size_t)bg * 64 * SEQ, 256, SEQ, wt, wm, ~0ull, qf, slope2, tbw, tq, 512, smem, ot, l, tid);
        const float lw_ = sum32(l);
        const float f = NSA_GATE(2, lw_) / lw_;
#pragma unroll
        for (int dt = 0; dt < 2; ++dt)
#pragma unroll
            for (int r = 0; r < 16; ++r) res[dt][r] += ot[dt][r] * f;
    }
    {
        const int tid2 = opq_tid();
        bf16_t* dst = att + (size_t)(b * SEQ + t0 + (tid2 & 31)) * 1024 + (g * 4 + (tid2 >> 6)) * 64;
#pragma unroll
        for (int dt = 0; dt < 2; ++dt)
#pragma unroll
            for (int q4 = 0; q4 < 4; ++q4) {
                const int d = 32 * dt + 8 * q4 + 4 * hh;
                uint2 o; o.x = pk2(res[dt][4 * q4], res[dt][4 * q4 + 1]); o.y = pk2(res[dt][4 * q4 + 2], res[dt][4 * q4 + 3]);
                *(uint2*)(dst + d) = o;
            }
    }
}


template <bool COMBINE, int R>
__device__ __forceinline__ void rp_rows(const float* __restrict__ in, float* __restrict__ hw, const bf16_t* __restrict__ ys, bf16_t* __restrict__ hi, int row0, int rstride, int nrows_valid, float* rs_out) {
    const int lane = opq_tid() & 63;
    float4 v[R][4]; float ss[R];
#pragma unroll
    for (int r = 0; r < R; ++r) {
        const size_t row = (size_t)(row0 + r * rstride);
        ss[r] = 0.f;
        if (r < nrows_valid) {
#pragma unroll
            for (int i = 0; i < 4; ++i) v[r][i] = ((const float4*)(in + row * DM))[lane + 64 * i];
        }
    }
    if (COMBINE) {
#pragma unroll
        for (int r = 0; r < R; ++r) {
            const size_t row = (size_t)(row0 + r * rstride);
            if (r < nrows_valid) {
#pragma unroll
                for (int i = 0; i < 4; ++i) {
                    const uint2 b = ((const uint2*)(ys + row * 2 * DM))[lane + 64 * i], c = ((const uint2*)(ys + row * 2 * DM + DM))[lane + 64 * i];
                    float4 a = v[r][i];
                    a.x += bf16_lo_f(b.x) + bf16_lo_f(c.x); a.y += bf16_hi_f(b.x) + bf16_hi_f(c.x);
                    a.z += bf16_lo_f(b.y) + bf16_lo_f(c.y); a.w += bf16_hi_f(b.y) + bf16_hi_f(c.y);
                    v[r][i] = a;
                    ((float4*)(hw + row * DM))[lane + 64 * i] = a;
                }
            }
        }
    }
#pragma unroll
    for (int r = 0; r < R; ++r) {
        if (r < nrows_valid) {
#pragma unroll
            for (int i = 0; i < 4; ++i) ss[r] += v[r][i].x * v[r][i].x + v[r][i].y * v[r][i].y + v[r][i].z * v[r][i].z + v[r][i].w * v[r][i].w;
        }
    }
#pragma unroll
    for (int r = 0; r < R; ++r) ss[r] = wave_sum(ss[r]);
#pragma unroll
    for (int r = 0; r < R; ++r) {
        const size_t row = (size_t)(row0 + r * rstride);
        if (r < nrows_valid) {
            const float rr = rsqrtf(ss[r] * (1.f / DM) + 1e-6f);
            if (rs_out && lane == 0) rs_out[r] = rr;
#pragma unroll
            for (int i = 0; i < 4; ++i) {
                uint2 o; o.x = pk2(v[r][i].x * rr, v[r][i].y * rr); o.y = pk2(v[r][i].z * rr, v[r][i].w * rr);
                ((uint2*)(hi + row * DM))[lane + 64 * i] = o;
            }
        }
    }
}

__device__ __forceinline__ void rw_build(const float* __restrict__ wg, const float* __restrict__ we, const float* __restrict__ gain, float* __restrict__ dst, int start, int stride) {
    for (int idx = start; idx < 1024 * 36; idx += stride) {
        const int k = idx / 36, n = idx - k * 36;
        dst[idx] = ((n < 4) ? wg[k * 4 + n] : we[k * 32 + (n - 4)]) * gain[k];
    }
}
struct RouteSel { int x1, x2; float w1, w2; };
__device__ __forceinline__ RouteSel route_select(const float (&lg)[36], const float* __restrict__ bgp, const float* __restrict__ bep) {
    float gl[4];
#pragma unroll
    for (int i = 0; i < 4; ++i) gl[i] = lg[i] + bgp[i];
    int gi = 0; float gm = gl[0];
#pragma unroll
    for (int i = 1; i < 4; ++i) if (gl[i] > gm) { gm = gl[i]; gi = i; }
    float gs = 0.f;
#pragma unroll
    for (int i = 0; i < 4; ++i) gs += expf(gl[i] - gm);
    const float gw = 1.f / gs;
    float el[8];
#pragma unroll
    for (int e = 0; e < 8; ++e) {
        float v = 0.f;
#pragma unroll
        for (int gg = 0; gg < 4; ++gg) v = (gg == gi) ? (lg[4 + gg * 8 + e] + bep[gg * 8 + e]) : v;
        el[e] = v;
    }
    int e1 = 0; float m1 = el[0];
#pragma unroll
    for (int e = 1; e < 8; ++e) if (el[e] > m1) { m1 = el[e]; e1 = e; }
    int e2 = -1; float m2 = -INFINITY;
#pragma unroll
    for (int e = 0; e < 8; ++e) if (e != e1 && el[e] > m2) { m2 = el[e]; e2 = e; }
    const float p2 = expf(m2 - m1);
    RouteSel R;
    R.w1 = gw / (1.f + p2); R.w2 = gw * p2 / (1.f + p2);
    R.x1 = gi * 8 + e1; R.x2 = gi * 8 + e2;
    return R;
}
__device__ __forceinline__ void route_item(const float* __restrict__ h, bf16_t* __restrict__ xhi, const float* __restrict__ wr32,
                                           const float* __restrict__ bgp, const float* __restrict__ bep,
                                           int* __restrict__ cnt, int* __restrict__ lslot, float* __restrict__ lw, int it, char* smem) {
    const int tid = opq_tid(), wave = tid >> 6, lane = tid & 63;
    const int m0 = it * 32;
    float* wch = (float*)smem;
    float* rs = (float*)(smem + 36864);
    rp_rows<false, 4>(h, nullptr, nullptr, xhi, m0 + wave * 8, 1, 4, rs + wave * 8);
    rp_rows<false, 4>(h, nullptr, nullptr, xhi, m0 + wave * 8 + 4, 1, 4, rs + wave * 8 + 4);
    const int tp = tid >> 4, part = tid & 15;
    float a0[36], a1[36];
#pragma unroll
    for (int n = 0; n < 36; ++n) { a0[n] = 0.f; a1[n] = 0.f; }
    float* xch = (float*)(smem + 36864 + 128);
    for (int ch = 0; ch < 4; ++ch) {
        __syncthreads();
#pragma unroll
        for (int i = 0; i < 9; ++i) ((float4*)wch)[tid + 256 * i] = ((const float4*)(wr32 + (size_t)ch * 256 * 36))[tid + 256 * i];
#pragma unroll
        for (int i = 0; i < 8; ++i) { const int e = tid + 256 * i, r = e >> 6, c4 = e & 63; *(float4*)(xch + r * 260 + c4 * 4) = *(const float4*)(h + (size_t)(m0 + r) * DM + ch * 256 + c4 * 4); }
        __syncthreads();
        const float* xr0 = xch + (2 * tp) * 260 + part;
#pragma unroll 2
        for (int kk = 0; kk < 16; ++kk) {
            const float v0 = xr0[kk * 16], v1 = xr0[260 + kk * 16];
            const float4* wrow = (const float4*)(wch + (kk * 16 + part) * 36);
#pragma unroll
            for (int q = 0; q < 9; ++q) {
                const float4 w = wrow[q];
                a0[4 * q] += v0 * w.x; a0[4 * q + 1] += v0 * w.y; a0[4 * q + 2] += v0 * w.z; a0[4 * q + 3] += v0 * w.w;
                a1[4 * q] += v1 * w.x; a1[4 * q + 1] += v1 * w.y; a1[4 * q + 2] += v1 * w.z; a1[4 * q + 3] += v1 * w.w;
            }
        }
    }
    const float r0 = rs[2 * tp], r1 = rs[2 * tp + 1];
#pragma unroll
    for (int n = 0; n < 36; ++n) {
        float s0 = a0[n], s1 = a1[n];
        s0 += fx<1>(s0); s0 += fx<2>(s0); s0 += fx<4>(s0); s0 += fx<8>(s0);
        s1 += fx<1>(s1); s1 += fx<2>(s1); s1 += fx<4>(s1); s1 += fx<8>(s1);
        a0[n] = s0 * r0; a1[n] = s1 * r1;
    }
    if (part == 0) {
        const RouteSel A = route_select(a0, bgp, bep), B = route_select(a1, bgp, bep);
        const int t = m0 + 2 * tp;
        const int pa1 = atomicAdd(&cnt[A.x1 * CNT_STRIDE], 1), pa2 = atomicAdd(&cnt[A.x2 * CNT_STRIDE], 1);
        const int pb1 = atomicAdd(&cnt[B.x1 * CNT_STRIDE], 1), pb2 = atomicAdd(&cnt[B.x2 * CNT_STRIDE], 1);
        lslot[A.x1 * TTOK + pa1] = t * 2;     lw[A.x1 * TTOK + pa1] = A.w1;
        lslot[A.x2 * TTOK + pa2] = t * 2 + 1; lw[A.x2 * TTOK + pa2] = A.w2;
        lslot[B.x1 * TTOK + pb1] = t * 2 + 2; lw[B.x1 * TTOK + pb1] = B.w1;
        lslot[B.x2 * TTOK + pb2] = t * 2 + 3; lw[B.x2 * TTOK + pb2] = B.w2;
    }
}

struct EpiStoreB { bf16_t* C; long long ldc; __device__ void operator()(int r, int c, float4 v) const { uint2 o; o.x = pk2(v.x, v.y); o.y = pk2(v.z, v.w); *(uint2*)(C + (size_t)r * ldc + c) = o; } };
struct EpiPleB { const bf16_t* Pj; float* H; long long ldc; __device__ void operator()(int r, int c, float4 v) const {
    const uint2 p = *(const uint2*)(Pj + (size_t)r * ldc + c); float4 a = *(const float4*)(H + (size_t)r * ldc + c);
    a.x += bf16_lo_f(p.x) / (1.f + __expf(-v.x)); a.y += bf16_hi_f(p.x) / (1.f + __expf(-v.y)); a.z += bf16_lo_f(p.y) / (1.f + __expf(-v.z)); a.w += bf16_hi_f(p.y) / (1.f + __expf(-v.w));
    *(float4*)(H + (size_t)r * ldc + c) = a; } };
__device__ __forceinline__ void ple_proj_item(const float* __restrict__ pin, const bf16_t* __restrict__ wp, bf16_t* __restrict__ pj, int bx, int by, char* smem) {
    d_gemm<true>(pin, wp, 256, TTOK, DM, 256, EpiStoreB{pj, DM}, bx, by, smem);
}
__device__ __forceinline__ void ple_item(const bf16_t* __restrict__ xhat, const bf16_t* __restrict__ wg, const bf16_t* __restrict__ pj, float* __restrict__ h, int bx, int by, char* smem) {
    d_gemm<false>(xhat, wg, DM, TTOK, DM, DM, EpiPleB{pj, h, DM}, bx, by, smem);
}

#define HROW 272
#define MOE_W_OFF 36864
template <bool A_F32>
__device__ __forceinline__ void moe_item(const void* __restrict__ xn, const bf16_t* __restrict__ wgu, const bf16_t* __restrict__ wd,
                                         const int* __restrict__ slots, const float* __restrict__ wts, int nvalid, bf16_t* __restrict__ ys, char* smem) {
    const int tid = opq_tid(), lane = tid & 63, wave = tid >> 6;
    const int wn = wave >> 1, wm = wave & 1, c = lane & 31, h = lane >> 5;
    const int sr = tid >> 3, sc = tid & 7;
    auto rowp = [&](int i) -> const char* {
        const int idx = sr + 32 * i;
        if (idx >= nvalid) return nullptr;
        const int tok = slots[idx] >> 1;
        return (const char*)xn + (size_t)tok * 1024 * (A_F32 ? 4 : 2);
    };
    const char* rp0 = rowp(0); const char* rp1 = rowp(1); const char* rp2 = rowp(2); const char* rp3 = rowp(3);
    float cw[2]; int myslot[2];
#pragma unroll
    for (int j = 0; j < 2; ++j) {
        const int idx = wm * 64 + 32 * j + c;
        const bool ok = idx < nvalid;
        cw[j] = ok ? wts[idx] : 0.f;
        myslot[j] = ok ? slots[idx] : -1;
    }
    unsigned hp[2][2][8];
#pragma unroll
    for (int pass = 0; pass < 2; ++pass) {
        f32x16 acc[2][2];
        static_assert(!A_F32, "the expert GEMM streams bf16 rows straight into LDS");
        gemm_core_glds([&](int i, int r, int k0) -> const void* {
            const char* p = (i == 0) ? rp0 : (i == 1) ? rp1 : (i == 2) ? rp2 : rp3;
            return (const void*)((p ? p : (const char*)xn) + (size_t)k0 * 2); }, wgu, 1024, pass * 128, 1024, smem, acc);
#pragma unroll
        for (int j = 0; j < 2; ++j)
#pragma unroll
            for (int r2 = 0; r2 < 8; ++r2) {
                const float g0 = acc[0][j][2 * r2], g1 = acc[0][j][2 * r2 + 1];
                const float u0 = acc[1][j][2 * r2], u1 = acc[1][j][2 * r2 + 1];
                const float h0 = g0 / (1.f + __expf(-g0)) * u0 * cw[j], h1 = g1 / (1.f + __expf(-g1)) * u1 * cw[j];
                hp[pass][j][r2] = pk2(h0, h1);
            }
    }
#pragma unroll
    for (int pass = 0; pass < 2; ++pass)
#pragma unroll
        for (int j = 0; j < 2; ++j)
#pragma unroll
            for (int q4 = 0; q4 < 4; ++q4) {
                const int m = wm * 64 + 32 * j + c, f = pass * 64 + wn * 32 + 8 * q4 + 4 * h;
                *(uint2*)(smem + m * HROW + f * 2) = make_uint2(hp[pass][j][2 * q4], hp[pass][j][2 * q4 + 1]);
            }
    uint4 wa0, wa1, wa2, wa3;
    auto wload = [&](int s) {
        const int nt = s >> 1, kt = s & 1;
        const bf16_t* p = wd + (size_t)(nt * 128 + sr) * 128 + kt * 64 + sc * 8;
        wa0 = *(const uint4*)p; wa1 = *(const uint4*)(p + 32 * 128); wa2 = *(const uint4*)(p + 64 * 128); wa3 = *(const uint4*)(p + 96 * 128);
    };
    auto wstore = [&](int buf) {
        char* wb = smem + MOE_W_OFF + buf * TILE_BYTES + sr * LDS_ROW + sc * 16;
        *(uint4*)wb = wa0; *(uint4*)(wb + 32 * LDS_ROW) = wa1; *(uint4*)(wb + 64 * LDS_ROW) = wa2; *(uint4*)(wb + 96 * LDS_ROW) = wa3;
    };
    wload(0); wstore(0);
    __syncthreads();
    f32x16 acc[2][2];
    for (int s = 0; s < 16; ++s) {
        const int kt = s & 1;
        if (kt == 0) {
#pragma unroll
            for (int i = 0; i < 2; ++i)
#pragma unroll
                for (int j = 0; j < 2; ++j)
#pragma unroll
                    for (int r = 0; r < 16; ++r) acc[i][j][r] = 0.f;
        }
        if (s + 1 < 16) wload(s + 1);
        const char* wb = smem + MOE_W_OFF + (s & 1) * TILE_BYTES;
        {
            const char* wp0 = wb + (wn * 64 + c) * LDS_ROW + h * 16;
            const char* xp0 = smem + (wm * 64 + c) * HROW + kt * 128 + h * 16;
            bf16x8 wfa0 = *(const bf16x8*)(wp0), wfa1 = *(const bf16x8*)(wp0 + 32 * LDS_ROW), xfa0 = *(const bf16x8*)(xp0), xfa1 = *(const bf16x8*)(xp0 + 32 * HROW);
#pragma unroll
            for (int ks = 0; ks < 4; ++ks) {
                bf16x8 wfb0, wfb1, xfb0, xfb1;
                if (ks < 3) {
                    wfb0 = *(const bf16x8*)(wp0 + (ks + 1) * 32); wfb1 = *(const bf16x8*)(wp0 + 32 * LDS_ROW + (ks + 1) * 32);
                    xfb0 = *(const bf16x8*)(xp0 + (ks + 1) * 32); xfb1 = *(const bf16x8*)(xp0 + 32 * HROW + (ks + 1) * 32);
                }
                acc[0][0] = __builtin_amdgcn_mfma_f32_32x32x16_bf16(wfa0, xfa0, acc[0][0], 0, 0, 0);
                acc[0][1] = __builtin_amdgcn_mfma_f32_32x32x16_bf16(wfa0, xfa1, acc[0][1], 0, 0, 0);
                acc[1][0] = __builtin_amdgcn_mfma_f32_32x32x16_bf16(wfa1, xfa0, acc[1][0], 0, 0, 0);
                acc[1][1] = __builtin_amdgcn_mfma_f32_32x32x16_bf16(wfa1, xfa1, acc[1][1], 0, 0, 0);
                __builtin_amdgcn_sched_barrier(0);
                if (ks < 3) { wfa0 = wfb0; wfa1 = wfb1; xfa0 = xfb0; xfa1 = xfb1; }
            }
        }
        if (s + 1 < 16) wstore((s + 1) & 1);
        if (kt == 1) {
            const int nt = s >> 1;
#pragma unroll
            for (int j = 0; j < 2; ++j) {
                if (myslot[j] >= 0) {
                    bf16_t* dst = ys + (size_t)myslot[j] * 1024 + nt * 128 + wn * 64;
#pragma unroll
                    for (int i = 0; i < 2; ++i)
#pragma unroll
                        for (int q4 = 0; q4 < 4; ++q4) {
                            uint2 o; o.x = pk2(acc[i][j][4 * q4], acc[i][j][4 * q4 + 1]); o.y = pk2(acc[i][j][4 * q4 + 2], acc[i][j][4 * q4 + 3]);
                            *(uint2*)(dst + 32 * i + 8 * q4 + 4 * h) = o;
                        }
                }
            }
        }
        __syncthreads();
    }
}

struct L1Bufs { bf16_t *q, *k, *vt; float* kmpart; };

__device__ __forceinline__ void p7_item(const bf16_t* __restrict__ xn, const bf16_t* __restrict__ wt, const float* __restrict__ qn, const float* __restrict__ kn,
                                        const L1Bufs& B, int bx, int by, char* smem) {
    const int m0 = by * 128, n0 = bx * 128;
    f32x16 acc[2][2];
    gemm_core_glds([&](int i, int r, int k0) -> const void* { return (const void*)(xn + (size_t)(m0 + r) * DM + k0); }, wt, DM, n0, DM, smem, acc);
    const int tid_ = opq_tid(), lane = tid_ & 63, wave = tid_ >> 6;
    const int wn = wave >> 1, wm = wave & 1, c = lane & 31, h = lane >> 5;
    const int ch = (n0 >> 6) + wn;
    if (ch < 4 || ch >= 8) {
        const float* g = (ch < 4) ? kn : qn;
        float nv[2][2][16];
#pragma unroll
        for (int j = 0; j < 2; ++j) {
            const int m = m0 + wm * 64 + 32 * j + c;
            float ss = 0.f;
#pragma unroll
            for (int i = 0; i < 2; ++i)
#pragma unroll
                for (int r = 0; r < 16; ++r) ss += acc[i][j][r] * acc[i][j][r];
            ss = sum32(ss);
            float rs = rsqrtf(ss * (1.f / 64.f) + 1e-6f);
            if (ch >= 8) rs *= 0.125f * LOG2E;
            bf16_t* dst = (ch < 4) ? (B.k + (size_t)m * 256 + ch * 64) : (B.q + (size_t)m * 1024 + (ch - 8) * 64);
#pragma unroll
            for (int i = 0; i < 2; ++i)
#pragma unroll
                for (int q4 = 0; q4 < 4; ++q4) {
                    const int nl = 32 * i + 8 * q4 + 4 * h;
                    const float4 gg = *(const float4*)(g + nl);
                    const float v0 = acc[i][j][4 * q4] * rs * gg.x, v1 = acc[i][j][4 * q4 + 1] * rs * gg.y, v2 = acc[i][j][4 * q4 + 2] * rs * gg.z, v3 = acc[i][j][4 * q4 + 3] * rs * gg.w;
                    nv[i][j][4 * q4] = v0; nv[i][j][4 * q4 + 1] = v1; nv[i][j][4 * q4 + 2] = v2; nv[i][j][4 * q4 + 3] = v3;
                    uint2 o; o.x = pk2(v0, v1); o.y = pk2(v2, v3);
                    *(uint2*)(dst + nl) = o;
                }
        }
        if (ch < 4) {
            const int mb = m0 + wm * 64, b = mb >> 12, grp = (mb & 4095) >> 6;
            float* dst = B.kmpart + ((size_t)(b * 4 + ch) * 64 + grp) * 64;
#pragma unroll
            for (int i = 0; i < 2; ++i)
#pragma unroll
                for (int r = 0; r < 16; ++r) {
                    float s = sum_lo32(nv[i][0][r] + nv[i][1][r]);
                    if (c == 0) dst[32 * i + (r & 3) + 8 * (r >> 2) + 4 * h] = s;
                }
        }
    } else {
        const int g = ch - 4;
#pragma unroll
        for (int j = 0; j < 2; ++j) {
            const int m = m0 + wm * 64 + 32 * j + c;
            const int b = m >> 12, t = m & 4095;
            bf16_t* dst = B.vt + ((size_t)(b * 4 + g) * 64) * SEQ + t;
#pragma unroll
            for (int i = 0; i < 2; ++i)
#pragma unroll
                for (int r = 0; r < 16; ++r) {
                    const int d = 32 * i + (r & 3) + 8 * (r >> 2) + 4 * h;
                    dst[(size_t)d * SEQ] = (bf16_t)(pk2(acc[i][j][r], 0.f) & 0xffffu);
                }
        }
    }
}

__device__ __forceinline__ void moba_attn_item(const L1Bufs& B, const float* __restrict__ qn, const float* __restrict__ kn, bf16_t* __restrict__ att, int bg, int qb, char* smem) {
    const int tid = opq_tid();
    const int lane = tid & 63, wave = tid >> 6, cl = lane & 31, hh = lane >> 5;
    const int b = bg >> 2, g = bg & 3, hd = g * 4 + wave;
    const int t0 = qb * 32, c = qb >> 1, cb = qb >> 3, tq = t0 + cl;
    const float slope2 = exp2f(-0.5f * (float)(hd + 1)) * LOG2E;
    float* kms = (float*)(smem + ATT_IMP_OFF);
    unsigned* um = (unsigned*)(smem + ATT_MASK_OFF);
    const float m2 = (8.f * wave_max(fabsf(qn[lane])) * wave_max(fabsf(kn[lane])) * 1.02f + 0.5f) * LOG2E;
    __syncthreads();
    {
        const int n = tid >> 4, d4 = (tid & 15) * 4;
        float4 a = make_float4(0.f, 0.f, 0.f, 0.f);
        if (n < cb) {
            const float* p = B.kmpart + ((size_t)bg * 64 + n * 4) * 64 + d4;
#pragma unroll
            for (int u = 0; u < 4; ++u) { const float4 x = *(const float4*)(p + u * 64); a.x += x.x; a.y += x.y; a.z += x.z; a.w += x.w; }
        }
        const float sc = 1.f / 256.f;
        *(float4*)(kms + n * 64 + d4) = make_float4(a.x * sc, a.y * sc, a.z * sc, a.w * sc);
        if (tid == 0) um[0] = 0u;
    }
    bf16x8 qf[4];
    {
        const bf16_t* qp = B.q + (size_t)(b * SEQ + tq) * 1024 + hd * 64 + 8 * hh;
#pragma unroll
        for (int ks = 0; ks < 4; ++ks) qf[ks] = *(const bf16x8*)(qp + ks * 16);
    }
    __syncthreads();
    float sg[16];
    {
        float qv[32];
#pragma unroll
        for (int ks = 0; ks < 4; ++ks) {
            const uint4 u = __builtin_bit_cast(uint4, qf[ks]);
            qv[ks * 8 + 0] = __uint_as_float(u.x << 16); qv[ks * 8 + 1] = __uint_as_float(u.x & 0xffff0000u);
            qv[ks * 8 + 2] = __uint_as_float(u.y << 16); qv[ks * 8 + 3] = __uint_as_float(u.y & 0xffff0000u);
            qv[ks * 8 + 4] = __uint_as_float(u.z << 16); qv[ks * 8 + 5] = __uint_as_float(u.z & 0xffff0000u);
            qv[ks * 8 + 6] = __uint_as_float(u.w << 16); qv[ks * 8 + 7] = __uint_as_float(u.w & 0xffff0000u);
        }
#pragma unroll
        for (int n = 0; n < 16; ++n) {
            float s = 0.f;
            if (n < cb) {
#pragma unroll
                for (int ks = 0; ks < 4; ++ks) {
                    const float4 k0 = *(const float4*)(kms + n * 64 + ks * 16 + 8 * hh), k1 = *(const float4*)(kms + n * 64 + ks * 16 + 8 * hh + 4);
                    s += qv[ks * 8 + 0] * k0.x + qv[ks * 8 + 1] * k0.y + qv[ks * 8 + 2] * k0.z + qv[ks * 8 + 3] * k0.w
                       + qv[ks * 8 + 4] * k1.x + qv[ks * 8 + 5] * k1.y + qv[ks * 8 + 6] * k1.z + qv[ks * 8 + 7] * k1.w;
                }
                s = sum32(s);
            } else s = -INFINITY;
            sg[n] = s;
        }
    }
    unsigned bm = 0u;
#pragma unroll
    for (int n = 0; n < 16; ++n) {
        int rank = 0;
#pragma unroll
        for (int n2 = 0; n2 < 16; ++n2) rank += (sg[n2] > sg[n] || (sg[n2] == sg[n] && n2 < n)) ? 1 : 0;
        if (rank < 3 && n < cb) bm |= 1u << n;
    }
    unsigned long long mytiles = 0ull;
#pragma unroll
    for (int n = 0; n < 16; ++n) if ((bm >> n) & 1u) mytiles |= 0xFull << (4 * n);
    unsigned long long own = 0ull;
    for (int j = 4 * cb; j <= c; ++j) own |= 1ull << j;
    mytiles |= own;
    const unsigned wb = or32(or_lo32(bm));
    if (lane == 0) atomicOr(um, wb);
    __syncthreads();
    const unsigned ub = um[0];
    unsigned long long U = own;
    for (int n = 0; n < 16; ++n) if ((ub >> n) & 1u) U |= 0xFull << (4 * n);
    f32x16 ot[2]; float l;
    const float tb0 = -(slope2 * (float)tq) - m2;
    attn_branch<1, 0>(B.k + (size_t)(b * SEQ) * 256 + g * 64, B.vt + (size_t)bg * 64 * SEQ, 256, SEQ, U, 1ull << c, mytiles, qf, slope2, tb0, tq, 1 << 30, smem, ot, l, tid);
    const float lt = sum32(l);
    const float f = 1.f / lt;
    bf16_t* dst = att + (size_t)(b * SEQ + tq) * 1024 + hd * 64;
#pragma unroll
    for (int dt = 0; dt < 2; ++dt)
#pragma unroll
        for (int q4 = 0; q4 < 4; ++q4) {
            const int d = 32 * dt + 8 * q4 + 4 * hh;
            uint2 o; o.x = pk2(ot[dt][4 * q4] * f, ot[dt][4 * q4 + 1] * f); o.y = pk2(ot[dt][4 * q4 + 2] * f, ot[dt][4 * q4 + 3] * f);
            *(uint2*)(dst + d) = o;
        }
}


#define XB_TMO      128
#define XB_XCNT(j)  (256  + 64 * (j))
#define XB_XSUB(j)  (1280 + 64 * (j))
#define XB_XGEN(j)  (2304 + 64 * (j))
#define XB_TOP      3328
#define XB_TOPGEN   3392
#define XCD_BAR_WORDS 3456
#define XB_SPIN_CAP (1u << 22)
#define LAS __attribute__((address_space(3)))
__device__ __forceinline__ unsigned xb_ld(unsigned* p)              { return __hip_atomic_load(p, __ATOMIC_RELAXED, __HIP_MEMORY_SCOPE_AGENT); }
__device__ __forceinline__ unsigned xb_add(unsigned* p, unsigned v) { return __hip_atomic_fetch_add(p, v, __ATOMIC_RELAXED, __HIP_MEMORY_SCOPE_AGENT); }
__device__ __forceinline__ unsigned xb_xcc_id() { return (unsigned)__builtin_amdgcn_s_getreg((3 << 11) | 20) & 0xFu; }
#define XB_SPIN(cond, bar) do { unsigned _sp = 0; while (cond) { __builtin_amdgcn_s_sleep(1); \
    if ((++_sp & 255u) == 0u) { if (xb_ld(&(bar)[XB_TMO])) break; if (_sp > XB_SPIN_CAP) { atomicAdd(&(bar)[XB_TMO], 1u); break; } } } } while (0)
struct XcdBarrier { unsigned* bar; unsigned x; volatile LAS unsigned* st; };
__device__ __forceinline__ XcdBarrier xcd_barrier_post(unsigned* bar, volatile LAS unsigned* st) {
    XcdBarrier b; b.bar = bar; b.x = xb_xcc_id(); b.st = st;
    if (threadIdx.x == 0) (void)xb_add(&bar[XB_XCNT(b.x)], 1u);
    return b;
}
__device__ __forceinline__ void xcd_barrier_complete(unsigned* bar, unsigned x, unsigned& nloc, unsigned& nx) {
    const unsigned G = gridDim.x * gridDim.y * gridDim.z;
    unsigned sum, cnt, mine, sp = 0u;
    for (;;) {
        sum = 0u; cnt = 0u; mine = 0u;
#pragma unroll
        for (unsigned j = 0; j < 16; ++j) { const unsigned c = xb_ld(&bar[XB_XCNT(j)]); sum += c; cnt += (c > 0u) ? 1u : 0u; mine = (j == x) ? c : mine; }
        if (sum == G) break;
        __builtin_amdgcn_s_sleep(1);
        if ((++sp & 255u) == 0u) { if (xb_ld(&bar[XB_TMO])) break; if (sp > XB_SPIN_CAP) { atomicAdd(&bar[XB_TMO], 1u); break; } }
    }
    nloc = mine > 0u ? mine : 1u; nx = cnt > 0u ? cnt : 1u;
}
__device__ __forceinline__ void xcd_barrier(const XcdBarrier& b) {
    asm volatile("s_waitcnt vmcnt(0)" ::: "memory");
    __syncthreads();
    if (threadIdx.x == 0) {
        unsigned* bar = b.bar;
        __builtin_amdgcn_s_waitcnt(0);
        unsigned nloc = b.st[0], nx = b.st[1];
        if (nloc == 0u) { xcd_barrier_complete(bar, b.x, nloc, nx); b.st[0] = nloc; b.st[1] = nx; }
        const unsigned old = xb_add(&bar[XB_XSUB(b.x)], 1u);
        const unsigned gen = old / nloc;
        if (old + 1u == (gen + 1u) * nloc) {
            __builtin_amdgcn_fence(__ATOMIC_RELEASE, "agent");
            asm volatile("s_waitcnt vmcnt(0)" ::: "memory");
            const unsigned og = xb_add(&bar[XB_TOP], 1u);
            const unsigned tg = og / nx;
            if (og + 1u == (tg + 1u) * nx) xb_add(&bar[XB_TOPGEN], 1u);
            else XB_SPIN(xb_ld(&bar[XB_TOPGEN]) == tg, bar);
            __builtin_amdgcn_fence(__ATOMIC_ACQUIRE, "agent");
            xb_add(&bar[XB_XGEN(b.x)], 1u);
            asm volatile("s_waitcnt vmcnt(0)" ::: "memory");
        } else {
            XB_SPIN(xb_ld(&bar[XB_XGEN(b.x)]) == gen, bar);
            __builtin_amdgcn_fence(__ATOMIC_ACQUIRE, "agent");
            asm volatile("s_waitcnt vmcnt(0)" ::: "memory");
        }
    }
    __syncthreads();
}

struct Params {
    const float* in[30];
    float* out;
    float* ws;
    WJob jobs[NJOBS];
};

#define SMEM_TOTAL 73744
__shared__ __attribute__((aligned(16))) char g_smem[SMEM_TOTAL];
typedef const Params __attribute__((address_space(4)))* PPtr;
#define PP() ({ PPtr _p = (PPtr)__builtin_amdgcn_kernarg_segment_ptr(); asm volatile("" : "+s"(_p)); _p; })
__device__ __forceinline__ WJob load_job(PPtr pp, int j) { WJob J; J.src = pp->jobs[j].src; J.dst = pp->jobs[j].dst; J.gain = pp->jobs[j].gain; J.sbs = pp->jobs[j].sbs; J.dbs = pp->jobs[j].dbs; J.K = pp->jobs[j].K; J.N = pp->jobs[j].N; J.Npad = pp->jobs[j].Npad; J.batch = pp->jobs[j].batch; J.perm = pp->jobs[j].perm; J.gbs = pp->jobs[j].gbs; return J; }
__device__ __forceinline__ void grid_sync() {
    XcdBarrier xb; xb.bar = (unsigned*)((char*)PP()->ws + (size_t)166 * 1048576); xb.x = xb_xcc_id(); xb.st = (volatile LAS unsigned*)(g_smem + 73728);
    xcd_barrier(xb);
}
#define GRID_SYNC() grid_sync()
#define PHASE_1D(NB, CALL) do { for (int vb = blockIdx.x; vb < (NB); vb += gridDim.x) { const int bx = vb; __syncthreads(); CALL; } GRID_SYNC(); } while (0)
#define PHASE_2D(NX, NY, CW, CALL) do { \
    const int xcd_ = blockIdx.x & 7, slot_ = blockIdx.x >> 3, nslot_ = gridDim.x >> 3, RY_ = (NY) >> 3; \
    for (int li = slot_; li < (NX) * RY_; li += nslot_) { \
        const int cs_ = li / (RY_ * (CW)), rem_ = li - cs_ * (RY_ * (CW)); \
        const int bx = cs_ * (CW) + rem_ % (CW), by = xcd_ + 8 * (rem_ / (CW)); \
        __syncthreads(); CALL; } \
    GRID_SYNC(); } while (0)
#define GWAVE ((int)blockIdx.x * 4 + (opq_tid() >> 6))
#define NWAVE ((int)gridDim.x * 4)

__device__ __forceinline__ L0Bufs make_l0(char* wsb) {
    L0Bufs LB;
    LB.q = (bf16_t*)wsb;
    LB.kcr = (bf16_t*)(wsb + 33554432);
    LB.vcr = LB.kcr + (size_t)TTOK * 256;
    LB.ks = LB.vcr + (size_t)TTOK * 256;
    LB.vst = LB.ks + (size_t)TTOK * 256;
    LB.kw = LB.vst + (size_t)TTOK * 256;
    LB.vwt = LB.kw + (size_t)TTOK * 256;
    LB.gates = (float*)(LB.vwt + (size_t)TTOK * 256);
    LB.hidc = (bf16_t*)(wsb + 92274688);
    char* regC = wsb + (size_t)160 * 1048576;
    LB.kc = (bf16_t*)regC;
    LB.vct = (bf16_t*)(regC + 524288);
    LB.bias1 = (float*)(regC + 1048576);
    return LB;
}
__device__ __forceinline__ L1Bufs make_l1(char* wsb) {
    L1Bufs B;
    B.q = (bf16_t*)wsb;
    B.k = (bf16_t*)(wsb + 33554432);
    B.vt = B.k + (size_t)TTOK * 256;
    B.kmpart = (float*)(wsb + (size_t)160 * 1048576 + 5245440);
    return B;
}
#define WS_RLOG(wsb) ((float*)((wsb) + 92274688))
#define WS_QCTR(wsb) ((int*)((wsb) + (size_t)160 * 1048576 + 5586944))
#define WS_CNT(wsb) ((int*)((wsb) + (size_t)160 * 1048576 + 5570560))
#define WS_LSLOT(wsb) ((int*)((wsb) + (size_t)160 * 1048576 + 1051136))
#define WS_LW(wsb) ((float*)((wsb) + (size_t)160 * 1048576 + 3148288))
#define WS_PJ(wsb) ((bf16_t*)((wsb) + (size_t)64 * 1048576))
#define WS_XA(wsb) ((bf16_t*)((wsb) + (size_t)96 * 1048576))
#define WS_XB(wsb) ((bf16_t*)((wsb) + (size_t)128 * 1048576))

__device__ __forceinline__ void ph_prologue() {
    char* smem = g_smem;
    const PPtr pp = PP();
    char* wsb = (char*)pp->ws;
    int base = 0;
    for (int j = 0; j < 17; ++j) {
        if (j >= 11 && j < 14) continue;
        const WJob J = load_job(pp, j);
        if (J.src == nullptr) continue;
        const int cntj = J.batch * (J.Npad >> 6) * (J.K >> 6);
        int first = ((int)blockIdx.x - base) % (int)gridDim.x; if (first < 0) first += gridDim.x;
        for (int it = first; it < cntj; it += gridDim.x) wconv_item(J, it, (float*)smem);
        base += cntj;
    }
    for (int layer = 0; layer < 2; ++layer)
        rw_build(pp->in[21] + (size_t)layer * DM * 4, pp->in[23] + (size_t)layer * DM * 32, pp->in[3] + layer * DM, (float*)pp->jobs[17].dst + (size_t)layer * 1024 * 36,
                 (int)(blockIdx.x * 256 + threadIdx.x), (int)(gridDim.x * 256));
    {
        const float* x = pp->in[0]; bf16_t* XA = WS_XA(wsb);
        for (int row = GWAVE; row < TTOK; row += 4 * NWAVE) rp_rows<false, 4>(x, nullptr, nullptr, XA, row, NWAVE, (TTOK - row + NWAVE - 1) / NWAVE, nullptr);
    }
    if ((int)blockIdx.x >= (int)gridDim.x - 32) {
        const int q = (int)gridDim.x - 1 - (int)blockIdx.x, which = q >> 4, kb = q & 15;
        const float* pos = (which ? pp->in[11] : pp->in[8]) + kb * 128;
        const float* w1 = (which ? pp->in[12] : pp->in[9]) + (size_t)kb * 128 * 256;
        float a = 0.f;
#pragma unroll 16
        for (int kk = 0; kk < 128; ++kk) a += pos[kk] * w1[(size_t)kk * 256 + threadIdx.x];
        WS_RLOG(wsb)[(which * 16 + kb) * 256 + threadIdx.x] = a;
    }
    if (blockIdx.x == 0) { for (int i = threadIdx.x; i < 4 * 8 * 64; i += 256) WS_QCTR(wsb)[i] = 0; for (int i = threadIdx.x; i < 2 * 32 * CNT_STRIDE; i += 256) WS_CNT(wsb)[i] = 0; }
    GRID_SYNC();
}
__device__ __forceinline__ void ph_p1() {
    char* smem = g_smem;
    const PPtr pp = PP(); char* wsb = (char*)pp->ws;
    const L0Bufs LB = make_l0(wsb);
    const bf16_t* XA = WS_XA(wsb); const bf16_t* w = pp->jobs[0].dst; const float* qn = pp->in[6]; const float* kn = pp->in[7];
    if (blockIdx.x < 2) {
        const float* part = WS_RLOG(wsb) + (size_t)blockIdx.x * 16 * 256 + threadIdx.x;
        float a = 0.f;
#pragma unroll
        for (int kb = 0; kb < 16; ++kb) a += part[kb * 256];
        LB.bias1[blockIdx.x * 256 + threadIdx.x] = a;
    }
    PHASE_2D(21, 128, 7, p1_item(XA, w, qn, kn, LB, bx, by, smem));
}
__device__ __forceinline__ void ph_p2a() {
    char* smem = g_smem;
    const PPtr pp = PP(); char* wsb = (char*)pp->ws;
    const L0Bufs LB = make_l0(wsb);
    const bf16_t* wk = pp->jobs[1].dst; const bf16_t* wv = pp->jobs[3].dst;
    const int nb = (int)gridDim.x;
    const bool split = nb > 128;
    if (!split || (int)blockIdx.x < 128) {
        for (int vb = blockIdx.x; vb < 128; vb += split ? 128 : nb) { const int bx = vb; __syncthreads(); p2a_item(LB, (bx >> 6) ? wv : wk, bx >> 6, (bx >> 1) & 31, bx & 1, smem); }
    }
    if (!split || (int)blockIdx.x >= 128) {
        const int wid = split ? (int)blockIdx.x - 128 : (int)blockIdx.x, nw = split ? nb - 128 : nb;
        int base = 0;
        for (int j = 11; j < 14; ++j) {
            const WJob J = load_job(pp, j);
            if (J.src == nullptr) continue;
            const int cntj = J.batch * (J.Npad >> 6) * (J.K >> 6);
            int first = (wid - base) % nw; if (first < 0) first += nw;
            for (int it = first; it < cntj; it += nw) wconv_item(J, it, (float*)smem);
            base += cntj;
        }
    }
    GRID_SYNC();
}
__device__ __forceinline__ void ph_p2b() {
    char* smem = g_smem;
    const PPtr pp = PP(); char* wsb = (char*)pp->ws;
    const L0Bufs LB = make_l0(wsb);
    const bf16_t* wk = pp->jobs[2].dst; const bf16_t* wv = pp->jobs[4].dst; const float* kn = pp->in[7];
    PHASE_1D(64, p2b_item(LB, (bx >> 5) ? wv : wk, kn, bx >> 5, bx & 31, smem));
}
__device__ __forceinline__ void ph_nsa() {
    char* smem = g_smem;
    const PPtr pp = PP(); char* wsb = (char*)pp->ws;
    const L0Bufs LB = make_l0(wsb);
    const float* qn = pp->in[6]; const float* kn = pp->in[7]; bf16_t* XB = WS_XB(wsb); int* qctr = WS_QCTR(wsb);
    int* misc = (int*)(smem + ATT_MISC_OFF);
    const int myx = (int)xb_xcc_id() & 7;
    const int ln_ = threadIdx.x & 63;
    const float gq_ = wave_max(fabsf(qn[ln_]));
    const float m2c = (8.f * gq_ * wave_max(fabsf(kn[ln_])) * 1.02f + 0.5f) * LOG2E;
    const float m2s = (8.f * gq_ * wave_max(fabsf(kn[64 + ln_])) * 1.02f + 0.5f) * LOG2E;
    const float m2w = (8.f * gq_ * wave_max(fabsf(kn[128 + ln_])) * 1.02f + 0.5f) * LOG2E;
    for (int dx = 0; dx < 8; ++dx) {
        const int x = (myx + dx) & 7;
        for (;;) {
            __syncthreads();
            if (threadIdx.x == 0) misc[0] = atomicAdd(&qctr[x * 64], 1);
            __syncthreads();
            const int id = __builtin_amdgcn_readfirstlane(misc[0]);
            if (id >= 256) break;
            nsa_attn_item(LB, m2c, m2s, m2w, XB, x + 8 * (id >> 7), 127 - (id & 127), smem);
        }
    }
    GRID_SYNC();
}
__device__ __forceinline__ void ph_outproj(int layer) {
    char* smem = g_smem;
    const PPtr pp = PP(); char* wsb = (char*)pp->ws;
    const bf16_t* XB = WS_XB(wsb); const bf16_t* w = pp->jobs[layer ? 8 : 5].dst; const float* r = layer ? pp->out : pp->in[0]; float* h = pp->out;
    PHASE_2D(8, 128, 8, (d_gemm<false>(XB, w, (long long)DM, TTOK, DM, DM, EpiResid{r, h, DM}, bx, by, smem)));
}
__device__ __forceinline__ void ph_route(int layer) {
    char* smem = g_smem;
    const PPtr pp = PP(); char* wsb = (char*)pp->ws;
    const float* h = pp->out; bf16_t* XA = WS_XA(wsb);
    const float* wr = (const float*)pp->jobs[17].dst + (size_t)layer * 1024 * 36;
    const float* bgp = pp->in[22] + layer * 4; const float* bep = pp->in[24] + layer * 32;
    int* cntl = WS_CNT(wsb) + layer * 32 * CNT_STRIDE; int* lslot = WS_LSLOT(wsb); float* lw = WS_LW(wsb);
    PHASE_1D(512, route_item(h, XA, wr, bgp, bep, cntl, lslot, lw, bx, smem));
}
__device__ __forceinline__ void ph_moe(int layer) {
    char* smem = g_smem;
    const PPtr pp = PP(); char* wsb = (char*)pp->ws;
    const bf16_t* wgu_l = pp->jobs[11 + 3 * layer].dst;
    const bf16_t* wd_l = pp->jobs[13 + 3 * layer].dst;
    const bf16_t* XA = WS_XA(wsb); bf16_t* ysb = (bf16_t*)wsb;
    const int* cntl = WS_CNT(wsb) + layer * 32 * CNT_STRIDE; const int* lslot = WS_LSLOT(wsb); const float* lw = WS_LW(wsb);
    const int xcd = blockIdx.x & 7, nslot = gridDim.x >> 3;
    int it = blockIdx.x >> 3;
    int q = 0, basei = 0;
    for (;;) {
        int nch = 0, e = 0;
        while (q < 4) { e = xcd + 8 * q; nch = (cntl[e * CNT_STRIDE] + 127) >> 7; if (it < basei + nch) break; basei += nch; ++q; }
        if (q >= 4) break;
        const int chunk = it - basei;
        const int nvalid = min(128, cntl[e * CNT_STRIDE] - chunk * 128);
        __syncthreads();
        moe_item<false>(XA, wgu_l + (size_t)e * 256 * 1024, wd_l + (size_t)e * 1024 * 128, lslot + e * TTOK + chunk * 128, lw + e * TTOK + chunk * 128, nvalid, ysb, smem);
        it += nslot;
    }
    {
        const float* pin = pp->in[1] + (size_t)layer * TTOK * 256; const bf16_t* wp = pp->jobs[10].dst + (size_t)layer * 256 * DM; bf16_t* pj = WS_PJ(wsb);
        int* qp = WS_QCTR(wsb) + 1024 + layer * 512;
        int* misc = (int*)(smem + 73712);
        for (int dx = 0; dx < 8; ++dx) {
            const int x = (xcd + dx) & 7;
            for (;;) {
                __syncthreads();
                if (threadIdx.x == 0) misc[0] = atomicAdd(&qp[x * 64], 1);
                __syncthreads();
                const int id = __builtin_amdgcn_readfirstlane(misc[0]);
                if (id >= 128) break;
                ple_proj_item(pin, wp, pj, id & 7, x + 8 * (id >> 3), smem);
            }
        }
    }
    GRID_SYNC();
}
__device__ __forceinline__ void ph_combine() {
    const PPtr pp = PP(); char* wsb = (char*)pp->ws;
    float* h = pp->out; const bf16_t* ysb = (const bf16_t*)wsb; bf16_t* XB = WS_XB(wsb);
    for (int row = GWAVE; row < TTOK; row += 2 * NWAVE) rp_rows<true, 2>(h, h, ysb, XB, row, NWAVE, (TTOK - row + NWAVE - 1) / NWAVE, nullptr);
    GRID_SYNC();
}
__device__ __forceinline__ void ph_ple(int layer) {
    char* smem = g_smem;
    const PPtr pp = PP(); char* wsb = (char*)pp->ws;
    float* h = pp->out; const bf16_t* XB = WS_XB(wsb);
    const bf16_t* wg = pp->jobs[9].dst + (size_t)layer * DM * DM;
    const bf16_t* pj = WS_PJ(wsb);
    PHASE_2D(8, 128, 8, ple_item(XB, wg, pj, h, bx, by, smem));
}
__device__ __forceinline__ void ph_norm() {
    const PPtr pp = PP(); char* wsb = (char*)pp->ws;
    const float* h = pp->out; bf16_t* XA = WS_XA(wsb);
    for (int row = GWAVE; row < TTOK; row += 4 * NWAVE) rp_rows<false, 4>(h, nullptr, nullptr, XA, row, NWAVE, (TTOK - row + NWAVE - 1) / NWAVE, nullptr);
    GRID_SYNC();
}
__device__ __forceinline__ void ph_p7() {
    char* smem = g_smem;
    const PPtr pp = PP(); char* wsb = (char*)pp->ws;
    const L1Bufs L1B = make_l1(wsb);
    const bf16_t* XA = WS_XA(wsb); const bf16_t* w = pp->jobs[6].dst; const float* qn = pp->in[19]; const float* kn = pp->in[17];
    PHASE_2D(12, 128, 6, p7_item(XA, w, qn, kn, L1B, bx, by, smem));
}
__device__ __forceinline__ void ph_moba() {
    char* smem = g_smem;
    const PPtr pp = PP(); char* wsb = (char*)pp->ws;
    const L1Bufs L1B = make_l1(wsb);
    const float* qn = pp->in[19]; const float* kn = pp->in[17]; bf16_t* XB = WS_XB(wsb); int* qctr = WS_QCTR(wsb);
    int* misc = (int*)(smem + ATT_MISC_OFF);
    const int myx = (int)xb_xcc_id() & 7;
    for (int dx = 0; dx < 8; ++dx) {
        const int x = (myx + dx) & 7;
        for (;;) {
            __syncthreads();
            if (threadIdx.x == 0) misc[0] = atomicAdd(&qctr[512 + x * 64], 1);
            __syncthreads();
            const int id = __builtin_amdgcn_readfirstlane(misc[0]);
            if (id >= 256) break;
            moba_attn_item(L1B, qn, kn, XB, x + 8 * (id >> 7), 127 - (id & 127), smem);
        }
    }
    GRID_SYNC();
}

#ifndef PROBE_PHASE
#define PROBE_PHASE -1
#endif
#define PH(id, CALL) do { if (PROBE_PHASE == (id) && blockIdx.x == 0) pt0 = __builtin_amdgcn_s_memrealtime(); CALL; if (PROBE_PHASE == (id) && blockIdx.x == 0) pt1 = __builtin_amdgcn_s_memrealtime(); } while (0)

__global__ void __launch_bounds__(256, 2) mega(Params Pdummy) {
    if (threadIdx.x == 0) *(uint4*)(g_smem + 73728) = make_uint4(0u, 0u, 0u, 0u);
    __syncthreads();
    if (threadIdx.x == 0) (void)xb_add(&((unsigned*)((char*)PP()->ws + (size_t)166 * 1048576))[XB_XCNT(xb_xcc_id())], 1u);
    unsigned long long pt0 = 0ull, pt1 = 0ull;
    PH(0, ph_prologue());
    PH(1, ph_p1());
    PH(2, { ph_p2a(); ph_p2b(); });
    PH(3, ph_nsa());
    PH(4, ph_outproj(0));
    PH(5, ph_route(0));
    PH(6, ph_moe(0));
    PH(7, ph_combine());
    PH(8, ph_ple(0));
    PH(9, ph_norm());
    PH(11, ph_p7());
    PH(12, ph_moba());
    PH(13, ph_outproj(1));
    PH(15, ph_route(1));
    PH(16, ph_moe(1));
    PH(17, ph_combine());
    PH(18, ph_ple(1));
    if (PROBE_PHASE >= 0 && blockIdx.x == 0) {
        const unsigned long long span = pt1 - pt0, t2 = __builtin_amdgcn_s_memrealtime();
        while (__builtin_amdgcn_s_memrealtime() - t2 < span) __builtin_amdgcn_s_sleep(16);
    }
}

extern "C" void kernel_launch(void* const* d_in, const int* in_sizes, int n_in, void* d_out, int out_size, void* d_ws, size_t ws_size, hipStream_t stream) {
    static int grid_blocks = 0;
    if (!grid_blocks) {
        int dev = 0, cus = 0, per_cu = 0;
        (void)hipGetDevice(&dev);
        (void)hipDeviceGetAttribute(&cus, hipDeviceAttributeMultiprocessorCount, dev);
        (void)hipOccupancyMaxActiveBlocksPerMultiprocessor(&per_cu, (const void*)mega, 256, 0);
        if (per_cu < 1) per_cu = 1;
        if (per_cu > 2) per_cu = 2;
        grid_blocks = cus * per_cu;
    }
    Params P{};
    for (int i = 0; i < 30; ++i) P.in[i] = (const float*)d_in[i];
    P.out = (float*)d_out;
    P.ws = (float*)d_ws;
    {
        size_t off = (size_t)168 * 1048576;
        char* wbase = (char*)d_ws + off;
        size_t wo = 0;
        auto add = [&](int j, const void* src, int K, int N, int Npad, int batch, const float* gain) {
            WJob& J = P.jobs[j];
            J.src = (const float*)src; J.dst = (bf16_t*)(wbase + wo); J.gain = gain;
            J.sbs = (long long)K * N; J.dbs = (long long)Npad * K; J.K = K; J.N = N; J.Npad = Npad; J.batch = batch; J.perm = 0; J.gbs = 0;
            wo += (size_t)batch * Npad * K * 2;
        };
        add(0, d_in[5], 1024, 2608, 2688, 1, (const float*)d_in[2]);
        add(1, d_in[9], 2048, 256, 256, 1, nullptr);
        add(2, d_in[10], 256, 64, 128, 1, nullptr);
        add(3, d_in[12], 2048, 256, 256, 1, nullptr);
        add(4, d_in[13], 256, 64, 128, 1, nullptr);
        add(5, d_in[14], 1024, 1024, 1024, 1, nullptr);
        add(6, d_in[16], 1024, 512, 512, 1, (const float*)d_in[15]);
        add(7, d_in[18], 1024, 1024, 1024, 1, (const float*)d_in[2] + 1024);
        add(8, d_in[20], 1024, 1024, 1024, 1, nullptr);
        add(9, d_in[29], 1024, 1024, 1024, 2, (const float*)d_in[4]); P.jobs[9].gbs = 1024;
        add(10, d_in[28], 256, 1024, 1024, 2, nullptr);
        for (int layer = 0; layer < 2; ++layer) {
            WJob& G = P.jobs[11 + 3 * layer]; WJob& U = P.jobs[12 + 3 * layer];
            G.src = (const float*)d_in[25] + (size_t)layer * 32 * 1024 * 128; G.dst = (bf16_t*)(wbase + wo); G.gain = (const float*)d_in[3] + layer * 1024;
            G.sbs = 1024 * 128; G.dbs = 256 * 1024; G.K = 1024; G.N = 128; G.Npad = 128; G.batch = 32; G.perm = 1; G.gbs = 0;
            U = G; U.src = (const float*)d_in[26] + (size_t)layer * 32 * 1024 * 128; U.perm = 2;
            wo += (size_t)32 * 256 * 1024 * 2;
            add(13 + 3 * layer, (const float*)d_in[27] + (size_t)layer * 32 * 128 * 1024, 128, 1024, 1024, 32, nullptr);
        }
        P.jobs[17].dst = (bf16_t*)(wbase + wo); wo += (size_t)2 * 128 * 3072 * 2;
        if (off + wo > ws_size) { fprintf(stderr, "workspace too small: need %zu have %zu\n", off + wo, ws_size); return; }
    }
    (void)hipMemsetAsync((char*)d_ws + (size_t)166 * 1048576, 0, XCD_BAR_WORDS * 4, stream);
    void* args[] = {&P};
    hipError_t e = hipLaunchCooperativeKernel((const void*)mega, dim3(grid_blocks), dim3(256), args, 0, stream);
    if (e != hipSuccess) fprintf(stderr, "cooperative launch failed: %s (grid %d)\n", hipGetErrorString(e), grid_blocks);
}
```

```cpp
#include <hip/hip_runtime.h>
#include <hip/hip_cooperative_groups.h>
namespace cg = cooperative_groups;
#include <stdint.h>
#include <math.h>
#include <stdio.h>

#define SEQ 4096
#define BATCH 4
#define TTOK 16384
#define DM 1024
#define NPROJ 2608
#define NCMP 255

#define C_Q 0
#define C_KC 1024
#define C_VC 1280
#define C_KS 1536
#define C_VS 1792
#define C_KW 2048
#define C_VW 2304
#define C_GL 2560

template <int M> __device__ __forceinline__ float fx(float v) { return __int_as_float(__builtin_amdgcn_ds_swizzle(__float_as_int(v), (M << 10) | 0x1f)); }
template <int M> __device__ __forceinline__ unsigned ux(unsigned v) { return (unsigned)__builtin_amdgcn_ds_swizzle((int)v, (M << 10) | 0x1f); }
__device__ __forceinline__ float sum32(float v) { const auto r = __builtin_amdgcn_permlane32_swap(__float_as_uint(v), __float_as_uint(v), false, false); return __uint_as_float(r[0]) + __uint_as_float(r[1]); }
__device__ __forceinline__ float max32(float v) { const auto r = __builtin_amdgcn_permlane32_swap(__float_as_uint(v), __float_as_uint(v), false, false); return fmaxf(__uint_as_float(r[0]), __uint_as_float(r[1])); }
__device__ __forceinline__ unsigned or32(unsigned v) { const auto r = __builtin_amdgcn_permlane32_swap(v, v, false, false); return r[0] | r[1]; }
__device__ __forceinline__ float sum_lo32(float v) { v += fx<1>(v); v += fx<2>(v); v += fx<4>(v); v += fx<8>(v); v += fx<16>(v); return v; }
__device__ __forceinline__ unsigned or_lo32(unsigned v) { v |= ux<1>(v); v |= ux<2>(v); v |= ux<4>(v); v |= ux<8>(v); v |= ux<16>(v); return v; }
__device__ __forceinline__ float wave_sum(float v) { return sum32(sum_lo32(v)); }
__device__ __forceinline__ int opq_tid() { int t = threadIdx.x; asm volatile("" : "+v"(t)); return t; }
__device__ __forceinline__ float gelu_tanh(float x) {
    const float c = 0.7978845608028654f;
    float u = c * (x + 0.044715f * x * x * x);
    return 0.5f * x * (1.f + tanhf(u));
}
__device__ __forceinline__ float sigm(float x) { return 1.f / (1.f + expf(-x)); }

typedef unsigned short bf16_t;
typedef float f32x16 __attribute__((ext_vector_type(16)));
typedef __bf16 bf16x8 __attribute__((ext_vector_type(8)));
typedef __bf16 bf16x2 __attribute__((ext_vector_type(2)));
__device__ __forceinline__ unsigned pk2(float lo, float hi) { bf16x2 v = {(__bf16)lo, (__bf16)hi}; return __builtin_bit_cast(unsigned, v); }
__device__ __forceinline__ uint4 pack8(float4 a, float4 b) { uint4 r; r.x = pk2(a.x, a.y); r.y = pk2(a.z, a.w); r.z = pk2(b.x, b.y); r.w = pk2(b.z, b.w); return r; }

__device__ __forceinline__ float bf16_lo_f(unsigned u) { return __uint_as_float(u << 16); }
__device__ __forceinline__ float bf16_hi_f(unsigned u) { return __uint_as_float(u & 0xffff0000u); }
#define LDS_ROW 144
#define TILE_BYTES (128 * LDS_ROW)

template <bool A_F32, class AFn>
__device__ __forceinline__ void gemm_core(AFn afn, const bf16_t* __restrict__ Wt, int ldw, int n0, int K, char* smem, f32x16 (&acc)[2][2]) {
    const int tid = opq_tid(), lane = tid & 63, wave = tid >> 6;
    const int wn = wave >> 1, wm = wave & 1;
    const int sr = tid >> 3, sc = tid & 7;
    const int c = lane & 31, h = lane >> 5;
    struct Stage { uint4 x0, x1, x2, x3, w0, w1, w2, w3; };
#pragma unroll
    for (int i = 0; i < 2; ++i)
#pragma unroll
        for (int j = 0; j < 2; ++j)
#pragma unroll
            for (int r = 0; r < 16; ++r) acc[i][j][r] = 0.f;
    auto loadx = [&](int i, int k0) -> uint4 {
        const int r = sr + 32 * i;
        if (A_F32) {
            const float* p = (const float*)afn(i, r, k0);
            if (p) { float4 f0 = *(const float4*)(p + sc * 8); float4 f1 = *(const float4*)(p + sc * 8 + 4); return pack8(f0, f1); }
            return make_uint4(0u, 0u, 0u, 0u);
        } else {
            const bf16_t* p = (const bf16_t*)afn(i, r, k0);
            return p ? *(const uint4*)(p + sc * 8) : make_uint4(0u, 0u, 0u, 0u);
        }
    };
    auto load = [&](int k0) -> Stage {
        Stage S;
        S.x0 = loadx(0, k0); S.x1 = loadx(1, k0); S.x2 = loadx(2, k0); S.x3 = loadx(3, k0);
        const bf16_t* wp = Wt + (size_t)(n0 + sr) * ldw + k0 + sc * 8;
        S.w0 = *(const uint4*)wp; S.w1 = *(const uint4*)(wp + (size_t)32 * ldw); S.w2 = *(const uint4*)(wp + (size_t)64 * ldw); S.w3 = *(const uint4*)(wp + (size_t)96 * ldw);
        return S;
    };
    auto store = [&](const Stage S, int buf) {
        char* xb = smem + buf * 2 * TILE_BYTES + sr * LDS_ROW + sc * 16; char* wb = xb + TILE_BYTES;
        *(uint4*)xb = S.x0; *(uint4*)(xb + 32 * LDS_ROW) = S.x1; *(uint4*)(xb + 64 * LDS_ROW) = S.x2; *(uint4*)(xb + 96 * LDS_ROW) = S.x3;
        *(uint4*)wb = S.w0; *(uint4*)(wb + 32 * LDS_ROW) = S.w1; *(uint4*)(wb + 64 * LDS_ROW) = S.w2; *(uint4*)(wb + 96 * LDS_ROW) = S.w3;
    };
    auto compute = [&](int buf) {
        const char* xb = smem + buf * 2 * TILE_BYTES; const char* wb = xb + TILE_BYTES;
        const char* wp0 = wb + (wn * 64 + c) * LDS_ROW + h * 16;
        const char* xp0 = xb + (wm * 64 + c) * LDS_ROW + h * 16;
        bf16x8 wfa0 = *(const bf16x8*)(wp0), wfa1 = *(const bf16x8*)(wp0 + 32 * LDS_ROW), xfa0 = *(const bf16x8*)(xp0), xfa1 = *(const bf16x8*)(xp0 + 32 * LDS_ROW);
#pragma unroll
        for (int ks = 0; ks < 4; ++ks) {
            bf16x8 wfb0, wfb1, xfb0, xfb1;
            if (ks < 3) {
                wfb0 = *(const bf16x8*)(wp0 + (ks + 1) * 32); wfb1 = *(const bf16x8*)(wp0 + 32 * LDS_ROW + (ks + 1) * 32);
                xfb0 = *(const bf16x8*)(xp0 + (ks + 1) * 32); xfb1 = *(const bf16x8*)(xp0 + 32 * LDS_ROW + (ks + 1) * 32);
            }
            acc[0][0] = __builtin_amdgcn_mfma_f32_32x32x16_bf16(wfa0, xfa0, acc[0][0], 0, 0, 0);
            acc[0][1] = __builtin_amdgcn_mfma_f32_32x32x16_bf16(wfa0, xfa1, acc[0][1], 0, 0, 0);
            acc[1][0] = __builtin_amdgcn_mfma_f32_32x32x16_bf16(wfa1, xfa0, acc[1][0], 0, 0, 0);
            acc[1][1] = __builtin_amdgcn_mfma_f32_32x32x16_bf16(wfa1, xfa1, acc[1][1], 0, 0, 0);
            __builtin_amdgcn_sched_barrier(0);
            if (ks < 3) { wfa0 = wfb0; wfa1 = wfb1; xfa0 = xfb0; xfa1 = xfb1; }
        }
    };
    const int nk = K >> 6;
    Stage S0 = load(0), S1 = S0;
    if (nk > 1) S1 = load(64);
    store(S0, 0);
    __syncthreads();
    for (int kt = 0; kt < nk; kt += 2) {
        if (kt + 2 < nk) S0 = load((kt + 2) * 64);
        compute(0);
        if (kt + 1 < nk) store(S1, 1);
        __syncthreads();
        if (kt + 1 >= nk) break;
        if (kt + 3 < nk) S1 = load((kt + 3) * 64);
        compute(1);
        if (kt + 2 < nk) store(S0, 0);
        __syncthreads();
    }
}
#define GT_BYTES 16384
template <class AFn>
__device__ __forceinline__ void gemm_core_glds(AFn afn, const bf16_t* __restrict__ Wt, int ldw, int n0, int K, char* smem, f32x16 (&acc)[2][2]) {
    const int tid = opq_tid(), lane = tid & 63, wave = tid >> 6;
    const int wn = wave >> 1, wm = wave & 1;
    const int sr = tid >> 3, sc = tid & 7;
    const int c = lane & 31, h = lane >> 5;
#pragma unroll
    for (int i = 0; i < 2; ++i)
#pragma unroll
        for (int j = 0; j < 2; ++j)
#pragma unroll
            for (int r = 0; r < 16; ++r) acc[i][j][r] = 0.f;
    auto issue = [&](int k0, int buf) {
        char* xb = smem + buf * 2 * GT_BYTES; char* wb = xb + GT_BYTES;
#pragma unroll
        for (int i = 0; i < 4; ++i) {
            const int r = sr + 32 * i;
            const int cs = sc ^ ((r >> 1) & 7);
            const char* xp = (const char*)afn(i, r, k0) + cs * 16;
            const char* wp = (const char*)(Wt + (size_t)(n0 + r) * ldw + k0) + cs * 16;
            __builtin_amdgcn_global_load_lds((const __attribute__((address_space(1))) void*)xp, (__attribute__((address_space(3))) void*)(xb + (32 * i + 8 * wave) * 128), 16, 0, 0);
            __builtin_amdgcn_global_load_lds((const __attribute__((address_space(1))) void*)wp, (__attribute__((address_space(3))) void*)(wb + (32 * i + 8 * wave) * 128), 16, 0, 0);
        }
    };
    auto compute = [&](int buf) {
        const char* xb = smem + buf * 2 * GT_BYTES; const char* wb = xb + GT_BYTES;
        const int rw0 = wn * 64 + c, rx0 = wm * 64 + c;
        const int kw = (rw0 >> 1) & 7, kx = (rx0 >> 1) & 7;
        const char* wp0 = wb + rw0 * 128; const char* xp0 = xb + rx0 * 128;
#define FRAG(base, key, ks) (*(const bf16x8*)((base) + (((2 * (ks) + h) ^ (key)) << 4)))
        bf16x8 wfa0 = FRAG(wp0, kw, 0), wfa1 = FRAG(wp0 + 32 * 128, kw, 0), xfa0 = FRAG(xp0, kx, 0), xfa1 = FRAG(xp0 + 32 * 128, kx, 0);
#pragma unroll
        for (int ks = 0; ks < 4; ++ks) {
            bf16x8 wfb0, wfb1, xfb0, xfb1;
            if (ks < 3) { wfb0 = FRAG(wp0, kw, ks + 1); wfb1 = FRAG(wp0 + 32 * 128, kw, ks + 1); xfb0 = FRAG(xp0, kx, ks + 1); xfb1 = FRAG(xp0 + 32 * 128, kx, ks + 1); }
            acc[0][0] = __builtin_amdgcn_mfma_f32_32x32x16_bf16(wfa0, xfa0, acc[0][0], 0, 0, 0);
            acc[0][1] = __builtin_amdgcn_mfma_f32_32x32x16_bf16(wfa0, xfa1, acc[0][1], 0, 0, 0);
            acc[1][0] = __builtin_amdgcn_mfma_f32_32x32x16_bf16(wfa1, xfa0, acc[1][0], 0, 0, 0);
            acc[1][1] = __builtin_amdgcn_mfma_f32_32x32x16_bf16(wfa1, xfa1, acc[1][1], 0, 0, 0);
            __builtin_amdgcn_sched_barrier(0);
            if (ks < 3) { wfa0 = wfb0; wfa1 = wfb1; xfa0 = xfb0; xfa1 = xfb1; }
        }
#undef FRAG
    };
    const int nk = K >> 6;
    issue(0, 0);
    __syncthreads();
    for (int kt = 0; kt < nk; ++kt) {
        if (kt + 1 < nk) issue((kt + 1) * 64, (kt + 1) & 1);
        compute(kt & 1);
        __syncthreads();
    }
}
template <class F>
__device__ __forceinline__ void epi_foreach(const f32x16 (&acc)[2][2], int m0, int n0, F f) {
    const int tid_ = opq_tid(), lane = tid_ & 63, wave = tid_ >> 6;
    const int wn = wave >> 1, wm = wave & 1, c = lane & 31, h = lane >> 5;
#pragma unroll
    for (int i = 0; i < 2; ++i)
#pragma unroll
        for (int j = 0; j < 2; ++j)
#pragma unroll
            for (int q = 0; q < 4; ++q) {
                const int n = n0 + wn * 64 + 32 * i + 8 * q + 4 * h, m = m0 + wm * 64 + 32 * j + c;
                f(m, n, make_float4(acc[i][j][4 * q], acc[i][j][4 * q + 1], acc[i][j][4 * q + 2], acc[i][j][4 * q + 3]));
            }
}
struct EpiStore { float* C; long long ldc; __device__ void operator()(int r, int c, float4 v) const { *(float4*)(C + (size_t)r * ldc + c) = v; } };
struct EpiGelu { float* C; long long ldc; __device__ void operator()(int r, int c, float4 v) const { *(float4*)(C + (size_t)r * ldc + c) = make_float4(gelu_tanh(v.x), gelu_tanh(v.y), gelu_tanh(v.z), gelu_tanh(v.w)); } };
struct EpiSigm { float* C; long long ldc; __device__ void operator()(int r, int c, float4 v) const { *(float4*)(C + (size_t)r * ldc + c) = make_float4(sigm(v.x), sigm(v.y), sigm(v.z), sigm(v.w)); } };
struct EpiResid { const float* R; float* C; long long ldc; __device__ void operator()(int r, int c, float4 v) const { float4 a = *(const float4*)(R + (size_t)r * ldc + c); *(float4*)(C + (size_t)r * ldc + c) = make_float4(a.x + v.x, a.y + v.y, a.z + v.z, a.w + v.w); } };
struct EpiPle { const float* G; float* H; long long ldc; __device__ void operator()(int r, int c, float4 v) const { float4 g = *(const float4*)(G + (size_t)r * ldc + c); float4 a = *(const float4*)(H + (size_t)r * ldc + c); *(float4*)(H + (size_t)r * ldc + c) = make_float4(a.x + g.x * v.x, a.y + g.y * v.y, a.z + g.z * v.z, a.w + g.w * v.w); } };

template <bool A_F32, class Epi>
__device__ __forceinline__ void d_gemm(const void* __restrict__ A, const bf16_t* __restrict__ Wt, long long lda, int M, int N, int K, Epi epi, int bx, int by, char* smem) {
    const int m0 = by * 128, n0 = bx * 128;
    f32x16 acc[2][2];
    if constexpr (A_F32) {
        gemm_core<true>([&](int i, int r, int k0) -> const void* {
            if (m0 + r >= M) return nullptr;
            return (const void*)((const float*)A + (size_t)(m0 + r) * lda + k0); }, Wt, K, n0, K, smem, acc);
    } else {
        gemm_core_glds([&](int i, int r, int k0) -> const void* {
            const int rr = (m0 + r < M) ? (m0 + r) : 0;
            return (const void*)((const bf16_t*)A + (size_t)rr * lda + k0); }, Wt, K, n0, K, smem, acc);
    }
    epi_foreach(acc, m0, n0, [&](int m, int n, float4 v) { if (m < M && n < N) epi(m, n, v); });
}

struct WJob { const float* src; bf16_t* dst; const float* gain; long long sbs, dbs; int K, N, Npad, batch, perm, gbs; };
#define NJOBS 20
__device__ __forceinline__ void wconv_item(const WJob& J, int item, float* lds) {
    const int tid = opq_tid(), lane = tid & 63;
    const int nt = J.Npad >> 6, kt = J.K >> 6;
    const int bi = item / (nt * kt), rem = item % (nt * kt), kb = rem / nt, nb = rem % nt;
    const float* W = J.src + (size_t)bi * J.sbs;
    bf16_t* D = J.dst + (size_t)bi * J.dbs;
    const int k0 = kb * 64, n0 = nb * 64;
    __syncthreads();
    {
        float vv[16];
        const int n = n0 + lane;
#pragma unroll
        for (int p = 0; p < 16; ++p) {
            const int k = p * 4 + (tid >> 6);
            vv[p] = (n < J.N) ? W[(size_t)(k0 + k) * J.N + n] : 0.f;
        }
        if (J.gain) {
#pragma unroll
            for (int p = 0; p < 16; ++p) vv[p] *= J.gain[(size_t)bi * J.gbs + k0 + p * 4 + (tid >> 6)];
        }
#pragma unroll
        for (int p = 0; p < 16; ++p) lds[(p * 4 + (tid >> 6)) * 65 + lane] = vv[p];
    }
    __syncthreads();
    const int n = tid >> 2, kq = (tid & 3) * 16;
    float f[16];
#pragma unroll
    for (int i = 0; i < 16; ++i) f[i] = lds[(kq + i) * 65 + n];
    uint4 o0, o1;
    o0.x = pk2(f[0], f[1]); o0.y = pk2(f[2], f[3]); o0.z = pk2(f[4], f[5]); o0.w = pk2(f[6], f[7]);
    o1.x = pk2(f[8], f[9]); o1.y = pk2(f[10], f[11]); o1.z = pk2(f[12], f[13]); o1.w = pk2(f[14], f[15]);
    int drow = n0 + n;
    if (J.perm) drow = (drow >> 5) * 64 + (J.perm - 1) * 32 + (drow & 31);
    uint4* dp = (uint4*)(D + (size_t)drow * J.K + k0 + kq);
    dp[0] = o0; dp[1] = o1;
}

#define LOG2E 1.4426950408889634f
#define CNT_STRIDE 64
struct L0Bufs { bf16_t *q, *kcr, *vcr, *ks, *vst, *kw, *vwt; float* gates; bf16_t *hidc, *kc, *vct; float* bias1; };

__device__ __forceinline__ float wave_max(float v) { v = fmaxf(v, fx<1>(v)); v = fmaxf(v, fx<2>(v)); v = fmaxf(v, fx<4>(v)); v = fmaxf(v, fx<8>(v)); v = fmaxf(v, fx<16>(v)); return max32(v); }

__device__ __forceinline__ void p1_item(const bf16_t* __restrict__ xn, const bf16_t* __restrict__ t_w_in, const float* __restrict__ qn, const float* __restrict__ kn,
                                        const L0Bufs& B, int bx, int by, char* smem) {
    const int m0 = by * 128, n0 = bx * 128;
    f32x16 acc[2][2];
    gemm_core_glds([&](int i, int r, int k0) -> const void* { return (const void*)(xn + (size_t)(m0 + r) * DM + k0); }, t_w_in, DM, n0, DM, smem, acc);
    const int tid_ = opq_tid(), lane = tid_ & 63, wave = tid_ >> 6;
    const int wn = wave >> 1, wm = wave & 1, c = lane & 31, h = lane >> 5;
    const int ch = (n0 >> 6) + wn;
#pragma unroll
    for (int j = 0; j < 2; ++j) {
        const int m = m0 + wm * 64 + 32 * j + c;
        const int b = m >> 12, t = m & 4095;
        if (ch < 16 || (ch >= 24 && ch < 28) || (ch >= 32 && ch < 36)) {
            float ss = 0.f;
#pragma unroll
            for (int i = 0; i < 2; ++i)
#pragma unroll
                for (int r = 0; r < 16; ++r) ss += acc[i][j][r] * acc[i][j][r];
            ss = sum32(ss);
            float rs = rsqrtf(ss * (1.f / 64.f) + 1e-6f);
            const float* g; bf16_t* dst;
            if (ch < 16) { g = qn; rs *= 0.125f * LOG2E; dst = B.q + (size_t)m * 1024 + ch * 64; }
            else if (ch < 28) { g = kn + 64; dst = B.ks + (size_t)m * 256 + (ch - 24) * 64; }
            else { g = kn + 128; dst = B.kw + (size_t)m * 256 + (ch - 32) * 64; }
#pragma unroll
            for (int i = 0; i < 2; ++i)
#pragma unroll
                for (int q4 = 0; q4 < 4; ++q4) {
                    const int nl = 32 * i + 8 * q4 + 4 * h;
                    const float4 gg = *(const float4*)(g + nl);
                    uint2 o;
                    o.x = pk2(acc[i][j][4 * q4] * rs * gg.x, acc[i][j][4 * q4 + 1] * rs * gg.y);
                    o.y = pk2(acc[i][j][4 * q4 + 2] * rs * gg.z, acc[i][j][4 * q4 + 3] * rs * gg.w);
                    *(uint2*)(dst + nl) = o;
                }
        } else if (ch >= 16 && ch < 24) {
            bf16_t* dst = (ch < 20) ? (B.kcr + (size_t)m * 256 + (ch - 16) * 64) : (B.vcr + (size_t)m * 256 + (ch - 20) * 64);
#pragma unroll
            for (int i = 0; i < 2; ++i)
#pragma unroll
                for (int q4 = 0; q4 < 4; ++q4) {
                    const int nl = 32 * i + 8 * q4 + 4 * h;
                    uint2 o;
                    o.x = pk2(acc[i][j][4 * q4], acc[i][j][4 * q4 + 1]);
                    o.y = pk2(acc[i][j][4 * q4 + 2], acc[i][j][4 * q4 + 3]);
                    *(uint2*)(dst + nl) = o;
                }
        } else if ((ch >= 28 && ch < 32) || (ch >= 36 && ch < 40)) {
            const int g = (ch < 32) ? (ch - 28) : (ch - 36);
            bf16_t* dst = ((ch < 32) ? B.vst : B.vwt) + ((size_t)(b * 4 + g) * 64) * SEQ + t;
#pragma unroll
            for (int i = 0; i < 2; ++i)
#pragma unroll
                for (int r = 0; r < 16; ++r) {
                    const int d = 32 * i + (r & 3) + 8 * (r >> 2) + 4 * h;
                    dst[(size_t)d * SEQ] = (bf16_t)(pk2(acc[i][j][r], 0.f) & 0xffffu);
                }
        } else if (ch == 40) {
#pragma unroll
            for (int i = 0; i < 2; ++i)
#pragma unroll
                for (int q4 = 0; q4 < 4; ++q4) {
                    const int nl = 32 * i + 8 * q4 + 4 * h;
                    if (nl < 48) *(float4*)(B.gates + (size_t)m * 48 + nl) = make_float4(sigm(acc[i][j][4 * q4]), sigm(acc[i][j][4 * q4 + 1]), sigm(acc[i][j][4 * q4 + 2]), sigm(acc[i][j][4 * q4 + 3]));
                }
        }
    }
}

__device__ __forceinline__ void p2a_item(const L0Bufs& B, const bf16_t* __restrict__ w1t, int which, int mt, int nt, char* smem) {
    const bf16_t* raw = which ? B.vcr : B.kcr;
    const int sr = opq_tid() >> 3;
    auto rowbase = [&](int i) -> const bf16_t* {
        const int m = mt * 128 + sr + 32 * i;
        if (m >= 4080) return nullptr;
        const int bg = m / NCMP, n = m - bg * NCMP;
        return raw + ((size_t)((bg >> 2) * SEQ + 16 * n)) * 256 + (bg & 3) * 64;
    };
    const bf16_t* rb0 = rowbase(0); const bf16_t* rb1 = rowbase(1); const bf16_t* rb2 = rowbase(2); const bf16_t* rb3 = rowbase(3);
    f32x16 acc[2][2];
    gemm_core_glds([&](int i, int r, int k0) -> const void* { const bf16_t* rbi = (i == 0) ? rb0 : (i == 1) ? rb1 : (i == 2) ? rb2 : rb3; return (const void*)((rbi ? rbi : raw) + (size_t)(k0 >> 6) * 256); }, w1t, 2048, nt * 128, 2048, smem, acc);
    const float* bias = B.bias1 + which * 256;
    bf16_t* hid = B.hidc + (size_t)which * 4096 * 256;
    epi_foreach(acc, mt * 128, nt * 128, [&](int m, int n, float4 v) {
        const float4 bb = *(const float4*)(bias + n);
        uint2 o; o.x = pk2(gelu_tanh(v.x + bb.x), gelu_tanh(v.y + bb.y)); o.y = pk2(gelu_tanh(v.z + bb.z), gelu_tanh(v.w + bb.w));
        *(uint2*)(hid + (size_t)m * 256 + n) = o;
    });
}
__device__ __forceinline__ void p2b_item(const L0Bufs& B, const bf16_t* __restrict__ w2t, const float* __restrict__ kn, int which, int mt, char* smem) {
    const bf16_t* hid = B.hidc + (size_t)which * 4096 * 256;
    f32x16 acc[2][2];
    gemm_core_glds([&](int i, int r, int k0) -> const void* { return (const void*)(hid + (size_t)(mt * 128 + r) * 256 + k0); }, w2t, 256, 0, 256, smem, acc);
    const int tid_ = opq_tid(), lane = tid_ & 63, wave = tid_ >> 6;
    const int wn = wave >> 1, wm = wave & 1, c = lane & 31, h = lane >> 5;
    if (wn != 0) return;
#pragma unroll
    for (int j = 0; j < 2; ++j) {
        const int m = mt * 128 + wm * 64 + 32 * j + c;
        const bool ok = m < 4080;
        const int bg = m / NCMP, n = m - bg * NCMP;
        if (which == 0) {
            float ss = 0.f;
#pragma unroll
            for (int i = 0; i < 2; ++i)
#pragma unroll
                for (int r = 0; r < 16; ++r) ss += acc[i][j][r] * acc[i][j][r];
            ss = sum32(ss);
            const float rs = rsqrtf(ss * (1.f / 64.f) + 1e-6f);
            if (ok) {
                bf16_t* dst = B.kc + ((size_t)bg * 256 + n) * 64;
#pragma unroll
                for (int i = 0; i < 2; ++i)
#pragma unroll
                    for (int q4 = 0; q4 < 4; ++q4) {
                        const int nl = 32 * i + 8 * q4 + 4 * h;
                        const float4 gg = *(const float4*)(kn + nl);
                        uint2 o;
                        o.x = pk2(acc[i][j][4 * q4] * rs * gg.x, acc[i][j][4 * q4 + 1] * rs * gg.y);
                        o.y = pk2(acc[i][j][4 * q4 + 2] * rs * gg.z, acc[i][j][4 * q4 + 3] * rs * gg.w);
                        *(uint2*)(dst + nl) = o;
                    }
            }
        } else if (ok) {
            bf16_t* dst = B.vct + ((size_t)bg * 64) * 256 + n;
#pragma unroll
            for (int i = 0; i < 2; ++i)
#pragma unroll
                for (int r = 0; r < 16; ++r) {
                    const int d = 32 * i + (r & 3) + 8 * (r >> 2) + 4 * h;
                    dst[(size_t)d * 256] = (bf16_t)(pk2(acc[i][j][r], 0.f) & 0xffffu);
                }
        }
    }
}

#define KROW 144
#define VROW 136
#define KT_BYTES (64 * KROW)
#define ABUF (KT_BYTES + 64 * VROW)
#define ATT_IMP_OFF (2 * ABUF)
#define ATT_MASK_OFF (ATT_IMP_OFF + 4 * 32 * 65 * 4)
#define ATT_MISC_OFF (ATT_MASK_OFF + 32 * 8)

struct KVRegs { uint4 k0, k1, v0, v1; };
typedef unsigned int u32x4 __attribute__((ext_vector_type(4)));
__device__ __forceinline__ uint4 bload16(__amdgpu_buffer_rsrc_t r, unsigned voff, unsigned soff) { const u32x4 v = __builtin_amdgcn_raw_buffer_load_b128(r, voff, soff, 0); return make_uint4(v.x, v.y, v.z, v.w); }
__device__ __forceinline__ KVRegs attn_load_tile(__amdgpu_buffer_rsrc_t rK, __amdgpu_buffer_rsrc_t rV, unsigned koff, unsigned voff, int kstride, int j) {
    KVRegs R;
    const unsigned ks = (unsigned)j * 128u * (unsigned)kstride, vs = (unsigned)j * 128u;
    R.k0 = bload16(rK, koff, ks); R.k1 = bload16(rK, koff + 16u, ks);
    R.v0 = bload16(rV, voff, vs); R.v1 = bload16(rV, voff + 16u, vs);
    return R;
}
__device__ __forceinline__ void attn_store_tile(char* buf, const KVRegs R, int tid) {
    const int row = tid >> 2, cq = tid & 3;
    char* kd = buf + row * KROW + cq * 32;
    *(uint4*)kd = R.k0; *(uint4*)(kd + 16) = R.k1;
    char* vd = buf + KT_BYTES + row * VROW + cq * 32;
    *(uint2*)vd = make_uint2(R.v0.x, R.v0.y); *(uint2*)(vd + 8) = make_uint2(R.v0.z, R.v0.w);
    *(uint2*)(vd + 16) = make_uint2(R.v1.x, R.v1.y); *(uint2*)(vd + 24) = make_uint2(R.v1.z, R.v1.w);
}
template <bool AUG>
__device__ __forceinline__ void attn_qk(const char* buf, const bf16x8 (&qf)[4], f32x16 (&st)[2], int tid, const bf16x8 (&kaug)[2], const bf16x8 qaug) {
    const int lane = tid & 63, cl = lane & 31, hh = lane >> 5;
    const char* kp = buf + cl * KROW + hh * 16;
    const bf16x8 k00 = *(const bf16x8*)(kp), k01 = *(const bf16x8*)(kp + 32), k02 = *(const bf16x8*)(kp + 64), k03 = *(const bf16x8*)(kp + 96);
    const bf16x8 k10 = *(const bf16x8*)(kp + 32 * KROW), k11 = *(const bf16x8*)(kp + 32 * KROW + 32), k12 = *(const bf16x8*)(kp + 32 * KROW + 64), k13 = *(const bf16x8*)(kp + 32 * KROW + 96);
    __builtin_amdgcn_sched_barrier(0);
#pragma unroll
    for (int r = 0; r < 16; ++r) { st[0][r] = 0.f; st[1][r] = 0.f; }
    st[0] = __builtin_amdgcn_mfma_f32_32x32x16_bf16(k00, qf[0], st[0], 0, 0, 0);
    st[1] = __builtin_amdgcn_mfma_f32_32x32x16_bf16(k10, qf[0], st[1], 0, 0, 0);
    st[0] = __builtin_amdgcn_mfma_f32_32x32x16_bf16(k01, qf[1], st[0], 0, 0, 0);
    st[1] = __builtin_amdgcn_mfma_f32_32x32x16_bf16(k11, qf[1], st[1], 0, 0, 0);
    st[0] = __builtin_amdgcn_mfma_f32_32x32x16_bf16(k02, qf[2], st[0], 0, 0, 0);
    st[1] = __builtin_amdgcn_mfma_f32_32x32x16_bf16(k12, qf[2], st[1], 0, 0, 0);
    st[0] = __builtin_amdgcn_mfma_f32_32x32x16_bf16(k03, qf[3], st[0], 0, 0, 0);
    st[1] = __builtin_amdgcn_mfma_f32_32x32x16_bf16(k13, qf[3], st[1], 0, 0, 0);
    if (AUG) {
        st[0] = __builtin_amdgcn_mfma_f32_32x32x16_bf16(kaug[0], qaug, st[0], 0, 0, 0);
        st[1] = __builtin_amdgcn_mfma_f32_32x32x16_bf16(kaug[1], qaug, st[1], 0, 0, 0);
    }
}
template <bool MASKED, int PSC>
__device__ __forceinline__ void attn_exp(f32x16 (&st)[2], bf16x8 (&pf)[2][2], int pos0, int tq, int wlim, float& l) {
    float l0 = 0.f, l1 = 0.f;
#pragma unroll
    for (int i = 0; i < 2; ++i) {
#pragma unroll
        for (int r = 0; r < 16; ++r) {
            float e = st[i][r];
            if (MASKED) { const int kl = 32 * i + (r & 3) + 8 * (r >> 2); const int dist = tq - (pos0 + PSC * kl); e = (dist >= 0 && dist < wlim) ? e : -INFINITY; }
            const float p = __builtin_amdgcn_exp2f(e);
            if (r & 1) l1 += p; else l0 += p;
            st[i][r] = p;
        }
#pragma unroll
        for (int s = 0; s < 2; ++s) {
            uint4 u;
            u.x = pk2(st[i][8 * s + 0], st[i][8 * s + 1]); u.y = pk2(st[i][8 * s + 2], st[i][8 * s + 3]);
            u.z = pk2(st[i][8 * s + 4], st[i][8 * s + 5]); u.w = pk2(st[i][8 * s + 6], st[i][8 * s + 7]);
            pf[i][s] = __builtin_bit_cast(bf16x8, u);
        }
    }
    l += l0 + l1;
}
struct VFrags { uint2 a[8]; };
__device__ __forceinline__ bf16x8 vjoin(uint2 v0, uint2 v1) { return __builtin_bit_cast(bf16x8, make_uint4(v0.x, v0.y, v1.x, v1.y)); }
#define VADDR(buf, dt, i, s) ((buf) + KT_BYTES + (32 * (dt) + cl) * VROW + (32 * (i) + 16 * (s) + 4 * hh) * 2)
__device__ __forceinline__ void attn_pv(const char* buf, const bf16x8 (&pf)[2][2], f32x16 (&ot)[2], int tid) {
    const int lane = tid & 63, cl = lane & 31, hh = lane >> 5;
    const char* a00 = VADDR(buf, 0, 0, 0);
    const uint2 p0 = *(const uint2*)(a00), p1 = *(const uint2*)(a00 + 16), p2 = *(const uint2*)(a00 + 32), p3 = *(const uint2*)(a00 + 48);
    const uint2 p4 = *(const uint2*)(a00 + 64), p5 = *(const uint2*)(a00 + 80), p6 = *(const uint2*)(a00 + 96), p7 = *(const uint2*)(a00 + 112);
    const char* a10 = a00 + 32 * VROW;
    const uint2 q0 = *(const uint2*)(a10), q1 = *(const uint2*)(a10 + 16), q2 = *(const uint2*)(a10 + 32), q3 = *(const uint2*)(a10 + 48);
    const uint2 q4 = *(const uint2*)(a10 + 64), q5 = *(const uint2*)(a10 + 80), q6 = *(const uint2*)(a10 + 96), q7 = *(const uint2*)(a10 + 112);
    __builtin_amdgcn_sched_barrier(0);
    ot[0] = __builtin_amdgcn_mfma_f32_32x32x16_bf16(vjoin(p0, p1), pf[0][0], ot[0], 0, 0, 0);
    ot[1] = __builtin_amdgcn_mfma_f32_32x32x16_bf16(vjoin(q0, q1), pf[0][0], ot[1], 0, 0, 0);
    ot[0] = __builtin_amdgcn_mfma_f32_32x32x16_bf16(vjoin(p2, p3), pf[0][1], ot[0], 0, 0, 0);
    ot[1] = __builtin_amdgcn_mfma_f32_32x32x16_bf16(vjoin(q2, q3), pf[0][1], ot[1], 0, 0, 0);
    ot[0] = __builtin_amdgcn_mfma_f32_32x32x16_bf16(vjoin(p4, p5), pf[1][0], ot[0], 0, 0, 0);
    ot[1] = __builtin_amdgcn_mfma_f32_32x32x16_bf16(vjoin(q4, q5), pf[1][0], ot[1], 0, 0, 0);
    ot[0] = __builtin_amdgcn_mfma_f32_32x32x16_bf16(vjoin(p6, p7), pf[1][1], ot[0], 0, 0, 0);
    ot[1] = __builtin_amdgcn_mfma_f32_32x32x16_bf16(vjoin(q6, q7), pf[1][1], ot[1], 0, 0, 0);
}

template <int PSC, int POFF>
__device__ __forceinline__ void attn_branch(const bf16_t* SK, const bf16_t* SVT, int kstride, int vstride, unsigned long long tiles, unsigned long long maskbits, unsigned long long lane_mask,
                                            const bf16x8 (&qf)[4], float slope2, float tb0, int tq, int wlim, char* smem, f32x16 (&ot)[2], float& l, int tid) {
    const int hh = (tid & 63) >> 5;
#pragma unroll
    for (int dt = 0; dt < 2; ++dt)
#pragma unroll
        for (int r = 0; r < 16; ++r) ot[dt][r] = 0.f;
    l = 0.f;
    if (tiles == 0ull) return;
    const __amdgpu_buffer_rsrc_t rK = __builtin_amdgcn_make_buffer_rsrc((void*)SK, 0, 0x7fffffff, 0x00020000);
    const __amdgpu_buffer_rsrc_t rV = __builtin_amdgcn_make_buffer_rsrc((void*)SVT, 0, 0x7fffffff, 0x00020000);
    const unsigned koff = (((unsigned)tid >> 2) * (unsigned)kstride + ((unsigned)tid & 3) * 16u) * 2u, voff = (((unsigned)tid >> 2) * (unsigned)vstride + ((unsigned)tid & 3) * 16u) * 2u;
    bf16x8 kaug[2];
    const float sk = slope2 * (float)PSC;
    const unsigned s_hi = pk2(sk, 0.f) & 0xffffu, s_lo = pk2(sk - bf16_lo_f(s_hi), 0.f) & 0xffffu;
    {
        const int cl = tid & 31;
#pragma unroll
        for (int i = 0; i < 2; ++i) {
            const float klf = (float)(32 * i + cl);
            uint4 u = make_uint4(pk2(klf, klf), 0x3f803f80u, 0x00003f80u, 0u);
            if (hh) u = make_uint4(0u, 0u, 0u, 0u);
            kaug[i] = __builtin_bit_cast(bf16x8, u);
        }
    }
    auto compute = [&](const char* buf, int j) {
        f32x16 st[2]; bf16x8 pf[2][2];
        const float t = fmaf(slope2, (float)(PSC * 64 * j + POFF), tb0);
        const bool on = (lane_mask >> j) & 1ull;
        const unsigned t_hi = on ? (pk2(t, 0.f) & 0xffffu) : 0xff80u;
        const float r1 = on ? (t - bf16_lo_f(t_hi)) : 0.f;
        const unsigned t_lo = pk2(r1, 0.f) & 0xffffu;
        const unsigned t_l2 = pk2(r1 - bf16_lo_f(t_lo), 0.f) & 0xffffu;
        uint4 qu = make_uint4(s_hi | (s_lo << 16), t_hi | (t_lo << 16), t_l2, 0u);
        if (hh) qu = make_uint4(0u, 0u, 0u, 0u);
        attn_qk<true>(buf, qf, st, tid, kaug, __builtin_bit_cast(bf16x8, qu));
        const int pos0 = PSC * (64 * j + 4 * hh) + POFF;
        if ((maskbits >> j) & 1ull) attn_exp<true, PSC>(st, pf, pos0, tq, wlim, l);
        else attn_exp<false, PSC>(st, pf, pos0, tq, wlim, l);
        attn_pv(buf, pf, ot, tid);
    };
    int j = __builtin_ctzll(tiles); tiles &= tiles - 1;
    KVRegs R = attn_load_tile(rK, rV, koff, voff, kstride, j);
    __syncthreads();
    attn_store_tile(smem, R, tid);
    __syncthreads();
    int cur = 0;
    for (;;) {
        const bool more = tiles != 0ull;
        int jn = 0;
        if (more) { jn = __builtin_ctzll(tiles); tiles &= tiles - 1; R = attn_load_tile(rK, rV, koff, voff, kstride, jn); }
        compute(smem + cur * ABUF, j);
        if (more) attn_store_tile(smem + (cur ^ 1) * ABUF, R, tid);
        __syncthreads();
        if (!more) break;
        j = jn; cur ^= 1;
    }
}

__device__ __forceinline__ void nsa_attn_item(const L0Bufs& B, float m2c, float m2s, float m2w, bf16_t* __restrict__ att, int bg, int qb, char* smem) {
    const int tid = opq_tid();
    const int lane = tid & 63, wave = tid >> 6, cl = lane & 31, hh = lane >> 5;
    const int b = bg >> 2, g = bg & 3, hd = g * 4 + wave;
    const int t0 = qb * 32, c = qb >> 1, tq = t0 + cl;
    const float slope2 = exp2f(-0.5f * (float)(hd + 1)) * LOG2E;
    float* imp = (float*)(smem + ATT_IMP_OFF);
    uint2* msk = (uint2*)(smem + ATT_MASK_OFF);
    bf16x8 qf[4];
    {
        const bf16_t* qp = B.q + (size_t)(b * SEQ + tq) * 1024 + hd * 64 + 8 * hh;
#pragma unroll
        for (int ks = 0; ks < 4; ++ks) qf[ks] = *(const bf16x8*)(qp + ks * 16);
    }
#define NSA_GATE(idx, dep) ({ int t_ = threadIdx.x; asm volatile("" : "+v"(t_) : "v"(dep)); B.gates[(size_t)(b * SEQ + t0 + (t_ & 31)) * 48 + (g * 4 + (t_ >> 6)) * 3 + (idx)]; })
    f32x16 res[2], ot[2];
    float l;
    for (int e = tid; e < 4 * 32 * 65; e += 256) imp[e] = 0.f;
    const int ntc = (qb >> 5) + 1;
    const unsigned long long ctiles = (1ull << ntc) - 1ull;
    const bf16_t* SCK = B.kc + (size_t)bg * 256 * 64;
    const bf16_t* SCV = B.vct + (size_t)bg * 64 * 256;
    const float tbc = -(slope2 * (float)tq) - m2c;
    attn_branch<16, 31>(SCK, SCV, 64, 256, ctiles, ctiles, ~0ull, qf, slope2, tbc, tq, 1 << 30, smem, ot, l, tid);
    const float lc = sum32(l);
    const float invc = (lc > 0.f) ? 1.f / lc : 0.f;
    {
        const float f = NSA_GATE(0, invc) * invc;
#pragma unroll
        for (int dt = 0; dt < 2; ++dt)
#pragma unroll
            for (int r = 0; r < 16; ++r) res[dt][r] = ot[dt][r] * f;
    }
    {
        float* row = imp + wave * (32 * 65) + cl * 65;
        for (int jt = 0; jt < ntc; ++jt) {
            {
                const int rowi = tid >> 2, cq = tid & 3;
                const bf16_t* kp = SCK + (size_t)(jt * 64 + rowi) * 64 + cq * 16;
                const uint4 ka = *(const uint4*)kp, kb = *(const uint4*)(kp + 8);
                __syncthreads();
                char* kd = smem + rowi * KROW + cq * 32;
                *(uint4*)kd = ka; *(uint4*)(kd + 16) = kb;
                __syncthreads();
            }
            f32x16 st[2];
            { bf16x8 kz[2]; kz[0] = __builtin_bit_cast(bf16x8, make_uint4(0u, 0u, 0u, 0u)); kz[1] = kz[0]; attn_qk<false>(smem, qf, st, tid, kz, kz[0]); }
            const int pos0 = 16 * (64 * jt + 4 * hh) + 31;
            const float tb = fmaf(slope2, (float)pos0, tbc);
#pragma unroll
            for (int i = 0; i < 2; ++i)
#pragma unroll
                for (int gq4 = 0; gq4 < 4; ++gq4) {
                    float p[4];
#pragma unroll
                    for (int e4 = 0; e4 < 4; ++e4) {
                        const int r = 4 * gq4 + e4;
                        const int kl = 32 * i + (r & 3) + 8 * (r >> 2);
                        float e = fmaf(slope2 * 16.f, (float)kl, st[i][r]) + tb;
                        e = (tq - (pos0 + 16 * kl) >= 0) ? e : -INFINITY;
                        p[e4] = __builtin_amdgcn_exp2f(e) * invc;
                    }
                    const int js = 16 * jt + 8 * i + 2 * gq4 + hh;
                    row[js] += p[0] + p[1] + p[2] + 0.5f * p[3];
                    st[i][4 * gq4] = 0.5f * p[3];
                }
            __builtin_amdgcn_s_waitcnt(0xc07f);
#pragma unroll
            for (int i = 0; i < 2; ++i)
#pragma unroll
                for (int gq4 = 0; gq4 < 4; ++gq4) { const int js = 16 * jt + 8 * i + 2 * gq4 + hh; row[js + 1] += st[i][4 * gq4]; }
        }
    }
    __syncthreads();
    {
        const int q = tid >> 3, part = tid & 7;
        const float* row = imp + q * 65;
        auto impv = [&](int j) -> float { return ((row[j] + row[j + 32 * 65]) + row[j + 2 * 32 * 65]) + row[j + 3 * 32 * 65]; };
        float myv[8]; int rank[8];
#pragma unroll
        for (int u = 0; u < 8; ++u) { const int j = part * 8 + u; const bool f = (j == 0) || (j == c) || (j == c - 1); myv[u] = f ? 1e9f : impv(j); rank[u] = 0; }
        for (int j2 = 0; j2 <= c; ++j2) {
            const bool f2 = (j2 == 0) || (j2 == c) || (j2 == c - 1);
            const float v2 = f2 ? 1e9f : impv(j2);
#pragma unroll
            for (int u = 0; u < 8; ++u) { const int j = part * 8 + u; rank[u] += (v2 > myv[u] || (v2 == myv[u] && j2 < j)) ? 1 : 0; }
        }
        unsigned bits = 0u;
#pragma unroll
        for (int u = 0; u < 8; ++u) { const int j = part * 8 + u; if (j <= c && rank[u] < 16) bits |= 1u << u; }
        unsigned lo = (part < 4) ? (bits << (8 * part)) : 0u, hi = (part >= 4) ? (bits << (8 * (part - 4))) : 0u;
        lo |= ux<1>(lo); lo |= ux<2>(lo); lo |= ux<4>(lo); hi |= ux<1>(hi); hi |= ux<2>(hi); hi |= ux<4>(hi);
        if (part == 0) msk[q] = make_uint2(lo, hi);
    }
    __syncthreads();
    const uint2 mm = msk[cl];
    const unsigned long long mymask = (unsigned long long)mm.x | ((unsigned long long)mm.y << 32);
    const unsigned ulo = or_lo32(mm.x), uhi = or_lo32(mm.y);
    const unsigned long long U = (unsigned long long)__builtin_amdgcn_readfirstlane(ulo) | ((unsigned long long)__builtin_amdgcn_readfirstlane(uhi) << 32);
    {
        const float tbs = -(slope2 * (float)tq) - m2s;
        attn_branch<1, 0>(B.ks + (size_t)(b * SEQ) * 256 + g * 64, B.vst + (size_t)bg * 64 * SEQ, 256, SEQ, U, 1ull << c, mymask, qf, slope2, tbs, tq, 1 << 30, smem, ot, l, tid);
        const float ls = sum32(l);
        const float f = NSA_GATE(1, ls) / ls;
#pragma unroll
        for (int dt = 0; dt < 2; ++dt)
#pragma unroll
            for (int r = 0; r < 16; ++r) res[dt][r] += ot[dt][r] * f;
    }
    {
        const float tbw = -(slope2 * (float)tq) - m2w;
        const int lo_pos = t0 - 511;
        const int jlo = lo_pos > 0 ? (lo_pos >> 6) : 0;
        unsigned long long wt = 0ull, wm = 0ull;
        for (int j = jlo; j <= c; ++j) { wt |= 1ull << j; if (j == c || 64 * j < t0 + 31 - 511) wm |= 1ull << j; }
        attn_branch<1, 0>(B.kw + (size_t)(b * SEQ) * 256 + g * 64, B.vwt + (size_t)bg * 64 * SEQ, 256, SEQ, wt, wm, ~0ull, qf, slope2, tbw, tq, 512, smem, ot, l, tid);
        const float lw_ = sum32(l);
        const float f = NSA_GATE(2, lw_) / lw_;
#pragma unroll
        for (int dt = 0; dt < 2; ++dt)
#pragma unroll
            for (int r = 0; r < 16; ++r) res[dt][r] += ot[dt][r] * f;
    }
    {
        const int tid2 = opq_tid();
        bf16_t* dst = att + (size_t)(b * SEQ + t0 + (tid2 & 31)) * 1024 + (g * 4 + (tid2 >> 6)) * 64;
#pragma unroll
        for (int dt = 0; dt < 2; ++dt)
#pragma unroll
            for (int q4 = 0; q4 < 4; ++q4) {
                const int d = 32 * dt + 8 * q4 + 4 * hh;
                uint2 o; o.x = pk2(res[dt][4 * q4], res[dt][4 * q4 + 1]); o.y = pk2(res[dt][4 * q4 + 2], res[dt][4 * q4 + 3]);
                *(uint2*)(dst + d) = o;
            }
    }
}


template <bool COMBINE, int R>
__device__ __forceinline__ void rp_rows(const float* __restrict__ in, float* __restrict__ hw, const bf16_t* __restrict__ ys, bf16_t* __restrict__ hi, int row0, int rstride, int nrows_valid, float* rs_out) {
    const int lane = opq_tid() & 63;
    float4 v[R][4]; float ss[R];
#pragma unroll
    for (int r = 0; r < R; ++r) {
        const size_t row = (size_t)(row0 + r * rstride);
        ss[r] = 0.f;
        if (r < nrows_valid) {
#pragma unroll
            for (int i = 0; i < 4; ++i) v[r][i] = ((const float4*)(in + row * DM))[lane + 64 * i];
        }
    }
    if (COMBINE) {
#pragma unroll
        for (int r = 0; r < R; ++r) {
            const size_t row = (size_t)(row0 + r * rstride);
            if (r < nrows_valid) {
#pragma unroll
                for (int i = 0; i < 4; ++i) {
                    const uint2 b = ((const uint2*)(ys + row * 2 * DM))[lane + 64 * i], c = ((const uint2*)(ys + row * 2 * DM + DM))[lane + 64 * i];
                    float4 a = v[r][i];
                    a.x += bf16_lo_f(b.x) + bf16_lo_f(c.x); a.y += bf16_hi_f(b.x) + bf16_hi_f(c.x);
                    a.z += bf16_lo_f(b.y) + bf16_lo_f(c.y); a.w += bf16_hi_f(b.y) + bf16_hi_f(c.y);
                    v[r][i] = a;
                    ((float4*)(hw + row * DM))[lane + 64 * i] = a;
                }
            }
        }
    }
#pragma unroll
    for (int r = 0; r < R; ++r) {
        if (r < nrows_valid) {
#pragma unroll
            for (int i = 0; i < 4; ++i) ss[r] += v[r][i].x * v[r][i].x + v[r][i].y * v[r][i].y + v[r][i].z * v[r][i].z + v[r][i].w * v[r][i].w;
        }
    }
#pragma unroll
    for (int r = 0; r < R; ++r) ss[r] = wave_sum(ss[r]);
#pragma unroll
    for (int r = 0; r < R; ++r) {
        const size_t row = (size_t)(row0 + r * rstride);
        if (r < nrows_valid) {
            const float rr = rsqrtf(ss[r] * (1.f / DM) + 1e-6f);
            if (rs_out && lane == 0) rs_out[r] = rr;
#pragma unroll
            for (int i = 0; i < 4; ++i) {
                uint2 o; o.x = pk2(v[r][i].x * rr, v[r][i].y * rr); o.y = pk2(v[r][i].z * rr, v[r][i].w * rr);
                ((uint2*)(hi + row * DM))[lane + 64 * i] = o;
            }
        }
    }
}

__device__ __forceinline__ void rw_build(const float* __restrict__ wg, const float* __restrict__ we, const float* __restrict__ gain, float* __restrict__ dst, int start, int stride) {
    for (int idx = start; idx < 1024 * 36; idx += stride) {
        const int k = idx / 36, n = idx - k * 36;
        dst[idx] = ((n < 4) ? wg[k * 4 + n] : we[k * 32 + (n - 4)]) * gain[k];
    }
}
struct RouteSel { int x1, x2; float w1, w2; };
__device__ __forceinline__ RouteSel route_select(const float (&lg)[36], const float* __restrict__ bgp, const float* __restrict__ bep) {
    float gl[4];
#pragma unroll
    for (int i = 0; i < 4; ++i) gl[i] = lg[i] + bgp[i];
    int gi = 0; float gm = gl[0];
#pragma unroll
    for (int i = 1; i < 4; ++i) if (gl[i] > gm) { gm = gl[i]; gi = i; }
    float gs = 0.f;
#pragma unroll
    for (int i = 0; i < 4; ++i) gs += expf(gl[i] - gm);
    const float gw = 1.f / gs;
    float el[8];
#pragma unroll
    for (int e = 0; e < 8; ++e) {
        float v = 0.f;
#pragma unroll
        for (int gg = 0; gg < 4; ++gg) v = (gg == gi) ? (lg[4 + gg * 8 + e] + bep[gg * 8 + e]) : v;
        el[e] = v;
    }
    int e1 = 0; float m1 = el[0];
#pragma unroll
    for (int e = 1; e < 8; ++e) if (el[e] > m1) { m1 = el[e]; e1 = e; }
    int e2 = -1; float m2 = -INFINITY;
#pragma unroll
    for (int e = 0; e < 8; ++e) if (e != e1 && el[e] > m2) { m2 = el[e]; e2 = e; }
    const float p2 = expf(m2 - m1);
    RouteSel R;
    R.w1 = gw / (1.f + p2); R.w2 = gw * p2 / (1.f + p2);
    R.x1 = gi * 8 + e1; R.x2 = gi * 8 + e2;
    return R;
}
__device__ __forceinline__ void route_item(const float* __restrict__ h, bf16_t* __restrict__ xhi, const float* __restrict__ wr32,
                                           const float* __restrict__ bgp, const float* __restrict__ bep,
                                           int* __restrict__ cnt, int* __restrict__ lslot, float* __restrict__ lw, int it, char* smem) {
    const int tid = opq_tid(), wave = tid >> 6, lane = tid & 63;
    const int m0 = it * 32;
    float* wch = (float*)smem;
    float* rs = (float*)(smem + 36864);
    rp_rows<false, 4>(h, nullptr, nullptr, xhi, m0 + wave * 8, 1, 4, rs + wave * 8);
    rp_rows<false, 4>(h, nullptr, nullptr, xhi, m0 + wave * 8 + 4, 1, 4, rs + wave * 8 + 4);
    const int tp = tid >> 4, part = tid & 15;
    float a0[36], a1[36];
#pragma unroll
    for (int n = 0; n < 36; ++n) { a0[n] = 0.f; a1[n] = 0.f; }
    float* xch = (float*)(smem + 36864 + 128);
    for (int ch = 0; ch < 4; ++ch) {
        __syncthreads();
#pragma unroll
        for (int i = 0; i < 9; ++i) ((float4*)wch)[tid + 256 * i] = ((const float4*)(wr32 + (size_t)ch * 256 * 36))[tid + 256 * i];
#pragma unroll
        for (int i = 0; i < 8; ++i) { const int e = tid + 256 * i, r = e >> 6, c4 = e & 63; *(float4*)(xch + r * 260 + c4 * 4) = *(const float4*)(h + (size_t)(m0 + r) * DM + ch * 256 + c4 * 4); }
        __syncthreads();
        const float* xr0 = xch + (2 * tp) * 260 + part;
#pragma unroll 2
        for (int kk = 0; kk < 16; ++kk) {
            const float v0 = xr0[kk * 16], v1 = xr0[260 + kk * 16];
            const float4* wrow = (const float4*)(wch + (kk * 16 + part) * 36);
#pragma unroll
            for (int q = 0; q < 9; ++q) {
                const float4 w = wrow[q];
                a0[4 * q] += v0 * w.x; a0[4 * q + 1] += v0 * w.y; a0[4 * q + 2] += v0 * w.z; a0[4 * q + 3] += v0 * w.w;
                a1[4 * q] += v1 * w.x; a1[4 * q + 1] += v1 * w.y; a1[4 * q + 2] += v1 * w.z; a1[4 * q + 3] += v1 * w.w;
            }
        }
    }
    const float r0 = rs[2 * tp], r1 = rs[2 * tp + 1];
#pragma unroll
    for (int n = 0; n < 36; ++n) {
        float s0 = a0[n], s1 = a1[n];
        s0 += fx<1>(s0); s0 += fx<2>(s0); s0 += fx<4>(s0); s0 += fx<8>(s0);
        s1 += fx<1>(s1); s1 += fx<2>(s1); s1 += fx<4>(s1); s1 += fx<8>(s1);
        a0[n] = s0 * r0; a1[n] = s1 * r1;
    }
    if (part == 0) {
        const RouteSel A = route_select(a0, bgp, bep), B = route_select(a1, bgp, bep);
        const int t = m0 + 2 * tp;
        const int pa1 = atomicAdd(&cnt[A.x1 * CNT_STRIDE], 1), pa2 = atomicAdd(&cnt[A.x2 * CNT_STRIDE], 1);
        const int pb1 = atomicAdd(&cnt[B.x1 * CNT_STRIDE], 1), pb2 = atomicAdd(&cnt[B.x2 * CNT_STRIDE], 1);
        lslot[A.x1 * TTOK + pa1] = t * 2;     lw[A.x1 * TTOK + pa1] = A.w1;
        lslot[A.x2 * TTOK + pa2] = t * 2 + 1; lw[A.x2 * TTOK + pa2] = A.w2;
        lslot[B.x1 * TTOK + pb1] = t * 2 + 2; lw[B.x1 * TTOK + pb1] = B.w1;
        lslot[B.x2 * TTOK + pb2] = t * 2 + 3; lw[B.x2 * TTOK + pb2] = B.w2;
    }
}

struct EpiStoreB { bf16_t* C; long long ldc; __device__ void operator()(int r, int c, float4 v) const { uint2 o; o.x = pk2(v.x, v.y); o.y = pk2(v.z, v.w); *(uint2*)(C + (size_t)r * ldc + c) = o; } };
struct EpiPleB { const bf16_t* Pj; float* H; long long ldc; __device__ void operator()(int r, int c, float4 v) const {
    const uint2 p = *(const uint2*)(Pj + (size_t)r * ldc + c); float4 a = *(const float4*)(H + (size_t)r * ldc + c);
    a.x += bf16_lo_f(p.x) / (1.f + __expf(-v.x)); a.y += bf16_hi_f(p.x) / (1.f + __expf(-v.y)); a.z += bf16_lo_f(p.y) / (1.f + __expf(-v.z)); a.w += bf16_hi_f(p.y) / (1.f + __expf(-v.w));
    *(float4*)(H + (size_t)r * ldc + c) = a; } };
__device__ __forceinline__ void ple_proj_item(const float* __restrict__ pin, const bf16_t* __restrict__ wp, bf16_t* __restrict__ pj, int bx, int by, char* smem) {
    d_gemm<true>(pin, wp, 256, TTOK, DM, 256, EpiStoreB{pj, DM}, bx, by, smem);
}
__device__ __forceinline__ void ple_item(const bf16_t* __restrict__ xhat, const bf16_t* __restrict__ wg, const bf16_t* __restrict__ pj, float* __restrict__ h, int bx, int by, char* smem) {
    d_gemm<false>(xhat, wg, DM, TTOK, DM, DM, EpiPleB{pj, h, DM}, bx, by, smem);
}
__device__ __forceinline__ void ple_item_l0(const bf16_t* __restrict__ xhat, const bf16_t* __restrict__ wg, const bf16_t* __restrict__ pj, float* __restrict__ h,
                                            bf16_t* __restrict__ hb, float* __restrict__ ssq, int bx, int by, char* smem) {
    const int m0 = by * 128, n0 = bx * 128;
    f32x16 acc[2][2];
    gemm_core_glds([&](int i, int r, int k0) -> const void* { return (const void*)(xhat + (size_t)(m0 + r) * DM + k0); }, wg, DM, n0, DM, smem, acc);
    const int tid_ = opq_tid(), lane = tid_ & 63, wave = tid_ >> 6;
    const int wn = wave >> 1, wm = wave & 1, c = lane & 31, hh = lane >> 5;
#pragma unroll
    for (int j = 0; j < 2; ++j) {
        const int m = m0 + wm * 64 + 32 * j + c;
        float ss = 0.f;
#pragma unroll
        for (int i = 0; i < 2; ++i)
#pragma unroll
            for (int q4 = 0; q4 < 4; ++q4) {
                const int n = n0 + wn * 64 + 32 * i + 8 * q4 + 4 * hh;
                const uint2 p = *(const uint2*)(pj + (size_t)m * DM + n);
                float4 a = *(const float4*)(h + (size_t)m * DM + n);
                a.x += bf16_lo_f(p.x) / (1.f + __expf(-acc[i][j][4 * q4])); a.y += bf16_hi_f(p.x) / (1.f + __expf(-acc[i][j][4 * q4 + 1]));
                a.z += bf16_lo_f(p.y) / (1.f + __expf(-acc[i][j][4 * q4 + 2])); a.w += bf16_hi_f(p.y) / (1.f + __expf(-acc[i][j][4 * q4 + 3]));
                *(float4*)(h + (size_t)m * DM + n) = a;
                uint2 o; o.x = pk2(a.x, a.y); o.y = pk2(a.z, a.w);
                *(uint2*)(hb + (size_t)m * DM + n) = o;
                const float b0 = bf16_lo_f(o.x), b1 = bf16_hi_f(o.x), b2 = bf16_lo_f(o.y), b3 = bf16_hi_f(o.y);
                ss += b0 * b0 + b1 * b1 + b2 * b2 + b3 * b3;
            }
        ss = sum32(ss);
        if (hh == 0) ssq[(size_t)m * 16 + bx * 2 + wn] = ss;
    }
}

#define HROW 272
#define MOE_W_OFF 36864
template <bool A_F32>
__device__ __forceinline__ void moe_item(const void* __restrict__ xn, const bf16_t* __restrict__ wgu, const bf16_t* __restrict__ wd,
                                         const int* __restrict__ slots, const float* __restrict__ wts, int nvalid, bf16_t* __restrict__ ys, char* smem) {
    const int tid = opq_tid(), lane = tid & 63, wave = tid >> 6;
    const int wn = wave >> 1, wm = wave & 1, c = lane & 31, h = lane >> 5;
    const int sr = tid >> 3, sc = tid & 7;
    auto rowp = [&](int i) -> const char* {
        const int idx = sr + 32 * i;
        if (idx >= nvalid) return nullptr;
        const int tok = slots[idx] >> 1;
        return (const char*)xn + (size_t)tok * 1024 * (A_F32 ? 4 : 2);
    };
    const char* rp0 = rowp(0); const char* rp1 = rowp(1); const char* rp2 = rowp(2); const char* rp3 = rowp(3);
    float cw[2]; int myslot[2];
#pragma unroll
    for (int j = 0; j < 2; ++j) {
        const int idx = wm * 64 + 32 * j + c;
        const bool ok = idx < nvalid;
        cw[j] = ok ? wts[idx] : 0.f;
        myslot[j] = ok ? slots[idx] : -1;
    }
    unsigned hp[2][2][8];
#pragma unroll
    for (int pass = 0; pass < 2; ++pass) {
        f32x16 acc[2][2];
        static_assert(!A_F32, "the expert GEMM streams bf16 rows straight into LDS");
        gemm_core_glds([&](int i, int r, int k0) -> const void* {
            const char* p = (i == 0) ? rp0 : (i == 1) ? rp1 : (i == 2) ? rp2 : rp3;
            return (const void*)((p ? p : (const char*)xn) + (size_t)k0 * 2); }, wgu, 1024, pass * 128, 1024, smem, acc);
#pragma unroll
        for (int j = 0; j < 2; ++j)
#pragma unroll
            for (int r2 = 0; r2 < 8; ++r2) {
                const float g0 = acc[0][j][2 * r2], g1 = acc[0][j][2 * r2 + 1];
                const float u0 = acc[1][j][2 * r2], u1 = acc[1][j][2 * r2 + 1];
                const float h0 = g0 / (1.f + __expf(-g0)) * u0 * cw[j], h1 = g1 / (1.f + __expf(-g1)) * u1 * cw[j];
                hp[pass][j][r2] = pk2(h0, h1);
            }
    }
#pragma unroll
    for (int pass = 0; pass < 2; ++pass)
#pragma unroll
        for (int j = 0; j < 2; ++j)
#pragma unroll
            for (int q4 = 0; q4 < 4; ++q4) {
                const int m = wm * 64 + 32 * j + c, f = pass * 64 + wn * 32 + 8 * q4 + 4 * h;
                *(uint2*)(smem + m * HROW + f * 2) = make_uint2(hp[pass][j][2 * q4], hp[pass][j][2 * q4 + 1]);
            }
    auto wissue = [&](int s, int buf) {
        const int nt = s >> 1, kt = s & 1;
        char* wb = smem + MOE_W_OFF + buf * GT_BYTES;
#pragma unroll
        for (int i = 0; i < 4; ++i) {
            const int r = sr + 32 * i;
            const int cs = sc ^ ((r >> 1) & 7);
            const char* wp = (const char*)(wd + (size_t)(nt * 128 + r) * 128 + kt * 64) + cs * 16;
            __builtin_amdgcn_global_load_lds((const __attribute__((address_space(1))) void*)wp, (__attribute__((address_space(3))) void*)(wb + (32 * i + 8 * wave) * 128), 16, 0, 0);
        }
    };
    wissue(0, 0);
    __syncthreads();
    f32x16 acc[2][2];
    for (int s = 0; s < 16; ++s) {
        const int kt = s & 1;
        if (kt == 0) {
#pragma unroll
            for (int i = 0; i < 2; ++i)
#pragma unroll
                for (int j = 0; j < 2; ++j)
#pragma unroll
                    for (int r = 0; r < 16; ++r) acc[i][j][r] = 0.f;
        }
        if (s + 1 < 16) wissue(s + 1, (s + 1) & 1);
        const char* wb = smem + MOE_W_OFF + (s & 1) * GT_BYTES;
        {
            const int rw0 = wn * 64 + c, kw = (rw0 >> 1) & 7;
            const char* wp0 = wb + rw0 * 128;
            const char* xp0 = smem + (wm * 64 + c) * HROW + kt * 128 + h * 16;
#define WFRAG(base, ks) (*(const bf16x8*)((base) + (((2 * (ks) + h) ^ kw) << 4)))
            bf16x8 wfa0 = WFRAG(wp0, 0), wfa1 = WFRAG(wp0 + 32 * 128, 0), xfa0 = *(const bf16x8*)(xp0), xfa1 = *(const bf16x8*)(xp0 + 32 * HROW);
#pragma unroll
            for (int ks = 0; ks < 4; ++ks) {
                bf16x8 wfb0, wfb1, xfb0, xfb1;
                if (ks < 3) {
                    wfb0 = WFRAG(wp0, ks + 1); wfb1 = WFRAG(wp0 + 32 * 128, ks + 1);
                    xfb0 = *(const bf16x8*)(xp0 + (ks + 1) * 32); xfb1 = *(const bf16x8*)(xp0 + 32 * HROW + (ks + 1) * 32);
                }
                acc[0][0] = __builtin_amdgcn_mfma_f32_32x32x16_bf16(wfa0, xfa0, acc[0][0], 0, 0, 0);
                acc[0][1] = __builtin_amdgcn_mfma_f32_32x32x16_bf16(wfa0, xfa1, acc[0][1], 0, 0, 0);
                acc[1][0] = __builtin_amdgcn_mfma_f32_32x32x16_bf16(wfa1, xfa0, acc[1][0], 0, 0, 0);
                acc[1][1] = __builtin_amdgcn_mfma_f32_32x32x16_bf16(wfa1, xfa1, acc[1][1], 0, 0, 0);
                __builtin_amdgcn_sched_barrier(0);
                if (ks < 3) { wfa0 = wfb0; wfa1 = wfb1; xfa0 = xfb0; xfa1 = xfb1; }
            }
#undef WFRAG
        }
        if (kt == 1) {
            const int nt = s >> 1;
#pragma unroll
            for (int j = 0; j < 2; ++j) {
                if (myslot[j] >= 0) {
                    bf16_t* dst = ys + (size_t)myslot[j] * 1024 + nt * 128 + wn * 64;
#pragma unroll
                    for (int i = 0; i < 2; ++i)
#pragma unroll
                        for (int q4 = 0; q4 < 4; ++q4) {
                            uint2 o; o.x = pk2(acc[i][j][4 * q4], acc[i][j][4 * q4 + 1]); o.y = pk2(acc[i][j][4 * q4 + 2], acc[i][j][4 * q4 + 3]);
                            *(uint2*)(dst + 32 * i + 8 * q4 + 4 * h) = o;
                        }
                }
            }
        }
        __syncthreads();
    }
}

struct L1Bufs { bf16_t *q, *k, *vt; float* kmpart; };

__device__ __forceinline__ void p7_item(const bf16_t* __restrict__ xn, const float* __restrict__ ssq, const bf16_t* __restrict__ wt, const float* __restrict__ qn, const float* __restrict__ kn,
                                        const L1Bufs& B, int bx, int by, char* smem) {
    const int m0 = by * 128, n0 = bx * 128;
    f32x16 acc[2][2];
    gemm_core_glds([&](int i, int r, int k0) -> const void* { return (const void*)(xn + (size_t)(m0 + r) * DM + k0); }, wt, DM, n0, DM, smem, acc);
    const int tid_ = opq_tid(), lane = tid_ & 63, wave = tid_ >> 6;
    const int wn = wave >> 1, wm = wave & 1, c = lane & 31, h = lane >> 5;
    const int ch = (n0 >> 6) + wn;
    float rstd[2];
#pragma unroll
    for (int j = 0; j < 2; ++j) {
        const float4* sp = (const float4*)(ssq + (size_t)(m0 + wm * 64 + 32 * j + c) * 16);
        const float4 s0 = sp[0], s1 = sp[1], s2 = sp[2], s3 = sp[3];
        const float S = (((s0.x + s0.y) + (s0.z + s0.w)) + ((s1.x + s1.y) + (s1.z + s1.w))) + (((s2.x + s2.y) + (s2.z + s2.w)) + ((s3.x + s3.y) + (s3.z + s3.w)));
        rstd[j] = rsqrtf(S * (1.f / DM) + 1e-6f);
    }
    if (ch < 4 || ch >= 8) {
        const float* g = (ch < 4) ? kn : qn;
        float nv[2][2][16];
#pragma unroll
        for (int j = 0; j < 2; ++j) {
            const int m = m0 + wm * 64 + 32 * j + c;
            float ss = 0.f;
#pragma unroll
            for (int i = 0; i < 2; ++i)
#pragma unroll
                for (int r = 0; r < 16; ++r) ss += acc[i][j][r] * acc[i][j][r];
            ss = sum32(ss);
            float rs = rstd[j] * rsqrtf(ss * rstd[j] * rstd[j] * (1.f / 64.f) + 1e-6f);
            if (ch >= 8) rs *= 0.125f * LOG2E;
            bf16_t* dst = (ch < 4) ? (B.k + (size_t)m * 256 + ch * 64) : (B.q + (size_t)m * 1024 + (ch - 8) * 64);
#pragma unroll
            for (int i = 0; i < 2; ++i)
#pragma unroll
                for (int q4 = 0; q4 < 4; ++q4) {
                    const int nl = 32 * i + 8 * q4 + 4 * h;
                    const float4 gg = *(const float4*)(g + nl);
                    const float v0 = acc[i][j][4 * q4] * rs * gg.x, v1 = acc[i][j][4 * q4 + 1] * rs * gg.y, v2 = acc[i][j][4 * q4 + 2] * rs * gg.z, v3 = acc[i][j][4 * q4 + 3] * rs * gg.w;
                    nv[i][j][4 * q4] = v0; nv[i][j][4 * q4 + 1] = v1; nv[i][j][4 * q4 + 2] = v2; nv[i][j][4 * q4 + 3] = v3;
                    uint2 o; o.x = pk2(v0, v1); o.y = pk2(v2, v3);
                    *(uint2*)(dst + nl) = o;
                }
        }
        if (ch < 4) {
            const int mb = m0 + wm * 64, b = mb >> 12, grp = (mb & 4095) >> 6;
            float* dst = B.kmpart + ((size_t)(b * 4 + ch) * 64 + grp) * 64;
#pragma unroll
            for (int i = 0; i < 2; ++i)
#pragma unroll
                for (int r = 0; r < 16; ++r) {
                    float s = sum_lo32(nv[i][0][r] + nv[i][1][r]);
                    if (c == 0) dst[32 * i + (r & 3) + 8 * (r >> 2) + 4 * h] = s;
                }
        }
    } else {
        const int g = ch - 4;
#pragma unroll
        for (int j = 0; j < 2; ++j) {
            const int m = m0 + wm * 64 + 32 * j + c;
            const int b = m >> 12, t = m & 4095;
            bf16_t* dst = B.vt + ((size_t)(b * 4 + g) * 64) * SEQ + t;
#pragma unroll
            for (int i = 0; i < 2; ++i)
#pragma unroll
                for (int r = 0; r < 16; ++r) {
                    const int d = 32 * i + (r & 3) + 8 * (r >> 2) + 4 * h;
                    dst[(size_t)d * SEQ] = (bf16_t)(pk2(acc[i][j][r] * rstd[j], 0.f) & 0xffffu);
                }
        }
    }
}

__device__ __forceinline__ void moba_attn_item(const L1Bufs& B, const float* __restrict__ qn, const float* __restrict__ kn, bf16_t* __restrict__ att, int bg, int qb, char* smem) {
    const int tid = opq_tid();
    const int lane = tid & 63, wave = tid >> 6, cl = lane & 31, hh = lane >> 5;
    const int b = bg >> 2, g = bg & 3, hd = g * 4 + wave;
    const int t0 = qb * 32, c = qb >> 1, cb = qb >> 3, tq = t0 + cl;
    const float slope2 = exp2f(-0.5f * (float)(hd + 1)) * LOG2E;
    float* kms = (float*)(smem + ATT_IMP_OFF);
    unsigned* um = (unsigned*)(smem + ATT_MASK_OFF);
    const float m2 = (8.f * wave_max(fabsf(qn[lane])) * wave_max(fabsf(kn[lane])) * 1.02f + 0.5f) * LOG2E;
    __syncthreads();
    {
        const int n = tid >> 4, d4 = (tid & 15) * 4;
        float4 a = make_float4(0.f, 0.f, 0.f, 0.f);
        if (n < cb) {
            const float* p = B.kmpart + ((size_t)bg * 64 + n * 4) * 64 + d4;
#pragma unroll
            for (int u = 0; u < 4; ++u) { const float4 x = *(const float4*)(p + u * 64); a.x += x.x; a.y += x.y; a.z += x.z; a.w += x.w; }
        }
        const float sc = 1.f / 256.f;
        *(float4*)(kms + n * 64 + d4) = make_float4(a.x * sc, a.y * sc, a.z * sc, a.w * sc);
        if (tid == 0) um[0] = 0u;
    }
    bf16x8 qf[4];
    {
        const bf16_t* qp = B.q + (size_t)(b * SEQ + tq) * 1024 + hd * 64 + 8 * hh;
#pragma unroll
        for (int ks = 0; ks < 4; ++ks) qf[ks] = *(const bf16x8*)(qp + ks * 16);
    }
    __syncthreads();
    float sg[16];
    {
        float qv[32];
#pragma unroll
        for (int ks = 0; ks < 4; ++ks) {
            const uint4 u = __builtin_bit_cast(uint4, qf[ks]);
            qv[ks * 8 + 0] = __uint_as_float(u.x << 16); qv[ks * 8 + 1] = __uint_as_float(u.x & 0xffff0000u);
            qv[ks * 8 + 2] = __uint_as_float(u.y << 16); qv[ks * 8 + 3] = __uint_as_float(u.y & 0xffff0000u);
            qv[ks * 8 + 4] = __uint_as_float(u.z << 16); qv[ks * 8 + 5] = __uint_as_float(u.z & 0xffff0000u);
            qv[ks * 8 + 6] = __uint_as_float(u.w << 16); qv[ks * 8 + 7] = __uint_as_float(u.w & 0xffff0000u);
        }
#pragma unroll
        for (int n = 0; n < 16; ++n) {
            float s = 0.f;
            if (n < cb) {
#pragma unroll
                for (int ks = 0; ks < 4; ++ks) {
                    const float4 k0 = *(const float4*)(kms + n * 64 + ks * 16 + 8 * hh), k1 = *(const float4*)(kms + n * 64 + ks * 16 + 8 * hh + 4);
                    s += qv[ks * 8 + 0] * k0.x + qv[ks * 8 + 1] * k0.y + qv[ks * 8 + 2] * k0.z + qv[ks * 8 + 3] * k0.w
                       + qv[ks * 8 + 4] * k1.x + qv[ks * 8 + 5] * k1.y + qv[ks * 8 + 6] * k1.z + qv[ks * 8 + 7] * k1.w;
                }
                s = sum32(s);
            } else s = -INFINITY;
            sg[n] = s;
        }
    }
    unsigned bm = 0u;
#pragma unroll
    for (int n = 0; n < 16; ++n) {
        int rank = 0;
#pragma unroll
        for (int n2 = 0; n2 < 16; ++n2) rank += (sg[n2] > sg[n] || (sg[n2] == sg[n] && n2 < n)) ? 1 : 0;
        if (rank < 3 && n < cb) bm |= 1u << n;
    }
    unsigned long long mytiles = 0ull;
#pragma unroll
    for (int n = 0; n < 16; ++n) if ((bm >> n) & 1u) mytiles |= 0xFull << (4 * n);
    unsigned long long own = 0ull;
    for (int j = 4 * cb; j <= c; ++j) own |= 1ull << j;
    mytiles |= own;
    const unsigned wb = or32(or_lo32(bm));
    if (lane == 0) atomicOr(um, wb);
    __syncthreads();
    const unsigned ub = um[0];
    unsigned long long U = own;
    for (int n = 0; n < 16; ++n) if ((ub >> n) & 1u) U |= 0xFull << (4 * n);
    f32x16 ot[2]; float l;
    const float tb0 = -(slope2 * (float)tq) - m2;
    attn_branch<1, 0>(B.k + (size_t)(b * SEQ) * 256 + g * 64, B.vt + (size_t)bg * 64 * SEQ, 256, SEQ, U, 1ull << c, mytiles, qf, slope2, tb0, tq, 1 << 30, smem, ot, l, tid);
    const float lt = sum32(l);
    const float f = 1.f / lt;
    bf16_t* dst = att + (size_t)(b * SEQ + tq) * 1024 + hd * 64;
#pragma unroll
    for (int dt = 0; dt < 2; ++dt)
#pragma unroll
        for (int q4 = 0; q4 < 4; ++q4) {
            const int d = 32 * dt + 8 * q4 + 4 * hh;
            uint2 o; o.x = pk2(ot[dt][4 * q4] * f, ot[dt][4 * q4 + 1] * f); o.y = pk2(ot[dt][4 * q4 + 2] * f, ot[dt][4 * q4 + 3] * f);
            *(uint2*)(dst + d) = o;
        }
}


#define XB_TMO      128
#define XB_XCNT(j)  (256  + 64 * (j))
#define XB_XSUB(j)  (1280 + 64 * (j))
#define XB_XGEN(j)  (2304 + 64 * (j))
#define XB_TOP      3328
#define XB_TOPGEN   3392
#define XCD_BAR_WORDS 3456
#define XB_SPIN_CAP (1u << 22)
#define LAS __attribute__((address_space(3)))
__device__ __forceinline__ unsigned xb_ld(unsigned* p)              { return __hip_atomic_load(p, __ATOMIC_RELAXED, __HIP_MEMORY_SCOPE_AGENT); }
__device__ __forceinline__ unsigned xb_add(unsigned* p, unsigned v) { return __hip_atomic_fetch_add(p, v, __ATOMIC_RELAXED, __HIP_MEMORY_SCOPE_AGENT); }
__device__ __forceinline__ unsigned xb_xcc_id() { return (unsigned)__builtin_amdgcn_s_getreg((3 << 11) | 20) & 0xFu; }
#define XB_SPIN(cond, bar) do { unsigned _sp = 0; while (cond) { __builtin_amdgcn_s_sleep(1); \
    if ((++_sp & 255u) == 0u) { if (xb_ld(&(bar)[XB_TMO])) break; if (_sp > XB_SPIN_CAP) { atomicAdd(&(bar)[XB_TMO], 1u); break; } } } } while (0)
struct XcdBarrier { unsigned* bar; unsigned x; volatile LAS unsigned* st; };
__device__ __forceinline__ XcdBarrier xcd_barrier_post(unsigned* bar, volatile LAS unsigned* st) {
    XcdBarrier b; b.bar = bar; b.x = xb_xcc_id(); b.st = st;
    if (threadIdx.x == 0) (void)xb_add(&bar[XB_XCNT(b.x)], 1u);
    return b;
}
__device__ __forceinline__ void xcd_barrier_complete(unsigned* bar, unsigned x, unsigned& nloc, unsigned& nx) {
    const unsigned G = gridDim.x * gridDim.y * gridDim.z;
    unsigned sum, cnt, mine, sp = 0u;
    for (;;) {
        sum = 0u; cnt = 0u; mine = 0u;
#pragma unroll
        for (unsigned j = 0; j < 16; ++j) { const unsigned c = xb_ld(&bar[XB_XCNT(j)]); sum += c; cnt += (c > 0u) ? 1u : 0u; mine = (j == x) ? c : mine; }
        if (sum == G) break;
        __builtin_amdgcn_s_sleep(1);
        if ((++sp & 255u) == 0u) { if (xb_ld(&bar[XB_TMO])) break; if (sp > XB_SPIN_CAP) { atomicAdd(&bar[XB_TMO], 1u); break; } }
    }
    nloc = mine > 0u ? mine : 1u; nx = cnt > 0u ? cnt : 1u;
}
__device__ __forceinline__ void xcd_barrier(const XcdBarrier& b) {
    asm volatile("s_waitcnt vmcnt(0)" ::: "memory");
    __syncthreads();
    if (threadIdx.x == 0) {
        unsigned* bar = b.bar;
        __builtin_amdgcn_s_waitcnt(0);
        unsigned nloc = b.st[0], nx = b.st[1];
        if (nloc == 0u) { xcd_barrier_complete(bar, b.x, nloc, nx); b.st[0] = nloc; b.st[1] = nx; }
        const unsigned old = xb_add(&bar[XB_XSUB(b.x)], 1u);
        const unsigned gen = old / nloc;
        if (old + 1u == (gen + 1u) * nloc) {
            __builtin_amdgcn_fence(__ATOMIC_RELEASE, "agent");
            asm volatile("s_waitcnt vmcnt(0)" ::: "memory");
            const unsigned og = xb_add(&bar[XB_TOP], 1u);
            const unsigned tg = og / nx;
            if (og + 1u == (tg + 1u) * nx) xb_add(&bar[XB_TOPGEN], 1u);
            else XB_SPIN(xb_ld(&bar[XB_TOPGEN]) == tg, bar);
            __builtin_amdgcn_fence(__ATOMIC_ACQUIRE, "agent");
            xb_add(&bar[XB_XGEN(b.x)], 1u);
            asm volatile("s_waitcnt vmcnt(0)" ::: "memory");
        } else {
            XB_SPIN(xb_ld(&bar[XB_XGEN(b.x)]) == gen, bar);
            __builtin_amdgcn_fence(__ATOMIC_ACQUIRE, "agent");
            asm volatile("s_waitcnt vmcnt(0)" ::: "memory");
        }
    }
    __syncthreads();
}

struct Params {
    const float* in[30];
    float* out;
    float* ws;
    WJob jobs[NJOBS];
};

#define SMEM_TOTAL 73744
__shared__ __attribute__((aligned(16))) char g_smem[SMEM_TOTAL];
typedef const Params __attribute__((address_space(4)))* PPtr;
#define PP() ({ PPtr _p = (PPtr)__builtin_amdgcn_kernarg_segment_ptr(); asm volatile("" : "+s"(_p)); _p; })
__device__ __forceinline__ WJob load_job(PPtr pp, int j) { WJob J; J.src = pp->jobs[j].src; J.dst = pp->jobs[j].dst; J.gain = pp->jobs[j].gain; J.sbs = pp->jobs[j].sbs; J.dbs = pp->jobs[j].dbs; J.K = pp->jobs[j].K; J.N = pp->jobs[j].N; J.Npad = pp->jobs[j].Npad; J.batch = pp->jobs[j].batch; J.perm = pp->jobs[j].perm; J.gbs = pp->jobs[j].gbs; return J; }
__device__ __forceinline__ void grid_sync() {
    XcdBarrier xb; xb.bar = (unsigned*)((char*)PP()->ws + (size_t)166 * 1048576); xb.x = xb_xcc_id(); xb.st = (volatile LAS unsigned*)(g_smem + 73728);
    xcd_barrier(xb);
}
#define GRID_SYNC() grid_sync()
#define PHASE_1D(NB, CALL) do { for (int vb = blockIdx.x; vb < (NB); vb += gridDim.x) { const int bx = vb; __syncthreads(); CALL; } GRID_SYNC(); } while (0)
#define PHASE_2D(NX, NY, CW, CALL) do { \
    const int xcd_ = blockIdx.x & 7, slot_ = blockIdx.x >> 3, nslot_ = gridDim.x >> 3, RY_ = (NY) >> 3; \
    for (int li = slot_; li < (NX) * RY_; li += nslot_) { \
        const int cs_ = li / (RY_ * (CW)), rem_ = li - cs_ * (RY_ * (CW)); \
        const int bx = cs_ * (CW) + rem_ % (CW), by = xcd_ + 8 * (rem_ / (CW)); \
        __syncthreads(); CALL; } \
    GRID_SYNC(); } while (0)
#define GWAVE ((int)blockIdx.x * 4 + (opq_tid() >> 6))
#define NWAVE ((int)gridDim.x * 4)

__device__ __forceinline__ L0Bufs make_l0(char* wsb) {
    L0Bufs LB;
    LB.q = (bf16_t*)wsb;
    LB.kcr = (bf16_t*)(wsb + 33554432);
    LB.vcr = LB.kcr + (size_t)TTOK * 256;
    LB.ks = LB.vcr + (size_t)TTOK * 256;
    LB.vst = LB.ks + (size_t)TTOK * 256;
    LB.kw = LB.vst + (size_t)TTOK * 256;
    LB.vwt = LB.kw + (size_t)TTOK * 256;
    LB.gates = (float*)(LB.vwt + (size_t)TTOK * 256);
    LB.hidc = (bf16_t*)(wsb + 92274688);
    char* regC = wsb + (size_t)160 * 1048576;
    LB.kc = (bf16_t*)regC;
    LB.vct = (bf16_t*)(regC + 524288);
    LB.bias1 = (float*)(regC + 1048576);
    return LB;
}
__device__ __forceinline__ L1Bufs make_l1(char* wsb) {
    L1Bufs B;
    B.q = (bf16_t*)wsb;
    B.k = (bf16_t*)(wsb + 33554432);
    B.vt = B.k + (size_t)TTOK * 256;
    B.kmpart = (float*)(wsb + (size_t)160 * 1048576 + 5245440);
    return B;
}
#define WS_RLOG(wsb) ((float*)((wsb) + 92274688))
#define WS_QCTR(wsb) ((int*)((wsb) + (size_t)160 * 1048576 + 5586944))
#define WS_CNT(wsb) ((int*)((wsb) + (size_t)160 * 1048576 + 5570560))
#define WS_LSLOT(wsb) ((int*)((wsb) + (size_t)160 * 1048576 + 1051136))
#define WS_LW(wsb) ((float*)((wsb) + (size_t)160 * 1048576 + 3148288))
#define WS_PJ(wsb) ((bf16_t*)((wsb) + (size_t)64 * 1048576))
#define WS_SSQ(wsb) ((float*)((wsb) + (size_t)160 * 1048576 + 6815744))
#define WS_XA(wsb) ((bf16_t*)((wsb) + (size_t)96 * 1048576))
#define WS_XB(wsb) ((bf16_t*)((wsb) + (size_t)128 * 1048576))

__device__ __forceinline__ void ph_prologue() {
    char* smem = g_smem;
    const PPtr pp = PP();
    char* wsb = (char*)pp->ws;
    int base = 0;
    for (int j = 0; j < 17; ++j) {
        if (j >= 11 && j < 14) continue;
        const WJob J = load_job(pp, j);
        if (J.src == nullptr) continue;
        const int cntj = J.batch * (J.Npad >> 6) * (J.K >> 6);
        int first = ((int)blockIdx.x - base) % (int)gridDim.x; if (first < 0) first += gridDim.x;
        for (int it = first; it < cntj; it += gridDim.x) wconv_item(J, it, (float*)smem);
        base += cntj;
    }
    for (int layer = 0; layer < 2; ++layer)
        rw_build(pp->in[21] + (size_t)layer * DM * 4, pp->in[23] + (size_t)layer * DM * 32, pp->in[3] + layer * DM, (float*)pp->jobs[17].dst + (size_t)layer * 1024 * 36,
                 (int)(blockIdx.x * 256 + threadIdx.x), (int)(gridDim.x * 256));
    {
        const float* x = pp->in[0]; bf16_t* XA = WS_XA(wsb);
        for (int row = GWAVE; row < TTOK; row += 4 * NWAVE) rp_rows<false, 4>(x, nullptr, nullptr, XA, row, NWAVE, (TTOK - row + NWAVE - 1) / NWAVE, nullptr);
    }
    if ((int)blockIdx.x >= (int)gridDim.x - 32) {
        const int q = (int)gridDim.x - 1 - (int)blockIdx.x, which = q >> 4, kb = q & 15;
        const float* pos = (which ? pp->in[11] : pp->in[8]) + kb * 128;
        const float* w1 = (which ? pp->in[12] : pp->in[9]) + (size_t)kb * 128 * 256;
        float a = 0.f;
#pragma unroll 16
        for (int kk = 0; kk < 128; ++kk) a += pos[kk] * w1[(size_t)kk * 256 + threadIdx.x];
        WS_RLOG(wsb)[(which * 16 + kb) * 256 + threadIdx.x] = a;
    }
    if (blockIdx.x == 0) { for (int i = threadIdx.x; i < 4 * 8 * 64; i += 256) WS_QCTR(wsb)[i] = 0; for (int i = threadIdx.x; i < 2 * 32 * CNT_STRIDE; i += 256) WS_CNT(wsb)[i] = 0; }
    GRID_SYNC();
}
__device__ __forceinline__ void ph_p1() {
    char* smem = g_smem;
    const PPtr pp = PP(); char* wsb = (char*)pp->ws;
    const L0Bufs LB = make_l0(wsb);
    const bf16_t* XA = WS_XA(wsb); const bf16_t* w = pp->jobs[0].dst; const float* qn = pp->in[6]; const float* kn = pp->in[7];
    if (blockIdx.x < 2) {
        const float* part = WS_RLOG(wsb) + (size_t)blockIdx.x * 16 * 256 + threadIdx.x;
        float a = 0.f;
#pragma unroll
        for (int kb = 0; kb < 16; ++kb) a += part[kb * 256];
        LB.bias1[blockIdx.x * 256 + threadIdx.x] = a;
    }
    PHASE_2D(21, 128, 7, p1_item(XA, w, qn, kn, LB, bx, by, smem));
}
__device__ __forceinline__ void ph_p2a() {
    char* smem = g_smem;
    const PPtr pp = PP(); char* wsb = (char*)pp->ws;
    const L0Bufs LB = make_l0(wsb);
    const bf16_t* wk = pp->jobs[1].dst; const bf16_t* wv = pp->jobs[3].dst;
    const int nb = (int)gridDim.x;
    const bool split = nb > 128;
    if (!split || (int)blockIdx.x < 128) {
        for (int vb = blockIdx.x; vb < 128; vb += split ? 128 : nb) { const int bx = vb; __syncthreads(); p2a_item(LB, (bx >> 6) ? wv : wk, bx >> 6, (bx >> 1) & 31, bx & 1, smem); }
    }
    if (!split || (int)blockIdx.x >= 128) {
        const int wid = split ? (int)blockIdx.x - 128 : (int)blockIdx.x, nw = split ? nb - 128 : nb;
        int base = 0;
        for (int j = 11; j < 14; ++j) {
            const WJob J = load_job(pp, j);
            if (J.src == nullptr) continue;
            const int cntj = J.batch * (J.Npad >> 6) * (J.K >> 6);
            int first = (wid - base) % nw; if (first < 0) first += nw;
            for (int it = first; it < cntj; it += nw) wconv_item(J, it, (float*)smem);
            base += cntj;
        }
    }
    GRID_SYNC();
}
__device__ __forceinline__ void ph_p2b() {
    char* smem = g_smem;
    const PPtr pp = PP(); char* wsb = (char*)pp->ws;
    const L0Bufs LB = make_l0(wsb);
    const bf16_t* wk = pp->jobs[2].dst; const bf16_t* wv = pp->jobs[4].dst; const float* kn = pp->in[7];
    PHASE_1D(64, p2b_item(LB, (bx >> 5) ? wv : wk, kn, bx >> 5, bx & 31, smem));
}
__device__ __forceinline__ void ph_nsa() {
    char* smem = g_smem;
    const PPtr pp = PP(); char* wsb = (char*)pp->ws;
    const L0Bufs LB = make_l0(wsb);
    const float* qn = pp->in[6]; const float* kn = pp->in[7]; bf16_t* XB = WS_XB(wsb); int* qctr = WS_QCTR(wsb);
    int* misc = (int*)(smem + ATT_MISC_OFF);
    const int myx = (int)xb_xcc_id() & 7;
    const int ln_ = threadIdx.x & 63;
    const float gq_ = wave_max(fabsf(qn[ln_]));
    const float m2c = (8.f * gq_ * wave_max(fabsf(kn[ln_])) * 1.02f + 0.5f) * LOG2E;
    const float m2s = (8.f * gq_ * wave_max(fabsf(kn[64 + ln_])) * 1.02f + 0.5f) * LOG2E;
    const float m2w = (8.f * gq_ * wave_max(fabsf(kn[128 + ln_])) * 1.02f + 0.5f) * LOG2E;
    for (int dx = 0; dx < 8; ++dx) {
        const int x = (myx + dx) & 7;
        for (;;) {
            __syncthreads();
            if (threadIdx.x == 0) misc[0] = atomicAdd(&qctr[x * 64], 1);
            __syncthreads();
            const int id = __builtin_amdgcn_readfirstlane(misc[0]);
            if (id >= 256) break;
            nsa_attn_item(LB, m2c, m2s, m2w, XB, x + 8 * (id >> 7), 127 - (id & 127), smem);
        }
    }
    GRID_SYNC();
}
__device__ __forceinline__ void ph_outproj(int layer) {
    char* smem = g_smem;
    const PPtr pp = PP(); char* wsb = (char*)pp->ws;
    const bf16_t* XB = WS_XB(wsb); const bf16_t* w = pp->jobs[layer ? 8 : 5].dst; const float* r = layer ? pp->out : pp->in[0]; float* h = pp->out;
    PHASE_2D(8, 128, 8, (d_gemm<false>(XB, w, (long long)DM, TTOK, DM, DM, EpiResid{r, h, DM}, bx, by, smem)));
}
__device__ __forceinline__ void ph_route(int layer) {
    char* smem = g_smem;
    const PPtr pp = PP(); char* wsb = (char*)pp->ws;
    const float* h = pp->out; bf16_t* XA = WS_XA(wsb);
    const float* wr = (const float*)pp->jobs[17].dst + (size_t)layer * 1024 * 36;
    const float* bgp = pp->in[22] + layer * 4; const float* bep = pp->in[24] + layer * 32;
    int* cntl = WS_CNT(wsb) + layer * 32 * CNT_STRIDE; int* lslot = WS_LSLOT(wsb); float* lw = WS_LW(wsb);
    PHASE_1D(512, route_item(h, XA, wr, bgp, bep, cntl, lslot, lw, bx, smem));
}
__device__ __forceinline__ void ph_moe(int layer) {
    char* smem = g_smem;
    const PPtr pp = PP(); char* wsb = (char*)pp->ws;
    const bf16_t* wgu_l = pp->jobs[11 + 3 * layer].dst;
    const bf16_t* wd_l = pp->jobs[13 + 3 * layer].dst;
    const bf16_t* XA = WS_XA(wsb); bf16_t* ysb = (bf16_t*)wsb;
    const int* cntl = WS_CNT(wsb) + layer * 32 * CNT_STRIDE; const int* lslot = WS_LSLOT(wsb); const float* lw = WS_LW(wsb);
    const int xcd = blockIdx.x & 7, nslot = gridDim.x >> 3;
    int it = blockIdx.x >> 3;
    int q = 0, basei = 0;
    for (;;) {
        int nch = 0, e = 0;
        while (q < 4) { e = xcd + 8 * q; nch = (cntl[e * CNT_STRIDE] + 127) >> 7; if (it < basei + nch) break; basei += nch; ++q; }
        if (q >= 4) break;
        const int chunk = it - basei;
        const int nvalid = min(128, cntl[e * CNT_STRIDE] - chunk * 128);
        __syncthreads();
        moe_item<false>(XA, wgu_l + (size_t)e * 256 * 1024, wd_l + (size_t)e * 1024 * 128, lslot + e * TTOK + chunk * 128, lw + e * TTOK + chunk * 128, nvalid, ysb, smem);
        it += nslot;
    }
    {
        const float* pin = pp->in[1] + (size_t)layer * TTOK * 256; const bf16_t* wp = pp->jobs[10].dst + (size_t)layer * 256 * DM; bf16_t* pj = WS_PJ(wsb);
        int* qp = WS_QCTR(wsb) + 1024 + layer * 512;
        int* misc = (int*)(smem + 73712);
        for (int dx = 0; dx < 8; ++dx) {
            const int x = (xcd + dx) & 7;
            for (;;) {
                __syncthreads();
                if (threadIdx.x == 0) misc[0] = atomicAdd(&qp[x * 64], 1);
                __syncthreads();
                const int id = __builtin_amdgcn_readfirstlane(misc[0]);
                if (id >= 128) break;
                ple_proj_item(pin, wp, pj, id & 7, x + 8 * (id >> 3), smem);
            }
        }
    }
    GRID_SYNC();
}
__device__ __forceinline__ void ph_combine() {
    const PPtr pp = PP(); char* wsb = (char*)pp->ws;
    float* h = pp->out; const bf16_t* ysb = (const bf16_t*)wsb; bf16_t* XB = WS_XB(wsb);
    for (int row = GWAVE; row < TTOK; row += 2 * NWAVE) rp_rows<true, 2>(h, h, ysb, XB, row, NWAVE, (TTOK - row + NWAVE - 1) / NWAVE, nullptr);
    GRID_SYNC();
}
__device__ __forceinline__ void ph_ple(int layer) {
    char* smem = g_smem;
    const PPtr pp = PP(); char* wsb = (char*)pp->ws;
    float* h = pp->out; const bf16_t* XB = WS_XB(wsb);
    const bf16_t* wg = pp->jobs[9].dst + (size_t)layer * DM * DM;
    const bf16_t* pj = WS_PJ(wsb);
    if (layer == 0) {
        bf16_t* XA = WS_XA(wsb); float* ssq = WS_SSQ(wsb);
        PHASE_2D(8, 128, 8, ple_item_l0(XB, wg, pj, h, XA, ssq, bx, by, smem));
    } else {
        PHASE_2D(8, 128, 8, ple_item(XB, wg, pj, h, bx, by, smem));
    }
}
__device__ __forceinline__ void ph_norm() {
    const PPtr pp = PP(); char* wsb = (char*)pp->ws;
    const float* h = pp->out; bf16_t* XA = WS_XA(wsb);
    for (int row = GWAVE; row < TTOK; row += 4 * NWAVE) rp_rows<false, 4>(h, nullptr, nullptr, XA, row, NWAVE, (TTOK - row + NWAVE - 1) / NWAVE, nullptr);
    GRID_SYNC();
}
__device__ __forceinline__ void ph_p7() {
    char* smem = g_smem;
    const PPtr pp = PP(); char* wsb = (char*)pp->ws;
    const L1Bufs L1B = make_l1(wsb);
    const bf16_t* XA = WS_XA(wsb); const bf16_t* w = pp->jobs[6].dst; const float* qn = pp->in[19]; const float* kn = pp->in[17];
    const float* ssq = WS_SSQ(wsb);
    PHASE_2D(12, 128, 6, p7_item(XA, ssq, w, qn, kn, L1B, bx, by, smem));
}
__device__ __forceinline__ void ph_moba() {
    char* smem = g_smem;
    const PPtr pp = PP(); char* wsb = (char*)pp->ws;
    const L1Bufs L1B = make_l1(wsb);
    const float* qn = pp->in[19]; const float* kn = pp->in[17]; bf16_t* XB = WS_XB(wsb); int* qctr = WS_QCTR(wsb);
    int* misc = (int*)(smem + ATT_MISC_OFF);
    const int myx = (int)xb_xcc_id() & 7;
    for (int dx = 0; dx < 8; ++dx) {
        const int x = (myx + dx) & 7;
        for (;;) {
            __syncthreads();
            if (threadIdx.x == 0) misc[0] = atomicAdd(&qctr[512 + x * 64], 1);
            __syncthreads();
            const int id = __builtin_amdgcn_readfirstlane(misc[0]);
            if (id >= 256) break;
            moba_attn_item(L1B, qn, kn, XB, x + 8 * (id >> 7), 127 - (id & 127), smem);
        }
    }
    GRID_SYNC();
}

#ifndef PROBE_PHASE
#define PROBE_PHASE -1
#endif
#define PH(id, CALL) do { if (PROBE_PHASE == (id) && blockIdx.x == 0) pt0 = __builtin_amdgcn_s_memrealtime(); CALL; if (PROBE_PHASE == (id) && blockIdx.x == 0) pt1 = __builtin_amdgcn_s_memrealtime(); } while (0)

__global__ void __launch_bounds__(256, 2) mega(Params Pdummy) {
    if (threadIdx.x == 0) *(uint4*)(g_smem + 73728) = make_uint4(0u, 0u, 0u, 0u);
    __syncthreads();
    if (threadIdx.x == 0) (void)xb_add(&((unsigned*)((char*)PP()->ws + (size_t)166 * 1048576))[XB_XCNT(xb_xcc_id())], 1u);
    unsigned long long pt0 = 0ull, pt1 = 0ull;
    PH(0, ph_prologue());
    PH(1, ph_p1());
    PH(2, { ph_p2a(); ph_p2b(); });
    PH(3, ph_nsa());
    PH(4, ph_outproj(0));
    PH(5, ph_route(0));
    PH(6, ph_moe(0));
    PH(7, ph_combine());
    PH(8, ph_ple(0));
    PH(11, ph_p7());
    PH(12, ph_moba());
    PH(13, ph_outproj(1));
    PH(15, ph_route(1));
    PH(16, ph_moe(1));
    PH(17, ph_combine());
    PH(18, ph_ple(1));
    if (PROBE_PHASE >= 0 && blockIdx.x == 0) {
        const unsigned long long span = pt1 - pt0, t2 = __builtin_amdgcn_s_memrealtime();
        while (__builtin_amdgcn_s_memrealtime() - t2 < span) __builtin_amdgcn_s_sleep(16);
    }
}

extern "C" void kernel_launch(void* const* d_in, const int* in_sizes, int n_in, void* d_out, int out_size, void* d_ws, size_t ws_size, hipStream_t stream) {
    static int grid_blocks = 0;
    if (!grid_blocks) {
        int dev = 0, cus = 0, per_cu = 0;
        (void)hipGetDevice(&dev);
        (void)hipDeviceGetAttribute(&cus, hipDeviceAttributeMultiprocessorCount, dev);
        (void)hipOccupancyMaxActiveBlocksPerMultiprocessor(&per_cu, (const void*)mega, 256, 0);
        if (per_cu < 1) per_cu = 1;
        if (per_cu > 2) per_cu = 2;
        grid_blocks = cus * per_cu;
    }
    Params P{};
    for (int i = 0; i < 30; ++i) P.in[i] = (const float*)d_in[i];
    P.out = (float*)d_out;
    P.ws = (float*)d_ws;
    {
        size_t off = (size_t)168 * 1048576;
        char* wbase = (char*)d_ws + off;
        size_t wo = 0;
        auto add = [&](int j, const void* src, int K, int N, int Npad, int batch, const float* gain) {
            WJob& J = P.jobs[j];
            J.src = (const float*)src; J.dst = (bf16_t*)(wbase + wo); J.gain = gain;
            J.sbs = (long long)K * N; J.dbs = (long long)Npad * K; J.K = K; J.N = N; J.Npad = Npad; J.batch = batch; J.perm = 0; J.gbs = 0;
            wo += (size_t)batch * Npad * K * 2;
        };
        add(0, d_in[5], 1024, 2608, 2688, 1, (const float*)d_in[2]);
        add(1, d_in[9], 2048, 256, 256, 1, nullptr);
        add(2, d_in[10], 256, 64, 128, 1, nullptr);
        add(3, d_in[12], 2048, 256, 256, 1, nullptr);
        add(4, d_in[13], 256, 64, 128, 1, nullptr);
        add(5, d_in[14], 1024, 1024, 1024, 1, nullptr);
        add(6, d_in[16], 1024, 512, 512, 1, (const float*)d_in[15]);
        add(7, d_in[18], 1024, 1024, 1024, 1, (const float*)d_in[2] + 1024);
        add(8, d_in[20], 1024, 1024, 1024, 1, nullptr);
        add(9, d_in[29], 1024, 1024, 1024, 2, (const float*)d_in[4]); P.jobs[9].gbs = 1024;
        add(10, d_in[28], 256, 1024, 1024, 2, nullptr);
        for (int layer = 0; layer < 2; ++layer) {
            WJob& G = P.jobs[11 + 3 * layer]; WJob& U = P.jobs[12 + 3 * layer];
            G.src = (const float*)d_in[25] + (size_t)layer * 32 * 1024 * 128; G.dst = (bf16_t*)(wbase + wo); G.gain = (const float*)d_in[3] + layer * 1024;
            G.sbs = 1024 * 128; G.dbs = 256 * 1024; G.K = 1024; G.N = 128; G.Npad = 128; G.batch = 32; G.perm = 1; G.gbs = 0;
            U = G; U.src = (const float*)d_in[26] + (size_t)layer * 32 * 1024 * 128; U.perm = 2;
            wo += (size_t)32 * 256 * 1024 * 2;
            add(13 + 3 * layer, (const float*)d_in[27] + (size_t)layer * 32 * 128 * 1024, 128, 1024, 1024, 32, nullptr);
        }
        P.jobs[17].dst = (bf16_t*)(wbase + wo); wo += (size_t)2 * 128 * 3072 * 2;
        if (off + wo > ws_size) { fprintf(stderr, "workspace too small: need %zu have %zu\n", off + wo, ws_size); return; }
    }
    (void)hipMemsetAsync((char*)d_ws + (size_t)166 * 1048576, 0, XCD_BAR_WORDS * 4, stream);
    void* args[] = {&P};
    hipError_t e = hipLaunchCooperativeKernel((const void*)mega, dim3(grid_blocks), dim3(256), args, 0, stream);
    if (e != hipSuccess) fprintf(stderr, "cooperative launch failed: %s (grid %d)\n", hipGetErrorString(e), grid_blocks);
}
```

```cpp
#include <hip/hip_runtime.h>
#include <hip/hip_cooperative_groups.h>
namespace cg = cooperative_groups;
#include <stdint.h>
#include <math.h>
#include <stdio.h>

#define SEQ 4096
#define BATCH 4
#define TTOK 16384
#define DM 1024
#define NPROJ 2608
#define NCMP 255

#define C_Q 0
#define C_KC 1024
#define C_VC 1280
#define C_KS 1536
#define C_VS 1792
#define C_KW 2048
#define C_VW 2304
#define C_GL 2560

template <int M> __device__ __forceinline__ float fx(float v) { return __int_as_float(__builtin_amdgcn_ds_swizzle(__float_as_int(v), (M << 10) | 0x1f)); }
template <int M> __device__ __forceinline__ unsigned ux(unsigned v) { return (unsigned)__builtin_amdgcn_ds_swizzle((int)v, (M << 10) | 0x1f); }
__device__ __forceinline__ float sum32(float v) { const auto r = __builtin_amdgcn_permlane32_swap(__float_as_uint(v), __float_as_uint(v), false, false); return __uint_as_float(r[0]) + __uint_as_float(r[1]); }
__device__ __forceinline__ float max32(float v) { const auto r = __builtin_amdgcn_permlane32_swap(__float_as_uint(v), __float_as_uint(v), false, false); return fmaxf(__uint_as_float(r[0]), __uint_as_float(r[1])); }
__device__ __forceinline__ unsigned or32(unsigned v) { const auto r = __builtin_amdgcn_permlane32_swap(v, v, false, false); return r[0] | r[1]; }
__device__ __forceinline__ float sum_lo32(float v) { v += fx<1>(v); v += fx<2>(v); v += fx<4>(v); v += fx<8>(v); v += fx<16>(v); return v; }
__device__ __forceinline__ unsigned or_lo32(unsigned v) { v |= ux<1>(v); v |= ux<2>(v); v |= ux<4>(v); v |= ux<8>(v); v |= ux<16>(v); return v; }
__device__ __forceinline__ float wave_sum(float v) { return sum32(sum_lo32(v)); }
__device__ __forceinline__ int opq_tid() { int t = threadIdx.x; asm volatile("" : "+v"(t)); return t; }
__device__ __forceinline__ float gelu_tanh(float x) {
    const float c = 0.7978845608028654f;
    float u = c * (x + 0.044715f * x * x * x);
    return 0.5f * x * (1.f + tanhf(u));
}
__device__ __forceinline__ float sigm(float x) { return 1.f / (1.f + expf(-x)); }

typedef unsigned short bf16_t;
typedef float f32x16 __attribute__((ext_vector_type(16)));
typedef __bf16 bf16x8 __attribute__((ext_vector_type(8)));
typedef __bf16 bf16x2 __attribute__((ext_vector_type(2)));
__device__ __forceinline__ unsigned pk2(float lo, float hi) { bf16x2 v = {(__bf16)lo, (__bf16)hi}; return __builtin_bit_cast(unsigned, v); }
__device__ __forceinline__ uint4 pack8(float4 a, float4 b) { uint4 r; r.x = pk2(a.x, a.y); r.y = pk2(a.z, a.w); r.z = pk2(b.x, b.y); r.w = pk2(b.z, b.w); return r; }

__device__ __forceinline__ float bf16_lo_f(unsigned u) { return __uint_as_float(u << 16); }
__device__ __forceinline__ float bf16_hi_f(unsigned u) { return __uint_as_float(u & 0xffff0000u); }
#define LDS_ROW 144
#define TILE_BYTES (128 * LDS_ROW)

template <bool A_F32, class AFn>
__device__ __forceinline__ void gemm_core(AFn afn, const bf16_t* __restrict__ Wt, int ldw, int n0, int K, char* smem, f32x16 (&acc)[2][2]) {
    const int tid = opq_tid(), lane = tid & 63, wave = tid >> 6;
    const int wn = wave >> 1, wm = wave & 1;
    const int sr = tid >> 3, sc = tid & 7;
    const int c = lane & 31, h = lane >> 5;
    struct Stage { uint4 x0, x1, x2, x3, w0, w1, w2, w3; };
#pragma unroll
    for (int i = 0; i < 2; ++i)
#pragma unroll
        for (int j = 0; j < 2; ++j)
#pragma unroll
            for (int r = 0; r < 16; ++r) acc[i][j][r] = 0.f;
    auto loadx = [&](int i, int k0) -> uint4 {
        const int r = sr + 32 * i;
        if (A_F32) {
            const float* p = (const float*)afn(i, r, k0);
            if (p) { float4 f0 = *(const float4*)(p + sc * 8); float4 f1 = *(const float4*)(p + sc * 8 + 4); return pack8(f0, f1); }
            return make_uint4(0u, 0u, 0u, 0u);
        } else {
            const bf16_t* p = (const bf16_t*)afn(i, r, k0);
            return p ? *(const uint4*)(p + sc * 8) : make_uint4(0u, 0u, 0u, 0u);
        }
    };
    auto load = [&](int k0) -> Stage {
        Stage S;
        S.x0 = loadx(0, k0); S.x1 = loadx(1, k0); S.x2 = loadx(2, k0); S.x3 = loadx(3, k0);
        const bf16_t* wp = Wt + (size_t)(n0 + sr) * ldw + k0 + sc * 8;
        S.w0 = *(const uint4*)wp; S.w1 = *(const uint4*)(wp + (size_t)32 * ldw); S.w2 = *(const uint4*)(wp + (size_t)64 * ldw); S.w3 = *(const uint4*)(wp + (size_t)96 * ldw);
        return S;
    };
    auto store = [&](const Stage S, int buf) {
        char* xb = smem + buf * 2 * TILE_BYTES + sr * LDS_ROW + sc * 16; char* wb = xb + TILE_BYTES;
        *(uint4*)xb = S.x0; *(uint4*)(xb + 32 * LDS_ROW) = S.x1; *(uint4*)(xb + 64 * LDS_ROW) = S.x2; *(uint4*)(xb + 96 * LDS_ROW) = S.x3;
        *(uint4*)wb = S.w0; *(uint4*)(wb + 32 * LDS_ROW) = S.w1; *(uint4*)(wb + 64 * LDS_ROW) = S.w2; *(uint4*)(wb + 96 * LDS_ROW) = S.w3;
    };
    auto compute = [&](int buf) {
        const char* xb = smem + buf * 2 * TILE_BYTES; const char* wb = xb + TILE_BYTES;
        const char* wp0 = wb + (wn * 64 + c) * LDS_ROW + h * 16;
        const char* xp0 = xb + (wm * 64 + c) * LDS_ROW + h * 16;
        bf16x8 wfa0 = *(const bf16x8*)(wp0), wfa1 = *(const bf16x8*)(wp0 + 32 * LDS_ROW), xfa0 = *(const bf16x8*)(xp0), xfa1 = *(const bf16x8*)(xp0 + 32 * LDS_ROW);
#pragma unroll
        for (int ks = 0; ks < 4; ++ks) {
            bf16x8 wfb0, wfb1, xfb0, xfb1;
            if (ks < 3) {
                wfb0 = *(const bf16x8*)(wp0 + (ks + 1) * 32); wfb1 = *(const bf16x8*)(wp0 + 32 * LDS_ROW + (ks + 1) * 32);
                xfb0 = *(const bf16x8*)(xp0 + (ks + 1) * 32); xfb1 = *(const bf16x8*)(xp0 + 32 * LDS_ROW + (ks + 1) * 32);
            }
            acc[0][0] = __builtin_amdgcn_mfma_f32_32x32x16_bf16(wfa0, xfa0, acc[0][0], 0, 0, 0);
            acc[0][1] = __builtin_amdgcn_mfma_f32_32x32x16_bf16(wfa0, xfa1, acc[0][1], 0, 0, 0);
            acc[1][0] = __builtin_amdgcn_mfma_f32_32x32x16_bf16(wfa1, xfa0, acc[1][0], 0, 0, 0);
            acc[1][1] = __builtin_amdgcn_mfma_f32_32x32x16_bf16(wfa1, xfa1, acc[1][1], 0, 0, 0);
            __builtin_amdgcn_sched_barrier(0);
            if (ks < 3) { wfa0 = wfb0; wfa1 = wfb1; xfa0 = xfb0; xfa1 = xfb1; }
        }
    };
    const int nk = K >> 6;
    Stage S0 = load(0), S1 = S0;
    if (nk > 1) S1 = load(64);
    store(S0, 0);
    __syncthreads();
    for (int kt = 0; kt < nk; kt += 2) {
        if (kt + 2 < nk) S0 = load((kt + 2) * 64);
        compute(0);
        if (kt + 1 < nk) store(S1, 1);
        __syncthreads();
        if (kt + 1 >= nk) break;
        if (kt + 3 < nk) S1 = load((kt + 3) * 64);
        compute(1);
        if (kt + 2 < nk) store(S0, 0);
        __syncthreads();
    }
}
#define GT_BYTES 16384
template <class AOff>
__device__ __forceinline__ void gemm_core_glds(const void* abase, AOff aoff, unsigned akstep, const bf16_t* __restrict__ Wt, int ldw, int n0, int K, char* smem, f32x16 (&acc)[2][2]) {
    const int tid = opq_tid(), lane = tid & 63, wave = tid >> 6;
    const int wn = wave >> 1, wm = wave & 1;
    const int sr = tid >> 3, sc = tid & 7;
    const int c = lane & 31, h = lane >> 5;
#pragma unroll
    for (int i = 0; i < 2; ++i)
#pragma unroll
        for (int j = 0; j < 2; ++j)
#pragma unroll
            for (int r = 0; r < 16; ++r) acc[i][j][r] = 0.f;
    const __amdgpu_buffer_rsrc_t rA = __builtin_amdgcn_make_buffer_rsrc((void*)abase, 0, 0x7fffffff, 0x00020000);
    const __amdgpu_buffer_rsrc_t rW = __builtin_amdgcn_make_buffer_rsrc((void*)Wt, 0, 0x7fffffff, 0x00020000);
    const unsigned cs16 = (unsigned)(sc ^ ((sr >> 1) & 7)) * 16u;
    const unsigned xo0 = aoff(0, sr) + cs16, xo1 = aoff(1, sr + 32) + cs16, xo2 = aoff(2, sr + 64) + cs16, xo3 = aoff(3, sr + 96) + cs16;
    const unsigned wo0 = (unsigned)(n0 + sr) * (unsigned)ldw * 2u + cs16, wst = 32u * (unsigned)ldw * 2u;
    auto issue = [&](int kt, int buf) {
        char* xb = smem + buf * 2 * GT_BYTES + 8 * wave * 128; char* wb = xb + GT_BYTES;
        const unsigned ak = (unsigned)kt * akstep, wk = (unsigned)kt * 128u;
#define GLDS(rs, dst, voff, soff) __builtin_amdgcn_raw_ptr_buffer_load_lds(rs, (__attribute__((address_space(3))) void*)(dst), 16, voff, soff, 0, 0)
        GLDS(rA, xb, xo0, ak); GLDS(rW, wb, wo0, wk);
        GLDS(rA, xb + 32 * 128, xo1, ak); GLDS(rW, wb + 32 * 128, wo0 + wst, wk);
        GLDS(rA, xb + 64 * 128, xo2, ak); GLDS(rW, wb + 64 * 128, wo0 + 2 * wst, wk);
        GLDS(rA, xb + 96 * 128, xo3, ak); GLDS(rW, wb + 96 * 128, wo0 + 3 * wst, wk);
#undef GLDS
    };
    auto compute = [&](int buf) {
        const char* xb = smem + buf * 2 * GT_BYTES; const char* wb = xb + GT_BYTES;
        const int rw0 = wn * 64 + c, rx0 = wm * 64 + c;
        const int kw = (rw0 >> 1) & 7, kx = (rx0 >> 1) & 7;
        const char* wp0 = wb + rw0 * 128; const char* xp0 = xb + rx0 * 128;
#define FRAG(base, key, ks) (*(const bf16x8*)((base) + (((2 * (ks) + h) ^ (key)) << 4)))
        bf16x8 wfa0 = FRAG(wp0, kw, 0), wfa1 = FRAG(wp0 + 32 * 128, kw, 0), xfa0 = FRAG(xp0, kx, 0), xfa1 = FRAG(xp0 + 32 * 128, kx, 0);
#pragma unroll
        for (int ks = 0; ks < 4; ++ks) {
            bf16x8 wfb0, wfb1, xfb0, xfb1;
            if (ks < 3) { wfb0 = FRAG(wp0, kw, ks + 1); wfb1 = FRAG(wp0 + 32 * 128, kw, ks + 1); xfb0 = FRAG(xp0, kx, ks + 1); xfb1 = FRAG(xp0 + 32 * 128, kx, ks + 1); }
            acc[0][0] = __builtin_amdgcn_mfma_f32_32x32x16_bf16(wfa0, xfa0, acc[0][0], 0, 0, 0);
            acc[0][1] = __builtin_amdgcn_mfma_f32_32x32x16_bf16(wfa0, xfa1, acc[0][1], 0, 0, 0);
            acc[1][0] = __builtin_amdgcn_mfma_f32_32x32x16_bf16(wfa1, xfa0, acc[1][0], 0, 0, 0);
            acc[1][1] = __builtin_amdgcn_mfma_f32_32x32x16_bf16(wfa1, xfa1, acc[1][1], 0, 0, 0);
            __builtin_amdgcn_sched_barrier(0);
            if (ks < 3) { wfa0 = wfb0; wfa1 = wfb1; xfa0 = xfb0; xfa1 = xfb1; }
        }
#undef FRAG
    };
    const int nk = K >> 6;
    issue(0, 0);
    __syncthreads();
    for (int kt = 0; kt < nk; ++kt) {
        if (kt + 1 < nk) issue(kt + 1, (kt + 1) & 1);
        compute(kt & 1);
        __syncthreads();
    }
}
template <class F>
__device__ __forceinline__ void epi_foreach(const f32x16 (&acc)[2][2], int m0, int n0, F f) {
    const int tid_ = opq_tid(), lane = tid_ & 63, wave = tid_ >> 6;
    const int wn = wave >> 1, wm = wave & 1, c = lane & 31, h = lane >> 5;
#pragma unroll
    for (int i = 0; i < 2; ++i)
#pragma unroll
        for (int j = 0; j < 2; ++j)
#pragma unroll
            for (int q = 0; q < 4; ++q) {
                const int n = n0 + wn * 64 + 32 * i + 8 * q + 4 * h, m = m0 + wm * 64 + 32 * j + c;
                f(m, n, make_float4(acc[i][j][4 * q], acc[i][j][4 * q + 1], acc[i][j][4 * q + 2], acc[i][j][4 * q + 3]));
            }
}
struct EpiStore { float* C; long long ldc; __device__ void operator()(int r, int c, float4 v) const { *(float4*)(C + (size_t)r * ldc + c) = v; } };
struct EpiGelu { float* C; long long ldc; __device__ void operator()(int r, int c, float4 v) const { *(float4*)(C + (size_t)r * ldc + c) = make_float4(gelu_tanh(v.x), gelu_tanh(v.y), gelu_tanh(v.z), gelu_tanh(v.w)); } };
struct EpiSigm { float* C; long long ldc; __device__ void operator()(int r, int c, float4 v) const { *(float4*)(C + (size_t)r * ldc + c) = make_float4(sigm(v.x), sigm(v.y), sigm(v.z), sigm(v.w)); } };
struct EpiResid { const float* R; float* C; long long ldc; __device__ void operator()(int r, int c, float4 v) const { float4 a = *(const float4*)(R + (size_t)r * ldc + c); *(float4*)(C + (size_t)r * ldc + c) = make_float4(a.x + v.x, a.y + v.y, a.z + v.z, a.w + v.w); } };
struct EpiPle { const float* G; float* H; long long ldc; __device__ void operator()(int r, int c, float4 v) const { float4 g = *(const float4*)(G + (size_t)r * ldc + c); float4 a = *(const float4*)(H + (size_t)r * ldc + c); *(float4*)(H + (size_t)r * ldc + c) = make_float4(a.x + g.x * v.x, a.y + g.y * v.y, a.z + g.z * v.z, a.w + g.w * v.w); } };

template <bool A_F32, class Epi>
__device__ __forceinline__ void d_gemm(const void* __restrict__ A, const bf16_t* __restrict__ Wt, long long lda, int M, int N, int K, Epi epi, int bx, int by, char* smem) {
    const int m0 = by * 128, n0 = bx * 128;
    f32x16 acc[2][2];
    if constexpr (A_F32) {
        gemm_core<true>([&](int i, int r, int k0) -> const void* {
            if (m0 + r >= M) return nullptr;
            return (const void*)((const float*)A + (size_t)(m0 + r) * lda + k0); }, Wt, K, n0, K, smem, acc);
    } else {
        gemm_core_glds(A, [&](int i, int r) -> unsigned {
            const int rr = (m0 + r < M) ? (m0 + r) : 0;
            return (unsigned)rr * (unsigned)lda * 2u; }, 128u, Wt, K, n0, K, smem, acc);
    }
    epi_foreach(acc, m0, n0, [&](int m, int n, float4 v) { if (m < M && n < N) epi(m, n, v); });
}

struct WJob { const float* src; bf16_t* dst; const float* gain; long long sbs, dbs; int K, N, Npad, batch, perm, gbs; };
#define NJOBS 20
__device__ __forceinline__ void wconv_item(const WJob& J, int item, float* lds) {
    const int tid = opq_tid(), lane = tid & 63;
    const int nt = J.Npad >> 6, kt = J.K >> 6;
    const int bi = item / (nt * kt), rem = item % (nt * kt), kb = rem / nt, nb = rem % nt;
    const float* W = J.src + (size_t)bi * J.sbs;
    bf16_t* D = J.dst + (size_t)bi * J.dbs;
    const int k0 = kb * 64, n0 = nb * 64;
    __syncthreads();
    {
        float vv[16];
        const int n = n0 + lane;
#pragma unroll
        for (int p = 0; p < 16; ++p) {
            const int k = p * 4 + (tid >> 6);
            vv[p] = (n < J.N) ? W[(size_t)(k0 + k) * J.N + n] : 0.f;
        }
        if (J.gain) {
#pragma unroll
            for (int p = 0; p < 16; ++p) vv[p] *= J.gain[(size_t)bi * J.gbs + k0 + p * 4 + (tid >> 6)];
        }
#pragma unroll
        for (int p = 0; p < 16; ++p) lds[(p * 4 + (tid >> 6)) * 65 + lane] = vv[p];
    }
    __syncthreads();
    const int n = tid >> 2, kq = (tid & 3) * 16;
    float f[16];
#pragma unroll
    for (int i = 0; i < 16; ++i) f[i] = lds[(kq + i) * 65 + n];
    uint4 o0, o1;
    o0.x = pk2(f[0], f[1]); o0.y = pk2(f[2], f[3]); o0.z = pk2(f[4], f[5]); o0.w = pk2(f[6], f[7]);
    o1.x = pk2(f[8], f[9]); o1.y = pk2(f[10], f[11]); o1.z = pk2(f[12], f[13]); o1.w = pk2(f[14], f[15]);
    int drow = n0 + n;
    if (J.perm) drow = (drow >> 5) * 64 + (J.perm - 1) * 32 + (drow & 31);
    uint4* dp = (uint4*)(D + (size_t)drow * J.K + k0 + kq);
    dp[0] = o0; dp[1] = o1;
}

#define LOG2E 1.4426950408889634f
#define CNT_STRIDE 64
struct L0Bufs { bf16_t *q, *kcr, *vcr, *ks, *vst, *kw, *vwt; float* gates; bf16_t *hidc, *kc, *vct; float* bias1; };

__device__ __forceinline__ float wave_max(float v) { v = fmaxf(v, fx<1>(v)); v = fmaxf(v, fx<2>(v)); v = fmaxf(v, fx<4>(v)); v = fmaxf(v, fx<8>(v)); v = fmaxf(v, fx<16>(v)); return max32(v); }

__device__ __forceinline__ void p1_item(const bf16_t* __restrict__ xn, const bf16_t* __restrict__ t_w_in, const float* __restrict__ qn, const float* __restrict__ kn,
                                        const L0Bufs& B, int bx, int by, char* smem) {
    const int m0 = by * 128, n0 = bx * 128;
    f32x16 acc[2][2];
    gemm_core_glds(xn, [&](int i, int r) -> unsigned { return (unsigned)(m0 + r) * (DM * 2u); }, 128u, t_w_in, DM, n0, DM, smem, acc);
    const int tid_ = opq_tid(), lane = tid_ & 63, wave = tid_ >> 6;
    const int wn = wave >> 1, wm = wave & 1, c = lane & 31, h = lane >> 5;
    const int ch = (n0 >> 6) + wn;
#pragma unroll
    for (int j = 0; j < 2; ++j) {
        const int m = m0 + wm * 64 + 32 * j + c;
        const int b = m >> 12, t = m & 4095;
        if (ch < 16 || (ch >= 24 && ch < 28) || (ch >= 32 && ch < 36)) {
            float ss = 0.f;
#pragma unroll
            for (int i = 0; i < 2; ++i)
#pragma unroll
                for (int r = 0; r < 16; ++r) ss += acc[i][j][r] * acc[i][j][r];
            ss = sum32(ss);
            float rs = rsqrtf(ss * (1.f / 64.f) + 1e-6f);
            const float* g; bf16_t* dst;
            if (ch < 16) { g = qn; rs *= 0.125f * LOG2E; dst = B.q + (size_t)m * 1024 + ch * 64; }
            else if (ch < 28) { g = kn + 64; dst = B.ks + (size_t)m * 256 + (ch - 24) * 64; }
            else { g = kn + 128; dst = B.kw + (size_t)m * 256 + (ch - 32) * 64; }
#pragma unroll
            for (int i = 0; i < 2; ++i)
#pragma unroll
                for (int q4 = 0; q4 < 4; ++q4) {
                    const int nl = 32 * i + 8 * q4 + 4 * h;
                    const float4 gg = *(const float4*)(g + nl);
                    uint2 o;
                    o.x = pk2(acc[i][j][4 * q4] * rs * gg.x, acc[i][j][4 * q4 + 1] * rs * gg.y);
                    o.y = pk2(acc[i][j][4 * q4 + 2] * rs * gg.z, acc[i][j][4 * q4 + 3] * rs * gg.w);
                    *(uint2*)(dst + nl) = o;
                }
        } else if (ch >= 16 && ch < 24) {
            bf16_t* dst = (ch < 20) ? (B.kcr + (size_t)m * 256 + (ch - 16) * 64) : (B.vcr + (size_t)m * 256 + (ch - 20) * 64);
#pragma unroll
            for (int i = 0; i < 2; ++i)
#pragma unroll
                for (int q4 = 0; q4 < 4; ++q4) {
                    const int nl = 32 * i + 8 * q4 + 4 * h;
                    uint2 o;
                    o.x = pk2(acc[i][j][4 * q4], acc[i][j][4 * q4 + 1]);
                    o.y = pk2(acc[i][j][4 * q4 + 2], acc[i][j][4 * q4 + 3]);
                    *(uint2*)(dst + nl) = o;
                }
        } else if ((ch >= 28 && ch < 32) || (ch >= 36 && ch < 40)) {
            const int g = (ch < 32) ? (ch - 28) : (ch - 36);
            bf16_t* dst = ((ch < 32) ? B.vst : B.vwt) + ((size_t)(b * 4 + g) * 64) * SEQ + t;
#pragma unroll
            for (int i = 0; i < 2; ++i)
#pragma unroll
                for (int r = 0; r < 16; ++r) {
                    const int d = 32 * i + (r & 3) + 8 * (r >> 2) + 4 * h;
                    dst[(size_t)d * SEQ] = (bf16_t)(pk2(acc[i][j][r], 0.f) & 0xffffu);
                }
        } else if (ch == 40) {
#pragma unroll
            for (int i = 0; i < 2; ++i)
#pragma unroll
                for (int q4 = 0; q4 < 4; ++q4) {
                    const int nl = 32 * i + 8 * q4 + 4 * h;
                    if (nl < 48) *(float4*)(B.gates + (size_t)m * 48 + nl) = make_float4(sigm(acc[i][j][4 * q4]), sigm(acc[i][j][4 * q4 + 1]), sigm(acc[i][j][4 * q4 + 2]), sigm(acc[i][j][4 * q4 + 3]));
                }
        }
    }
}

__device__ __forceinline__ void p2a_item(const L0Bufs& B, const bf16_t* __restrict__ w1t, int which, int mt, int nt, char* smem) {
    const bf16_t* raw = which ? B.vcr : B.kcr;
    const int sr = opq_tid() >> 3;
    auto rowoff = [&](int i) -> unsigned {
        const int m = mt * 128 + sr + 32 * i;
        if (m >= 4080) return 0u;
        const int bg = m / NCMP, n = m - bg * NCMP;
        return (unsigned)(((bg >> 2) * SEQ + 16 * n) * 256 + (bg & 3) * 64) * 2u;
    };
    const unsigned ro0 = rowoff(0), ro1 = rowoff(1), ro2 = rowoff(2), ro3 = rowoff(3);
    f32x16 acc[2][2];
    gemm_core_glds(raw, [&](int i, int r) -> unsigned { return (i == 0) ? ro0 : (i == 1) ? ro1 : (i == 2) ? ro2 : ro3; }, 512u, w1t, 2048, nt * 128, 2048, smem, acc);
    const float* bias = B.bias1 + which * 256;
    bf16_t* hid = B.hidc + (size_t)which * 4096 * 256;
    epi_foreach(acc, mt * 128, nt * 128, [&](int m, int n, float4 v) {
        const float4 bb = *(const float4*)(bias + n);
        uint2 o; o.x = pk2(gelu_tanh(v.x + bb.x), gelu_tanh(v.y + bb.y)); o.y = pk2(gelu_tanh(v.z + bb.z), gelu_tanh(v.w + bb.w));
        *(uint2*)(hid + (size_t)m * 256 + n) = o;
    });
}
__device__ __forceinline__ void p2b_item(const L0Bufs& B, const bf16_t* __restrict__ w2t, const float* __restrict__ kn, int which, int mt, char* smem) {
    const bf16_t* hid = B.hidc + (size_t)which * 4096 * 256;
    f32x16 acc[2][2];
    gemm_core_glds(hid, [&](int i, int r) -> unsigned { return (unsigned)(mt * 128 + r) * 512u; }, 128u, w2t, 256, 0, 256, smem, acc);
    const int tid_ = opq_tid(), lane = tid_ & 63, wave = tid_ >> 6;
    const int wn = wave >> 1, wm = wave & 1, c = lane & 31, h = lane >> 5;
    if (wn != 0) return;
#pragma unroll
    for (int j = 0; j < 2; ++j) {
        const int m = mt * 128 + wm * 64 + 32 * j + c;
        const bool ok = m < 4080;
        const int bg = m / NCMP, n = m - bg * NCMP;
        if (which == 0) {
            float ss = 0.f;
#pragma unroll
            for (int i = 0; i < 2; ++i)
#pragma unroll
                for (int r = 0; r < 16; ++r) ss += acc[i][j][r] * acc[i][j][r];
            ss = sum32(ss);
            const float rs = rsqrtf(ss * (1.f / 64.f) + 1e-6f);
            if (ok) {
                bf16_t* dst = B.kc + ((size_t)bg * 256 + n) * 64;
#pragma unroll
                for (int i = 0; i < 2; ++i)
#pragma unroll
                    for (int q4 = 0; q4 < 4; ++q4) {
                        const int nl = 32 * i + 8 * q4 + 4 * h;
                        const float4 gg = *(const float4*)(kn + nl);
                        uint2 o;
                        o.x = pk2(acc[i][j][4 * q4] * rs * gg.x, acc[i][j][4 * q4 + 1] * rs * gg.y);
                        o.y = pk2(acc[i][j][4 * q4 + 2] * rs * gg.z, acc[i][j][4 * q4 + 3] * rs * gg.w);
                        *(uint2*)(dst + nl) = o;
                    }
            }
        } else if (ok) {
            bf16_t* dst = B.vct + ((size_t)bg * 64) * 256 + n;
#pragma unroll
            for (int i = 0; i < 2; ++i)
#pragma unroll
                for (int r = 0; r < 16; ++r) {
                    const int d = 32 * i + (r & 3) + 8 * (r >> 2) + 4 * h;
                    dst[(size_t)d * 256] = (bf16_t)(pk2(acc[i][j][r], 0.f) & 0xffffu);
                }
        }
    }
}

#define KROW 144
#define VROW 136
#define KT_BYTES (64 * KROW)
#define ABUF (KT_BYTES + 64 * VROW)
#define ATT_IMP_OFF (2 * ABUF)
#define ATT_MASK_OFF (ATT_IMP_OFF + 4 * 32 * 65 * 4)
#define ATT_MISC_OFF (ATT_MASK_OFF + 32 * 8)

struct KVRegs { uint4 k0, k1, v0, v1; };
typedef unsigned int u32x4 __attribute__((ext_vector_type(4)));
__device__ __forceinline__ uint4 bload16(__amdgpu_buffer_rsrc_t r, unsigned voff, unsigned soff) { const u32x4 v = __builtin_amdgcn_raw_buffer_load_b128(r, voff, soff, 0); return make_uint4(v.x, v.y, v.z, v.w); }
__device__ __forceinline__ KVRegs attn_load_tile(__amdgpu_buffer_rsrc_t rK, __amdgpu_buffer_rsrc_t rV, unsigned koff, unsigned voff, int kstride, int j) {
    KVRegs R;
    const unsigned ks = (unsigned)j * 128u * (unsigned)kstride, vs = (unsigned)j * 128u;
    R.k0 = bload16(rK, koff, ks); R.k1 = bload16(rK, koff + 16u, ks);
    R.v0 = bload16(rV, voff, vs); R.v1 = bload16(rV, voff + 16u, vs);
    return R;
}
__device__ __forceinline__ void attn_store_tile(char* buf, const KVRegs R, int tid) {
    const int row = tid >> 2, cq = tid & 3;
    char* kd = buf + row * KROW + cq * 32;
    *(uint4*)kd = R.k0; *(uint4*)(kd + 16) = R.k1;
    char* vd = buf + KT_BYTES + row * VROW + cq * 32;
    *(uint2*)vd = make_uint2(R.v0.x, R.v0.y); *(uint2*)(vd + 8) = make_uint2(R.v0.z, R.v0.w);
    *(uint2*)(vd + 16) = make_uint2(R.v1.x, R.v1.y); *(uint2*)(vd + 24) = make_uint2(R.v1.z, R.v1.w);
}
template <bool AUG>
__device__ __forceinline__ void attn_qk(const char* buf, const bf16x8 (&qf)[4], f32x16 (&st)[2], int tid, const bf16x8 (&kaug)[2], const bf16x8 qaug) {
    const int lane = tid & 63, cl = lane & 31, hh = lane >> 5;
    const char* kp = buf + cl * KROW + hh * 16;
    const bf16x8 k00 = *(const bf16x8*)(kp), k01 = *(const bf16x8*)(kp + 32), k02 = *(const bf16x8*)(kp + 64), k03 = *(const bf16x8*)(kp + 96);
    const bf16x8 k10 = *(const bf16x8*)(kp + 32 * KROW), k11 = *(const bf16x8*)(kp + 32 * KROW + 32), k12 = *(const bf16x8*)(kp + 32 * KROW + 64), k13 = *(const bf16x8*)(kp + 32 * KROW + 96);
    __builtin_amdgcn_sched_barrier(0);
#pragma unroll
    for (int r = 0; r < 16; ++r) { st[0][r] = 0.f; st[1][r] = 0.f; }
    st[0] = __builtin_amdgcn_mfma_f32_32x32x16_bf16(k00, qf[0], st[0], 0, 0, 0);
    st[1] = __builtin_amdgcn_mfma_f32_32x32x16_bf16(k10, qf[0], st[1], 0, 0, 0);
    st[0] = __builtin_amdgcn_mfma_f32_32x32x16_bf16(k01, qf[1], st[0], 0, 0, 0);
    st[1] = __builtin_amdgcn_mfma_f32_32x32x16_bf16(k11, qf[1], st[1], 0, 0, 0);
    st[0] = __builtin_amdgcn_mfma_f32_32x32x16_bf16(k02, qf[2], st[0], 0, 0, 0);
    st[1] = __builtin_amdgcn_mfma_f32_32x32x16_bf16(k12, qf[2], st[1], 0, 0, 0);
    st[0] = __builtin_amdgcn_mfma_f32_32x32x16_bf16(k03, qf[3], st[0], 0, 0, 0);
    st[1] = __builtin_amdgcn_mfma_f32_32x32x16_bf16(k13, qf[3], st[1], 0, 0, 0);
    if (AUG) {
        st[0] = __builtin_amdgcn_mfma_f32_32x32x16_bf16(kaug[0], qaug, st[0], 0, 0, 0);
        st[1] = __builtin_amdgcn_mfma_f32_32x32x16_bf16(kaug[1], qaug, st[1], 0, 0, 0);
    }
}
template <bool MASKED, int PSC>
__device__ __forceinline__ void attn_exp(f32x16 (&st)[2], bf16x8 (&pf)[2][2], int pos0, int tq, int wlim, float& l) {
    float l0 = 0.f, l1 = 0.f;
#pragma unroll
    for (int i = 0; i < 2; ++i) {
#pragma unroll
        for (int r = 0; r < 16; ++r) {
            float e = st[i][r];
            if (MASKED) { const int kl = 32 * i + (r & 3) + 8 * (r >> 2); const int dist = tq - (pos0 + PSC * kl); e = (dist >= 0 && dist < wlim) ? e : -INFINITY; }
            const float p = __builtin_amdgcn_exp2f(e);
            if (r & 1) l1 += p; else l0 += p;
            st[i][r] = p;
        }
#pragma unroll
        for (int s = 0; s < 2; ++s) {
            uint4 u;
            u.x = pk2(st[i][8 * s + 0], st[i][8 * s + 1]); u.y = pk2(st[i][8 * s + 2], st[i][8 * s + 3]);
            u.z = pk2(st[i][8 * s + 4], st[i][8 * s + 5]); u.w = pk2(st[i][8 * s + 6], st[i][8 * s + 7]);
            pf[i][s] = __builtin_bit_cast(bf16x8, u);
        }
    }
    l += l0 + l1;
}
struct VFrags { uint2 a[8]; };
__device__ __forceinline__ bf16x8 vjoin(uint2 v0, uint2 v1) { return __builtin_bit_cast(bf16x8, make_uint4(v0.x, v0.y, v1.x, v1.y)); }
#define VADDR(buf, dt, i, s) ((buf) + KT_BYTES + (32 * (dt) + cl) * VROW + (32 * (i) + 16 * (s) + 4 * hh) * 2)
__device__ __forceinline__ void attn_pv(const char* buf, const bf16x8 (&pf)[2][2], f32x16 (&ot)[2], int tid) {
    const int lane = tid & 63, cl = lane & 31, hh = lane >> 5;
    const char* a00 = VADDR(buf, 0, 0, 0);
    const uint2 p0 = *(const uint2*)(a00), p1 = *(const uint2*)(a00 + 16), p2 = *(const uint2*)(a00 + 32), p3 = *(const uint2*)(a00 + 48);
    const uint2 p4 = *(const uint2*)(a00 + 64), p5 = *(const uint2*)(a00 + 80), p6 = *(const uint2*)(a00 + 96), p7 = *(const uint2*)(a00 + 112);
    const char* a10 = a00 + 32 * VROW;
    const uint2 q0 = *(const uint2*)(a10), q1 = *(const uint2*)(a10 + 16), q2 = *(const uint2*)(a10 + 32), q3 = *(const uint2*)(a10 + 48);
    const uint2 q4 = *(const uint2*)(a10 + 64), q5 = *(const uint2*)(a10 + 80), q6 = *(const uint2*)(a10 + 96), q7 = *(const uint2*)(a10 + 112);
    __builtin_amdgcn_sched_barrier(0);
    ot[0] = __builtin_amdgcn_mfma_f32_32x32x16_bf16(vjoin(p0, p1), pf[0][0], ot[0], 0, 0, 0);
    ot[1] = __builtin_amdgcn_mfma_f32_32x32x16_bf16(vjoin(q0, q1), pf[0][0], ot[1], 0, 0, 0);
    ot[0] = __builtin_amdgcn_mfma_f32_32x32x16_bf16(vjoin(p2, p3), pf[0][1], ot[0], 0, 0, 0);
    ot[1] = __builtin_amdgcn_mfma_f32_32x32x16_bf16(vjoin(q2, q3), pf[0][1], ot[1], 0, 0, 0);
    ot[0] = __builtin_amdgcn_mfma_f32_32x32x16_bf16(vjoin(p4, p5), pf[1][0], ot[0], 0, 0, 0);
    ot[1] = __builtin_amdgcn_mfma_f32_32x32x16_bf16(vjoin(q4, q5), pf[1][0], ot[1], 0, 0, 0);
    ot[0] = __builtin_amdgcn_mfma_f32_32x32x16_bf16(vjoin(p6, p7), pf[1][1], ot[0], 0, 0, 0);
    ot[1] = __builtin_amdgcn_mfma_f32_32x32x16_bf16(vjoin(q6, q7), pf[1][1], ot[1], 0, 0, 0);
}

template <int PSC, int POFF>
__device__ __forceinline__ void attn_branch(const bf16_t* SK, const bf16_t* SVT, int kstride, int vstride, unsigned long long tiles, unsigned long long maskbits, unsigned long long lane_mask,
                                            const bf16x8 (&qf)[4], float slope2, float tb0, int tq, int wlim, char* smem, f32x16 (&ot)[2], float& l, int tid) {
    const int hh = (tid & 63) >> 5;
#pragma unroll
    for (int dt = 0; dt < 2; ++dt)
#pragma unroll
        for (int r = 0; r < 16; ++r) ot[dt][r] = 0.f;
    l = 0.f;
    if (tiles == 0ull) return;
    const __amdgpu_buffer_rsrc_t rK = __builtin_amdgcn_make_buffer_rsrc((void*)SK, 0, 0x7fffffff, 0x00020000);
    const __amdgpu_buffer_rsrc_t rV = __builtin_amdgcn_make_buffer_rsrc((void*)SVT, 0, 0x7fffffff, 0x00020000);
    const unsigned koff = (((unsigned)tid >> 2) * (unsigned)kstride + ((unsigned)tid & 3) * 16u) * 2u, voff = (((unsigned)tid >> 2) * (unsigned)vstride + ((unsigned)tid & 3) * 16u) * 2u;
    bf16x8 kaug[2];
    const float sk = slope2 * (float)PSC;
    const unsigned s_hi = pk2(sk, 0.f) & 0xffffu, s_lo = pk2(sk - bf16_lo_f(s_hi), 0.f) & 0xffffu;
    {
        const int cl = tid & 31;
#pragma unroll
        for (int i = 0; i < 2; ++i) {
            const float klf = (float)(32 * i + cl);
            uint4 u = make_uint4(pk2(klf, klf), 0x3f803f80u, 0x00003f80u, 0u);
            if (hh) u = make_uint4(0u, 0u, 0u, 0u);
            kaug[i] = __builtin_bit_cast(bf16x8, u);
        }
    }
    auto compute = [&](const char* buf, int j) {
        f32x16 st[2]; bf16x8 pf[2][2];
        const float t = fmaf(slope2, (float)(PSC * 64 * j + POFF), tb0);
        const bool on = (lane_mask >> j) & 1ull;
        const unsigned t_hi = on ? (pk2(t, 0.f) & 0xffffu) : 0xff80u;
        const float r1 = on ? (t - bf16_lo_f(t_hi)) : 0.f;
        const unsigned t_lo = pk2(r1, 0.f) & 0xffffu;
        const unsigned t_l2 = pk2(r1 - bf16_lo_f(t_lo), 0.f) & 0xffffu;
        uint4 qu = make_uint4(s_hi | (s_lo << 16), t_hi | (t_lo << 16), t_l2, 0u);
        if (hh) qu = make_uint4(0u, 0u, 0u, 0u);
        attn_qk<true>(buf, qf, st, tid, kaug, __builtin_bit_cast(bf16x8, qu));
        const int pos0 = PSC * (64 * j + 4 * hh) + POFF;
        if ((maskbits >> j) & 1ull) attn_exp<true, PSC>(st, pf, pos0, tq, wlim, l);
        else attn_exp<false, PSC>(st, pf, pos0, tq, wlim, l);
        attn_pv(buf, pf, ot, tid);
    };
    int j = __builtin_ctzll(tiles); tiles &= tiles - 1;
    KVRegs R = attn_load_tile(rK, rV, koff, voff, kstride, j);
    __syncthreads();
    attn_store_tile(smem, R, tid);
    __syncthreads();
    int cur = 0;
    for (;;) {
        const bool more = tiles != 0ull;
        int jn = 0;
        if (more) { jn = __builtin_ctzll(tiles); tiles &= tiles - 1; R = attn_load_tile(rK, rV, koff, voff, kstride, jn); }
        compute(smem + cur * ABUF, j);
        if (more) attn_store_tile(smem + (cur ^ 1) * ABUF, R, tid);
        __syncthreads();
        if (!more) break;
        j = jn; cur ^= 1;
    }
}

__device__ __forceinline__ void nsa_attn_item(const L0Bufs& B, float m2c, float m2s, float m2w, bf16_t* __restrict__ att, int bg, int qb, char* smem) {
    const int tid = opq_tid();
    const int lane = tid & 63, wave = tid >> 6, cl = lane & 31, hh = lane >> 5;
    const int b = bg >> 2, g = bg & 3, hd = g * 4 + wave;
    const int t0 = qb * 32, c = qb >> 1, tq = t0 + cl;
    const float slope2 = exp2f(-0.5f * (float)(hd + 1)) * LOG2E;
    float* imp = (float*)(smem + ATT_IMP_OFF);
    uint2* msk = (uint2*)(smem + ATT_MASK_OFF);
    bf16x8 qf[4];
    {
        const bf16_t* qp = B.q + (size_t)(b * SEQ + tq) * 1024 + hd * 64 + 8 * hh;
#pragma unroll
        for (int ks = 0; ks < 4; ++ks) qf[ks] = *(const bf16x8*)(qp + ks * 16);
    }
#define NSA_GATE(idx, dep) ({ int t_ = threadIdx.x; asm volatile("" : "+v"(t_) : "v"(dep)); B.gates[(size_t)(b * SEQ + t0 + (t_ & 31)) * 48 + (g * 4 + (t_ >> 6)) * 3 + (idx)]; })
    f32x16 res[2], ot[2];
    float l;
    for (int e = tid; e < 4 * 32 * 65; e += 256) imp[e] = 0.f;
    const int ntc = (qb >> 5) + 1;
    const unsigned long long ctiles = (1ull << ntc) - 1ull;
    const bf16_t* SCK = B.kc + (size_t)bg * 256 * 64;
    const bf16_t* SCV = B.vct + (size_t)bg * 64 * 256;
    const float tbc = -(slope2 * (float)tq) - m2c;
    attn_branch<16, 31>(SCK, SCV, 64, 256, ctiles, ctiles, ~0ull, qf, slope2, tbc, tq, 1 << 30, smem, ot, l, tid);
    const float lc = sum32(l);
    const float invc = (lc > 0.f) ? 1.f / lc : 0.f;
    {
        const float f = NSA_GATE(0, invc) * invc;
#pragma unroll
        for (int dt = 0; dt < 2; ++dt)
#pragma unroll
            for (int r = 0; r < 16; ++r) res[dt][r] = ot[dt][r] * f;
    }
    {
        float* row = imp + wave * (32 * 65) + cl * 65;
        for (int jt = 0; jt < ntc; ++jt) {
            {
                const int rowi = tid >> 2, cq = tid & 3;
                const bf16_t* kp = SCK + (size_t)(jt * 64 + rowi) * 64 + cq * 16;
                const uint4 ka = *(const uint4*)kp, kb = *(const uint4*)(kp + 8);
                __syncthreads();
                char* kd = smem + rowi * KROW + cq * 32;
                *(uint4*)kd = ka; *(uint4*)(kd + 16) = kb;
                __syncthreads();
            }
            f32x16 st[2];
            { bf16x8 kz[2]; kz[0] = __builtin_bit_cast(bf16x8, make_uint4(0u, 0u, 0u, 0u)); kz[1] = kz[0]; attn_qk<false>(smem, qf, st, tid, kz, kz[0]); }
            const int pos0 = 16 * (64 * jt + 4 * hh) + 31;
            const float tb = fmaf(slope2, (float)pos0, tbc);
#pragma unroll
            for (int i = 0; i < 2; ++i)
#pragma unroll
                for (int gq4 = 0; gq4 < 4; ++gq4) {
                    float p[4];
#pragma unroll
                    for (int e4 = 0; e4 < 4; ++e4) {
                        const int r = 4 * gq4 + e4;
                        const int kl = 32 * i + (r & 3) + 8 * (r >> 2);
                        float e = fmaf(slope2 * 16.f, (float)kl, st[i][r]) + tb;
                        e = (tq - (pos0 + 16 * kl) >= 0) ? e : -INFINITY;
                        p[e4] = __builtin_amdgcn_exp2f(e) * invc;
                    }
                    const int js = 16 * jt + 8 * i + 2 * gq4 + hh;
                    row[js] += p[0] + p[1] + p[2] + 0.5f * p[3];
                    st[i][4 * gq4] = 0.5f * p[3];
                }
            __builtin_amdgcn_s_waitcnt(0xc07f);
#pragma unroll
            for (int i = 0; i < 2; ++i)
#pragma unroll
                for (int gq4 = 0; gq4 < 4; ++gq4) { const int js = 16 * jt + 8 * i + 2 * gq4 + hh; row[js + 1] += st[i][4 * gq4]; }
        }
    }
    __syncthreads();
    {
        const int q = tid >> 3, part = tid & 7;
        const float* row = imp + q * 65;
        auto impv = [&](int j) -> float { return ((row[j] + row[j + 32 * 65]) + row[j + 2 * 32 * 65]) + row[j + 3 * 32 * 65]; };
        float myv[8]; int rank[8];
#pragma unroll
        for (int u = 0; u < 8; ++u) { const int j = part * 8 + u; const bool f = (j == 0) || (j == c) || (j == c - 1); myv[u] = f ? 1e9f : impv(j); rank[u] = 0; }
        for (int j2 = 0; j2 <= c; ++j2) {
            const bool f2 = (j2 == 0) || (j2 == c) || (j2 == c - 1);
            const float v2 = f2 ? 1e9f : impv(j2);
#pragma unroll
            for (int u = 0; u < 8; ++u) { const int j = part * 8 + u; rank[u] += (v2 > myv[u] || (v2 == myv[u] && j2 < j)) ? 1 : 0; }
        }
        unsigned bits = 0u;
#pragma unroll
        for (int u = 0; u < 8; ++u) { const int j = part * 8 + u; if (j <= c && rank[u] < 16) bits |= 1u << u; }
        unsigned lo = (part < 4) ? (bits << (8 * part)) : 0u, hi = (part >= 4) ? (bits << (8 * (part - 4))) : 0u;
        lo |= ux<1>(lo); lo |= ux<2>(lo); lo |= ux<4>(lo); hi |= ux<1>(hi); hi |= ux<2>(hi); hi |= ux<4>(hi);
        if (part == 0) msk[q] = make_uint2(lo, hi);
    }
    __syncthreads();
    const uint2 mm = msk[cl];
    const unsigned long long mymask = (unsigned long long)mm.x | ((unsigned long long)mm.y << 32);
    const unsigned ulo = or_lo32(mm.x), uhi = or_lo32(mm.y);
    const unsigned long long U = (unsigned long long)__builtin_amdgcn_readfirstlane(ulo) | ((unsigned long long)__builtin_amdgcn_readfirstlane(uhi) << 32);
    {
        const float tbs = -(slope2 * (float)tq) - m2s;
        attn_branch<1, 0>(B.ks + (size_t)(b * SEQ) * 256 + g * 64, B.vst + (size_t)bg * 64 * SEQ, 256, SEQ, U, 1ull << c, mymask, qf, slope2, tbs, tq, 1 << 30, smem, ot, l, tid);
        const float ls = sum32(l);
        const float f = NSA_GATE(1, ls) / ls;
#pragma unroll
        for (int dt = 0; dt < 2; ++dt)
#pragma unroll
            for (int r = 0; r < 16; ++r) res[dt][r] += ot[dt][r] * f;
    }
    {
        const float tbw = -(slope2 * (float)tq) - m2w;
        const int lo_pos = t0 - 511;
        const int jlo = lo_pos > 0 ? (lo_pos >> 6) : 0;
        unsigned long long wt = 0ull, wm = 0ull;
        for (int j = jlo; j <= c; ++j) { wt |= 1ull << j; if (j == c || 64 * j < t0 + 31 - 511) wm |= 1ull << j; }
        attn_branch<1, 0>(B.kw + (size_t)(b * SEQ) * 256 + g * 64, B.vwt + (size_t)bg * 64 * SEQ, 256, SEQ, wt, wm, ~0ull, qf, slope2, tbw, tq, 512, smem, ot, l, tid);
        const float lw_ = sum32(l);
        const float f = NSA_GATE(2, lw_) / lw_;
#pragma unroll
        for (int dt = 0; dt < 2; ++dt)
#pragma unroll
            for (int r = 0; r < 16; ++r) res[dt][r] += ot[dt][r] * f;
    }
    {
        const int tid2 = opq_tid();
        bf16_t* dst = att + (size_t)(b * SEQ + t0 + (tid2 & 31)) * 1024 + (g * 4 + (tid2 >> 6)) * 64;
#pragma unroll
        for (int dt = 0; dt < 2; ++dt)
#pragma unroll
            for (int q4 = 0; q4 < 4; ++q4) {
                const int d = 32 * dt + 8 * q4 + 4 * hh;
                uint2 o; o.x = pk2(res[dt][4 * q4], res[dt][4 * q4 + 1]); o.y = pk2(res[dt][4 * q4 + 2], res[dt][4 * q4 + 3]);
                *(uint2*)(dst + d) = o;
            }
    }
}


template <bool COMBINE, int R>
__device__ __forceinline__ void rp_rows(const float* __restrict__ in, float* __restrict__ hw, const bf16_t* __restrict__ ys, bf16_t* __restrict__ hi, int row0, int rstride, int nrows_valid, float* rs_out) {
    const int lane = opq_tid() & 63;
    float4 v[R][4]; float ss[R];
#pragma unroll
    for (int r = 0; r < R; ++r) {
        const size_t row = (size_t)(row0 + r * rstride);
        ss[r] = 0.f;
        if (r < nrows_valid) {
#pragma unroll
            for (int i = 0; i < 4; ++i) v[r][i] = ((const float4*)(in + row * DM))[lane + 64 * i];
        }
    }
    if (COMBINE) {
#pragma unroll
        for (int r = 0; r < R; ++r) {
            const size_t row = (size_t)(row0 + r * rstride);
            if (r < nrows_valid) {
#pragma unroll
                for (int i = 0; i < 4; ++i) {
                    const uint2 b = ((const uint2*)(ys + row * 2 * DM))[lane + 64 * i], c = ((const uint2*)(ys + row * 2 * DM + DM))[lane + 64 * i];
                    float4 a = v[r][i];
                    a.x += bf16_lo_f(b.x) + bf16_lo_f(c.x); a.y += bf16_hi_f(b.x) + bf16_hi_f(c.x);
                    a.z += bf16_lo_f(b.y) + bf16_lo_f(c.y); a.w += bf16_hi_f(b.y) + bf16_hi_f(c.y);
                    v[r][i] = a;
                    ((float4*)(hw + row * DM))[lane + 64 * i] = a;
                }
            }
        }
    }
#pragma unroll
    for (int r = 0; r < R; ++r) {
        if (r < nrows_valid) {
#pragma unroll
            for (int i = 0; i < 4; ++i) ss[r] += v[r][i].x * v[r][i].x + v[r][i].y * v[r][i].y + v[r][i].z * v[r][i].z + v[r][i].w * v[r][i].w;
        }
    }
#pragma unroll
    for (int r = 0; r < R; ++r) ss[r] = wave_sum(ss[r]);
#pragma unroll
    for (int r = 0; r < R; ++r) {
        const size_t row = (size_t)(row0 + r * rstride);
        if (r < nrows_valid) {
            const float rr = rsqrtf(ss[r] * (1.f / DM) + 1e-6f);
            if (rs_out && lane == 0) rs_out[r] = rr;
#pragma unroll
            for (int i = 0; i < 4; ++i) {
                uint2 o; o.x = pk2(v[r][i].x * rr, v[r][i].y * rr); o.y = pk2(v[r][i].z * rr, v[r][i].w * rr);
                ((uint2*)(hi + row * DM))[lane + 64 * i] = o;
            }
        }
    }
}

__device__ __forceinline__ void rw_build(const float* __restrict__ wg, const float* __restrict__ we, const float* __restrict__ gain, float* __restrict__ dst, int start, int stride) {
    for (int idx = start; idx < 1024 * 36; idx += stride) {
        const int k = idx / 36, n = idx - k * 36;
        dst[idx] = ((n < 4) ? wg[k * 4 + n] : we[k * 32 + (n - 4)]) * gain[k];
    }
}
struct RouteSel { int x1, x2; float w1, w2; };
__device__ __forceinline__ RouteSel route_select(const float (&lg)[36], const float* __restrict__ bgp, const float* __restrict__ bep) {
    float gl[4];
#pragma unroll
    for (int i = 0; i < 4; ++i) gl[i] = lg[i] + bgp[i];
    int gi = 0; float gm = gl[0];
#pragma unroll
    for (int i = 1; i < 4; ++i) if (gl[i] > gm) { gm = gl[i]; gi = i; }
    float gs = 0.f;
#pragma unroll
    for (int i = 0; i < 4; ++i) gs += expf(gl[i] - gm);
    const float gw = 1.f / gs;
    float el[8];
#pragma unroll
    for (int e = 0; e < 8; ++e) {
        float v = 0.f;
#pragma unroll
        for (int gg = 0; gg < 4; ++gg) v = (gg == gi) ? (lg[4 + gg * 8 + e] + bep[gg * 8 + e]) : v;
        el[e] = v;
    }
    int e1 = 0; float m1 = el[0];
#pragma unroll
    for (int e = 1; e < 8; ++e) if (el[e] > m1) { m1 = el[e]; e1 = e; }
    int e2 = -1; float m2 = -INFINITY;
#pragma unroll
    for (int e = 0; e < 8; ++e) if (e != e1 && el[e] > m2) { m2 = el[e]; e2 = e; }
    const float p2 = expf(m2 - m1);
    RouteSel R;
    R.w1 = gw / (1.f + p2); R.w2 = gw * p2 / (1.f + p2);
    R.x1 = gi * 8 + e1; R.x2 = gi * 8 + e2;
    return R;
}
__device__ __forceinline__ void route_item(const float* __restrict__ h, bf16_t* __restrict__ xhi, const float* __restrict__ wr32,
                                           const float* __restrict__ bgp, const float* __restrict__ bep,
                                           int* __restrict__ cnt, int* __restrict__ lslot, float* __restrict__ lw, int it, char* smem) {
    const int tid = opq_tid(), wave = tid >> 6, lane = tid & 63;
    const int m0 = it * 32;
    float* wch = (float*)smem;
    float* rs = (float*)(smem + 36864);
    rp_rows<false, 4>(h, nullptr, nullptr, xhi, m0 + wave * 8, 1, 4, rs + wave * 8);
    rp_rows<false, 4>(h, nullptr, nullptr, xhi, m0 + wave * 8 + 4, 1, 4, rs + wave * 8 + 4);
    const int tp = tid >> 4, part = tid & 15;
    float a0[36], a1[36];
#pragma unroll
    for (int n = 0; n < 36; ++n) { a0[n] = 0.f; a1[n] = 0.f; }
    float* xch = (float*)(smem + 36864 + 128);
    for (int ch = 0; ch < 4; ++ch) {
        __syncthreads();
#pragma unroll
        for (int i = 0; i < 9; ++i) ((float4*)wch)[tid + 256 * i] = ((const float4*)(wr32 + (size_t)ch * 256 * 36))[tid + 256 * i];
#pragma unroll
        for (int i = 0; i < 8; ++i) { const int e = tid + 256 * i, r = e >> 6, c4 = e & 63; *(float4*)(xch + r * 260 + c4 * 4) = *(const float4*)(h + (size_t)(m0 + r) * DM + ch * 256 + c4 * 4); }
        __syncthreads();
        const float* xr0 = xch + (2 * tp) * 260 + part;
#pragma unroll 2
        for (int kk = 0; kk < 16; ++kk) {
            const float v0 = xr0[kk * 16], v1 = xr0[260 + kk * 16];
            const float4* wrow = (const float4*)(wch + (kk * 16 + part) * 36);
#pragma unroll
            for (int q = 0; q < 9; ++q) {
                const float4 w = wrow[q];
                a0[4 * q] += v0 * w.x; a0[4 * q + 1] += v0 * w.y; a0[4 * q + 2] += v0 * w.z; a0[4 * q + 3] += v0 * w.w;
                a1[4 * q] += v1 * w.x; a1[4 * q + 1] += v1 * w.y; a1[4 * q + 2] += v1 * w.z; a1[4 * q + 3] += v1 * w.w;
            }
        }
    }
    const float r0 = rs[2 * tp], r1 = rs[2 * tp + 1];
#pragma unroll
    for (int n = 0; n < 36; ++n) {
        float s0 = a0[n], s1 = a1[n];
        s0 += fx<1>(s0); s0 += fx<2>(s0); s0 += fx<4>(s0); s0 += fx<8>(s0);
        s1 += fx<1>(s1); s1 += fx<2>(s1); s1 += fx<4>(s1); s1 += fx<8>(s1);
        a0[n] = s0 * r0; a1[n] = s1 * r1;
    }
    if (part == 0) {
        const RouteSel A = route_select(a0, bgp, bep), B = route_select(a1, bgp, bep);
        const int t = m0 + 2 * tp;
        const int pa1 = atomicAdd(&cnt[A.x1 * CNT_STRIDE], 1), pa2 = atomicAdd(&cnt[A.x2 * CNT_STRIDE], 1);
        const int pb1 = atomicAdd(&cnt[B.x1 * CNT_STRIDE], 1), pb2 = atomicAdd(&cnt[B.x2 * CNT_STRIDE], 1);
        lslot[A.x1 * TTOK + pa1] = t * 2;     lw[A.x1 * TTOK + pa1] = A.w1;
        lslot[A.x2 * TTOK + pa2] = t * 2 + 1; lw[A.x2 * TTOK + pa2] = A.w2;
        lslot[B.x1 * TTOK + pb1] = t * 2 + 2; lw[B.x1 * TTOK + pb1] = B.w1;
        lslot[B.x2 * TTOK + pb2] = t * 2 + 3; lw[B.x2 * TTOK + pb2] = B.w2;
    }
}

struct EpiStoreB { bf16_t* C; long long ldc; __device__ void operator()(int r, int c, float4 v) const { uint2 o; o.x = pk2(v.x, v.y); o.y = pk2(v.z, v.w); *(uint2*)(C + (size_t)r * ldc + c) = o; } };
struct EpiPleB { const bf16_t* Pj; float* H; long long ldc; __device__ void operator()(int r, int c, float4 v) const {
    const uint2 p = *(const uint2*)(Pj + (size_t)r * ldc + c); float4 a = *(const float4*)(H + (size_t)r * ldc + c);
    a.x += bf16_lo_f(p.x) / (1.f + __expf(-v.x)); a.y += bf16_hi_f(p.x) / (1.f + __expf(-v.y)); a.z += bf16_lo_f(p.y) / (1.f + __expf(-v.z)); a.w += bf16_hi_f(p.y) / (1.f + __expf(-v.w));
    *(float4*)(H + (size_t)r * ldc + c) = a; } };
__device__ __forceinline__ void ple_proj_item(const float* __restrict__ pin, const bf16_t* __restrict__ wp, bf16_t* __restrict__ pj, int bx, int by, char* smem) {
    d_gemm<true>(pin, wp, 256, TTOK, DM, 256, EpiStoreB{pj, DM}, bx, by, smem);
}
__device__ __forceinline__ void ple_item(const bf16_t* __restrict__ xhat, const bf16_t* __restrict__ wg, const bf16_t* __restrict__ pj, float* __restrict__ h, int bx, int by, char* smem) {
    d_gemm<false>(xhat, wg, DM, TTOK, DM, DM, EpiPleB{pj, h, DM}, bx, by, smem);
}
__device__ __forceinline__ void ple_item_l0(const bf16_t* __restrict__ xhat, const bf16_t* __restrict__ wg, const bf16_t* __restrict__ pj, float* __restrict__ h,
                                            bf16_t* __restrict__ hb, float* __restrict__ ssq, int bx, int by, char* smem) {
    const int m0 = by * 128, n0 = bx * 128;
    f32x16 acc[2][2];
    gemm_core_glds(xhat, [&](int i, int r) -> unsigned { return (unsigned)(m0 + r) * (DM * 2u); }, 128u, wg, DM, n0, DM, smem, acc);
    const int tid_ = opq_tid(), lane = tid_ & 63, wave = tid_ >> 6;
    const int wn = wave >> 1, wm = wave & 1, c = lane & 31, hh = lane >> 5;
#pragma unroll
    for (int j = 0; j < 2; ++j) {
        const int m = m0 + wm * 64 + 32 * j + c;
        float ss = 0.f;
#pragma unroll
        for (int i = 0; i < 2; ++i)
#pragma unroll
            for (int q4 = 0; q4 < 4; ++q4) {
                const int n = n0 + wn * 64 + 32 * i + 8 * q4 + 4 * hh;
                const uint2 p = *(const uint2*)(pj + (size_t)m * DM + n);
                float4 a = *(const float4*)(h + (size_t)m * DM + n);
                a.x += bf16_lo_f(p.x) / (1.f + __expf(-acc[i][j][4 * q4])); a.y += bf16_hi_f(p.x) / (1.f + __expf(-acc[i][j][4 * q4 + 1]));
                a.z += bf16_lo_f(p.y) / (1.f + __expf(-acc[i][j][4 * q4 + 2])); a.w += bf16_hi_f(p.y) / (1.f + __expf(-acc[i][j][4 * q4 + 3]));
                *(float4*)(h + (size_t)m * DM + n) = a;
                uint2 o; o.x = pk2(a.x, a.y); o.y = pk2(a.z, a.w);
                *(uint2*)(hb + (size_t)m * DM + n) = o;
                const float b0 = bf16_lo_f(o.x), b1 = bf16_hi_f(o.x), b2 = bf16_lo_f(o.y), b3 = bf16_hi_f(o.y);
                ss += b0 * b0 + b1 * b1 + b2 * b2 + b3 * b3;
            }
        ss = sum32(ss);
        if (hh == 0) ssq[(size_t)m * 16 + bx * 2 + wn] = ss;
    }
}

#define HROW 272
#define MOE_W_OFF 36864
template <bool A_F32>
__device__ __forceinline__ void moe_item(const void* __restrict__ xn, const bf16_t* __restrict__ wgu, const bf16_t* __restrict__ wd,
                                         const int* __restrict__ slots, const float* __restrict__ wts, int nvalid, bf16_t* __restrict__ ys, char* smem) {
    const int tid = opq_tid(), lane = tid & 63, wave = tid >> 6;
    const int wn = wave >> 1, wm = wave & 1, c = lane & 31, h = lane >> 5;
    const int sr = tid >> 3, sc = tid & 7;
    auto rowo = [&](int i) -> unsigned {
        const int idx = sr + 32 * i;
        if (idx >= nvalid) return 0u;
        return (unsigned)(slots[idx] >> 1) * 2048u;
    };
    const unsigned ro0 = rowo(0), ro1 = rowo(1), ro2 = rowo(2), ro3 = rowo(3);
    float cw[2]; int myslot[2];
#pragma unroll
    for (int j = 0; j < 2; ++j) {
        const int idx = wm * 64 + 32 * j + c;
        const bool ok = idx < nvalid;
        cw[j] = ok ? wts[idx] : 0.f;
        myslot[j] = ok ? slots[idx] : -1;
    }
    unsigned hp[2][2][8];
#pragma unroll
    for (int pass = 0; pass < 2; ++pass) {
        f32x16 acc[2][2];
        static_assert(!A_F32, "the expert GEMM streams bf16 rows straight into LDS");
        gemm_core_glds(xn, [&](int i, int r) -> unsigned { return (i == 0) ? ro0 : (i == 1) ? ro1 : (i == 2) ? ro2 : ro3; }, 128u, wgu, 1024, pass * 128, 1024, smem, acc);
#pragma unroll
        for (int j = 0; j < 2; ++j)
#pragma unroll
            for (int r2 = 0; r2 < 8; ++r2) {
                const float g0 = acc[0][j][2 * r2], g1 = acc[0][j][2 * r2 + 1];
                const float u0 = acc[1][j][2 * r2], u1 = acc[1][j][2 * r2 + 1];
                const float h0 = g0 / (1.f + __expf(-g0)) * u0 * cw[j], h1 = g1 / (1.f + __expf(-g1)) * u1 * cw[j];
                hp[pass][j][r2] = pk2(h0, h1);
            }
    }
#pragma unroll
    for (int pass = 0; pass < 2; ++pass)
#pragma unroll
        for (int j = 0; j < 2; ++j)
#pragma unroll
            for (int q4 = 0; q4 < 4; ++q4) {
                const int m = wm * 64 + 32 * j + c, f = pass * 64 + wn * 32 + 8 * q4 + 4 * h;
                *(uint2*)(smem + m * HROW + f * 2) = make_uint2(hp[pass][j][2 * q4], hp[pass][j][2 * q4 + 1]);
            }
    auto wissue = [&](int s, int buf) {
        const int nt = s >> 1, kt = s & 1;
        char* wb = smem + MOE_W_OFF + buf * GT_BYTES;
#pragma unroll
        for (int i = 0; i < 4; ++i) {
            const int r = sr + 32 * i;
            const int cs = sc ^ ((r >> 1) & 7);
            const char* wp = (const char*)(wd + (size_t)(nt * 128 + r) * 128 + kt * 64) + cs * 16;
            __builtin_amdgcn_global_load_lds((const __attribute__((address_space(1))) void*)wp, (__attribute__((address_space(3))) void*)(wb + (32 * i + 8 * wave) * 128), 16, 0, 0);
        }
    };
    wissue(0, 0);
    __syncthreads();
    f32x16 acc[2][2];
    for (int s = 0; s < 16; ++s) {
        const int kt = s & 1;
        if (kt == 0) {
#pragma unroll
            for (int i = 0; i < 2; ++i)
#pragma unroll
                for (int j = 0; j < 2; ++j)
#pragma unroll
                    for (int r = 0; r < 16; ++r) acc[i][j][r] = 0.f;
        }
        if (s + 1 < 16) wissue(s + 1, (s + 1) & 1);
        const char* wb = smem + MOE_W_OFF + (s & 1) * GT_BYTES;
        {
            const int rw0 = wn * 64 + c, kw = (rw0 >> 1) & 7;
            const char* wp0 = wb + rw0 * 128;
            const char* xp0 = smem + (wm * 64 + c) * HROW + kt * 128 + h * 16;
#define WFRAG(base, ks) (*(const bf16x8*)((base) + (((2 * (ks) + h) ^ kw) << 4)))
            bf16x8 wfa0 = WFRAG(wp0, 0), wfa1 = WFRAG(wp0 + 32 * 128, 0), xfa0 = *(const bf16x8*)(xp0), xfa1 = *(const bf16x8*)(xp0 + 32 * HROW);
#pragma unroll
            for (int ks = 0; ks < 4; ++ks) {
                bf16x8 wfb0, wfb1, xfb0, xfb1;
                if (ks < 3) {
                    wfb0 = WFRAG(wp0, ks + 1); wfb1 = WFRAG(wp0 + 32 * 128, ks + 1);
                    xfb0 = *(const bf16x8*)(xp0 + (ks + 1) * 32); xfb1 = *(const bf16x8*)(xp0 + 32 * HROW + (ks + 1) * 32);
                }
                acc[0][0] = __builtin_amdgcn_mfma_f32_32x32x16_bf16(wfa0, xfa0, acc[0][0], 0, 0, 0);
                acc[0][1] = __builtin_amdgcn_mfma_f32_32x32x16_bf16(wfa0, xfa1, acc[0][1], 0, 0, 0);
                acc[1][0] = __builtin_amdgcn_mfma_f32_32x32x16_bf16(wfa1, xfa0, acc[1][0], 0, 0, 0);
                acc[1][1] = __builtin_amdgcn_mfma_f32_32x32x16_bf16(wfa1, xfa1, acc[1][1], 0, 0, 0);
                __builtin_amdgcn_sched_barrier(0);
                if (ks < 3) { wfa0 = wfb0; wfa1 = wfb1; xfa0 = xfb0; xfa1 = xfb1; }
            }
#undef WFRAG
        }
        if (kt == 1) {
            const int nt = s >> 1;
#pragma unroll
            for (int j = 0; j < 2; ++j) {
                if (myslot[j] >= 0) {
                    bf16_t* dst = ys + (size_t)myslot[j] * 1024 + nt * 128 + wn * 64;
#pragma unroll
                    for (int i = 0; i < 2; ++i)
#pragma unroll
                        for (int q4 = 0; q4 < 4; ++q4) {
                            uint2 o; o.x = pk2(acc[i][j][4 * q4], acc[i][j][4 * q4 + 1]); o.y = pk2(acc[i][j][4 * q4 + 2], acc[i][j][4 * q4 + 3]);
                            *(uint2*)(dst + 32 * i + 8 * q4 + 4 * h) = o;
                        }
                }
            }
        }
        __syncthreads();
    }
}

struct L1Bufs { bf16_t *q, *k, *vt; float* kmpart; };

__device__ __forceinline__ void p7_item(const bf16_t* __restrict__ xn, const float* __restrict__ ssq, const bf16_t* __restrict__ wt, const float* __restrict__ qn, const float* __restrict__ kn,
                                        const L1Bufs& B, int bx, int by, char* smem) {
    const int m0 = by * 128, n0 = bx * 128;
    f32x16 acc[2][2];
    gemm_core_glds(xn, [&](int i, int r) -> unsigned { return (unsigned)(m0 + r) * (DM * 2u); }, 128u, wt, DM, n0, DM, smem, acc);
    const int tid_ = opq_tid(), lane = tid_ & 63, wave = tid_ >> 6;
    const int wn = wave >> 1, wm = wave & 1, c = lane & 31, h = lane >> 5;
    const int ch = (n0 >> 6) + wn;
    float rstd[2];
#pragma unroll
    for (int j = 0; j < 2; ++j) {
        const float4* sp = (const float4*)(ssq + (size_t)(m0 + wm * 64 + 32 * j + c) * 16);
        const float4 s0 = sp[0], s1 = sp[1], s2 = sp[2], s3 = sp[3];
        const float S = (((s0.x + s0.y) + (s0.z + s0.w)) + ((s1.x + s1.y) + (s1.z + s1.w))) + (((s2.x + s2.y) + (s2.z + s2.w)) + ((s3.x + s3.y) + (s3.z + s3.w)));
        rstd[j] = rsqrtf(S * (1.f / DM) + 1e-6f);
    }
    if (ch < 4 || ch >= 8) {
        const float* g = (ch < 4) ? kn : qn;
        float nv[2][2][16];
#pragma unroll
        for (int j = 0; j < 2; ++j) {
            const int m = m0 + wm * 64 + 32 * j + c;
            float ss = 0.f;
#pragma unroll
            for (int i = 0; i < 2; ++i)
#pragma unroll
                for (int r = 0; r < 16; ++r) ss += acc[i][j][r] * acc[i][j][r];
            ss = sum32(ss);
            float rs = rstd[j] * rsqrtf(ss * rstd[j] * rstd[j] * (1.f / 64.f) + 1e-6f);
            if (ch >= 8) rs *= 0.125f * LOG2E;
            bf16_t* dst = (ch < 4) ? (B.k + (size_t)m * 256 + ch * 64) : (B.q + (size_t)m * 1024 + (ch - 8) * 64);
#pragma unroll
            for (int i = 0; i < 2; ++i)
#pragma unroll
                for (int q4 = 0; q4 < 4; ++q4) {
                    const int nl = 32 * i + 8 * q4 + 4 * h;
                    const float4 gg = *(const float4*)(g + nl);
                    const float v0 = acc[i][j][4 * q4] * rs * gg.x, v1 = acc[i][j][4 * q4 + 1] * rs * gg.y, v2 = acc[i][j][4 * q4 + 2] * rs * gg.z, v3 = acc[i][j][4 * q4 + 3] * rs * gg.w;
                    nv[i][j][4 * q4] = v0; nv[i][j][4 * q4 + 1] = v1; nv[i][j][4 * q4 + 2] = v2; nv[i][j][4 * q4 + 3] = v3;
                    uint2 o; o.x = pk2(v0, v1); o.y = pk2(v2, v3);
                    *(uint2*)(dst + nl) = o;
                }
        }
        if (ch < 4) {
            const int mb = m0 + wm * 64, b = mb >> 12, grp = (mb & 4095) >> 6;
            float* dst = B.kmpart + ((size_t)(b * 4 + ch) * 64 + grp) * 64;
#pragma unroll
            for (int i = 0; i < 2; ++i)
#pragma unroll
                for (int r = 0; r < 16; ++r) {
                    float s = sum_lo32(nv[i][0][r] + nv[i][1][r]);
                    if (c == 0) dst[32 * i + (r & 3) + 8 * (r >> 2) + 4 * h] = s;
                }
        }
    } else {
        const int g = ch - 4;
#pragma unroll
        for (int j = 0; j < 2; ++j) {
            const int m = m0 + wm * 64 + 32 * j + c;
            const int b = m >> 12, t = m & 4095;
            bf16_t* dst = B.vt + ((size_t)(b * 4 + g) * 64) * SEQ + t;
#pragma unroll
            for (int i = 0; i < 2; ++i)
#pragma unroll
                for (int r = 0; r < 16; ++r) {
                    const int d = 32 * i + (r & 3) + 8 * (r >> 2) + 4 * h;
                    dst[(size_t)d * SEQ] = (bf16_t)(pk2(acc[i][j][r] * rstd[j], 0.f) & 0xffffu);
                }
        }
    }
}

__device__ __forceinline__ void moba_attn_item(const L1Bufs& B, const float* __restrict__ qn, const float* __restrict__ kn, bf16_t* __restrict__ att, int bg, int qb, char* smem) {
    const int tid = opq_tid();
    const int lane = tid & 63, wave = tid >> 6, cl = lane & 31, hh = lane >> 5;
    const int b = bg >> 2, g = bg & 3, hd = g * 4 + wave;
    const int t0 = qb * 32, c = qb >> 1, cb = qb >> 3, tq = t0 + cl;
    const float slope2 = exp2f(-0.5f * (float)(hd + 1)) * LOG2E;
    float* kms = (float*)(smem + ATT_IMP_OFF);
    unsigned* um = (unsigned*)(smem + ATT_MASK_OFF);
    const float m2 = (8.f * wave_max(fabsf(qn[lane])) * wave_max(fabsf(kn[lane])) * 1.02f + 0.5f) * LOG2E;
    __syncthreads();
    {
        const int n = tid >> 4, d4 = (tid & 15) * 4;
        float4 a = make_float4(0.f, 0.f, 0.f, 0.f);
        if (n < cb) {
            const float* p = B.kmpart + ((size_t)bg * 64 + n * 4) * 64 + d4;
#pragma unroll
            for (int u = 0; u < 4; ++u) { const float4 x = *(const float4*)(p + u * 64); a.x += x.x; a.y += x.y; a.z += x.z; a.w += x.w; }
        }
        const float sc = 1.f / 256.f;
        *(float4*)(kms + n * 64 + d4) = make_float4(a.x * sc, a.y * sc, a.z * sc, a.w * sc);
        if (tid == 0) um[0] = 0u;
    }
    bf16x8 qf[4];
    {
        const bf16_t* qp = B.q + (size_t)(b * SEQ + tq) * 1024 + hd * 64 + 8 * hh;
#pragma unroll
        for (int ks = 0; ks < 4; ++ks) qf[ks] = *(const bf16x8*)(qp + ks * 16);
    }
    __syncthreads();
    float sg[16];
    {
        float qv[32];
#pragma unroll
        for (int ks = 0; ks < 4; ++ks) {
            const uint4 u = __builtin_bit_cast(uint4, qf[ks]);
            qv[ks * 8 + 0] = __uint_as_float(u.x << 16); qv[ks * 8 + 1] = __uint_as_float(u.x & 0xffff0000u);
            qv[ks * 8 + 2] = __uint_as_float(u.y << 16); qv[ks * 8 + 3] = __uint_as_float(u.y & 0xffff0000u);
            qv[ks * 8 + 4] = __uint_as_float(u.z << 16); qv[ks * 8 + 5] = __uint_as_float(u.z & 0xffff0000u);
            qv[ks * 8 + 6] = __uint_as_float(u.w << 16); qv[ks * 8 + 7] = __uint_as_float(u.w & 0xffff0000u);
        }
#pragma unroll
        for (int n = 0; n < 16; ++n) {
            float s = 0.f;
            if (n < cb) {
#pragma unroll
                for (int ks = 0; ks < 4; ++ks) {
                    const float4 k0 = *(const float4*)(kms + n * 64 + ks * 16 + 8 * hh), k1 = *(const float4*)(kms + n * 64 + ks * 16 + 8 * hh + 4);
                    s += qv[ks * 8 + 0] * k0.x + qv[ks * 8 + 1] * k0.y + qv[ks * 8 + 2] * k0.z + qv[ks * 8 + 3] * k0.w
                       + qv[ks * 8 + 4] * k1.x + qv[ks * 8 + 5] * k1.y + qv[ks * 8 + 6] * k1.z + qv[ks * 8 + 7] * k1.w;
                }
                s = sum32(s);
            } else s = -INFINITY;
            sg[n] = s;
        }
    }
    unsigned bm = 0u;
#pragma unroll
    for (int n = 0; n < 16; ++n) {
        int rank = 0;
#pragma unroll
        for (int n2 = 0; n2 < 16; ++n2) rank += (sg[n2] > sg[n] || (sg[n2] == sg[n] && n2 < n)) ? 1 : 0;
        if (rank < 3 && n < cb) bm |= 1u << n;
    }
    unsigned long long mytiles = 0ull;
#pragma unroll
    for (int n = 0; n < 16; ++n) if ((bm >> n) & 1u) mytiles |= 0xFull << (4 * n);
    unsigned long long own = 0ull;
    for (int j = 4 * cb; j <= c; ++j) own |= 1ull << j;
    mytiles |= own;
    const unsigned wb = or32(or_lo32(bm));
    if (lane == 0) atomicOr(um, wb);
    __syncthreads();
    const unsigned ub = um[0];
    unsigned long long U = own;
    for (int n = 0; n < 16; ++n) if ((ub >> n) & 1u) U |= 0xFull << (4 * n);
    f32x16 ot[2]; float l;
    const float tb0 = -(slope2 * (float)tq) - m2;
    attn_branch<1, 0>(B.k + (size_t)(b * SEQ) * 256 + g * 64, B.vt + (size_t)bg * 64 * SEQ, 256, SEQ, U, 1ull << c, mytiles, qf, slope2, tb0, tq, 1 << 30, smem, ot, l, tid);
    const float lt = sum32(l);
    const float f = 1.f / lt;
    bf16_t* dst = att + (size_t)(b * SEQ + tq) * 1024 + hd * 64;
#pragma unroll
    for (int dt = 0; dt < 2; ++dt)
#pragma unroll
        for (int q4 = 0; q4 < 4; ++q4) {
            const int d = 32 * dt + 8 * q4 + 4 * hh;
            uint2 o; o.x = pk2(ot[dt][4 * q4] * f, ot[dt][4 * q4 + 1] * f); o.y = pk2(ot[dt][4 * q4 + 2] * f, ot[dt][4 * q4 + 3] * f);
            *(uint2*)(dst + d) = o;
        }
}


#define XB_TMO      128
#define XB_XCNT(j)  (256  + 64 * (j))
#define XB_XSUB(j)  (1280 + 64 * (j))
#define XB_XGEN(j)  (2304 + 64 * (j))
#define XB_TOP      3328
#define XB_TOPGEN   3392
#define XCD_BAR_WORDS 3456
#define XB_SPIN_CAP (1u << 22)
#define LAS __attribute__((address_space(3)))
__device__ __forceinline__ unsigned xb_ld(unsigned* p)              { return __hip_atomic_load(p, __ATOMIC_RELAXED, __HIP_MEMORY_SCOPE_AGENT); }
__device__ __forceinline__ unsigned xb_add(unsigned* p, unsigned v) { return __hip_atomic_fetch_add(p, v, __ATOMIC_RELAXED, __HIP_MEMORY_SCOPE_AGENT); }
__device__ __forceinline__ unsigned xb_xcc_id() { return (unsigned)__builtin_amdgcn_s_getreg((3 << 11) | 20) & 0xFu; }
#define XB_SPIN(cond, bar) do { unsigned _sp = 0; while (cond) { __builtin_amdgcn_s_sleep(1); \
    if ((++_sp & 255u) == 0u) { if (xb_ld(&(bar)[XB_TMO])) break; if (_sp > XB_SPIN_CAP) { atomicAdd(&(bar)[XB_TMO], 1u); break; } } } } while (0)
struct XcdBarrier { unsigned* bar; unsigned x; volatile LAS unsigned* st; };
__device__ __forceinline__ XcdBarrier xcd_barrier_post(unsigned* bar, volatile LAS unsigned* st) {
    XcdBarrier b; b.bar = bar; b.x = xb_xcc_id(); b.st = st;
    if (threadIdx.x == 0) (void)xb_add(&bar[XB_XCNT(b.x)], 1u);
    return b;
}
__device__ __forceinline__ void xcd_barrier_complete(unsigned* bar, unsigned x, unsigned& nloc, unsigned& nx) {
    const unsigned G = gridDim.x * gridDim.y * gridDim.z;
    unsigned sum, cnt, mine, sp = 0u;
    for (;;) {
        sum = 0u; cnt = 0u; mine = 0u;
#pragma unroll
        for (unsigned j = 0; j < 16; ++j) { const unsigned c = xb_ld(&bar[XB_XCNT(j)]); sum += c; cnt += (c > 0u) ? 1u : 0u; mine = (j == x) ? c : mine; }
        if (sum == G) break;
        __builtin_amdgcn_s_sleep(1);
        if ((++sp & 255u) == 0u) { if (xb_ld(&bar[XB_TMO])) break; if (sp > XB_SPIN_CAP) { atomicAdd(&bar[XB_TMO], 1u); break; } }
    }
    nloc = mine > 0u ? mine : 1u; nx = cnt > 0u ? cnt : 1u;
}
__device__ __forceinline__ void xcd_barrier(const XcdBarrier& b) {
    asm volatile("s_waitcnt vmcnt(0)" ::: "memory");
    __syncthreads();
    if (threadIdx.x == 0) {
        unsigned* bar = b.bar;
        __builtin_amdgcn_s_waitcnt(0);
        unsigned nloc = b.st[0], nx = b.st[1];
        if (nloc == 0u) { xcd_barrier_complete(bar, b.x, nloc, nx); b.st[0] = nloc; b.st[1] = nx; }
        const unsigned old = xb_add(&bar[XB_XSUB(b.x)], 1u);
        const unsigned gen = old / nloc;
        if (old + 1u == (gen + 1u) * nloc) {
            __builtin_amdgcn_fence(__ATOMIC_RELEASE, "agent");
            asm volatile("s_waitcnt vmcnt(0)" ::: "memory");
            const unsigned og = xb_add(&bar[XB_TOP], 1u);
            const unsigned tg = og / nx;
            if (og + 1u == (tg + 1u) * nx) xb_add(&bar[XB_TOPGEN], 1u);
            else XB_SPIN(xb_ld(&bar[XB_TOPGEN]) == tg, bar);
            __builtin_amdgcn_fence(__ATOMIC_ACQUIRE, "agent");
            xb_add(&bar[XB_XGEN(b.x)], 1u);
            asm volatile("s_waitcnt vmcnt(0)" ::: "memory");
        } else {
            XB_SPIN(xb_ld(&bar[XB_XGEN(b.x)]) == gen, bar);
            __builtin_amdgcn_fence(__ATOMIC_ACQUIRE, "agent");
            asm volatile("s_waitcnt vmcnt(0)" ::: "memory");
        }
    }
    __syncthreads();
}

struct Params {
    const float* in[30];
    float* out;
    float* ws;
    WJob jobs[NJOBS];
};

#define SMEM_TOTAL 73744
__shared__ __attribute__((aligned(16))) char g_smem[SMEM_TOTAL];
typedef const Params __attribute__((address_space(4)))* PPtr;
#define PP() ({ PPtr _p = (PPtr)__builtin_amdgcn_kernarg_segment_ptr(); asm volatile("" : "+s"(_p)); _p; })
__device__ __forceinline__ WJob load_job(PPtr pp, int j) { WJob J; J.src = pp->jobs[j].src; J.dst = pp->jobs[j].dst; J.gain = pp->jobs[j].gain; J.sbs = pp->jobs[j].sbs; J.dbs = pp->jobs[j].dbs; J.K = pp->jobs[j].K; J.N = pp->jobs[j].N; J.Npad = pp->jobs[j].Npad; J.batch = pp->jobs[j].batch; J.perm = pp->jobs[j].perm; J.gbs = pp->jobs[j].gbs; return J; }
__device__ __forceinline__ void grid_sync() {
    XcdBarrier xb; xb.bar = (unsigned*)((char*)PP()->ws + (size_t)166 * 1048576); xb.x = xb_xcc_id(); xb.st = (volatile LAS unsigned*)(g_smem + 73728);
    xcd_barrier(xb);
}
#define GRID_SYNC() grid_sync()
#define PHASE_1D(NB, CALL) do { for (int vb = blockIdx.x; vb < (NB); vb += gridDim.x) { const int bx = vb; __syncthreads(); CALL; } GRID_SYNC(); } while (0)
#define PHASE_2D(NX, NY, CW, CALL) do { \
    const int xcd_ = blockIdx.x & 7, slot_ = blockIdx.x >> 3, nslot_ = gridDim.x >> 3, RY_ = (NY) >> 3; \
    for (int li = slot_; li < (NX) * RY_; li += nslot_) { \
        const int cs_ = li / (RY_ * (CW)), rem_ = li - cs_ * (RY_ * (CW)); \
        const int bx = cs_ * (CW) + rem_ % (CW), by = xcd_ + 8 * (rem_ / (CW)); \
        __syncthreads(); CALL; } \
    GRID_SYNC(); } while (0)
#define GWAVE ((int)blockIdx.x * 4 + (opq_tid() >> 6))
#define NWAVE ((int)gridDim.x * 4)

__device__ __forceinline__ L0Bufs make_l0(char* wsb) {
    L0Bufs LB;
    LB.q = (bf16_t*)wsb;
    LB.kcr = (bf16_t*)(wsb + 33554432);
    LB.vcr = LB.kcr + (size_t)TTOK * 256;
    LB.ks = LB.vcr + (size_t)TTOK * 256;
    LB.vst = LB.ks + (size_t)TTOK * 256;
    LB.kw = LB.vst + (size_t)TTOK * 256;
    LB.vwt = LB.kw + (size_t)TTOK * 256;
    LB.gates = (float*)(LB.vwt + (size_t)TTOK * 256);
    LB.hidc = (bf16_t*)(wsb + 92274688);
    char* regC = wsb + (size_t)160 * 1048576;
    LB.kc = (bf16_t*)regC;
    LB.vct = (bf16_t*)(regC + 524288);
    LB.bias1 = (float*)(regC + 1048576);
    return LB;
}
__device__ __forceinline__ L1Bufs make_l1(char* wsb) {
    L1Bufs B;
    B.q = (bf16_t*)wsb;
    B.k = (bf16_t*)(wsb + 33554432);
    B.vt = B.k + (size_t)TTOK * 256;
    B.kmpart = (float*)(wsb + (size_t)160 * 1048576 + 5245440);
    return B;
}
#define WS_RLOG(wsb) ((float*)((wsb) + 92274688))
#define WS_QCTR(wsb) ((int*)((wsb) + (size_t)160 * 1048576 + 5586944))
#define WS_CNT(wsb) ((int*)((wsb) + (size_t)160 * 1048576 + 5570560))
#define WS_LSLOT(wsb) ((int*)((wsb) + (size_t)160 * 1048576 + 1051136))
#define WS_LW(wsb) ((float*)((wsb) + (size_t)160 * 1048576 + 3148288))
#define WS_PJ(wsb) ((bf16_t*)((wsb) + (size_t)64 * 1048576))
#define WS_SSQ(wsb) ((float*)((wsb) + (size_t)160 * 1048576 + 6815744))
#define WS_XA(wsb) ((bf16_t*)((wsb) + (size_t)96 * 1048576))
#define WS_XB(wsb) ((bf16_t*)((wsb) + (size_t)128 * 1048576))

__device__ __forceinline__ void ph_prologue() {
    char* smem = g_smem;
    const PPtr pp = PP();
    char* wsb = (char*)pp->ws;
    int base = 0;
    for (int j = 0; j < 17; ++j) {
        if (j >= 11 && j < 14) continue;
        const WJob J = load_job(pp, j);
        if (J.src == nullptr) continue;
        const int cntj = J.batch * (J.Npad >> 6) * (J.K >> 6);
        int first = ((int)blockIdx.x - base) % (int)gridDim.x; if (first < 0) first += gridDim.x;
        for (int it = first; it < cntj; it += gridDim.x) wconv_item(J, it, (float*)smem);
        base += cntj;
    }
    for (int layer = 0; layer < 2; ++layer)
        rw_build(pp->in[21] + (size_t)layer * DM * 4, pp->in[23] + (size_t)layer * DM * 32, pp->in[3] + layer * DM, (float*)pp->jobs[17].dst + (size_t)layer * 1024 * 36,
                 (int)(blockIdx.x * 256 + threadIdx.x), (int)(gridDim.x * 256));
    {
        const float* x = pp->in[0]; bf16_t* XA = WS_XA(wsb);
        for (int row = GWAVE; row < TTOK; row += 4 * NWAVE) rp_rows<false, 4>(x, nullptr, nullptr, XA, row, NWAVE, (TTOK - row + NWAVE - 1) / NWAVE, nullptr);
    }
    if ((int)blockIdx.x >= (int)gridDim.x - 32) {
        const int q = (int)gridDim.x - 1 - (int)blockIdx.x, which = q >> 4, kb = q & 15;
        const float* pos = (which ? pp->in[11] : pp->in[8]) + kb * 128;
        const float* w1 = (which ? pp->in[12] : pp->in[9]) + (size_t)kb * 128 * 256;
        float a = 0.f;
#pragma unroll 16
        for (int kk = 0; kk < 128; ++kk) a += pos[kk] * w1[(size_t)kk * 256 + threadIdx.x];
        WS_RLOG(wsb)[(which * 16 + kb) * 256 + threadIdx.x] = a;
    }
    if (blockIdx.x == 0) { for (int i = threadIdx.x; i < 4 * 8 * 64; i += 256) WS_QCTR(wsb)[i] = 0; for (int i = threadIdx.x; i < 2 * 32 * CNT_STRIDE; i += 256) WS_CNT(wsb)[i] = 0; }
    GRID_SYNC();
}
__device__ __forceinline__ void ph_p1() {
    char* smem = g_smem;
    const PPtr pp = PP(); char* wsb = (char*)pp->ws;
    const L0Bufs LB = make_l0(wsb);
    const bf16_t* XA = WS_XA(wsb); const bf16_t* w = pp->jobs[0].dst; const float* qn = pp->in[6]; const float* kn = pp->in[7];
    if (blockIdx.x < 2) {
        const float* part = WS_RLOG(wsb) + (size_t)blockIdx.x * 16 * 256 + threadIdx.x;
        float a = 0.f;
#pragma unroll
        for (int kb = 0; kb < 16; ++kb) a += part[kb * 256];
        LB.bias1[blockIdx.x * 256 + threadIdx.x] = a;
    }
    PHASE_2D(21, 128, 7, p1_item(XA, w, qn, kn, LB, bx, by, smem));
}
__device__ __forceinline__ void ph_p2a() {
    char* smem = g_smem;
    const PPtr pp = PP(); char* wsb = (char*)pp->ws;
    const L0Bufs LB = make_l0(wsb);
    const bf16_t* wk = pp->jobs[1].dst; const bf16_t* wv = pp->jobs[3].dst;
    const int nb = (int)gridDim.x;
    const bool split = nb > 128;
    if (!split || (int)blockIdx.x < 128) {
        for (int vb = blockIdx.x; vb < 128; vb += split ? 128 : nb) { const int bx = vb; __syncthreads(); p2a_item(LB, (bx >> 6) ? wv : wk, bx >> 6, (bx >> 1) & 31, bx & 1, smem); }
    }
    if (!split || (int)blockIdx.x >= 128) {
        const int wid = split ? (int)blockIdx.x - 128 : (int)blockIdx.x, nw = split ? nb - 128 : nb;
        int base = 0;
        for (int j = 11; j < 14; ++j) {
            const WJob J = load_job(pp, j);
            if (J.src == nullptr) continue;
            const int cntj = J.batch * (J.Npad >> 6) * (J.K >> 6);
            int first = (wid - base) % nw; if (first < 0) first += nw;
            for (int it = first; it < cntj; it += nw) wconv_item(J, it, (float*)smem);
            base += cntj;
        }
    }
    GRID_SYNC();
}
__device__ __forceinline__ void ph_p2b() {
    char* smem = g_smem;
    const PPtr pp = PP(); char* wsb = (char*)pp->ws;
    const L0Bufs LB = make_l0(wsb);
    const bf16_t* wk = pp->jobs[2].dst; const bf16_t* wv = pp->jobs[4].dst; const float* kn = pp->in[7];
    PHASE_1D(64, p2b_item(LB, (bx >> 5) ? wv : wk, kn, bx >> 5, bx & 31, smem));
}
__device__ __forceinline__ void ph_nsa() {
    char* smem = g_smem;
    const PPtr pp = PP(); char* wsb = (char*)pp->ws;
    const L0Bufs LB = make_l0(wsb);
    const float* qn = pp->in[6]; const float* kn = pp->in[7]; bf16_t* XB = WS_XB(wsb); int* qctr = WS_QCTR(wsb);
    int* misc = (int*)(smem + ATT_MISC_OFF);
    const int myx = (int)xb_xcc_id() & 7;
    const int ln_ = threadIdx.x & 63;
    const float gq_ = wave_max(fabsf(qn[ln_]));
    const float m2c = (8.f * gq_ * wave_max(fabsf(kn[ln_])) * 1.02f + 0.5f) * LOG2E;
    const float m2s = (8.f * gq_ * wave_max(fabsf(kn[64 + ln_])) * 1.02f + 0.5f) * LOG2E;
    const float m2w = (8.f * gq_ * wave_max(fabsf(kn[128 + ln_])) * 1.02f + 0.5f) * LOG2E;
    for (int dx = 0; dx < 8; ++dx) {
        const int x = (myx + dx) & 7;
        for (;;) {
            __syncthreads();
            if (threadIdx.x == 0) misc[0] = atomicAdd(&qctr[x * 64], 1);
            __syncthreads();
            const int id = __builtin_amdgcn_readfirstlane(misc[0]);
            if (id >= 256) break;
            nsa_attn_item(LB, m2c, m2s, m2w, XB, x + 8 * (id >> 7), 127 - (id & 127), smem);
        }
    }
    GRID_SYNC();
}
__device__ __forceinline__ void ph_outproj(int layer) {
    char* smem = g_smem;
    const PPtr pp = PP(); char* wsb = (char*)pp->ws;
    const bf16_t* XB = WS_XB(wsb); const bf16_t* w = pp->jobs[layer ? 8 : 5].dst; const float* r = layer ? pp->out : pp->in[0]; float* h = pp->out;
    PHASE_2D(8, 128, 8, (d_gemm<false>(XB, w, (long long)DM, TTOK, DM, DM, EpiResid{r, h, DM}, bx, by, smem)));
}
__device__ __forceinline__ void ph_route(int layer) {
    char* smem = g_smem;
    const PPtr pp = PP(); char* wsb = (char*)pp->ws;
    const float* h = pp->out; bf16_t* XA = WS_XA(wsb);
    const float* wr = (const float*)pp->jobs[17].dst + (size_t)layer * 1024 * 36;
    const float* bgp = pp->in[22] + layer * 4; const float* bep = pp->in[24] + layer * 32;
    int* cntl = WS_CNT(wsb) + layer * 32 * CNT_STRIDE; int* lslot = WS_LSLOT(wsb); float* lw = WS_LW(wsb);
    PHASE_1D(512, route_item(h, XA, wr, bgp, bep, cntl, lslot, lw, bx, smem));
}
__device__ __forceinline__ void ph_moe(int layer) {
    char* smem = g_smem;
    const PPtr pp = PP(); char* wsb = (char*)pp->ws;
    const bf16_t* wgu_l = pp->jobs[11 + 3 * layer].dst;
    const bf16_t* wd_l = pp->jobs[13 + 3 * layer].dst;
    const bf16_t* XA = WS_XA(wsb); bf16_t* ysb = (bf16_t*)wsb;
    const int* cntl = WS_CNT(wsb) + layer * 32 * CNT_STRIDE; const int* lslot = WS_LSLOT(wsb); const float* lw = WS_LW(wsb);
    const int xcd = blockIdx.x & 7, nslot = gridDim.x >> 3;
    int it = blockIdx.x >> 3;
    int q = 0, basei = 0;
    for (;;) {
        int nch = 0, e = 0;
        while (q < 4) { e = xcd + 8 * q; nch = (cntl[e * CNT_STRIDE] + 127) >> 7; if (it < basei + nch) break; basei += nch; ++q; }
        if (q >= 4) break;
        const int chunk = it - basei;
        const int nvalid = min(128, cntl[e * CNT_STRIDE] - chunk * 128);
        __syncthreads();
        moe_item<false>(XA, wgu_l + (size_t)e * 256 * 1024, wd_l + (size_t)e * 1024 * 128, lslot + e * TTOK + chunk * 128, lw + e * TTOK + chunk * 128, nvalid, ysb, smem);
        it += nslot;
    }
    {
        const float* pin = pp->in[1] + (size_t)layer * TTOK * 256; const bf16_t* wp = pp->jobs[10].dst + (size_t)layer * 256 * DM; bf16_t* pj = WS_PJ(wsb);
        int* qp = WS_QCTR(wsb) + 1024 + layer * 512;
        int* misc = (int*)(smem + 73712);
        for (int dx = 0; dx < 8; ++dx) {
            const int x = (xcd + dx) & 7;
            for (;;) {
                __syncthreads();
                if (threadIdx.x == 0) misc[0] = atomicAdd(&qp[x * 64], 1);
                __syncthreads();
                const int id = __builtin_amdgcn_readfirstlane(misc[0]);
                if (id >= 128) break;
                ple_proj_item(pin, wp, pj, id & 7, x + 8 * (id >> 3), smem);
            }
        }
    }
    GRID_SYNC();
}
__device__ __forceinline__ void ph_combine() {
    const PPtr pp = PP(); char* wsb = (char*)pp->ws;
    float* h = pp->out; const bf16_t* ysb = (const bf16_t*)wsb; bf16_t* XB = WS_XB(wsb);
    for (int row = GWAVE; row < TTOK; row += 2 * NWAVE) rp_rows<true, 2>(h, h, ysb, XB, row, NWAVE, (TTOK - row + NWAVE - 1) / NWAVE, nullptr);
    GRID_SYNC();
}
__device__ __forceinline__ void ph_ple(int layer) {
    char* smem = g_smem;
    const PPtr pp = PP(); char* wsb = (char*)pp->ws;
    float* h = pp->out; const bf16_t* XB = WS_XB(wsb);
    const bf16_t* wg = pp->jobs[9].dst + (size_t)layer * DM * DM;
    const bf16_t* pj = WS_PJ(wsb);
    if (layer == 0) {
        bf16_t* XA = WS_XA(wsb); float* ssq = WS_SSQ(wsb);
        PHASE_2D(8, 128, 8, ple_item_l0(XB, wg, pj, h, XA, ssq, bx, by, smem));
    } else {
        PHASE_2D(8, 128, 8, ple_item(XB, wg, pj, h, bx, by, smem));
    }
}
__device__ __forceinline__ void ph_norm() {
    const PPtr pp = PP(); char* wsb = (char*)pp->ws;
    const float* h = pp->out; bf16_t* XA = WS_XA(wsb);
    for (int row = GWAVE; row < TTOK; row += 4 * NWAVE) rp_rows<false, 4>(h, nullptr, nullptr, XA, row, NWAVE, (TTOK - row + NWAVE - 1) / NWAVE, nullptr);
    GRID_SYNC();
}
__device__ __forceinline__ void ph_p7() {
    char* smem = g_smem;
    const PPtr pp = PP(); char* wsb = (char*)pp->ws;
    const L1Bufs L1B = make_l1(wsb);
    const bf16_t* XA = WS_XA(wsb); const bf16_t* w = pp->jobs[6].dst; const float* qn = pp->in[19]; const float* kn = pp->in[17];
    const float* ssq = WS_SSQ(wsb);
    PHASE_2D(12, 128, 6, p7_item(XA, ssq, w, qn, kn, L1B, bx, by, smem));
}
__device__ __forceinline__ void ph_moba() {
    char* smem = g_smem;
    const PPtr pp = PP(); char* wsb = (char*)pp->ws;
    const L1Bufs L1B = make_l1(wsb);
    const float* qn = pp->in[19]; const float* kn = pp->in[17]; bf16_t* XB = WS_XB(wsb); int* qctr = WS_QCTR(wsb);
    int* misc = (int*)(smem + ATT_MISC_OFF);
    const int myx = (int)xb_xcc_id() & 7;
    for (int dx = 0; dx < 8; ++dx) {
        const int x = (myx + dx) & 7;
        for (;;) {
            __syncthreads();
            if (threadIdx.x == 0) misc[0] = atomicAdd(&qctr[512 + x * 64], 1);
            __syncthreads();
            const int id = __builtin_amdgcn_readfirstlane(misc[0]);
            if (id >= 256) break;
            moba_attn_item(L1B, qn, kn, XB, x + 8 * (id >> 7), 127 - (id & 127), smem);
        }
    }
    GRID_SYNC();
}

#ifndef PROBE_PHASE
#define PROBE_PHASE -1
#endif
#define PH(id, CALL) do { if (PROBE_PHASE == (id) && blockIdx.x == 0) pt0 = __builtin_amdgcn_s_memrealtime(); CALL; if (PROBE_PHASE == (id) && blockIdx.x == 0) pt1 = __builtin_amdgcn_s_memrealtime(); } while (0)

__global__ void __launch_bounds__(256, 2) mega(Params Pdummy) {
    if (threadIdx.x == 0) *(uint4*)(g_smem + 73728) = make_uint4(0u, 0u, 0u, 0u);
    __syncthreads();
    if (threadIdx.x == 0) (void)xb_add(&((unsigned*)((char*)PP()->ws + (size_t)166 * 1048576))[XB_XCNT(xb_xcc_id())], 1u);
    unsigned long long pt0 = 0ull, pt1 = 0ull;
    PH(0, ph_prologue());
    PH(1, ph_p1());
    PH(2, { ph_p2a(); ph_p2b(); });
    PH(3, ph_nsa());
    PH(4, ph_outproj(0));
    PH(5, ph_route(0));
    PH(6, ph_moe(0));
    PH(7, ph_combine());
    PH(8, ph_ple(0));
    PH(11, ph_p7());
    PH(12, ph_moba());
    PH(13, ph_outproj(1));
    PH(15, ph_route(1));
    PH(16, ph_moe(1));
    PH(17, ph_combine());
    PH(18, ph_ple(1));
    if (PROBE_PHASE >= 0 && blockIdx.x == 0) {
        const unsigned long long span = pt1 - pt0, t2 = __builtin_amdgcn_s_memrealtime();
        while (__builtin_amdgcn_s_memrealtime() - t2 < span) __builtin_amdgcn_s_sleep(16);
    }
}

extern "C" void kernel_launch(void* const* d_in, const int* in_sizes, int n_in, void* d_out, int out_size, void* d_ws, size_t ws_size, hipStream_t stream) {
    static int grid_blocks = 0;
    if (!grid_blocks) {
        int dev = 0, cus = 0, per_cu = 0;
        (void)hipGetDevice(&dev);
        (void)hipDeviceGetAttribute(&cus, hipDeviceAttributeMultiprocessorCount, dev);
        (void)hipOccupancyMaxActiveBlocksPerMultiprocessor(&per_cu, (const void*)mega, 256, 0);
        if (per_cu < 1) per_cu = 1;
        if (per_cu > 2) per_cu = 2;
        grid_blocks = cus * per_cu;
    }
    Params P{};
    for (int i = 0; i < 30; ++i) P.in[i] = (const float*)d_in[i];
    P.out = (float*)d_out;
    P.ws = (float*)d_ws;
    {
        size_t off = (size_t)168 * 1048576;
        char* wbase = (char*)d_ws + off;
        size_t wo = 0;
        auto add = [&](int j, const void* src, int K, int N, int Npad, int batch, const float* gain) {
            WJob& J = P.jobs[j];
            J.src = (const float*)src; J.dst = (bf16_t*)(wbase + wo); J.gain = gain;
            J.sbs = (long long)K * N; J.dbs = (long long)Npad * K; J.K = K; J.N = N; J.Npad = Npad; J.batch = batch; J.perm = 0; J.gbs = 0;
            wo += (size_t)batch * Npad * K * 2;
        };
        add(0, d_in[5], 1024, 2608, 2688, 1, (const float*)d_in[2]);
        add(1, d_in[9], 2048, 256, 256, 1, nullptr);
        add(2, d_in[10], 256, 64, 128, 1, nullptr);
        add(3, d_in[12], 2048, 256, 256, 1, nullptr);
        add(4, d_in[13], 256, 64, 128, 1, nullptr);
        add(5, d_in[14], 1024, 1024, 1024, 1, nullptr);
        add(6, d_in[16], 1024, 512, 512, 1, (const float*)d_in[15]);
        add(7, d_in[18], 1024, 1024, 1024, 1, (const float*)d_in[2] + 1024);
        add(8, d_in[20], 1024, 1024, 1024, 1, nullptr);
        add(9, d_in[29], 1024, 1024, 1024, 2, (const float*)d_in[4]); P.jobs[9].gbs = 1024;
        add(10, d_in[28], 256, 1024, 1024, 2, nullptr);
        for (int layer = 0; layer < 2; ++layer) {
            WJob& G = P.jobs[11 + 3 * layer]; WJob& U = P.jobs[12 + 3 * layer];
            G.src = (const float*)d_in[25] + (size_t)layer * 32 * 1024 * 128; G.dst = (bf16_t*)(wbase + wo); G.gain = (const float*)d_in[3] + layer * 1024;
            G.sbs = 1024 * 128; G.dbs = 256 * 1024; G.K = 1024; G.N = 128; G.Npad = 128; G.batch = 32; G.perm = 1; G.gbs = 0;
            U = G; U.src = (const float*)d_in[26] + (size_t)layer * 32 * 1024 * 128; U.perm = 2;
            wo += (size_t)32 * 256 * 1024 * 2;
            add(13 + 3 * layer, (const float*)d_in[27] + (size_t)layer * 32 * 128 * 1024, 128, 1024, 1024, 32, nullptr);
        }
        P.jobs[17].dst = (bf16_t*)(wbase + wo); wo += (size_t)2 * 128 * 3072 * 2;
        if (off + wo > ws_size) { fprintf(stderr, "workspace too small: need %zu have %zu\n", off + wo, ws_size); return; }
    }
    (void)hipMemsetAsync((char*)d_ws + (size_t)166 * 1048576, 0, XCD_BAR_WORDS * 4, stream);
    void* args[] = {&P};
    hipError_t e = hipLaunchCooperativeKernel((const void*)mega, dim3(grid_blocks), dim3(256), args, 0, stream);
    if (e != hipSuccess) fprintf(stderr, "cooperative launch failed: %s (grid %d)\n", hipGetErrorString(e), grid_blocks);
}
```

```cpp
#include <hip/hip_runtime.h>
#include <hip/hip_cooperative_groups.h>
namespace cg = cooperative_groups;
#include <stdint.h>
#include <math.h>
#include <stdio.h>

#define SEQ 4096
#define BATCH 4
#define TTOK 16384
#define DM 1024
#define NPROJ 2608
#define NCMP 255

#define C_Q 0
#define C_KC 1024
#define C_VC 1280
#define C_KS 1536
#define C_VS 1792
#define C_KW 2048
#define C_VW 2304
#define C_GL 2560

template <int M> __device__ __forceinline__ float fx(float v) { return __int_as_float(__builtin_amdgcn_ds_swizzle(__float_as_int(v), (M << 10) | 0x1f)); }
template <int M> __device__ __forceinline__ unsigned ux(unsigned v) { return (unsigned)__builtin_amdgcn_ds_swizzle((int)v, (M << 10) | 0x1f); }
__device__ __forceinline__ float sum32(float v) { const auto r = __builtin_amdgcn_permlane32_swap(__float_as_uint(v), __float_as_uint(v), false, false); return __uint_as_float(r[0]) + __uint_as_float(r[1]); }
__device__ __forceinline__ float max32(float v) { const auto r = __builtin_amdgcn_permlane32_swap(__float_as_uint(v), __float_as_uint(v), false, false); return fmaxf(__uint_as_float(r[0]), __uint_as_float(r[1])); }
__device__ __forceinline__ unsigned or32(unsigned v) { const auto r = __builtin_amdgcn_permlane32_swap(v, v, false, false); return r[0] | r[1]; }
__device__ __forceinline__ float sum_lo32(float v) { v += fx<1>(v); v += fx<2>(v); v += fx<4>(v); v += fx<8>(v); v += fx<16>(v); return v; }
__device__ __forceinline__ unsigned or_lo32(unsigned v) { v |= ux<1>(v); v |= ux<2>(v); v |= ux<4>(v); v |= ux<8>(v); v |= ux<16>(v); return v; }
__device__ __forceinline__ float wave_sum(float v) { return sum32(sum_lo32(v)); }
__device__ __forceinline__ int opq_tid() { int t = threadIdx.x; asm volatile("" : "+v"(t)); return t; }
__device__ __forceinline__ float gelu_tanh(float x) {
    const float c = 0.7978845608028654f;
    float u = c * (x + 0.044715f * x * x * x);
    return 0.5f * x * (1.f + tanhf(u));
}
__device__ __forceinline__ float sigm(float x) { return 1.f / (1.f + expf(-x)); }

typedef unsigned short bf16_t;
typedef float f32x16 __attribute__((ext_vector_type(16)));
typedef __bf16 bf16x8 __attribute__((ext_vector_type(8)));
typedef __bf16 bf16x2 __attribute__((ext_vector_type(2)));
__device__ __forceinline__ unsigned pk2(float lo, float hi) { bf16x2 v = {(__bf16)lo, (__bf16)hi}; return __builtin_bit_cast(unsigned, v); }
__device__ __forceinline__ uint4 pack8(float4 a, float4 b) { uint4 r; r.x = pk2(a.x, a.y); r.y = pk2(a.z, a.w); r.z = pk2(b.x, b.y); r.w = pk2(b.z, b.w); return r; }

__device__ __forceinline__ float bf16_lo_f(unsigned u) { return __uint_as_float(u << 16); }
__device__ __forceinline__ float bf16_hi_f(unsigned u) { return __uint_as_float(u & 0xffff0000u); }
#define LDS_ROW 144
#define TILE_BYTES (128 * LDS_ROW)

template <bool A_F32, class AFn>
__device__ __forceinline__ void gemm_core(AFn afn, const bf16_t* __restrict__ Wt, int ldw, int n0, int K, char* smem, f32x16 (&acc)[2][2]) {
    const int tid = opq_tid(), lane = tid & 63, wave = tid >> 6;
    const int wn = wave >> 1, wm = wave & 1;
    const int sr = tid >> 3, sc = tid & 7;
    const int c = lane & 31, h = lane >> 5;
    struct Stage { uint4 x0, x1, x2, x3, w0, w1, w2, w3; };
#pragma unroll
    for (int i = 0; i < 2; ++i)
#pragma unroll
        for (int j = 0; j < 2; ++j)
#pragma unroll
            for (int r = 0; r < 16; ++r) acc[i][j][r] = 0.f;
    auto loadx = [&](int i, int k0) -> uint4 {
        const int r = sr + 32 * i;
        if (A_F32) {
            const float* p = (const float*)afn(i, r, k0);
            if (p) { float4 f0 = *(const float4*)(p + sc * 8); float4 f1 = *(const float4*)(p + sc * 8 + 4); return pack8(f0, f1); }
            return make_uint4(0u, 0u, 0u, 0u);
        } else {
            const bf16_t* p = (const bf16_t*)afn(i, r, k0);
            return p ? *(const uint4*)(p + sc * 8) : make_uint4(0u, 0u, 0u, 0u);
        }
    };
    auto load = [&](int k0) -> Stage {
        Stage S;
        S.x0 = loadx(0, k0); S.x1 = loadx(1, k0); S.x2 = loadx(2, k0); S.x3 = loadx(3, k0);
        const bf16_t* wp = Wt + (size_t)(n0 + sr) * ldw + k0 + sc * 8;
        S.w0 = *(const uint4*)wp; S.w1 = *(const uint4*)(wp + (size_t)32 * ldw); S.w2 = *(const uint4*)(wp + (size_t)64 * ldw); S.w3 = *(const uint4*)(wp + (size_t)96 * ldw);
        return S;
    };
    auto store = [&](const Stage S, int buf) {
        char* xb = smem + buf * 2 * TILE_BYTES + sr * LDS_ROW + sc * 16; char* wb = xb + TILE_BYTES;
        *(uint4*)xb = S.x0; *(uint4*)(xb + 32 * LDS_ROW) = S.x1; *(uint4*)(xb + 64 * LDS_ROW) = S.x2; *(uint4*)(xb + 96 * LDS_ROW) = S.x3;
        *(uint4*)wb = S.w0; *(uint4*)(wb + 32 * LDS_ROW) = S.w1; *(uint4*)(wb + 64 * LDS_ROW) = S.w2; *(uint4*)(wb + 96 * LDS_ROW) = S.w3;
    };
    auto compute = [&](int buf) {
        const char* xb = smem + buf * 2 * TILE_BYTES; const char* wb = xb + TILE_BYTES;
        const char* wp0 = wb + (wn * 64 + c) * LDS_ROW + h * 16;
        const char* xp0 = xb + (wm * 64 + c) * LDS_ROW + h * 16;
        bf16x8 wfa0 = *(const bf16x8*)(wp0), wfa1 = *(const bf16x8*)(wp0 + 32 * LDS_ROW), xfa0 = *(const bf16x8*)(xp0), xfa1 = *(const bf16x8*)(xp0 + 32 * LDS_ROW);
#pragma unroll
        for (int ks = 0; ks < 4; ++ks) {
            bf16x8 wfb0, wfb1, xfb0, xfb1;
            if (ks < 3) {
                wfb0 = *(const bf16x8*)(wp0 + (ks + 1) * 32); wfb1 = *(const bf16x8*)(wp0 + 32 * LDS_ROW + (ks + 1) * 32);
                xfb0 = *(const bf16x8*)(xp0 + (ks + 1) * 32); xfb1 = *(const bf16x8*)(xp0 + 32 * LDS_ROW + (ks + 1) * 32);
            }
            acc[0][0] = __builtin_amdgcn_mfma_f32_32x32x16_bf16(wfa0, xfa0, acc[0][0], 0, 0, 0);
            acc[0][1] = __builtin_amdgcn_mfma_f32_32x32x16_bf16(wfa0, xfa1, acc[0][1], 0, 0, 0);
            acc[1][0] = __builtin_amdgcn_mfma_f32_32x32x16_bf16(wfa1, xfa0, acc[1][0], 0, 0, 0);
            acc[1][1] = __builtin_amdgcn_mfma_f32_32x32x16_bf16(wfa1, xfa1, acc[1][1], 0, 0, 0);
            __builtin_amdgcn_sched_barrier(0);
            if (ks < 3) { wfa0 = wfb0; wfa1 = wfb1; xfa0 = xfb0; xfa1 = xfb1; }
        }
    };
    const int nk = K >> 6;
    Stage S0 = load(0), S1 = S0;
    if (nk > 1) S1 = load(64);
    store(S0, 0);
    __syncthreads();
    for (int kt = 0; kt < nk; kt += 2) {
        if (kt + 2 < nk) S0 = load((kt + 2) * 64);
        compute(0);
        if (kt + 1 < nk) store(S1, 1);
        __syncthreads();
        if (kt + 1 >= nk) break;
        if (kt + 3 < nk) S1 = load((kt + 3) * 64);
        compute(1);
        if (kt + 2 < nk) store(S0, 0);
        __syncthreads();
    }
}
#define GT_BYTES 16384
template <class AOff>
__device__ __forceinline__ void gemm_core_glds(const void* abase, AOff aoff, unsigned akstep, const bf16_t* __restrict__ Wt, int ldw, int n0, int K, char* smem, f32x16 (&acc)[2][2]) {
    const int tid = opq_tid(), lane = tid & 63, wave = tid >> 6;
    const int wn = wave >> 1, wm = wave & 1;
    const int sr = tid >> 3, sc = tid & 7;
    const int c = lane & 31, h = lane >> 5;
#pragma unroll
    for (int i = 0; i < 2; ++i)
#pragma unroll
        for (int j = 0; j < 2; ++j)
#pragma unroll
            for (int r = 0; r < 16; ++r) acc[i][j][r] = 0.f;
    const __amdgpu_buffer_rsrc_t rA = __builtin_amdgcn_make_buffer_rsrc((void*)abase, 0, 0x7fffffff, 0x00020000);
    const __amdgpu_buffer_rsrc_t rW = __builtin_amdgcn_make_buffer_rsrc((void*)Wt, 0, 0x7fffffff, 0x00020000);
    const unsigned cs16 = (unsigned)(sc ^ ((sr >> 1) & 7)) * 16u;
    const unsigned xo0 = aoff(0, sr) + cs16, xo1 = aoff(1, sr + 32) + cs16, xo2 = aoff(2, sr + 64) + cs16, xo3 = aoff(3, sr + 96) + cs16;
    const unsigned wo0 = (unsigned)(n0 + sr) * (unsigned)ldw * 2u + cs16, wst = 32u * (unsigned)ldw * 2u;
    auto issue = [&](int kt, int buf) {
        char* xb = smem + buf * 2 * GT_BYTES + 8 * wave * 128; char* wb = xb + GT_BYTES;
        const unsigned ak = (unsigned)kt * akstep, wk = (unsigned)kt * 128u;
#define GLDS(rs, dst, voff, soff) __builtin_amdgcn_raw_ptr_buffer_load_lds(rs, (__attribute__((address_space(3))) void*)(dst), 16, voff, soff, 0, 0)
        GLDS(rA, xb, xo0, ak); GLDS(rW, wb, wo0, wk);
        GLDS(rA, xb + 32 * 128, xo1, ak); GLDS(rW, wb + 32 * 128, wo0 + wst, wk);
        GLDS(rA, xb + 64 * 128, xo2, ak); GLDS(rW, wb + 64 * 128, wo0 + 2 * wst, wk);
        GLDS(rA, xb + 96 * 128, xo3, ak); GLDS(rW, wb + 96 * 128, wo0 + 3 * wst, wk);
#undef GLDS
    };
    auto compute = [&](int buf) {
        const char* xb = smem + buf * 2 * GT_BYTES; const char* wb = xb + GT_BYTES;
        const int rw0 = wn * 64 + c, rx0 = wm * 64 + c;
        const int kw = (rw0 >> 1) & 7, kx = (rx0 >> 1) & 7;
        const char* wp0 = wb + rw0 * 128; const char* xp0 = xb + rx0 * 128;
#define FRAG(base, key, ks) (*(const bf16x8*)((base) + (((2 * (ks) + h) ^ (key)) << 4)))
        bf16x8 wfa0 = FRAG(wp0, kw, 0), wfa1 = FRAG(wp0 + 32 * 128, kw, 0), xfa0 = FRAG(xp0, kx, 0), xfa1 = FRAG(xp0 + 32 * 128, kx, 0);
#pragma unroll
        for (int ks = 0; ks < 4; ++ks) {
            bf16x8 wfb0, wfb1, xfb0, xfb1;
            if (ks < 3) { wfb0 = FRAG(wp0, kw, ks + 1); wfb1 = FRAG(wp0 + 32 * 128, kw, ks + 1); xfb0 = FRAG(xp0, kx, ks + 1); xfb1 = FRAG(xp0 + 32 * 128, kx, ks + 1); }
            acc[0][0] = __builtin_amdgcn_mfma_f32_32x32x16_bf16(wfa0, xfa0, acc[0][0], 0, 0, 0);
            acc[0][1] = __builtin_amdgcn_mfma_f32_32x32x16_bf16(wfa0, xfa1, acc[0][1], 0, 0, 0);
            acc[1][0] = __builtin_amdgcn_mfma_f32_32x32x16_bf16(wfa1, xfa0, acc[1][0], 0, 0, 0);
            acc[1][1] = __builtin_amdgcn_mfma_f32_32x32x16_bf16(wfa1, xfa1, acc[1][1], 0, 0, 0);
            __builtin_amdgcn_sched_barrier(0);
            if (ks < 3) { wfa0 = wfb0; wfa1 = wfb1; xfa0 = xfb0; xfa1 = xfb1; }
        }
#undef FRAG
    };
    const int nk = K >> 6;
    issue(0, 0);
    __syncthreads();
    for (int kt = 0; kt < nk; ++kt) {
        if (kt + 1 < nk) issue(kt + 1, (kt + 1) & 1);
        compute(kt & 1);
        __syncthreads();
    }
}
template <class F>
__device__ __forceinline__ void epi_foreach(const f32x16 (&acc)[2][2], int m0, int n0, F f) {
    const int tid_ = opq_tid(), lane = tid_ & 63, wave = tid_ >> 6;
    const int wn = wave >> 1, wm = wave & 1, c = lane & 31, h = lane >> 5;
#pragma unroll
    for (int i = 0; i < 2; ++i)
#pragma unroll
        for (int j = 0; j < 2; ++j)
#pragma unroll
            for (int q = 0; q < 4; ++q) {
                const int n = n0 + wn * 64 + 32 * i + 8 * q + 4 * h, m = m0 + wm * 64 + 32 * j + c;
                f(m, n, make_float4(acc[i][j][4 * q], acc[i][j][4 * q + 1], acc[i][j][4 * q + 2], acc[i][j][4 * q + 3]));
            }
}
struct EpiStore { float* C; long long ldc; __device__ void operator()(int r, int c, float4 v) const { *(float4*)(C + (size_t)r * ldc + c) = v; } };
struct EpiGelu { float* C; long long ldc; __device__ void operator()(int r, int c, float4 v) const { *(float4*)(C + (size_t)r * ldc + c) = make_float4(gelu_tanh(v.x), gelu_tanh(v.y), gelu_tanh(v.z), gelu_tanh(v.w)); } };
struct EpiSigm { float* C; long long ldc; __device__ void operator()(int r, int c, float4 v) const { *(float4*)(C + (size_t)r * ldc + c) = make_float4(sigm(v.x), sigm(v.y), sigm(v.z), sigm(v.w)); } };
struct EpiResid { const float* R; float* C; long long ldc; __device__ void operator()(int r, int c, float4 v) const { float4 a = *(const float4*)(R + (size_t)r * ldc + c); *(float4*)(C + (size_t)r * ldc + c) = make_float4(a.x + v.x, a.y + v.y, a.z + v.z, a.w + v.w); } };
struct EpiPle { const float* G; float* H; long long ldc; __device__ void operator()(int r, int c, float4 v) const { float4 g = *(const float4*)(G + (size_t)r * ldc + c); float4 a = *(const float4*)(H + (size_t)r * ldc + c); *(float4*)(H + (size_t)r * ldc + c) = make_float4(a.x + g.x * v.x, a.y + g.y * v.y, a.z + g.z * v.z, a.w + g.w * v.w); } };

template <bool A_F32, class Epi>
__device__ __forceinline__ void d_gemm(const void* __restrict__ A, const bf16_t* __restrict__ Wt, long long lda, int M, int N, int K, Epi epi, int bx, int by, char* smem) {
    const int m0 = by * 128, n0 = bx * 128;
    f32x16 acc[2][2];
    if constexpr (A_F32) {
        gemm_core<true>([&](int i, int r, int k0) -> const void* {
            if (m0 + r >= M) return nullptr;
            return (const void*)((const float*)A + (size_t)(m0 + r) * lda + k0); }, Wt, K, n0, K, smem, acc);
    } else {
        gemm_core_glds(A, [&](int i, int r) -> unsigned {
            const int rr = (m0 + r < M) ? (m0 + r) : 0;
            return (unsigned)rr * (unsigned)lda * 2u; }, 128u, Wt, K, n0, K, smem, acc);
    }
    epi_foreach(acc, m0, n0, [&](int m, int n, float4 v) { if (m < M && n < N) epi(m, n, v); });
}

struct WJob { const float* src; bf16_t* dst; const float* gain; long long sbs, dbs; int K, N, Npad, batch, perm, gbs; };
#define NJOBS 20
__device__ __forceinline__ void wconv_item(const WJob& J, int item, float* lds) {
    const int tid = opq_tid(), lane = tid & 63;
    const int nt = J.Npad >> 6, kt = J.K >> 6;
    const int bi = item / (nt * kt), rem = item % (nt * kt), kb = rem / nt, nb = rem % nt;
    const float* W = J.src + (size_t)bi * J.sbs;
    bf16_t* D = J.dst + (size_t)bi * J.dbs;
    const int k0 = kb * 64, n0 = nb * 64;
    __syncthreads();
    {
        float vv[16];
        const int n = n0 + lane;
#pragma unroll
        for (int p = 0; p < 16; ++p) {
            const int k = p * 4 + (tid >> 6);
            vv[p] = (n < J.N) ? W[(size_t)(k0 + k) * J.N + n] : 0.f;
        }
        if (J.gain) {
#pragma unroll
            for (int p = 0; p < 16; ++p) vv[p] *= J.gain[(size_t)bi * J.gbs + k0 + p * 4 + (tid >> 6)];
        }
#pragma unroll
        for (int p = 0; p < 16; ++p) lds[(p * 4 + (tid >> 6)) * 65 + lane] = vv[p];
    }
    __syncthreads();
    const int n = tid >> 2, kq = (tid & 3) * 16;
    float f[16];
#pragma unroll
    for (int i = 0; i < 16; ++i) f[i] = lds[(kq + i) * 65 + n];
    uint4 o0, o1;
    o0.x = pk2(f[0], f[1]); o0.y = pk2(f[2], f[3]); o0.z = pk2(f[4], f[5]); o0.w = pk2(f[6], f[7]);
    o1.x = pk2(f[8], f[9]); o1.y = pk2(f[10], f[11]); o1.z = pk2(f[12], f[13]); o1.w = pk2(f[14], f[15]);
    int drow = n0 + n;
    if (J.perm) drow = (drow >> 5) * 64 + (J.perm - 1) * 32 + (drow & 31);
    uint4* dp = (uint4*)(D + (size_t)drow * J.K + k0 + kq);
    dp[0] = o0; dp[1] = o1;
}

#define LOG2E 1.4426950408889634f
#define CNT_STRIDE 64
struct L0Bufs { bf16_t *q, *kcr, *vcr, *ks, *vst, *kw, *vwt; float* gates; bf16_t *hidc, *kc, *vct; float* bias1; };

__device__ __forceinline__ float wave_max(float v) { v = fmaxf(v, fx<1>(v)); v = fmaxf(v, fx<2>(v)); v = fmaxf(v, fx<4>(v)); v = fmaxf(v, fx<8>(v)); v = fmaxf(v, fx<16>(v)); return max32(v); }

__device__ __forceinline__ void p1_item(const bf16_t* __restrict__ xn, const bf16_t* __restrict__ t_w_in, const float* __restrict__ qn, const float* __restrict__ kn,
                                        const L0Bufs& B, int bx, int by, char* smem) {
    const int m0 = by * 128, n0 = bx * 128;
    f32x16 acc[2][2];
    gemm_core_glds(xn, [&](int i, int r) -> unsigned { return (unsigned)(m0 + r) * (DM * 2u); }, 128u, t_w_in, DM, n0, DM, smem, acc);
    const int tid_ = opq_tid(), lane = tid_ & 63, wave = tid_ >> 6;
    const int wn = wave >> 1, wm = wave & 1, c = lane & 31, h = lane >> 5;
    const int ch = (n0 >> 6) + wn;
#pragma unroll
    for (int j = 0; j < 2; ++j) {
        const int m = m0 + wm * 64 + 32 * j + c;
        const int b = m >> 12, t = m & 4095;
        if (ch < 16 || (ch >= 24 && ch < 28) || (ch >= 32 && ch < 36)) {
            float ss = 0.f;
#pragma unroll
            for (int i = 0; i < 2; ++i)
#pragma unroll
                for (int r = 0; r < 16; ++r) ss += acc[i][j][r] * acc[i][j][r];
            ss = sum32(ss);
            float rs = rsqrtf(ss * (1.f / 64.f) + 1e-6f);
            const float* g; bf16_t* dst;
            if (ch < 16) { g = qn; rs *= 0.125f * LOG2E; dst = B.q + (size_t)m * 1024 + ch * 64; }
            else if (ch < 28) { g = kn + 64; dst = B.ks + (size_t)m * 256 + (ch - 24) * 64; }
            else { g = kn + 128; dst = B.kw + (size_t)m * 256 + (ch - 32) * 64; }
#pragma unroll
            for (int i = 0; i < 2; ++i)
#pragma unroll
                for (int q4 = 0; q4 < 4; ++q4) {
                    const int nl = 32 * i + 8 * q4 + 4 * h;
                    const float4 gg = *(const float4*)(g + nl);
                    uint2 o;
                    o.x = pk2(acc[i][j][4 * q4] * rs * gg.x, acc[i][j][4 * q4 + 1] * rs * gg.y);
                    o.y = pk2(acc[i][j][4 * q4 + 2] * rs * gg.z, acc[i][j][4 * q4 + 3] * rs * gg.w);
                    *(uint2*)(dst + nl) = o;
                }
        } else if (ch >= 16 && ch < 24) {
            bf16_t* dst = (ch < 20) ? (B.kcr + (size_t)m * 256 + (ch - 16) * 64) : (B.vcr + (size_t)m * 256 + (ch - 20) * 64);
#pragma unroll
            for (int i = 0; i < 2; ++i)
#pragma unroll
                for (int q4 = 0; q4 < 4; ++q4) {
                    const int nl = 32 * i + 8 * q4 + 4 * h;
                    uint2 o;
                    o.x = pk2(acc[i][j][4 * q4], acc[i][j][4 * q4 + 1]);
                    o.y = pk2(acc[i][j][4 * q4 + 2], acc[i][j][4 * q4 + 3]);
                    *(uint2*)(dst + nl) = o;
                }
        } else if ((ch >= 28 && ch < 32) || (ch >= 36 && ch < 40)) {
            const int g = (ch < 32) ? (ch - 28) : (ch - 36);
            bf16_t* dst = ((ch < 32) ? B.vst : B.vwt) + ((size_t)(b * 4 + g) * 64) * SEQ + t;
#pragma unroll
            for (int i = 0; i < 2; ++i)
#pragma unroll
                for (int r = 0; r < 16; ++r) {
                    const int d = 32 * i + (r & 3) + 8 * (r >> 2) + 4 * h;
                    dst[(size_t)d * SEQ] = (bf16_t)(pk2(acc[i][j][r], 0.f) & 0xffffu);
                }
        } else if (ch == 40) {
#pragma unroll
            for (int i = 0; i < 2; ++i)
#pragma unroll
                for (int q4 = 0; q4 < 4; ++q4) {
                    const int nl = 32 * i + 8 * q4 + 4 * h;
                    if (nl < 48) *(float4*)(B.gates + (size_t)m * 48 + nl) = make_float4(sigm(acc[i][j][4 * q4]), sigm(acc[i][j][4 * q4 + 1]), sigm(acc[i][j][4 * q4 + 2]), sigm(acc[i][j][4 * q4 + 3]));
                }
        }
    }
}

__device__ __forceinline__ void p2a_item(const L0Bufs& B, const bf16_t* __restrict__ w1t, int which, int mt, int nt, char* smem) {
    const bf16_t* raw = which ? B.vcr : B.kcr;
    const int sr = opq_tid() >> 3;
    auto rowoff = [&](int i) -> unsigned {
        const int m = mt * 128 + sr + 32 * i;
        if (m >= 4080) return 0u;
        const int bg = m / NCMP, n = m - bg * NCMP;
        return (unsigned)(((bg >> 2) * SEQ + 16 * n) * 256 + (bg & 3) * 64) * 2u;
    };
    const unsigned ro0 = rowoff(0), ro1 = rowoff(1), ro2 = rowoff(2), ro3 = rowoff(3);
    f32x16 acc[2][2];
    gemm_core_glds(raw, [&](int i, int r) -> unsigned { return (i == 0) ? ro0 : (i == 1) ? ro1 : (i == 2) ? ro2 : ro3; }, 512u, w1t, 2048, nt * 128, 2048, smem, acc);
    const float* bias = B.bias1 + which * 256;
    bf16_t* hid = B.hidc + (size_t)which * 4096 * 256;
    epi_foreach(acc, mt * 128, nt * 128, [&](int m, int n, float4 v) {
        const float4 bb = *(const float4*)(bias + n);
        uint2 o; o.x = pk2(gelu_tanh(v.x + bb.x), gelu_tanh(v.y + bb.y)); o.y = pk2(gelu_tanh(v.z + bb.z), gelu_tanh(v.w + bb.w));
        *(uint2*)(hid + (size_t)m * 256 + n) = o;
    });
}
__device__ __forceinline__ void p2b_item(const L0Bufs& B, const bf16_t* __restrict__ w2t, const float* __restrict__ kn, int which, int mt, char* smem) {
    const bf16_t* hid = B.hidc + (size_t)which * 4096 * 256;
    f32x16 acc[2][2];
    gemm_core_glds(hid, [&](int i, int r) -> unsigned { return (unsigned)(mt * 128 + r) * 512u; }, 128u, w2t, 256, 0, 256, smem, acc);
    const int tid_ = opq_tid(), lane = tid_ & 63, wave = tid_ >> 6;
    const int wn = wave >> 1, wm = wave & 1, c = lane & 31, h = lane >> 5;
    if (wn != 0) return;
#pragma unroll
    for (int j = 0; j < 2; ++j) {
        const int m = mt * 128 + wm * 64 + 32 * j + c;
        const bool ok = m < 4080;
        const int bg = m / NCMP, n = m - bg * NCMP;
        if (which == 0) {
            float ss = 0.f;
#pragma unroll
            for (int i = 0; i < 2; ++i)
#pragma unroll
                for (int r = 0; r < 16; ++r) ss += acc[i][j][r] * acc[i][j][r];
            ss = sum32(ss);
            const float rs = rsqrtf(ss * (1.f / 64.f) + 1e-6f);
            if (ok) {
                bf16_t* dst = B.kc + ((size_t)bg * 256 + n) * 64;
#pragma unroll
                for (int i = 0; i < 2; ++i)
#pragma unroll
                    for (int q4 = 0; q4 < 4; ++q4) {
                        const int nl = 32 * i + 8 * q4 + 4 * h;
                        const float4 gg = *(const float4*)(kn + nl);
                        uint2 o;
                        o.x = pk2(acc[i][j][4 * q4] * rs * gg.x, acc[i][j][4 * q4 + 1] * rs * gg.y);
                        o.y = pk2(acc[i][j][4 * q4 + 2] * rs * gg.z, acc[i][j][4 * q4 + 3] * rs * gg.w);
                        *(uint2*)(dst + nl) = o;
                    }
            }
        } else if (ok) {
            bf16_t* dst = B.vct + ((size_t)bg * 64) * 256 + n;
#pragma unroll
            for (int i = 0; i < 2; ++i)
#pragma unroll
                for (int r = 0; r < 16; ++r) {
                    const int d = 32 * i + (r & 3) + 8 * (r >> 2) + 4 * h;
                    dst[(size_t)d * 256] = (bf16_t)(pk2(acc[i][j][r], 0.f) & 0xffffu);
                }
        }
    }
}

#define KROW 144
#define VROW 136
#define KT_BYTES (64 * KROW)
#define ABUF (KT_BYTES + 64 * VROW)
#define ATT_IMP_OFF (2 * ABUF)
#define ATT_MASK_OFF (ATT_IMP_OFF + 4 * 32 * 65 * 4)
#define ATT_MISC_OFF (ATT_MASK_OFF + 32 * 8)

struct KVRegs { uint4 k0, k1, v0, v1; };
typedef unsigned int u32x4 __attribute__((ext_vector_type(4)));
__device__ __forceinline__ uint4 bload16(__amdgpu_buffer_rsrc_t r, unsigned voff, unsigned soff) { const u32x4 v = __builtin_amdgcn_raw_buffer_load_b128(r, voff, soff, 0); return make_uint4(v.x, v.y, v.z, v.w); }
__device__ __forceinline__ KVRegs attn_load_tile(__amdgpu_buffer_rsrc_t rK, __amdgpu_buffer_rsrc_t rV, unsigned koff, unsigned voff, int kstride, int j) {
    KVRegs R;
    const unsigned ks = (unsigned)j * 128u * (unsigned)kstride, vs = (unsigned)j * 128u;
    R.k0 = bload16(rK, koff, ks); R.k1 = bload16(rK, koff + 16u, ks);
    R.v0 = bload16(rV, voff, vs); R.v1 = bload16(rV, voff + 16u, vs);
    return R;
}
__device__ __forceinline__ void attn_store_tile(char* buf, const KVRegs R, int tid) {
    const int row = tid >> 2, cq = tid & 3;
    char* kd = buf + row * KROW + cq * 32;
    *(uint4*)kd = R.k0; *(uint4*)(kd + 16) = R.k1;
    char* vd = buf + KT_BYTES + row * VROW + cq * 32;
    *(uint2*)vd = make_uint2(R.v0.x, R.v0.y); *(uint2*)(vd + 8) = make_uint2(R.v0.z, R.v0.w);
    *(uint2*)(vd + 16) = make_uint2(R.v1.x, R.v1.y); *(uint2*)(vd + 24) = make_uint2(R.v1.z, R.v1.w);
}
template <bool AUG>
__device__ __forceinline__ void attn_qk(const char* buf, const bf16x8 (&qf)[4], f32x16 (&st)[2], int tid, const bf16x8 (&kaug)[2], const bf16x8 qaug) {
    const int lane = tid & 63, cl = lane & 31, hh = lane >> 5;
    const char* kp = buf + cl * KROW + hh * 16;
    const bf16x8 k00 = *(const bf16x8*)(kp), k01 = *(const bf16x8*)(kp + 32), k02 = *(const bf16x8*)(kp + 64), k03 = *(const bf16x8*)(kp + 96);
    const bf16x8 k10 = *(const bf16x8*)(kp + 32 * KROW), k11 = *(const bf16x8*)(kp + 32 * KROW + 32), k12 = *(const bf16x8*)(kp + 32 * KROW + 64), k13 = *(const bf16x8*)(kp + 32 * KROW + 96);
    __builtin_amdgcn_sched_barrier(0);
#pragma unroll
    for (int r = 0; r < 16; ++r) { st[0][r] = 0.f; st[1][r] = 0.f; }
    st[0] = __builtin_amdgcn_mfma_f32_32x32x16_bf16(k00, qf[0], st[0], 0, 0, 0);
    st[1] = __builtin_amdgcn_mfma_f32_32x32x16_bf16(k10, qf[0], st[1], 0, 0, 0);
    st[0] = __builtin_amdgcn_mfma_f32_32x32x16_bf16(k01, qf[1], st[0], 0, 0, 0);
    st[1] = __builtin_amdgcn_mfma_f32_32x32x16_bf16(k11, qf[1], st[1], 0, 0, 0);
    st[0] = __builtin_amdgcn_mfma_f32_32x32x16_bf16(k02, qf[2], st[0], 0, 0, 0);
    st[1] = __builtin_amdgcn_mfma_f32_32x32x16_bf16(k12, qf[2], st[1], 0, 0, 0);
    st[0] = __builtin_amdgcn_mfma_f32_32x32x16_bf16(k03, qf[3], st[0], 0, 0, 0);
    st[1] = __builtin_amdgcn_mfma_f32_32x32x16_bf16(k13, qf[3], st[1], 0, 0, 0);
    if (AUG) {
        st[0] = __builtin_amdgcn_mfma_f32_32x32x16_bf16(kaug[0], qaug, st[0], 0, 0, 0);
        st[1] = __builtin_amdgcn_mfma_f32_32x32x16_bf16(kaug[1], qaug, st[1], 0, 0, 0);
    }
}
template <bool MASKED, int PSC>
__device__ __forceinline__ void attn_exp(f32x16 (&st)[2], bf16x8 (&pf)[2][2], int pos0, int tq, int wlim, float& l) {
    float l0 = 0.f, l1 = 0.f;
#pragma unroll
    for (int i = 0; i < 2; ++i) {
#pragma unroll
        for (int r = 0; r < 16; ++r) {
            float e = st[i][r];
            if (MASKED) { const int kl = 32 * i + (r & 3) + 8 * (r >> 2); const int dist = tq - (pos0 + PSC * kl); e = (dist >= 0 && dist < wlim) ? e : -INFINITY; }
            const float p = __builtin_amdgcn_exp2f(e);
            if (r & 1) l1 += p; else l0 += p;
            st[i][r] = p;
        }
#pragma unroll
        for (int s = 0; s < 2; ++s) {
            uint4 u;
            u.x = pk2(st[i][8 * s + 0], st[i][8 * s + 1]); u.y = pk2(st[i][8 * s + 2], st[i][8 * s + 3]);
            u.z = pk2(st[i][8 * s + 4], st[i][8 * s + 5]); u.w = pk2(st[i][8 * s + 6], st[i][8 * s + 7]);
            pf[i][s] = __builtin_bit_cast(bf16x8, u);
        }
    }
    l += l0 + l1;
}
struct VFrags { uint2 a[8]; };
__device__ __forceinline__ bf16x8 vjoin(uint2 v0, uint2 v1) { return __builtin_bit_cast(bf16x8, make_uint4(v0.x, v0.y, v1.x, v1.y)); }
#define VADDR(buf, dt, i, s) ((buf) + KT_BYTES + (32 * (dt) + cl) * VROW + (32 * (i) + 16 * (s) + 4 * hh) * 2)
__device__ __forceinline__ void attn_pv(const char* buf, const bf16x8 (&pf)[2][2], f32x16 (&ot)[2], int tid) {
    const int lane = tid & 63, cl = lane & 31, hh = lane >> 5;
    const char* a00 = VADDR(buf, 0, 0, 0);
    const uint2 p0 = *(const uint2*)(a00), p1 = *(const uint2*)(a00 + 16), p2 = *(const uint2*)(a00 + 32), p3 = *(const uint2*)(a00 + 48);
    const uint2 p4 = *(const uint2*)(a00 + 64), p5 = *(const uint2*)(a00 + 80), p6 = *(const uint2*)(a00 + 96), p7 = *(const uint2*)(a00 + 112);
    const char* a10 = a00 + 32 * VROW;
    const uint2 q0 = *(const uint2*)(a10), q1 = *(const uint2*)(a10 + 16), q2 = *(const uint2*)(a10 + 32), q3 = *(const uint2*)(a10 + 48);
    const uint2 q4 = *(const uint2*)(a10 + 64), q5 = *(const uint2*)(a10 + 80), q6 = *(const uint2*)(a10 + 96), q7 = *(const uint2*)(a10 + 112);
    __builtin_amdgcn_sched_barrier(0);
    ot[0] = __builtin_amdgcn_mfma_f32_32x32x16_bf16(vjoin(p0, p1), pf[0][0], ot[0], 0, 0, 0);
    ot[1] = __builtin_amdgcn_mfma_f32_32x32x16_bf16(vjoin(q0, q1), pf[0][0], ot[1], 0, 0, 0);
    ot[0] = __builtin_amdgcn_mfma_f32_32x32x16_bf16(vjoin(p2, p3), pf[0][1], ot[0], 0, 0, 0);
    ot[1] = __builtin_amdgcn_mfma_f32_32x32x16_bf16(vjoin(q2, q3), pf[0][1], ot[1], 0, 0, 0);
    ot[0] = __builtin_amdgcn_mfma_f32_32x32x16_bf16(vjoin(p4, p5), pf[1][0], ot[0], 0, 0, 0);
    ot[1] = __builtin_amdgcn_mfma_f32_32x32x16_bf16(vjoin(q4, q5), pf[1][0], ot[1], 0, 0, 0);
    ot[0] = __builtin_amdgcn_mfma_f32_32x32x16_bf16(vjoin(p6, p7), pf[1][1], ot[0], 0, 0, 0);
    ot[1] = __builtin_amdgcn_mfma_f32_32x32x16_bf16(vjoin(q6, q7), pf[1][1], ot[1], 0, 0, 0);
}

template <int PSC, int POFF>
__device__ __forceinline__ void attn_branch(const bf16_t* SK, const bf16_t* SVT, int kstride, int vstride, unsigned long long tiles, unsigned long long maskbits, unsigned long long lane_mask,
                                            const bf16x8 (&qf)[4], float slope2, float tb0, int tq, int wlim, char* smem, f32x16 (&ot)[2], float& l, int tid) {
    const int hh = (tid & 63) >> 5;
#pragma unroll
    for (int dt = 0; dt < 2; ++dt)
#pragma unroll
        for (int r = 0; r < 16; ++r) ot[dt][r] = 0.f;
    l = 0.f;
    if (tiles == 0ull) return;
    const __amdgpu_buffer_rsrc_t rK = __builtin_amdgcn_make_buffer_rsrc((void*)SK, 0, 0x7fffffff, 0x00020000);
    const __amdgpu_buffer_rsrc_t rV = __builtin_amdgcn_make_buffer_rsrc((void*)SVT, 0, 0x7fffffff, 0x00020000);
    const unsigned koff = (((unsigned)tid >> 2) * (unsigned)kstride + ((unsigned)tid & 3) * 16u) * 2u, voff = (((unsigned)tid >> 2) * (unsigned)vstride + ((unsigned)tid & 3) * 16u) * 2u;
    bf16x8 kaug[2];
    const float sk = slope2 * (float)PSC;
    const unsigned s_hi = pk2(sk, 0.f) & 0xffffu, s_lo = pk2(sk - bf16_lo_f(s_hi), 0.f) & 0xffffu;
    {
        const int cl = tid & 31;
#pragma unroll
        for (int i = 0; i < 2; ++i) {
            const float klf = (float)(32 * i + cl);
            uint4 u = make_uint4(pk2(klf, klf), 0x3f803f80u, 0x00003f80u, 0u);
            if (hh) u = make_uint4(0u, 0u, 0u, 0u);
            kaug[i] = __builtin_bit_cast(bf16x8, u);
        }
    }
    auto compute = [&](const char* buf, int j) {
        f32x16 st[2]; bf16x8 pf[2][2];
        const float t = fmaf(slope2, (float)(PSC * 64 * j + POFF), tb0);
        const bool on = (lane_mask >> j) & 1ull;
        const unsigned t_hi = on ? (pk2(t, 0.f) & 0xffffu) : 0xff80u;
        const float r1 = on ? (t - bf16_lo_f(t_hi)) : 0.f;
        const unsigned t_lo = pk2(r1, 0.f) & 0xffffu;
        const unsigned t_l2 = pk2(r1 - bf16_lo_f(t_lo), 0.f) & 0xffffu;
        uint4 qu = make_uint4(s_hi | (s_lo << 16), t_hi | (t_lo << 16), t_l2, 0u);
        if (hh) qu = make_uint4(0u, 0u, 0u, 0u);
        attn_qk<true>(buf, qf, st, tid, kaug, __builtin_bit_cast(bf16x8, qu));
        const int pos0 = PSC * (64 * j + 4 * hh) + POFF;
        if ((maskbits >> j) & 1ull) attn_exp<true, PSC>(st, pf, pos0, tq, wlim, l);
        else attn_exp<false, PSC>(st, pf, pos0, tq, wlim, l);
        attn_pv(buf, pf, ot, tid);
    };
    int j = __builtin_ctzll(tiles); tiles &= tiles - 1;
    KVRegs R = attn_load_tile(rK, rV, koff, voff, kstride, j);
    __syncthreads();
    attn_store_tile(smem, R, tid);
    __syncthreads();
    int cur = 0;
    for (;;) {
        const bool more = tiles != 0ull;
        int jn = 0;
        if (more) { jn = __builtin_ctzll(tiles); tiles &= tiles - 1; R = attn_load_tile(rK, rV, koff, voff, kstride, jn); }
        compute(smem + cur * ABUF, j);
        if (more) attn_store_tile(smem + (cur ^ 1) * ABUF, R, tid);
        __syncthreads();
        if (!more) break;
        j = jn; cur ^= 1;
    }
}

__device__ __forceinline__ void nsa_attn_item(const L0Bufs& B, float m2c, float m2s, float m2w, bf16_t* __restrict__ att, int bg, int qb, char* smem) {
    const int tid = opq_tid();
    const int lane = tid & 63, wave = tid >> 6, cl = lane & 31, hh = lane >> 5;
    const int b = bg >> 2, g = bg & 3, hd = g * 4 + wave;
    const int t0 = qb * 32, c = qb >> 1, tq = t0 + cl;
    const float slope2 = exp2f(-0.5f * (float)(hd + 1)) * LOG2E;
    float* imp = (float*)(smem + ATT_IMP_OFF);
    uint2* msk = (uint2*)(smem + ATT_MASK_OFF);
    bf16x8 qf[4];
    {
        const bf16_t* qp = B.q + (size_t)(b * SEQ + tq) * 1024 + hd * 64 + 8 * hh;
#pragma unroll
        for (int ks = 0; ks < 4; ++ks) qf[ks] = *(const bf16x8*)(qp + ks * 16);
    }
#define NSA_GATE(idx, dep) ({ int t_ = threadIdx.x; asm volatile("" : "+v"(t_) : "v"(dep)); B.gates[(size_t)(b * SEQ + t0 + (t_ & 31)) * 48 + (g * 4 + (t_ >> 6)) * 3 + (idx)]; })
    f32x16 res[2], ot[2];
    float l;
    for (int e = tid; e < 4 * 32 * 65; e += 256) imp[e] = 0.f;
    const int ntc = (qb >> 5) + 1;
    const unsigned long long ctiles = (1ull << ntc) - 1ull;
    const bf16_t* SCK = B.kc + (size_t)bg * 256 * 64;
    const bf16_t* SCV = B.vct + (size_t)bg * 64 * 256;
    const float tbc = -(slope2 * (float)tq) - m2c;
    attn_branch<16, 31>(SCK, SCV, 64, 256, ctiles, ctiles, ~0ull, qf, slope2, tbc, tq, 1 << 30, smem, ot, l, tid);
    const float lc = sum32(l);
    const float invc = (lc > 0.f) ? 1.f / lc : 0.f;
    {
        const float f = NSA_GATE(0, invc) * invc;
#pragma unroll
        for (int dt = 0; dt < 2; ++dt)
#pragma unroll
            for (int r = 0; r < 16; ++r) res[dt][r] = ot[dt][r] * f;
    }
    {
        float* row = imp + wave * (32 * 65) + cl * 65;
        for (int jt = 0; jt < ntc; ++jt) {
            {
                const int rowi = tid >> 2, cq = tid & 3;
                const bf16_t* kp = SCK + (size_t)(jt * 64 + rowi) * 64 + cq * 16;
                const uint4 ka = *(const uint4*)kp, kb = *(const uint4*)(kp + 8);
                __syncthreads();
                char* kd = smem + rowi * KROW + cq * 32;
                *(uint4*)kd = ka; *(uint4*)(kd + 16) = kb;
                __syncthreads();
            }
            f32x16 st[2];
            { bf16x8 kz[2]; kz[0] = __builtin_bit_cast(bf16x8, make_uint4(0u, 0u, 0u, 0u)); kz[1] = kz[0]; attn_qk<false>(smem, qf, st, tid, kz, kz[0]); }
            const int pos0 = 16 * (64 * jt + 4 * hh) + 31;
            const float tb = fmaf(slope2, (float)pos0, tbc);
#pragma unroll
            for (int i = 0; i < 2; ++i)
#pragma unroll
                for (int gq4 = 0; gq4 < 4; ++gq4) {
                    float p[4];
#pragma unroll
                    for (int e4 = 0; e4 < 4; ++e4) {
                        const int r = 4 * gq4 + e4;
                        const int kl = 32 * i + (r & 3) + 8 * (r >> 2);
                        float e = fmaf(slope2 * 16.f, (float)kl, st[i][r]) + tb;
                        e = (tq - (pos0 + 16 * kl) >= 0) ? e : -INFINITY;
                        p[e4] = __builtin_amdgcn_exp2f(e) * invc;
                    }
                    const int js = 16 * jt + 8 * i + 2 * gq4 + hh;
                    row[js] += p[0] + p[1] + p[2] + 0.5f * p[3];
                    st[i][4 * gq4] = 0.5f * p[3];
                }
            __builtin_amdgcn_s_waitcnt(0xc07f);
#pragma unroll
            for (int i = 0; i < 2; ++i)
#pragma unroll
                for (int gq4 = 0; gq4 < 4; ++gq4) { const int js = 16 * jt + 8 * i + 2 * gq4 + hh; row[js + 1] += st[i][4 * gq4]; }
        }
    }
    __syncthreads();
    {
        const int q = tid >> 3, part = tid & 7;
        const float* row = imp + q * 65;
        auto impv = [&](int j) -> float { return ((row[j] + row[j + 32 * 65]) + row[j + 2 * 32 * 65]) + row[j + 3 * 32 * 65]; };
        float myv[8]; int rank[8];
#pragma unroll
        for (int u = 0; u < 8; ++u) { const int j = part * 8 + u; const bool f = (j == 0) || (j == c) || (j == c - 1); myv[u] = f ? 1e9f : impv(j); rank[u] = 0; }
        for (int j2 = 0; j2 <= c; ++j2) {
            const bool f2 = (j2 == 0) || (j2 == c) || (j2 == c - 1);
            const float v2 = f2 ? 1e9f : impv(j2);
#pragma unroll
            for (int u = 0; u < 8; ++u) { const int j = part * 8 + u; rank[u] += (v2 > myv[u] || (v2 == myv[u] && j2 < j)) ? 1 : 0; }
        }
        unsigned bits = 0u;
#pragma unroll
        for (int u = 0; u < 8; ++u) { const int j = part * 8 + u; if (j <= c && rank[u] < 16) bits |= 1u << u; }
        unsigned lo = (part < 4) ? (bits << (8 * part)) : 0u, hi = (part >= 4) ? (bits << (8 * (part - 4))) : 0u;
        lo |= ux<1>(lo); lo |= ux<2>(lo); lo |= ux<4>(lo); hi |= ux<1>(hi); hi |= ux<2>(hi); hi |= ux<4>(hi);
        if (part == 0) msk[q] = make_uint2(lo, hi);
    }
    __syncthreads();
    const uint2 mm = msk[cl];
    const unsigned long long mymask = (unsigned long long)mm.x | ((unsigned long long)mm.y << 32);
    const unsigned ulo = or_lo32(mm.x), uhi = or_lo32(mm.y);
    const unsigned long long U = (unsigned long long)__builtin_amdgcn_readfirstlane(ulo) | ((unsigned long long)__builtin_amdgcn_readfirstlane(uhi) << 32);
    {
        const float tbs = -(slope2 * (float)tq) - m2s;
        attn_branch<1, 0>(B.ks + (size_t)(b * SEQ) * 256 + g * 64, B.vst + (size_t)bg * 64 * SEQ, 256, SEQ, U, 1ull << c, mymask, qf, slope2, tbs, tq, 1 << 30, smem, ot, l, tid);
        const float ls = sum32(l);
        const float f = NSA_GATE(1, ls) / ls;
#pragma unroll
        for (int dt = 0; dt < 2; ++dt)
#pragma unroll
            for (int r = 0; r < 16; ++r) res[dt][r] += ot[dt][r] * f;
    }
    {
        const float tbw = -(slope2 * (float)tq) - m2w;
        const int lo_pos = t0 - 511;
        const int jlo = lo_pos > 0 ? (lo_pos >> 6) : 0;
        unsigned long long wt = 0ull, wm = 0ull;
        for (int j = jlo; j <= c; ++j) { wt |= 1ull << j; if (j == c || 64 * j < t0 + 31 - 511) wm |= 1ull << j; }
        attn_branch<1, 0>(B.kw + (size_t)(b * SEQ) * 256 + g * 64, B.vwt + (size_t)bg * 64 * SEQ, 256, SEQ, wt, wm, ~0ull, qf, slope2, tbw, tq, 512, smem, ot, l, tid);
        const float lw_ = sum32(l);
        const float f = NSA_GATE(2, lw_) / lw_;
#pragma unroll
        for (int dt = 0; dt < 2; ++dt)
#pragma unroll
            for (int r = 0; r < 16; ++r) res[dt][r] += ot[dt][r] * f;
    }
    {
        const int tid2 = opq_tid();
        bf16_t* dst = att + (size_t)(b * SEQ + t0 + (tid2 & 31)) * 1024 + (g * 4 + (tid2 >> 6)) * 64;
#pragma unroll
        for (int dt = 0; dt < 2; ++dt)
#pragma unroll
            for (int q4 = 0; q4 < 4; ++q4) {
                const int d = 32 * dt + 8 * q4 + 4 * hh;
                uint2 o; o.x = pk2(res[dt][4 * q4], res[dt][4 * q4 + 1]); o.y = pk2(res[dt][4 * q4 + 2], res[dt][4 * q4 + 3]);
                *(uint2*)(dst + d) = o;
            }
    }
}


template <bool COMBINE, int R>
__device__ __forceinline__ void rp_rows(const float* __restrict__ in, float* __restrict__ hw, const bf16_t* __restrict__ ys, bf16_t* __restrict__ hi, int row0, int rstride, int nrows_valid, float* rs_out) {
    const int lane = opq_tid() & 63;
    float4 v[R][4]; float ss[R];
#pragma unroll
    for (int r = 0; r < R; ++r) {
        const size_t row = (size_t)(row0 + r * rstride);
        ss[r] = 0.f;
        if (r < nrows_valid) {
#pragma unroll
            for (int i = 0; i < 4; ++i) v[r][i] = ((const float4*)(in + row * DM))[lane + 64 * i];
        }
    }
    if (COMBINE) {
#pragma unroll
        for (int r = 0; r < R; ++r) {
            const size_t row = (size_t)(row0 + r * rstride);
            if (r < nrows_valid) {
#pragma unroll
                for (int i = 0; i < 4; ++i) {
                    const uint2 b = ((const uint2*)(ys + row * 2 * DM))[lane + 64 * i], c = ((const uint2*)(ys + row * 2 * DM + DM))[lane + 64 * i];
                    float4 a = v[r][i];
                    a.x += bf16_lo_f(b.x) + bf16_lo_f(c.x); a.y += bf16_hi_f(b.x) + bf16_hi_f(c.x);
                    a.z += bf16_lo_f(b.y) + bf16_lo_f(c.y); a.w += bf16_hi_f(b.y) + bf16_hi_f(c.y);
                    v[r][i] = a;
                    ((float4*)(hw + row * DM))[lane + 64 * i] = a;
                }
            }
        }
    }
#pragma unroll
    for (int r = 0; r < R; ++r) {
        if (r < nrows_valid) {
#pragma unroll
            for (int i = 0; i < 4; ++i) ss[r] += v[r][i].x * v[r][i].x + v[r][i].y * v[r][i].y + v[r][i].z * v[r][i].z + v[r][i].w * v[r][i].w;
        }
    }
#pragma unroll
    for (int r = 0; r < R; ++r) ss[r] = wave_sum(ss[r]);
#pragma unroll
    for (int r = 0; r < R; ++r) {
        const size_t row = (size_t)(row0 + r * rstride);
        if (r < nrows_valid) {
            const float rr = rsqrtf(ss[r] * (1.f / DM) + 1e-6f);
            if (rs_out && lane == 0) rs_out[r] = rr;
#pragma unroll
            for (int i = 0; i < 4; ++i) {
                uint2 o; o.x = pk2(v[r][i].x * rr, v[r][i].y * rr); o.y = pk2(v[r][i].z * rr, v[r][i].w * rr);
                ((uint2*)(hi + row * DM))[lane + 64 * i] = o;
            }
        }
    }
}

__device__ __forceinline__ void rw_build(const float* __restrict__ wg, const float* __restrict__ we, const float* __restrict__ gain, bf16_t* __restrict__ dh, bf16_t* __restrict__ dl, int start, int stride) {
    for (int idx = start; idx < 48 * 1024; idx += stride) {
        const int n = idx >> 10, kk = idx & 1023;
        float v = 0.f;
        if (n < 4) v = wg[kk * 4 + n] * gain[kk];
        else if (n < 36) v = we[kk * 32 + (n - 4)] * gain[kk];
        const unsigned hi = pk2(v, 0.f) & 0xffffu;
        dh[idx] = (bf16_t)hi;
        dl[idx] = (bf16_t)(pk2(v - bf16_lo_f(hi), 0.f) & 0xffffu);
    }
}
struct RouteSel { int x1, x2; float w1, w2; };
__device__ __forceinline__ RouteSel route_select(const float (&lg)[36], const float* __restrict__ bgp, const float* __restrict__ bep) {
    float gl[4];
#pragma unroll
    for (int i = 0; i < 4; ++i) gl[i] = lg[i] + bgp[i];
    int gi = 0; float gm = gl[0];
#pragma unroll
    for (int i = 1; i < 4; ++i) if (gl[i] > gm) { gm = gl[i]; gi = i; }
    float gs = 0.f;
#pragma unroll
    for (int i = 0; i < 4; ++i) gs += expf(gl[i] - gm);
    const float gw = 1.f / gs;
    float el[8];
#pragma unroll
    for (int e = 0; e < 8; ++e) {
        float v = 0.f;
#pragma unroll
        for (int gg = 0; gg < 4; ++gg) v = (gg == gi) ? (lg[4 + gg * 8 + e] + bep[gg * 8 + e]) : v;
        el[e] = v;
    }
    int e1 = 0; float m1 = el[0];
#pragma unroll
    for (int e = 1; e < 8; ++e) if (el[e] > m1) { m1 = el[e]; e1 = e; }
    int e2 = -1; float m2 = -INFINITY;
#pragma unroll
    for (int e = 0; e < 8; ++e) if (e != e1 && el[e] > m2) { m2 = el[e]; e2 = e; }
    const float p2 = expf(m2 - m1);
    RouteSel R;
    R.w1 = gw / (1.f + p2); R.w2 = gw * p2 / (1.f + p2);
    R.x1 = gi * 8 + e1; R.x2 = gi * 8 + e2;
    return R;
}
typedef float f32x4v __attribute__((ext_vector_type(4)));
#define RT_ROW 272
#define RT_XH 0
#define RT_XL 8704
#define RT_WH 17408
#define RT_WL 30464
#define RT_RS 43520
#define RT_RED 43648
__device__ __forceinline__ void route_item(const float* __restrict__ h, bf16_t* __restrict__ xhi, const bf16_t* __restrict__ wrh, const bf16_t* __restrict__ wrl,
                                           const float* __restrict__ bgp, const float* __restrict__ bep,
                                           int* __restrict__ cnt, int* __restrict__ lslot, float* __restrict__ lw, int it, char* smem) {
    const int tid = opq_tid(), wave = tid >> 6, lane = tid & 63;
    const int m0 = it * 32;
    float* rs = (float*)(smem + RT_RS);
    float* red = (float*)(smem + RT_RED);
    rp_rows<false, 4>(h, nullptr, nullptr, xhi, m0 + wave * 8, 1, 4, rs + wave * 8);
    rp_rows<false, 4>(h, nullptr, nullptr, xhi, m0 + wave * 8 + 4, 1, 4, rs + wave * 8 + 4);
    f32x4v acc[3][2];
#pragma unroll
    for (int t = 0; t < 3; ++t)
#pragma unroll
        for (int u = 0; u < 2; ++u) acc[t][u] = (f32x4v){0.f, 0.f, 0.f, 0.f};
    const int stok = tid >> 3, sk = (tid & 7) * 16;
    for (int ch = 0; ch < 8; ++ch) {
        __syncthreads();
#pragma unroll
        for (int p = 0; p < 3; ++p) {
            const int idx = tid + 256 * p, row = idx >> 4, c16 = idx & 15;
            *(uint4*)(smem + RT_WH + row * RT_ROW + c16 * 16) = *(const uint4*)(wrh + (size_t)row * 1024 + ch * 128 + c16 * 8);
            *(uint4*)(smem + RT_WL + row * RT_ROW + c16 * 16) = *(const uint4*)(wrl + (size_t)row * 1024 + ch * 128 + c16 * 8);
        }
        {
            const float* hp = h + (size_t)(m0 + stok) * DM + ch * 128 + sk;
            const float r = rs[stok];
            unsigned ph[8], pl[8];
#pragma unroll
            for (int q = 0; q < 4; ++q) {
                const float4 v = *(const float4*)(hp + 4 * q);
                const float a0 = v.x * r, a1 = v.y * r, a2 = v.z * r, a3 = v.w * r;
                const unsigned h0 = pk2(a0, a1), h1 = pk2(a2, a3);
                ph[2 * q] = h0; ph[2 * q + 1] = h1;
                pl[2 * q] = pk2(a0 - bf16_lo_f(h0), a1 - bf16_hi_f(h0)); pl[2 * q + 1] = pk2(a2 - bf16_lo_f(h1), a3 - bf16_hi_f(h1));
            }
            char* dx = smem + stok * RT_ROW + sk * 2;
            *(uint4*)(dx + RT_XH) = make_uint4(ph[0], ph[1], ph[2], ph[3]); *(uint4*)(dx + RT_XH + 16) = make_uint4(ph[4], ph[5], ph[6], ph[7]);
            *(uint4*)(dx + RT_XL) = make_uint4(pl[0], pl[1], pl[2], pl[3]); *(uint4*)(dx + RT_XL + 16) = make_uint4(pl[4], pl[5], pl[6], pl[7]);
        }
        __syncthreads();
        {
            const int ko = (32 * wave + 8 * (lane >> 4)) * 2, rr = lane & 15;
            bf16x8 ah[3], al[3], bh[2], bl[2];
#pragma unroll
            for (int t = 0; t < 3; ++t) { ah[t] = *(const bf16x8*)(smem + RT_WH + (16 * t + rr) * RT_ROW + ko); al[t] = *(const bf16x8*)(smem + RT_WL + (16 * t + rr) * RT_ROW + ko); }
#pragma unroll
            for (int u = 0; u < 2; ++u) { bh[u] = *(const bf16x8*)(smem + RT_XH + (16 * u + rr) * RT_ROW + ko); bl[u] = *(const bf16x8*)(smem + RT_XL + (16 * u + rr) * RT_ROW + ko); }
#pragma unroll
            for (int t = 0; t < 3; ++t)
#pragma unroll
                for (int u = 0; u < 2; ++u) {
                    acc[t][u] = __builtin_amdgcn_mfma_f32_16x16x32_bf16(ah[t], bh[u], acc[t][u], 0, 0, 0);
                    acc[t][u] = __builtin_amdgcn_mfma_f32_16x16x32_bf16(ah[t], bl[u], acc[t][u], 0, 0, 0);
                    acc[t][u] = __builtin_amdgcn_mfma_f32_16x16x32_bf16(al[t], bh[u], acc[t][u], 0, 0, 0);
                }
        }
    }
#pragma unroll
    for (int t = 0; t < 3; ++t)
#pragma unroll
        for (int u = 0; u < 2; ++u)
#pragma unroll
            for (int r = 0; r < 4; ++r) red[(wave * 48 + 16 * t + 4 * (lane >> 4) + r) * 32 + 16 * u + (lane & 15)] = acc[t][u][r];
    __syncthreads();
    if (tid < 32) {
        float lg[36];
#pragma unroll
        for (int n = 0; n < 36; ++n) lg[n] = ((red[n * 32 + tid] + red[(48 + n) * 32 + tid]) + red[(96 + n) * 32 + tid]) + red[(144 + n) * 32 + tid];
        const RouteSel A = route_select(lg, bgp, bep);
        const int t = m0 + tid;
        const int pa1 = atomicAdd(&cnt[A.x1 * CNT_STRIDE], 1), pa2 = atomicAdd(&cnt[A.x2 * CNT_STRIDE], 1);
        lslot[A.x1 * TTOK + pa1] = t * 2;     lw[A.x1 * TTOK + pa1] = A.w1;
        lslot[A.x2 * TTOK + pa2] = t * 2 + 1; lw[A.x2 * TTOK + pa2] = A.w2;
    }
}

struct EpiStoreB { bf16_t* C; long long ldc; __device__ void operator()(int r, int c, float4 v) const { uint2 o; o.x = pk2(v.x, v.y); o.y = pk2(v.z, v.w); *(uint2*)(C + (size_t)r * ldc + c) = o; } };
struct EpiPleB { const bf16_t* Pj; float* H; long long ldc; __device__ void operator()(int r, int c, float4 v) const {
    const uint2 p = *(const uint2*)(Pj + (size_t)r * ldc + c); float4 a = *(const float4*)(H + (size_t)r * ldc + c);
    a.x += bf16_lo_f(p.x) / (1.f + __expf(-v.x)); a.y += bf16_hi_f(p.x) / (1.f + __expf(-v.y)); a.z += bf16_lo_f(p.y) / (1.f + __expf(-v.z)); a.w += bf16_hi_f(p.y) / (1.f + __expf(-v.w));
    *(float4*)(H + (size_t)r * ldc + c) = a; } };
__device__ __forceinline__ void ple_proj_item(const float* __restrict__ pin, const bf16_t* __restrict__ wp, bf16_t* __restrict__ pj, int bx, int by, char* smem) {
    d_gemm<true>(pin, wp, 256, TTOK, DM, 256, EpiStoreB{pj, DM}, bx, by, smem);
}
__device__ __forceinline__ void ple_item(const bf16_t* __restrict__ xhat, const bf16_t* __restrict__ wg, const bf16_t* __restrict__ pj, float* __restrict__ h, int bx, int by, char* smem) {
    d_gemm<false>(xhat, wg, DM, TTOK, DM, DM, EpiPleB{pj, h, DM}, bx, by, smem);
}
__device__ __forceinline__ void ple_item_l0(const bf16_t* __restrict__ xhat, const bf16_t* __restrict__ wg, const bf16_t* __restrict__ pj, float* __restrict__ h,
                                            bf16_t* __restrict__ hb, float* __restrict__ ssq, int bx, int by, char* smem) {
    const int m0 = by * 128, n0 = bx * 128;
    f32x16 acc[2][2];
    gemm_core_glds(xhat, [&](int i, int r) -> unsigned { return (unsigned)(m0 + r) * (DM * 2u); }, 128u, wg, DM, n0, DM, smem, acc);
    const int tid_ = opq_tid(), lane = tid_ & 63, wave = tid_ >> 6;
    const int wn = wave >> 1, wm = wave & 1, c = lane & 31, hh = lane >> 5;
#pragma unroll
    for (int j = 0; j < 2; ++j) {
        const int m = m0 + wm * 64 + 32 * j + c;
        float ss = 0.f;
#pragma unroll
        for (int i = 0; i < 2; ++i)
#pragma unroll
            for (int q4 = 0; q4 < 4; ++q4) {
                const int n = n0 + wn * 64 + 32 * i + 8 * q4 + 4 * hh;
                const uint2 p = *(const uint2*)(pj + (size_t)m * DM + n);
                float4 a = *(const float4*)(h + (size_t)m * DM + n);
                a.x += bf16_lo_f(p.x) / (1.f + __expf(-acc[i][j][4 * q4])); a.y += bf16_hi_f(p.x) / (1.f + __expf(-acc[i][j][4 * q4 + 1]));
                a.z += bf16_lo_f(p.y) / (1.f + __expf(-acc[i][j][4 * q4 + 2])); a.w += bf16_hi_f(p.y) / (1.f + __expf(-acc[i][j][4 * q4 + 3]));
                *(float4*)(h + (size_t)m * DM + n) = a;
                uint2 o; o.x = pk2(a.x, a.y); o.y = pk2(a.z, a.w);
                *(uint2*)(hb + (size_t)m * DM + n) = o;
                const float b0 = bf16_lo_f(o.x), b1 = bf16_hi_f(o.x), b2 = bf16_lo_f(o.y), b3 = bf16_hi_f(o.y);
                ss += b0 * b0 + b1 * b1 + b2 * b2 + b3 * b3;
            }
        ss = sum32(ss);
        if (hh == 0) ssq[(size_t)m * 16 + bx * 2 + wn] = ss;
    }
}

#define HROW 272
#define MOE_W_OFF 36864
template <bool A_F32>
__device__ __forceinline__ void moe_item(const void* __restrict__ xn, const bf16_t* __restrict__ wgu, const bf16_t* __restrict__ wd,
                                         const int* __restrict__ slots, const float* __restrict__ wts, int nvalid, bf16_t* __restrict__ ys, char* smem) {
    const int tid = opq_tid(), lane = tid & 63, wave = tid >> 6;
    const int wn = wave >> 1, wm = wave & 1, c = lane & 31, h = lane >> 5;
    const int sr = tid >> 3, sc = tid & 7;
    auto rowo = [&](int i) -> unsigned {
        const int idx = sr + 32 * i;
        if (idx >= nvalid) return 0u;
        return (unsigned)(slots[idx] >> 1) * 2048u;
    };
    const unsigned ro0 = rowo(0), ro1 = rowo(1), ro2 = rowo(2), ro3 = rowo(3);
    float cw[2]; int myslot[2];
#pragma unroll
    for (int j = 0; j < 2; ++j) {
        const int idx = wm * 64 + 32 * j + c;
        const bool ok = idx < nvalid;
        cw[j] = ok ? wts[idx] : 0.f;
        myslot[j] = ok ? slots[idx] : -1;
    }
    unsigned hp[2][2][8];
#pragma unroll
    for (int pass = 0; pass < 2; ++pass) {
        f32x16 acc[2][2];
        static_assert(!A_F32, "the expert GEMM streams bf16 rows straight into LDS");
        gemm_core_glds(xn, [&](int i, int r) -> unsigned { return (i == 0) ? ro0 : (i == 1) ? ro1 : (i == 2) ? ro2 : ro3; }, 128u, wgu, 1024, pass * 128, 1024, smem, acc);
#pragma unroll
        for (int j = 0; j < 2; ++j)
#pragma unroll
            for (int r2 = 0; r2 < 8; ++r2) {
                const float g0 = acc[0][j][2 * r2], g1 = acc[0][j][2 * r2 + 1];
                const float u0 = acc[1][j][2 * r2], u1 = acc[1][j][2 * r2 + 1];
                const float h0 = g0 / (1.f + __expf(-g0)) * u0 * cw[j], h1 = g1 / (1.f + __expf(-g1)) * u1 * cw[j];
                hp[pass][j][r2] = pk2(h0, h1);
            }
    }
#pragma unroll
    for (int pass = 0; pass < 2; ++pass)
#pragma unroll
        for (int j = 0; j < 2; ++j)
#pragma unroll
            for (int q4 = 0; q4 < 4; ++q4) {
                const int m = wm * 64 + 32 * j + c, f = pass * 64 + wn * 32 + 8 * q4 + 4 * h;
                *(uint2*)(smem + m * HROW + f * 2) = make_uint2(hp[pass][j][2 * q4], hp[pass][j][2 * q4 + 1]);
            }
    auto wissue = [&](int s, int buf) {
        const int nt = s >> 1, kt = s & 1;
        char* wb = smem + MOE_W_OFF + buf * GT_BYTES;
#pragma unroll
        for (int i = 0; i < 4; ++i) {
            const int r = sr + 32 * i;
            const int cs = sc ^ ((r >> 1) & 7);
            const char* wp = (const char*)(wd + (size_t)(nt * 128 + r) * 128 + kt * 64) + cs * 16;
            __builtin_amdgcn_global_load_lds((const __attribute__((address_space(1))) void*)wp, (__attribute__((address_space(3))) void*)(wb + (32 * i + 8 * wave) * 128), 16, 0, 0);
        }
    };
    wissue(0, 0);
    __syncthreads();
    f32x16 acc[2][2];
    for (int s = 0; s < 16; ++s) {
        const int kt = s & 1;
        if (kt == 0) {
#pragma unroll
            for (int i = 0; i < 2; ++i)
#pragma unroll
                for (int j = 0; j < 2; ++j)
#pragma unroll
                    for (int r = 0; r < 16; ++r) acc[i][j][r] = 0.f;
        }
        if (s + 1 < 16) wissue(s + 1, (s + 1) & 1);
        const char* wb = smem + MOE_W_OFF + (s & 1) * GT_BYTES;
        {
            const int rw0 = wn * 64 + c, kw = (rw0 >> 1) & 7;
            const char* wp0 = wb + rw0 * 128;
            const char* xp0 = smem + (wm * 64 + c) * HROW + kt * 128 + h * 16;
#define WFRAG(base, ks) (*(const bf16x8*)((base) + (((2 * (ks) + h) ^ kw) << 4)))
            bf16x8 wfa0 = WFRAG(wp0, 0), wfa1 = WFRAG(wp0 + 32 * 128, 0), xfa0 = *(const bf16x8*)(xp0), xfa1 = *(const bf16x8*)(xp0 + 32 * HROW);
#pragma unroll
            for (int ks = 0; ks < 4; ++ks) {
                bf16x8 wfb0, wfb1, xfb0, xfb1;
                if (ks < 3) {
                    wfb0 = WFRAG(wp0, ks + 1); wfb1 = WFRAG(wp0 + 32 * 128, ks + 1);
                    xfb0 = *(const bf16x8*)(xp0 + (ks + 1) * 32); xfb1 = *(const bf16x8*)(xp0 + 32 * HROW + (ks + 1) * 32);
                }
                acc[0][0] = __builtin_amdgcn_mfma_f32_32x32x16_bf16(wfa0, xfa0, acc[0][0], 0, 0, 0);
                acc[0][1] = __builtin_amdgcn_mfma_f32_32x32x16_bf16(wfa0, xfa1, acc[0][1], 0, 0, 0);
                acc[1][0] = __builtin_amdgcn_mfma_f32_32x32x16_bf16(wfa1, xfa0, acc[1][0], 0, 0, 0);
                acc[1][1] = __builtin_amdgcn_mfma_f32_32x32x16_bf16(wfa1, xfa1, acc[1][1], 0, 0, 0);
                __builtin_amdgcn_sched_barrier(0);
                if (ks < 3) { wfa0 = wfb0; wfa1 = wfb1; xfa0 = xfb0; xfa1 = xfb1; }
            }
#undef WFRAG
        }
        if (kt == 1) {
            const int nt = s >> 1;
#pragma unroll
            for (int j = 0; j < 2; ++j) {
                if (myslot[j] >= 0) {
                    bf16_t* dst = ys + (size_t)myslot[j] * 1024 + nt * 128 + wn * 64;
#pragma unroll
                    for (int i = 0; i < 2; ++i)
#pragma unroll
                        for (int q4 = 0; q4 < 4; ++q4) {
                            uint2 o; o.x = pk2(acc[i][j][4 * q4], acc[i][j][4 * q4 + 1]); o.y = pk2(acc[i][j][4 * q4 + 2], acc[i][j][4 * q4 + 3]);
                            *(uint2*)(dst + 32 * i + 8 * q4 + 4 * h) = o;
                        }
                }
            }
        }
        __syncthreads();
    }
}

struct L1Bufs { bf16_t *q, *k, *vt; float* kmpart; };

__device__ __forceinline__ void p7_item(const bf16_t* __restrict__ xn, const float* __restrict__ ssq, const bf16_t* __restrict__ wt, const float* __restrict__ qn, const float* __restrict__ kn,
                                        const L1Bufs& B, int bx, int by, char* smem) {
    const int m0 = by * 128, n0 = bx * 128;
    f32x16 acc[2][2];
    gemm_core_glds(xn, [&](int i, int r) -> unsigned { return (unsigned)(m0 + r) * (DM * 2u); }, 128u, wt, DM, n0, DM, smem, acc);
    const int tid_ = opq_tid(), lane = tid_ & 63, wave = tid_ >> 6;
    const int wn = wave >> 1, wm = wave & 1, c = lane & 31, h = lane >> 5;
    const int ch = (n0 >> 6) + wn;
    float rstd[2];
#pragma unroll
    for (int j = 0; j < 2; ++j) {
        const float4* sp = (const float4*)(ssq + (size_t)(m0 + wm * 64 + 32 * j + c) * 16);
        const float4 s0 = sp[0], s1 = sp[1], s2 = sp[2], s3 = sp[3];
        const float S = (((s0.x + s0.y) + (s0.z + s0.w)) + ((s1.x + s1.y) + (s1.z + s1.w))) + (((s2.x + s2.y) + (s2.z + s2.w)) + ((s3.x + s3.y) + (s3.z + s3.w)));
        rstd[j] = rsqrtf(S * (1.f / DM) + 1e-6f);
    }
    if (ch < 4 || ch >= 8) {
        const float* g = (ch < 4) ? kn : qn;
        float nv[2][2][16];
#pragma unroll
        for (int j = 0; j < 2; ++j) {
            const int m = m0 + wm * 64 + 32 * j + c;
            float ss = 0.f;
#pragma unroll
            for (int i = 0; i < 2; ++i)
#pragma unroll
                for (int r = 0; r < 16; ++r) ss += acc[i][j][r] * acc[i][j][r];
            ss = sum32(ss);
            float rs = rstd[j] * rsqrtf(ss * rstd[j] * rstd[j] * (1.f / 64.f) + 1e-6f);
            if (ch >= 8) rs *= 0.125f * LOG2E;
            bf16_t* dst = (ch < 4) ? (B.k + (size_t)m * 256 + ch * 64) : (B.q + (size_t)m * 1024 + (ch - 8) * 64);
#pragma unroll
            for (int i = 0; i < 2; ++i)
#pragma unroll
                for (int q4 = 0; q4 < 4; ++q4) {
                    const int nl = 32 * i + 8 * q4 + 4 * h;
                    const float4 gg = *(const float4*)(g + nl);
                    const float v0 = acc[i][j][4 * q4] * rs * gg.x, v1 = acc[i][j][4 * q4 + 1] * rs * gg.y, v2 = acc[i][j][4 * q4 + 2] * rs * gg.z, v3 = acc[i][j][4 * q4 + 3] * rs * gg.w;
                    nv[i][j][4 * q4] = v0; nv[i][j][4 * q4 + 1] = v1; nv[i][j][4 * q4 + 2] = v2; nv[i][j][4 * q4 + 3] = v3;
                    uint2 o; o.x = pk2(v0, v1); o.y = pk2(v2, v3);
                    *(uint2*)(dst + nl) = o;
                }
        }
        if (ch < 4) {
            const int mb = m0 + wm * 64, b = mb >> 12, grp = (mb & 4095) >> 6;
            float* dst = B.kmpart + ((size_t)(b * 4 + ch) * 64 + grp) * 64;
#pragma unroll
            for (int i = 0; i < 2; ++i)
#pragma unroll
                for (int r = 0; r < 16; ++r) {
                    float s = sum_lo32(nv[i][0][r] + nv[i][1][r]);
                    if (c == 0) dst[32 * i + (r & 3) + 8 * (r >> 2) + 4 * h] = s;
                }
        }
    } else {
        const int g = ch - 4;
#pragma unroll
        for (int j = 0; j < 2; ++j) {
            const int m = m0 + wm * 64 + 32 * j + c;
            const int b = m >> 12, t = m & 4095;
            bf16_t* dst = B.vt + ((size_t)(b * 4 + g) * 64) * SEQ + t;
#pragma unroll
            for (int i = 0; i < 2; ++i)
#pragma unroll
                for (int r = 0; r < 16; ++r) {
                    const int d = 32 * i + (r & 3) + 8 * (r >> 2) + 4 * h;
                    dst[(size_t)d * SEQ] = (bf16_t)(pk2(acc[i][j][r] * rstd[j], 0.f) & 0xffffu);
                }
        }
    }
}

__device__ __forceinline__ void moba_attn_item(const L1Bufs& B, const float* __restrict__ qn, const float* __restrict__ kn, bf16_t* __restrict__ att, int bg, int qb, char* smem) {
    const int tid = opq_tid();
    const int lane = tid & 63, wave = tid >> 6, cl = lane & 31, hh = lane >> 5;
    const int b = bg >> 2, g = bg & 3, hd = g * 4 + wave;
    const int t0 = qb * 32, c = qb >> 1, cb = qb >> 3, tq = t0 + cl;
    const float slope2 = exp2f(-0.5f * (float)(hd + 1)) * LOG2E;
    float* kms = (float*)(smem + ATT_IMP_OFF);
    unsigned* um = (unsigned*)(smem + ATT_MASK_OFF);
    const float m2 = (8.f * wave_max(fabsf(qn[lane])) * wave_max(fabsf(kn[lane])) * 1.02f + 0.5f) * LOG2E;
    __syncthreads();
    {
        const int n = tid >> 4, d4 = (tid & 15) * 4;
        float4 a = make_float4(0.f, 0.f, 0.f, 0.f);
        if (n < cb) {
            const float* p = B.kmpart + ((size_t)bg * 64 + n * 4) * 64 + d4;
#pragma unroll
            for (int u = 0; u < 4; ++u) { const float4 x = *(const float4*)(p + u * 64); a.x += x.x; a.y += x.y; a.z += x.z; a.w += x.w; }
        }
        const float sc = 1.f / 256.f;
        *(float4*)(kms + n * 64 + d4) = make_float4(a.x * sc, a.y * sc, a.z * sc, a.w * sc);
        if (tid == 0) um[0] = 0u;
    }
    bf16x8 qf[4];
    {
        const bf16_t* qp = B.q + (size_t)(b * SEQ + tq) * 1024 + hd * 64 + 8 * hh;
#pragma unroll
        for (int ks = 0; ks < 4; ++ks) qf[ks] = *(const bf16x8*)(qp + ks * 16);
    }
    __syncthreads();
    float sg[16];
    {
        float qv[32];
#pragma unroll
        for (int ks = 0; ks < 4; ++ks) {
            const uint4 u = __builtin_bit_cast(uint4, qf[ks]);
            qv[ks * 8 + 0] = __uint_as_float(u.x << 16); qv[ks * 8 + 1] = __uint_as_float(u.x & 0xffff0000u);
            qv[ks * 8 + 2] = __uint_as_float(u.y << 16); qv[ks * 8 + 3] = __uint_as_float(u.y & 0xffff0000u);
            qv[ks * 8 + 4] = __uint_as_float(u.z << 16); qv[ks * 8 + 5] = __uint_as_float(u.z & 0xffff0000u);
            qv[ks * 8 + 6] = __uint_as_float(u.w << 16); qv[ks * 8 + 7] = __uint_as_float(u.w & 0xffff0000u);
        }
#pragma unroll
        for (int n = 0; n < 16; ++n) {
            float s = 0.f;
            if (n < cb) {
#pragma unroll
                for (int ks = 0; ks < 4; ++ks) {
                    const float4 k0 = *(const float4*)(kms + n * 64 + ks * 16 + 8 * hh), k1 = *(const float4*)(kms + n * 64 + ks * 16 + 8 * hh + 4);
                    s += qv[ks * 8 + 0] * k0.x + qv[ks * 8 + 1] * k0.y + qv[ks * 8 + 2] * k0.z + qv[ks * 8 + 3] * k0.w
                       + qv[ks * 8 + 4] * k1.x + qv[ks * 8 + 5] * k1.y + qv[ks * 8 + 6] * k1.z + qv[ks * 8 + 7] * k1.w;
                }
                s = sum32(s);
            } else s = -INFINITY;
            sg[n] = s;
        }
    }
    unsigned bm = 0u;
#pragma unroll
    for (int n = 0; n < 16; ++n) {
        int rank = 0;
#pragma unroll
        for (int n2 = 0; n2 < 16; ++n2) rank += (sg[n2] > sg[n] || (sg[n2] == sg[n] && n2 < n)) ? 1 : 0;
        if (rank < 3 && n < cb) bm |= 1u << n;
    }
    unsigned long long mytiles = 0ull;
#pragma unroll
    for (int n = 0; n < 16; ++n) if ((bm >> n) & 1u) mytiles |= 0xFull << (4 * n);
    unsigned long long own = 0ull;
    for (int j = 4 * cb; j <= c; ++j) own |= 1ull << j;
    mytiles |= own;
    const unsigned wb = or32(or_lo32(bm));
    if (lane == 0) atomicOr(um, wb);
    __syncthreads();
    const unsigned ub = um[0];
    unsigned long long U = own;
    for (int n = 0; n < 16; ++n) if ((ub >> n) & 1u) U |= 0xFull << (4 * n);
    f32x16 ot[2]; float l;
    const float tb0 = -(slope2 * (float)tq) - m2;
    attn_branch<1, 0>(B.k + (size_t)(b * SEQ) * 256 + g * 64, B.vt + (size_t)bg * 64 * SEQ, 256, SEQ, U, 1ull << c, mytiles, qf, slope2, tb0, tq, 1 << 30, smem, ot, l, tid);
    const float lt = sum32(l);
    const float f = 1.f / lt;
    bf16_t* dst = att + (size_t)(b * SEQ + tq) * 1024 + hd * 64;
#pragma unroll
    for (int dt = 0; dt < 2; ++dt)
#pragma unroll
        for (int q4 = 0; q4 < 4; ++q4) {
            const int d = 32 * dt + 8 * q4 + 4 * hh;
            uint2 o; o.x = pk2(ot[dt][4 * q4] * f, ot[dt][4 * q4 + 1] * f); o.y = pk2(ot[dt][4 * q4 + 2] * f, ot[dt][4 * q4 + 3] * f);
            *(uint2*)(dst + d) = o;
        }
}


#define XB_TMO      128
#define XB_XCNT(j)  (256  + 64 * (j))
#define XB_XSUB(j)  (1280 + 64 * (j))
#define XB_XGEN(j)  (2304 + 64 * (j))
#define XB_TOP      3328
#define XB_TOPGEN   3392
#define XCD_BAR_WORDS 3456
#define XB_SPIN_CAP (1u << 22)
#define LAS __attribute__((address_space(3)))
__device__ __forceinline__ unsigned xb_ld(unsigned* p)              { return __hip_atomic_load(p, __ATOMIC_RELAXED, __HIP_MEMORY_SCOPE_AGENT); }
__device__ __forceinline__ unsigned xb_add(unsigned* p, unsigned v) { return __hip_atomic_fetch_add(p, v, __ATOMIC_RELAXED, __HIP_MEMORY_SCOPE_AGENT); }
__device__ __forceinline__ unsigned xb_xcc_id() { return (unsigned)__builtin_amdgcn_s_getreg((3 << 11) | 20) & 0xFu; }
#define XB_SPIN(cond, bar) do { unsigned _sp = 0; while (cond) { __builtin_amdgcn_s_sleep(1); \
    if ((++_sp & 255u) == 0u) { if (xb_ld(&(bar)[XB_TMO])) break; if (_sp > XB_SPIN_CAP) { atomicAdd(&(bar)[XB_TMO], 1u); break; } } } } while (0)
struct XcdBarrier { unsigned* bar; unsigned x; volatile LAS unsigned* st; };
__device__ __forceinline__ XcdBarrier xcd_barrier_post(unsigned* bar, volatile LAS unsigned* st) {
    XcdBarrier b; b.bar = bar; b.x = xb_xcc_id(); b.st = st;
    if (threadIdx.x == 0) (void)xb_add(&bar[XB_XCNT(b.x)], 1u);
    return b;
}
__device__ __forceinline__ void xcd_barrier_complete(unsigned* bar, unsigned x, unsigned& nloc, unsigned& nx) {
    const unsigned G = gridDim.x * gridDim.y * gridDim.z;
    unsigned sum, cnt, mine, sp = 0u;
    for (;;) {
        sum = 0u; cnt = 0u; mine = 0u;
#pragma unroll
        for (unsigned j = 0; j < 16; ++j) { const unsigned c = xb_ld(&bar[XB_XCNT(j)]); sum += c; cnt += (c > 0u) ? 1u : 0u; mine = (j == x) ? c : mine; }
        if (sum == G) break;
        __builtin_amdgcn_s_sleep(1);
        if ((++sp & 255u) == 0u) { if (xb_ld(&bar[XB_TMO])) break; if (sp > XB_SPIN_CAP) { atomicAdd(&bar[XB_TMO], 1u); break; } }
    }
    nloc = mine > 0u ? mine : 1u; nx = cnt > 0u ? cnt : 1u;
}
__device__ __forceinline__ void xcd_barrier(const XcdBarrier& b) {
    asm volatile("s_waitcnt vmcnt(0)" ::: "memory");
    __syncthreads();
    if (threadIdx.x == 0) {
        unsigned* bar = b.bar;
        __builtin_amdgcn_s_waitcnt(0);
        unsigned nloc = b.st[0], nx = b.st[1];
        if (nloc == 0u) { xcd_barrier_complete(bar, b.x, nloc, nx); b.st[0] = nloc; b.st[1] = nx; }
        const unsigned old = xb_add(&bar[XB_XSUB(b.x)], 1u);
        const unsigned gen = old / nloc;
        if (old + 1u == (gen + 1u) * nloc) {
            __builtin_amdgcn_fence(__ATOMIC_RELEASE, "agent");
            asm volatile("s_waitcnt vmcnt(0)" ::: "memory");
            const unsigned og = xb_add(&bar[XB_TOP], 1u);
            const unsigned tg = og / nx;
            if (og + 1u == (tg + 1u) * nx) xb_add(&bar[XB_TOPGEN], 1u);
            else XB_SPIN(xb_ld(&bar[XB_TOPGEN]) == tg, bar);
            __builtin_amdgcn_fence(__ATOMIC_ACQUIRE, "agent");
            xb_add(&bar[XB_XGEN(b.x)], 1u);
            asm volatile("s_waitcnt vmcnt(0)" ::: "memory");
        } else {
            XB_SPIN(xb_ld(&bar[XB_XGEN(b.x)]) == gen, bar);
            __builtin_amdgcn_fence(__ATOMIC_ACQUIRE, "agent");
            asm volatile("s_waitcnt vmcnt(0)" ::: "memory");
        }
    }
    __syncthreads();
}

struct Params {
    const float* in[30];
    float* out;
    float* ws;
    WJob jobs[NJOBS];
};

#define SMEM_TOTAL 73744
__shared__ __attribute__((aligned(16))) char g_smem[SMEM_TOTAL];
typedef const Params __attribute__((address_space(4)))* PPtr;
#define PP() ({ PPtr _p = (PPtr)__builtin_amdgcn_kernarg_segment_ptr(); asm volatile("" : "+s"(_p)); _p; })
__device__ __forceinline__ WJob load_job(PPtr pp, int j) { WJob J; J.src = pp->jobs[j].src; J.dst = pp->jobs[j].dst; J.gain = pp->jobs[j].gain; J.sbs = pp->jobs[j].sbs; J.dbs = pp->jobs[j].dbs; J.K = pp->jobs[j].K; J.N = pp->jobs[j].N; J.Npad = pp->jobs[j].Npad; J.batch = pp->jobs[j].batch; J.perm = pp->jobs[j].perm; J.gbs = pp->jobs[j].gbs; return J; }
__device__ __forceinline__ void grid_sync() {
    XcdBarrier xb; xb.bar = (unsigned*)((char*)PP()->ws + (size_t)166 * 1048576); xb.x = xb_xcc_id(); xb.st = (volatile LAS unsigned*)(g_smem + 73728);
    xcd_barrier(xb);
}
#define GRID_SYNC() grid_sync()
#define PHASE_1D(NB, CALL) do { for (int vb = blockIdx.x; vb < (NB); vb += gridDim.x) { const int bx = vb; __syncthreads(); CALL; } GRID_SYNC(); } while (0)
#define PHASE_2D(NX, NY, CW, CALL) do { \
    const int xcd_ = blockIdx.x & 7, slot_ = blockIdx.x >> 3, nslot_ = gridDim.x >> 3, RY_ = (NY) >> 3; \
    for (int li = slot_; li < (NX) * RY_; li += nslot_) { \
        const int cs_ = li / (RY_ * (CW)), rem_ = li - cs_ * (RY_ * (CW)); \
        const int bx = cs_ * (CW) + rem_ % (CW), by = xcd_ + 8 * (rem_ / (CW)); \
        __syncthreads(); CALL; } \
    GRID_SYNC(); } while (0)
#define GWAVE ((int)blockIdx.x * 4 + (opq_tid() >> 6))
#define NWAVE ((int)gridDim.x * 4)

__device__ __forceinline__ L0Bufs make_l0(char* wsb) {
    L0Bufs LB;
    LB.q = (bf16_t*)wsb;
    LB.kcr = (bf16_t*)(wsb + 33554432);
    LB.vcr = LB.kcr + (size_t)TTOK * 256;
    LB.ks = LB.vcr + (size_t)TTOK * 256;
    LB.vst = LB.ks + (size_t)TTOK * 256;
    LB.kw = LB.vst + (size_t)TTOK * 256;
    LB.vwt = LB.kw + (size_t)TTOK * 256;
    LB.gates = (float*)(LB.vwt + (size_t)TTOK * 256);
    LB.hidc = (bf16_t*)(wsb + 92274688);
    char* regC = wsb + (size_t)160 * 1048576;
    LB.kc = (bf16_t*)regC;
    LB.vct = (bf16_t*)(regC + 524288);
    LB.bias1 = (float*)(regC + 1048576);
    return LB;
}
__device__ __forceinline__ L1Bufs make_l1(char* wsb) {
    L1Bufs B;
    B.q = (bf16_t*)wsb;
    B.k = (bf16_t*)(wsb + 33554432);
    B.vt = B.k + (size_t)TTOK * 256;
    B.kmpart = (float*)(wsb + (size_t)160 * 1048576 + 5245440);
    return B;
}
#define WS_RLOG(wsb) ((float*)((wsb) + 92274688))
#define WS_QCTR(wsb) ((int*)((wsb) + (size_t)160 * 1048576 + 5586944))
#define WS_CNT(wsb) ((int*)((wsb) + (size_t)160 * 1048576 + 5570560))
#define WS_LSLOT(wsb) ((int*)((wsb) + (size_t)160 * 1048576 + 1051136))
#define WS_LW(wsb) ((float*)((wsb) + (size_t)160 * 1048576 + 3148288))
#define WS_PJ(wsb) ((bf16_t*)((wsb) + (size_t)64 * 1048576))
#define WS_SSQ(wsb) ((float*)((wsb) + (size_t)160 * 1048576 + 6815744))
#define WS_XA(wsb) ((bf16_t*)((wsb) + (size_t)96 * 1048576))
#define WS_XB(wsb) ((bf16_t*)((wsb) + (size_t)128 * 1048576))

__device__ __forceinline__ void ph_prologue() {
    char* smem = g_smem;
    const PPtr pp = PP();
    char* wsb = (char*)pp->ws;
    int base = 0;
    for (int j = 0; j < 17; ++j) {
        if (j >= 11 && j < 14) continue;
        const WJob J = load_job(pp, j);
        if (J.src == nullptr) continue;
        const int cntj = J.batch * (J.Npad >> 6) * (J.K >> 6);
        int first = ((int)blockIdx.x - base) % (int)gridDim.x; if (first < 0) first += gridDim.x;
        for (int it = first; it < cntj; it += gridDim.x) wconv_item(J, it, (float*)smem);
        base += cntj;
    }
    for (int layer = 0; layer < 2; ++layer)
        rw_build(pp->in[21] + (size_t)layer * DM * 4, pp->in[23] + (size_t)layer * DM * 32, pp->in[3] + layer * DM, pp->jobs[17].dst + (size_t)layer * 48 * 1024, pp->jobs[17].dst + (size_t)(2 + layer) * 48 * 1024,
                 (int)(blockIdx.x * 256 + threadIdx.x), (int)(gridDim.x * 256));
    {
        const float* x = pp->in[0]; bf16_t* XA = WS_XA(wsb);
        for (int row = GWAVE; row < TTOK; row += 4 * NWAVE) rp_rows<false, 4>(x, nullptr, nullptr, XA, row, NWAVE, (TTOK - row + NWAVE - 1) / NWAVE, nullptr);
    }
    if ((int)blockIdx.x >= (int)gridDim.x - 32) {
        const int q = (int)gridDim.x - 1 - (int)blockIdx.x, which = q >> 4, kb = q & 15;
        const float* pos = (which ? pp->in[11] : pp->in[8]) + kb * 128;
        const float* w1 = (which ? pp->in[12] : pp->in[9]) + (size_t)kb * 128 * 256;
        float a = 0.f;
#pragma unroll 16
        for (int kk = 0; kk < 128; ++kk) a += pos[kk] * w1[(size_t)kk * 256 + threadIdx.x];
        WS_RLOG(wsb)[(which * 16 + kb) * 256 + threadIdx.x] = a;
    }
    if (blockIdx.x == 0) { for (int i = threadIdx.x; i < 4 * 8 * 64; i += 256) WS_QCTR(wsb)[i] = 0; for (int i = threadIdx.x; i < 2 * 32 * CNT_STRIDE; i += 256) WS_CNT(wsb)[i] = 0; }
    GRID_SYNC();
}
__device__ __forceinline__ void ph_p1() {
    char* smem = g_smem;
    const PPtr pp = PP(); char* wsb = (char*)pp->ws;
    const L0Bufs LB = make_l0(wsb);
    const bf16_t* XA = WS_XA(wsb); const bf16_t* w = pp->jobs[0].dst; const float* qn = pp->in[6]; const float* kn = pp->in[7];
    if (blockIdx.x < 2) {
        const float* part = WS_RLOG(wsb) + (size_t)blockIdx.x * 16 * 256 + threadIdx.x;
        float a = 0.f;
#pragma unroll
        for (int kb = 0; kb < 16; ++kb) a += part[kb * 256];
        LB.bias1[blockIdx.x * 256 + threadIdx.x] = a;
    }
    PHASE_2D(21, 128, 7, p1_item(XA, w, qn, kn, LB, bx, by, smem));
}
__device__ __forceinline__ void ph_p2a() {
    char* smem = g_smem;
    const PPtr pp = PP(); char* wsb = (char*)pp->ws;
    const L0Bufs LB = make_l0(wsb);
    const bf16_t* wk = pp->jobs[1].dst; const bf16_t* wv = pp->jobs[3].dst;
    const int nb = (int)gridDim.x;
    const bool split = nb > 128;
    if (!split || (int)blockIdx.x < 128) {
        for (int vb = blockIdx.x; vb < 128; vb += split ? 128 : nb) { const int bx = vb; __syncthreads(); p2a_item(LB, (bx >> 6) ? wv : wk, bx >> 6, (bx >> 1) & 31, bx & 1, smem); }
    }
    if (!split || (int)blockIdx.x >= 128) {
        const int wid = split ? (int)blockIdx.x - 128 : (int)blockIdx.x, nw = split ? nb - 128 : nb;
        int base = 0;
        for (int j = 11; j < 14; ++j) {
            const WJob J = load_job(pp, j);
            if (J.src == nullptr) continue;
            const int cntj = J.batch * (J.Npad >> 6) * (J.K >> 6);
            int first = (wid - base) % nw; if (first < 0) first += nw;
            for (int it = first; it < cntj; it += nw) wconv_item(J, it, (float*)smem);
            base += cntj;
        }
    }
    GRID_SYNC();
}
__device__ __forceinline__ void ph_p2b() {
    char* smem = g_smem;
    const PPtr pp = PP(); char* wsb = (char*)pp->ws;
    const L0Bufs LB = make_l0(wsb);
    const bf16_t* wk = pp->jobs[2].dst; const bf16_t* wv = pp->jobs[4].dst; const float* kn = pp->in[7];
    PHASE_1D(64, p2b_item(LB, (bx >> 5) ? wv : wk, kn, bx >> 5, bx & 31, smem));
}
__device__ __forceinline__ void ph_nsa() {
    char* smem = g_smem;
    const PPtr pp = PP(); char* wsb = (char*)pp->ws;
    const L0Bufs LB = make_l0(wsb);
    const float* qn = pp->in[6]; const float* kn = pp->in[7]; bf16_t* XB = WS_XB(wsb); int* qctr = WS_QCTR(wsb);
    int* misc = (int*)(smem + ATT_MISC_OFF);
    const int myx = (int)xb_xcc_id() & 7;
    const int ln_ = threadIdx.x & 63;
    const float gq_ = wave_max(fabsf(qn[ln_]));
    const float m2c = (8.f * gq_ * wave_max(fabsf(kn[ln_])) * 1.02f + 0.5f) * LOG2E;
    const float m2s = (8.f * gq_ * wave_max(fabsf(kn[64 + ln_])) * 1.02f + 0.5f) * LOG2E;
    const float m2w = (8.f * gq_ * wave_max(fabsf(kn[128 + ln_])) * 1.02f + 0.5f) * LOG2E;
    for (int dx = 0; dx < 8; ++dx) {
        const int x = (myx + dx) & 7;
        for (;;) {
            __syncthreads();
            if (threadIdx.x == 0) misc[0] = atomicAdd(&qctr[x * 64], 1);
            __syncthreads();
            const int id = __builtin_amdgcn_readfirstlane(misc[0]);
            if (id >= 256) break;
            nsa_attn_item(LB, m2c, m2s, m2w, XB, x + 8 * (id >> 7), 127 - (id & 127), smem);
        }
    }
    GRID_SYNC();
}
__device__ __forceinline__ void ph_outproj(int layer) {
    char* smem = g_smem;
    const PPtr pp = PP(); char* wsb = (char*)pp->ws;
    const bf16_t* XB = WS_XB(wsb); const bf16_t* w = pp->jobs[layer ? 8 : 5].dst; const float* r = layer ? pp->out : pp->in[0]; float* h = pp->out;
    PHASE_2D(8, 128, 8, (d_gemm<false>(XB, w, (long long)DM, TTOK, DM, DM, EpiResid{r, h, DM}, bx, by, smem)));
}
__device__ __forceinline__ void ph_route(int layer) {
    char* smem = g_smem;
    const PPtr pp = PP(); char* wsb = (char*)pp->ws;
    const float* h = pp->out; bf16_t* XA = WS_XA(wsb);
    const bf16_t* wrh = pp->jobs[17].dst + (size_t)layer * 48 * 1024; const bf16_t* wrl = pp->jobs[17].dst + (size_t)(2 + layer) * 48 * 1024;
    const float* bgp = pp->in[22] + layer * 4; const float* bep = pp->in[24] + layer * 32;
    int* cntl = WS_CNT(wsb) + layer * 32 * CNT_STRIDE; int* lslot = WS_LSLOT(wsb); float* lw = WS_LW(wsb);
    PHASE_1D(512, route_item(h, XA, wrh, wrl, bgp, bep, cntl, lslot, lw, bx, smem));
}
__device__ __forceinline__ void ph_moe(int layer) {
    char* smem = g_smem;
    const PPtr pp = PP(); char* wsb = (char*)pp->ws;
    const bf16_t* wgu_l = pp->jobs[11 + 3 * layer].dst;
    const bf16_t* wd_l = pp->jobs[13 + 3 * layer].dst;
    const bf16_t* XA = WS_XA(wsb); bf16_t* ysb = (bf16_t*)wsb;
    const int* cntl = WS_CNT(wsb) + layer * 32 * CNT_STRIDE; const int* lslot = WS_LSLOT(wsb); const float* lw = WS_LW(wsb);
    const int xcd = blockIdx.x & 7, nslot = gridDim.x >> 3;
    int it = blockIdx.x >> 3;
    int q = 0, basei = 0;
    for (;;) {
        int nch = 0, e = 0;
        while (q < 4) { e = xcd + 8 * q; nch = (cntl[e * CNT_STRIDE] + 127) >> 7; if (it < basei + nch) break; basei += nch; ++q; }
        if (q >= 4) break;
        const int chunk = it - basei;
        const int nvalid = min(128, cntl[e * CNT_STRIDE] - chunk * 128);
        __syncthreads();
        moe_item<false>(XA, wgu_l + (size_t)e * 256 * 1024, wd_l + (size_t)e * 1024 * 128, lslot + e * TTOK + chunk * 128, lw + e * TTOK + chunk * 128, nvalid, ysb, smem);
        it += nslot;
    }
    {
        const float* pin = pp->in[1] + (size_t)layer * TTOK * 256; const bf16_t* wp = pp->jobs[10].dst + (size_t)layer * 256 * DM; bf16_t* pj = WS_PJ(wsb);
        int* qp = WS_QCTR(wsb) + 1024 + layer * 512;
        int* misc = (int*)(smem + 73712);
        for (int dx = 0; dx < 8; ++dx) {
            const int x = (xcd + dx) & 7;
            for (;;) {
                __syncthreads();
                if (threadIdx.x == 0) misc[0] = atomicAdd(&qp[x * 64], 1);
                __syncthreads();
                const int id = __builtin_amdgcn_readfirstlane(misc[0]);
                if (id >= 128) break;
                ple_proj_item(pin, wp, pj, id & 7, x + 8 * (id >> 3), smem);
            }
        }
    }
    GRID_SYNC();
}
__device__ __forceinline__ void ph_combine() {
    const PPtr pp = PP(); char* wsb = (char*)pp->ws;
    float* h = pp->out; const bf16_t* ysb = (const bf16_t*)wsb; bf16_t* XB = WS_XB(wsb);
    for (int row = GWAVE; row < TTOK; row += 2 * NWAVE) rp_rows<true, 2>(h, h, ysb, XB, row, NWAVE, (TTOK - row + NWAVE - 1) / NWAVE, nullptr);
    GRID_SYNC();
}
__device__ __forceinline__ void ph_ple(int layer) {
    char* smem = g_smem;
    const PPtr pp = PP(); char* wsb = (char*)pp->ws;
    float* h = pp->out; const bf16_t* XB = WS_XB(wsb);
    const bf16_t* wg = pp->jobs[9].dst + (size_t)layer * DM * DM;
    const bf16_t* pj = WS_PJ(wsb);
    if (layer == 0) {
        bf16_t* XA = WS_XA(wsb); float* ssq = WS_SSQ(wsb);
        PHASE_2D(8, 128, 8, ple_item_l0(XB, wg, pj, h, XA, ssq, bx, by, smem));
    } else {
        PHASE_2D(8, 128, 8, ple_item(XB, wg, pj, h, bx, by, smem));
    }
}
__device__ __forceinline__ void ph_norm() {
    const PPtr pp = PP(); char* wsb = (char*)pp->ws;
    const float* h = pp->out; bf16_t* XA = WS_XA(wsb);
    for (int row = GWAVE; row < TTOK; row += 4 * NWAVE) rp_rows<false, 4>(h, nullptr, nullptr, XA, row, NWAVE, (TTOK - row + NWAVE - 1) / NWAVE, nullptr);
    GRID_SYNC();
}
__device__ __forceinline__ void ph_p7() {
    char* smem = g_smem;
    const PPtr pp = PP(); char* wsb = (char*)pp->ws;
    const L1Bufs L1B = make_l1(wsb);
    const bf16_t* XA = WS_XA(wsb); const bf16_t* w = pp->jobs[6].dst; const float* qn = pp->in[19]; const float* kn = pp->in[17];
    const float* ssq = WS_SSQ(wsb);
    PHASE_2D(12, 128, 6, p7_item(XA, ssq, w, qn, kn, L1B, bx, by, smem));
}
__device__ __forceinline__ void ph_moba() {
    char* smem = g_smem;
    const PPtr pp = PP(); char* wsb = (char*)pp->ws;
    const L1Bufs L1B = make_l1(wsb);
    const float* qn = pp->in[19]; const float* kn = pp->in[17]; bf16_t* XB = WS_XB(wsb); int* qctr = WS_QCTR(wsb);
    int* misc = (int*)(smem + ATT_MISC_OFF);
    const int myx = (int)xb_xcc_id() & 7;
    for (int dx = 0; dx < 8; ++dx) {
        const int x = (myx + dx) & 7;
        for (;;) {
            __syncthreads();
            if (threadIdx.x == 0) misc[0] = atomicAdd(&qctr[512 + x * 64], 1);
            __syncthreads();
            const int id = __builtin_amdgcn_readfirstlane(misc[0]);
            if (id >= 256) break;
            moba_attn_item(L1B, qn, kn, XB, x + 8 * (id >> 7), 127 - (id & 127), smem);
        }
    }
    GRID_SYNC();
}

#ifndef PROBE_PHASE
#define PROBE_PHASE -1
#endif
#define PH(id, CALL) do { if (PROBE_PHASE == (id) && blockIdx.x == 0) pt0 = __builtin_amdgcn_s_memrealtime(); CALL; if (PROBE_PHASE == (id) && blockIdx.x == 0) pt1 = __builtin_amdgcn_s_memrealtime(); } while (0)

__global__ void __launch_bounds__(256, 2) mega(Params Pdummy) {
    if (threadIdx.x == 0) *(uint4*)(g_smem + 73728) = make_uint4(0u, 0u, 0u, 0u);
    __syncthreads();
    if (threadIdx.x == 0) (void)xb_add(&((unsigned*)((char*)PP()->ws + (size_t)166 * 1048576))[XB_XCNT(xb_xcc_id())], 1u);
    unsigned long long pt0 = 0ull, pt1 = 0ull;
    PH(0, ph_prologue());
    PH(1, ph_p1());
    PH(2, { ph_p2a(); ph_p2b(); });
    PH(3, ph_nsa());
    PH(4, ph_outproj(0));
    PH(5, ph_route(0));
    PH(6, ph_moe(0));
    PH(7, ph_combine());
    PH(8, ph_ple(0));
    PH(11, ph_p7());
    PH(12, ph_moba());
    PH(13, ph_outproj(1));
    PH(15, ph_route(1));
    PH(16, ph_moe(1));
    PH(17, ph_combine());
    PH(18, ph_ple(1));
    if (PROBE_PHASE >= 0 && blockIdx.x == 0) {
        const unsigned long long span = pt1 - pt0, t2 = __builtin_amdgcn_s_memrealtime();
        while (__builtin_amdgcn_s_memrealtime() - t2 < span) __builtin_amdgcn_s_sleep(16);
    }
}

extern "C" void kernel_launch(void* const* d_in, const int* in_sizes, int n_in, void* d_out, int out_size, void* d_ws, size_t ws_size, hipStream_t stream) {
    static int grid_blocks = 0;
    if (!grid_blocks) {
        int dev = 0, cus = 0, per_cu = 0;
        (void)hipGetDevice(&dev);
        (void)hipDeviceGetAttribute(&cus, hipDeviceAttributeMultiprocessorCount, dev);
        (void)hipOccupancyMaxActiveBlocksPerMultiprocessor(&per_cu, (const void*)mega, 256, 0);
        if (per_cu < 1) per_cu = 1;
        if (per_cu > 2) per_cu = 2;
        grid_blocks = cus * per_cu;
    }
    Params P{};
    for (int i = 0; i < 30; ++i) P.in[i] = (const float*)d_in[i];
    P.out = (float*)d_out;
    P.ws = (float*)d_ws;
    {
        size_t off = (size_t)168 * 1048576;
        char* wbase = (char*)d_ws + off;
        size_t wo = 0;
        auto add = [&](int j, const void* src, int K, int N, int Npad, int batch, const float* gain) {
            WJob& J = P.jobs[j];
            J.src = (const float*)src; J.dst = (bf16_t*)(wbase + wo); J.gain = gain;
            J.sbs = (long long)K * N; J.dbs = (long long)Npad * K; J.K = K; J.N = N; J.Npad = Npad; J.batch = batch; J.perm = 0; J.gbs = 0;
            wo += (size_t)batch * Npad * K * 2;
        };
        add(0, d_in[5], 1024, 2608, 2688, 1, (const float*)d_in[2]);
        add(1, d_in[9], 2048, 256, 256, 1, nullptr);
        add(2, d_in[10], 256, 64, 128, 1, nullptr);
        add(3, d_in[12], 2048, 256, 256, 1, nullptr);
        add(4, d_in[13], 256, 64, 128, 1, nullptr);
        add(5, d_in[14], 1024, 1024, 1024, 1, nullptr);
        add(6, d_in[16], 1024, 512, 512, 1, (const float*)d_in[15]);
        add(7, d_in[18], 1024, 1024, 1024, 1, (const float*)d_in[2] + 1024);
        add(8, d_in[20], 1024, 1024, 1024, 1, nullptr);
        add(9, d_in[29], 1024, 1024, 1024, 2, (const float*)d_in[4]); P.jobs[9].gbs = 1024;
        add(10, d_in[28], 256, 1024, 1024, 2, nullptr);
        for (int layer = 0; layer < 2; ++layer) {
            WJob& G = P.jobs[11 + 3 * layer]; WJob& U = P.jobs[12 + 3 * layer];
            G.src = (const float*)d_in[25] + (size_t)layer * 32 * 1024 * 128; G.dst = (bf16_t*)(wbase + wo); G.gain = (const float*)d_in[3] + layer * 1024;
            G.sbs = 1024 * 128; G.dbs = 256 * 1024; G.K = 1024; G.N = 128; G.Npad = 128; G.batch = 32; G.perm = 1; G.gbs = 0;
            U = G; U.src = (const float*)d_in[26] + (size_t)layer * 32 * 1024 * 128; U.perm = 2;
            wo += (size_t)32 * 256 * 1024 * 2;
            add(13 + 3 * layer, (const float*)d_in[27] + (size_t)layer * 32 * 128 * 1024, 128, 1024, 1024, 32, nullptr);
        }
        P.jobs[17].dst = (bf16_t*)(wbase + wo); wo += (size_t)2 * 128 * 3072 * 2;
        if (off + wo > ws_size) { fprintf(stderr, "workspace too small: need %zu have %zu\n", off + wo, ws_size); return; }
    }
    (void)hipMemsetAsync((char*)d_ws + (size_t)166 * 1048576, 0, XCD_BAR_WORDS * 4, stream);
    void* args[] = {&P};
    hipError_t e = hipLaunchCooperativeKernel((const void*)mega, dim3(grid_blocks), dim3(256), args, 0, stream);
    if (e != hipSuccess) fprintf(stderr, "cooperative launch failed: %s (grid %d)\n", hipGetErrorString(e), grid_blocks);
}
```
